# Optimizing an MI355X kernel written in HIP

```python
import jax, jax.numpy as jnp
from jax import lax
import numpy as np

D_MODEL = 1024
BATCH = 8
SEQ = 4096
DEPTH = 1

GRID_W = 64
N_MEM = 256
EPS = 1e-6
Q_BLOCK = 128

NA_HEADS = 8
NA_HEAD_DIM = 64
NA_WIN_R = 8
NA_WIN_C = 16
MLA_HEADS = 8
MLA_NOPE = 64
MLA_ROPE = 32
MLA_V = 64
MLA_Q_RANK = 384
MLA_KV_RANK = 256
ROPE_BASE = 10000.0
MEM_HEADS = 4
MEM_HEAD_DIM = 128
N_EXPERTS = 16
EC_FACTOR = 2
EXPERT_FF = 1024

NA_W = NA_HEADS * NA_HEAD_DIM
MLA_W = MLA_HEADS * MLA_V
MEM_W = MEM_HEADS * MEM_HEAD_DIM
N_BRANCH = 3
IN_SIZES = [NA_W, NA_W, NA_W, MLA_Q_RANK, MLA_KV_RANK, MLA_ROPE, MEM_W, N_BRANCH * D_MODEL]
IN_COLS = int(sum(IN_SIZES))
IN_SPLITS = [int(v) for v in np.cumsum(IN_SIZES)[:-1]]

kernel_name = 'hybrid_na_mla_mem_ec_block'


def rmsnorm(x, g):
    xf = x.astype(jnp.float32)
    y = xf * lax.rsqrt(jnp.mean(xf * xf, axis=-1, keepdims=True) + EPS)
    return (y * g.astype(jnp.float32)).astype(x.dtype)


def rope_1d(x, pos):
    d = x.shape[-1]
    inv = ROPE_BASE ** (-jnp.arange(0, d, 2, dtype=jnp.float32) / d)
    ang = pos.astype(jnp.float32)[:, None] * inv[None, :]
    cos = jnp.cos(ang)[None, :, None, :]
    sin = jnp.sin(ang)[None, :, None, :]
    xf = x.astype(jnp.float32)
    x1, x2 = xf[..., : d // 2], xf[..., d // 2:]
    return jnp.concatenate([x1 * cos - x2 * sin, x1 * sin + x2 * cos], axis=-1).astype(x.dtype)


def axial_rope(x, row, col):
    half = x.shape[-1] // 2
    return jnp.concatenate([rope_1d(x[..., :half], row), rope_1d(x[..., half:], col)], axis=-1)


def neighbourhood_attention(q, k, v, rpb):
    b, s, h, dh = q.shape
    rows = s // GRID_W
    kr = min(NA_WIN_R, rows)
    kc = NA_WIN_C
    q = q.reshape(b, rows, GRID_W, h, dh)
    k = k.reshape(b, rows, GRID_W, h, dh)
    v = v.reshape(b, rows, GRID_W, h, dh)
    cols = jnp.arange(GRID_W)
    col_start = jnp.clip(cols - kc // 2, 0, GRID_W - kc)
    col_idx = col_start[:, None] + jnp.arange(kc)[None, :]
    bias_c = col_idx - cols[:, None] + (NA_WIN_C - 1)
    rpb = rpb.astype(jnp.float32)
    scale = dh ** -0.5

    def row_block(r):
        rs = jnp.clip(r - kr // 2, 0, rows - kr)
        k_band = lax.dynamic_slice_in_dim(k, rs, kr, axis=1)
        v_band = lax.dynamic_slice_in_dim(v, rs, kr, axis=1)
        k_win = k_band[:, :, col_idx]
        v_win = v_band[:, :, col_idx]
        q_row = lax.dynamic_index_in_dim(q, r, axis=1, keepdims=False)
        logits = jnp.einsum('bqhd,brqkhd->bhqrk', q_row, k_win,
                            preferred_element_type=jnp.float32) * scale
        dr = rs + jnp.arange(kr) - r + (NA_WIN_R - 1)
        bias = rpb[:, dr][:, :, bias_c]
        logits = logits + bias.transpose(0, 2, 1, 3)[None]
        p = jax.nn.softmax(logits.reshape(b, h, GRID_W, kr * kc), axis=-1)
        p = p.reshape(b, h, GRID_W, kr, kc).astype(v.dtype)
        return jnp.einsum('bhqrk,brqkhd->bqhd', p, v_win)

    out = lax.map(row_block, jnp.arange(rows))
    return out.transpose(1, 0, 2, 3, 4).reshape(b, s, h * dh)


def blocked_attention(q, k, v, scale):
    b, s, h, d = q.shape
    dv = v.shape[-1]
    nb = s // Q_BLOCK
    qb = q.reshape(b, nb, Q_BLOCK, h, d).transpose(1, 0, 2, 3, 4)

    def one(qblk):
        logits = jnp.einsum('bqhd,bkhd->bhqk', qblk, k,
                            preferred_element_type=jnp.float32) * scale
        p = jax.nn.softmax(logits, axis=-1).astype(v.dtype)
        return jnp.einsum('bhqk,bkhd->bqhd', p, v)

    out = lax.map(one, qb)
    return out.transpose(1, 0, 2, 3, 4).reshape(b, s, h * dv)


def latent_attention(c_q, c_kv, k_rope, q_norm, kv_norm, w_uq, w_ukv, row, col):
    b, s, _ = c_q.shape
    q = (rmsnorm(c_q, q_norm) @ w_uq).reshape(b, s, MLA_HEADS, MLA_NOPE + MLA_ROPE)
    q_nope, q_pe = q[..., :MLA_NOPE], q[..., MLA_NOPE:]
    q = jnp.concatenate([q_nope, axial_rope(q_pe, row, col)], axis=-1)
    kv = (rmsnorm(c_kv, kv_norm) @ w_ukv).reshape(b, s, MLA_HEADS, MLA_NOPE + MLA_V)
    k_nope, v = kv[..., :MLA_NOPE], kv[..., MLA_NOPE:]
    k_pe = axial_rope(k_rope[:, :, None, :], row, col)
    k = jnp.concatenate([k_nope, jnp.broadcast_to(k_pe, (b, s, MLA_HEADS, MLA_ROPE))], axis=-1)
    return blocked_attention(q, k, v, (MLA_NOPE + MLA_ROPE) ** -0.5)


def memory_attention(q, mem, g_mem, w_mem_kv):
    b, s, _ = q.shape
    m = mem.shape[1]
    kv = rmsnorm(mem, g_mem) @ w_mem_kv
    k = kv[..., :MEM_W].reshape(b, m, MEM_HEADS, MEM_HEAD_DIM)
    v = kv[..., MEM_W:].reshape(b, m, MEM_HEADS, MEM_HEAD_DIM)
    q = q.reshape(b, s, MEM_HEADS, MEM_HEAD_DIM)
    logits = jnp.einsum('bshd,bmhd->bhsm', q, k,
                        preferred_element_type=jnp.float32) * (MEM_HEAD_DIM ** -0.5)
    p = jax.nn.softmax(logits, axis=-1).astype(v.dtype)
    return jnp.einsum('bhsm,bmhd->bshd', p, v).reshape(b, s, MEM_W)


def expert_choice_ffn(x, w_router, b_router, w_gate, w_up, w_down):
    b, s, d = x.shape
    cap = EC_FACTOR * s // N_EXPERTS
    logits = jnp.einsum('bsd,de->bse', x, w_router,
                        preferred_element_type=jnp.float32) + b_router.astype(jnp.float32)
    aff = jax.nn.softmax(logits, axis=-1)
    g, idx = lax.top_k(aff.transpose(0, 2, 1), cap)
    xs = jax.vmap(lambda xb, ib: xb[ib])(x, idx)
    hg = jnp.einsum('becd,edf->becf', xs, w_gate)
    hu = jnp.einsum('becd,edf->becf', xs, w_up)
    y = jnp.einsum('becf,efd->becd', jax.nn.silu(hg) * hu, w_down)
    y = y * g[..., None].astype(y.dtype)
    return jax.vmap(lambda yb, ib: jnp.zeros((s, d), yb.dtype).at[ib.reshape(-1)].add(yb.reshape(-1, d)))(y, idx)


def setup_inputs(seed: int = 0) -> dict:
    key = jax.random.key(seed)
    ks = jax.random.split(key, 24)
    L = DEPTH
    nrm = lambda k, shape: jax.random.normal(k, shape, jnp.float32)
    w = lambda k, shape, fan_in: nrm(k, shape) * (fan_in ** -0.5)
    gain = lambda k, shape: 1.0 + 0.05 * nrm(k, shape)
    return {
        'x': nrm(ks[0], (BATCH, SEQ, D_MODEL)),
        'mem': nrm(ks[1], (BATCH, N_MEM, D_MODEL)),
        'g_mix': gain(ks[2], (L, D_MODEL)),
        'w_in': w(ks[3], (L, D_MODEL, IN_COLS), D_MODEL),
        'na_rpb': 0.1 * nrm(ks[4], (L, NA_HEADS, 2 * NA_WIN_R - 1, 2 * NA_WIN_C - 1)),
        'mla_q_norm': gain(ks[5], (L, MLA_Q_RANK)),
        'w_mla_uq': w(ks[6], (L, MLA_Q_RANK, MLA_HEADS * (MLA_NOPE + MLA_ROPE)), MLA_Q_RANK),
        'mla_kv_norm': gain(ks[7], (L, MLA_KV_RANK)),
        'w_mla_ukv': w(ks[8], (L, MLA_KV_RANK, MLA_HEADS * (MLA_NOPE + MLA_V)), MLA_KV_RANK),
        'g_mem': gain(ks[9], (L, D_MODEL)),
        'w_mem_kv': w(ks[10], (L, D_MODEL, 2 * MEM_W), D_MODEL),
        'w_o_na': w(ks[11], (L, NA_W, D_MODEL), NA_W),
        'w_o_mla': w(ks[12], (L, MLA_W, D_MODEL), MLA_W),
        'w_o_mem': w(ks[13], (L, MEM_W, D_MODEL), MEM_W),
        'w_out': w(ks[14], (L, D_MODEL, D_MODEL), D_MODEL),
        'g_ffn': gain(ks[15], (L, D_MODEL)),
        'w_router': w(ks[16], (L, D_MODEL, N_EXPERTS), D_MODEL),
        'b_router': 0.01 * nrm(ks[17], (L, N_EXPERTS)),
        'w_gate': w(ks[18], (L, N_EXPERTS, D_MODEL, EXPERT_FF), D_MODEL),
        'w_up': w(ks[19], (L, N_EXPERTS, D_MODEL, EXPERT_FF), D_MODEL),
        'w_down': w(ks[20], (L, N_EXPERTS, EXPERT_FF, D_MODEL), EXPERT_FF),
        'g_final': gain(ks[21], (D_MODEL,)),
    }


def reference(x, mem, g_mix, w_in, na_rpb, mla_q_norm, w_mla_uq, mla_kv_norm, w_mla_ukv,
              g_mem, w_mem_kv, w_o_na, w_o_mla, w_o_mem, w_out, g_ffn, w_router, b_router,
              w_gate, w_up, w_down, g_final):
    b, s, d = x.shape
    t = jnp.arange(s)
    row, col = t // GRID_W, t % GRID_W
    h = x
    for l in range(DEPTH):
        n = rmsnorm(h, g_mix[l])
        z = n @ w_in[l]
        q_na, k_na, v_na, c_q, c_kv, k_rope, q_mem, gate_logits = jnp.split(z, IN_SPLITS, axis=-1)
        shp = (b, s, NA_HEADS, NA_HEAD_DIM)
        y_na = neighbourhood_attention(q_na.reshape(shp), k_na.reshape(shp), v_na.reshape(shp), na_rpb[l])
        y_mla = latent_attention(c_q, c_kv, k_rope, mla_q_norm[l], mla_kv_norm[l],
                                 w_mla_uq[l], w_mla_ukv[l], row, col)
        y_mem = memory_attention(q_mem, mem, g_mem[l], w_mem_kv[l])
        gates = jax.nn.sigmoid(gate_logits.reshape(b, s, N_BRANCH, d))
        merged = (gates[:, :, 0] * (y_na @ w_o_na[l])
                  + gates[:, :, 1] * (y_mla @ w_o_mla[l])
                  + gates[:, :, 2] * (y_mem @ w_o_mem[l]))
        h = h + merged @ w_out[l]
        h = h + expert_choice_ffn(rmsnorm(h, g_ffn[l]), w_router[l], b_router[l],
                                  w_gate[l], w_up[l], w_down[l])
    return rmsnorm(h, g_final)
```

```cpp
#include <hip/hip_runtime.h>
#include <hip/hip_cooperative_groups.h>
#include <cstdio>
#include <cstdint>
namespace cg = cooperative_groups;

#define LAS __attribute__((address_space(3)))
typedef unsigned short bf16_t;
typedef short bf16x8 __attribute__((ext_vector_type(8)));
typedef short s16x4 __attribute__((ext_vector_type(4)));
typedef float f32x2 __attribute__((ext_vector_type(2)));
typedef float f32x4 __attribute__((ext_vector_type(4)));
typedef float f32x16 __attribute__((ext_vector_type(16)));
typedef unsigned u32x2 __attribute__((ext_vector_type(2)));
typedef unsigned u32x4 __attribute__((ext_vector_type(4)));

constexpr int T_ = 32768, S_ = 4096, D_ = 1024, NB_ = 8, INC_ = 5792, NZ_ = 5888;
constexpr float EPS_ = 1e-6f;
constexpr float LOG2E = 1.4426950408889634f;
constexpr float C_NA = 0.125f * LOG2E, C_MLA = 0.10206207261596577f * LOG2E, C_MEM = 0.08838834764831845f * LOG2E;

constexpr size_t MiB = (size_t)1 << 20;
constexpr size_t WS_WIN = 0;
constexpr size_t WS_WUQ = 12 * MiB;
constexpr size_t WS_WUKV = 13 * MiB;
constexpr size_t WS_WMK = 14 * MiB;
constexpr size_t WS_WO = 16 * MiB;
constexpr size_t WS_WOUT = 19 * MiB;
constexpr size_t WS_WGU = 21 * MiB;
constexpr size_t WS_WD = 85 * MiB;
constexpr size_t WS_RSTDX = 117 * MiB;
constexpr size_t WS_RSTDM = WS_RSTDX + 128 * 1024;
constexpr size_t WS_RSTDH = WS_RSTDM + 128 * 1024;
constexpr size_t WS_ROPE = WS_RSTDH + 128 * 1024;
constexpr size_t WS_RSTDXS = WS_ROPE + 128 * 1024;
constexpr size_t WS_GSEL = WS_RSTDXS + 256 * 1024;
constexpr size_t WS_IDX = WS_GSEL + 256 * 1024;
constexpr size_t WS_SSQQ = 119 * MiB;
constexpr size_t WS_SSQKV = 121 * MiB;
constexpr size_t WS_AFF = 122 * MiB;
constexpr size_t WS_SEL = 124 * MiB;
constexpr size_t WS_MEMB = 126 * MiB;
constexpr size_t WS_KVMEM = 130 * MiB;
constexpr size_t WS_ZG = 134 * MiB;
constexpr size_t WS_H = 134 * MiB;
constexpr size_t WS_HB = 262 * MiB;
constexpr size_t WS_NA = 326 * MiB;
constexpr size_t WS_XS = 326 * MiB;
constexpr size_t WS_ZC = 422 * MiB;
constexpr size_t WS_ZQM = 470 * MiB;
constexpr size_t WS_CTL = 502 * MiB;
constexpr size_t CTL_BYTES = 16384;
constexpr size_t WS_END = 503 * MiB;
constexpr size_t DO_XB = 0, DO_QMLA = 0, DO_KVBUF = 48 * MiB, DO_KPE = 112 * MiB, DO_MERGED = 0, DO_ACT = 0;

constexpr int LDS_BYTES = 147456;
constexpr int NTHREADS = 512;

__device__ __forceinline__ unsigned cvt_pk_bf16(float lo, float hi) { unsigned r; asm volatile("v_cvt_pk_bf16_f32 %0, %1, %2" : "=v"(r) : "v"(lo), "v"(hi)); return r; }
__device__ __forceinline__ float bf2f(unsigned short b) { return __uint_as_float(((unsigned)b) << 16); }
__device__ __forceinline__ float bflo(unsigned w) { return __uint_as_float(w << 16); }
__device__ __forceinline__ float bfhi(unsigned w) { return __uint_as_float(w & 0xffff0000u); }
__device__ __forceinline__ float wave_sum(float v) {
#pragma unroll
    for (int o = 1; o < 64; o <<= 1) v += __shfl_xor(v, o);
    return v;
}
__device__ __forceinline__ float fast_exp2(float x) { return __builtin_amdgcn_exp2f(x); }
__device__ __forceinline__ float fast_rcp(float x) { return __builtin_amdgcn_rcpf(x); }
__device__ __forceinline__ int crow(int r, int hi) { return (r & 3) + 8 * (r >> 2) + 4 * hi; }


#define XB_TMO      128
#define XB_XCNT(j)  (256  + 64 * (j))
#define XB_XSUB(j)  (1280 + 64 * (j))
#define XB_XGEN(j)  (2304 + 64 * (j))
#define XB_TOP      3328
#define XB_TOPGEN   3392
#define XCD_BAR_WORDS 3456
#define XB_SPIN_CAP (1u << 18)
__device__ __forceinline__ unsigned xb_ld(unsigned* p)              { return __hip_atomic_load(p, __ATOMIC_RELAXED, __HIP_MEMORY_SCOPE_AGENT); }
__device__ __forceinline__ unsigned xb_add(unsigned* p, unsigned v) { return __hip_atomic_fetch_add(p, v, __ATOMIC_RELAXED, __HIP_MEMORY_SCOPE_AGENT); }
__device__ __forceinline__ unsigned xb_xcc_id() { return (unsigned)__builtin_amdgcn_s_getreg((3 << 11) | 20) & 0xFu; }
#define XB_SPIN(cond, bar) do { unsigned _sp = 0; while (cond) { __builtin_amdgcn_s_sleep(1); \
    if ((++_sp & 255u) == 0u) { if (xb_ld(&(bar)[XB_TMO])) break; if (_sp > XB_SPIN_CAP) { atomicAdd(&(bar)[XB_TMO], 1u); break; } } } } while (0)
struct XcdBarrier { unsigned* bar; unsigned x; volatile LAS unsigned* st; };
__device__ __forceinline__ XcdBarrier xcd_barrier_post(unsigned* bar, volatile LAS unsigned* st) {
    XcdBarrier b; b.bar = bar; b.x = xb_xcc_id(); b.st = st;
    if (threadIdx.x == 0) (void)xb_add(&bar[XB_XCNT(b.x)], 1u);
    return b;
}
__device__ __forceinline__ void xcd_barrier_complete(unsigned* bar, unsigned x, unsigned& nloc, unsigned& nx) {
    const unsigned G = gridDim.x * gridDim.y * gridDim.z;
    unsigned sum, cnt, mine, sp = 0u;
    for (;;) {
        sum = 0u; cnt = 0u; mine = 0u;
#pragma unroll
        for (unsigned j = 0; j < 16; ++j) { const unsigned c = xb_ld(&bar[XB_XCNT(j)]); sum += c; cnt += (c > 0u) ? 1u : 0u; mine = (j == x) ? c : mine; }
        if (sum == G) break;
        __builtin_amdgcn_s_sleep(1);
        if ((++sp & 255u) == 0u) { if (xb_ld(&bar[XB_TMO])) break; if (sp > XB_SPIN_CAP) { atomicAdd(&bar[XB_TMO], 1u); break; } }
    }
    nloc = mine > 0u ? mine : 1u; nx = cnt > 0u ? cnt : 1u;
}
__device__ __forceinline__ void xcd_barrier(const XcdBarrier& b) {
    asm volatile("s_waitcnt vmcnt(0)" ::: "memory");
    __syncthreads();
    if (threadIdx.x == 0) {
        unsigned* bar = b.bar;
        __builtin_amdgcn_s_waitcnt(0);
        unsigned nloc = b.st[0], nx = b.st[1];
        if (nloc == 0u) { xcd_barrier_complete(bar, b.x, nloc, nx); b.st[0] = nloc; b.st[1] = nx; }
        const unsigned old = xb_add(&bar[XB_XSUB(b.x)], 1u);
        const unsigned gen = old / nloc;
        if (old + 1u == (gen + 1u) * nloc) {
            __builtin_amdgcn_fence(__ATOMIC_RELEASE, "agent");
            asm volatile("s_waitcnt vmcnt(0)" ::: "memory");
            const unsigned og = xb_add(&bar[XB_TOP], 1u);
            const unsigned tg = og / nx;
            if (og + 1u == (tg + 1u) * nx) xb_add(&bar[XB_TOPGEN], 1u);
            else XB_SPIN(xb_ld(&bar[XB_TOPGEN]) == tg, bar);
            __builtin_amdgcn_fence(__ATOMIC_ACQUIRE, "agent");
            xb_add(&bar[XB_XGEN(b.x)], 1u);
            asm volatile("s_waitcnt vmcnt(0)" ::: "memory");
        } else {
            XB_SPIN(xb_ld(&bar[XB_XGEN(b.x)]) == gen, bar);
            __builtin_amdgcn_fence(__ATOMIC_ACQUIRE, "agent");
            asm volatile("s_waitcnt vmcnt(0)" ::: "memory");
        }
    }
    __syncthreads();
}

struct Args { const float* in[22]; float* out; unsigned char* ws; int ph_lo, ph_hi, coop, pad; };

namespace pg8 {
constexpr int BM = 256, BK = 64, HALF = 128, HTB = HALF * BK * 2, STAGE_BYTES = 8 * HTB, NXCD = 8, WGM = 8;
__device__ __forceinline__ int lds_byte(int r, int c) { const int st = (r >> 4) * 2 + (c >> 5), rr = r & 15, cc = c & 31, ob = rr * 64 + cc * 2; return st * 1024 + (ob ^ (((ob >> 9) & 1) << 5)); }
__device__ __forceinline__ void stage_rc(int b, int& R, int& C) { const int st = b / 1024, sb = b % 1024, swz = sb ^ (((sb >> 9) & 1) << 5); R = (st >> 1) * 16 + swz / 64; C = (st & 1) * 32 + (swz % 64) / 2; }
__device__ __forceinline__ int perm32(int rho) { const int n = rho >> 4, i = rho & 15; return 8 * (i >> 2) + 4 * n + (i & 3); }

struct Unit { int pm, pn, kind, nt, aux; const char* A; const char* A1; const char* A2; const char* B; };

__device__ __forceinline__ void tile_order(int L, int nM, int nN, int& pm, int& pn) {
    const int nwg = nM * nN; int wgid = L;
    { const int q = nwg / NXCD, r = nwg % NXCD, xcd = wgid % NXCD, off = wgid / NXCD; wgid = (xcd < r ? xcd * (q + 1) : r * (q + 1) + (xcd - r) * q) + off; }
    const int nig = WGM * nN, gid = wgid / nig, fm = gid * WGM, gsz = (nM - fm) < WGM ? (nM - fm) : WGM;
    pm = fm + ((wgid % nig) % gsz); pn = (wgid % nig) / gsz;
}

template <class Epi, class Sched, bool SEG3, bool GATHER = false>
__device__ __forceinline__ void gemm_phase(LAS unsigned char* lds, const int lda, const int ldb, const Sched& S, const Epi& E, const LAS int* gtab = nullptr) {
    int tid_ = threadIdx.x; asm volatile("" : "+v"(tid_));
    const int tid = tid_, wid = __builtin_amdgcn_readfirstlane(tid >> 6), lane = tid & 63, wr = wid >> 2, wc = wid & 3, fr = lane & 15, fq = lane >> 4;
    unsigned voffA[2], voffB[2]; int gR[2]; unsigned gC[2];
#pragma unroll
    for (int i = 0; i < 2; ++i) { int R, C; stage_rc(tid * 16 + i * 8192, R, C); gR[i] = R; gC[i] = (unsigned)C * 2u; const int Rb = Epi::PERM ? ((R & ~31) + perm32(R & 31)) : R;
        voffA[i] = (unsigned)(R * lda + C) * 2u; voffB[i] = (unsigned)(Rb * ldb + C) * 2u; }
    const size_t kstep = (size_t)(BK * 2);
    const size_t hstepA = (size_t)HALF * lda * 2, hstepB = (size_t)HALF * ldb * 2;
    const unsigned ldsw = (unsigned)wid * 1024u;
    const int aoff = lds_byte(wr * 64 + fr, fq * 8), boff = lds_byte(wc * 32 + fr, fq * 8);
#define PG8_SA(b, h) (((b) * 2 + (h)) * HTB)
#define PG8_SB(b, h) ((4 + (b) * 2 + (h)) * HTB)
#define PG8_STAGE(bufoff, gbase, voff) do { _Pragma("unroll") for (int _i = 0; _i < 2; ++_i) \
        __builtin_amdgcn_global_load_lds((const unsigned*)((const char*)(gbase) + (voff)[_i]), (LAS unsigned*)(lds + (bufoff) + ldsw + _i * 8192), 16, 0, 0); } while (0)
#define PG8_GLOAD(dst, ord) do { _Pragma("unroll") for (int _h = 0; _h < 2; ++_h) _Pragma("unroll") for (int _i = 0; _i < 2; ++_i) dst[_h][_i] = (unsigned)gtab[(ord) * 256 + _h * 128 + gR[_i]] * (unsigned)(lda * 2) + gC[_i]; } while (0)
#define PG8_STAGE_A(bufoff, kptr, h, VS) do { if constexpr (GATHER) { PG8_STAGE(bufoff, kptr, VS[h]); } else { PG8_STAGE(bufoff, (kptr) + (h) * hstepA, voffA); } } while (0)
#define PG8_LDA(dst, b, h) do { _Pragma("unroll") for (int m = 0; m < 4; ++m) _Pragma("unroll") for (int k = 0; k < 2; ++k) dst[m][k] = *(const LAS bf16x8*)(lds + PG8_SA(b, h) + aoff + m * 2048 + k * 1024); } while (0)
#define PG8_LDB(dst, b, h) do { _Pragma("unroll") for (int n = 0; n < 2; ++n) _Pragma("unroll") for (int k = 0; k < 2; ++k) dst[n][k] = *(const LAS bf16x8*)(lds + PG8_SB(b, h) + boff + n * 2048 + k * 1024); } while (0)
#define PG8_MMA(ai, bj, At, Bt) do { __builtin_amdgcn_s_setprio(1); _Pragma("unroll") for (int m = 0; m < 4; ++m) _Pragma("unroll") for (int n = 0; n < 2; ++n) _Pragma("unroll") for (int k = 0; k < 2; ++k) \
        acc[ai][bj][m][n] = __builtin_amdgcn_mfma_f32_16x16x32_bf16(Bt[n][k], At[m][k], acc[ai][bj][m][n], 0, 0, 0); __builtin_amdgcn_s_setprio(0); } while (0)
#define PG8_WAIT_V(n) asm volatile("s_waitcnt vmcnt(" #n ")" ::: "memory")
#define PG8_WAIT_L(n) asm volatile("s_waitcnt lgkmcnt(" #n ")" ::: "memory")
#define PG8_BAR __builtin_amdgcn_s_barrier()
#define PG8_SCHED __builtin_amdgcn_sched_barrier(0)
#define PG8_TA(u, kt) (SEG3 ? (((kt) < 8 ? (u).A : ((kt) < 16 ? (u).A1 : (u).A2)) + (size_t)((kt) & 7) * kstep) : ((u).A + (size_t)(kt) * kstep))
#define PG8_TB(u, kt) ((u).B + (size_t)(kt) * kstep)
    Unit cur, nxt; int ui = 0;
    if (!S.next(0, cur)) return;
    f32x4 acc[2][2][4][2];
#pragma unroll
    for (int a = 0; a < 2; ++a)
#pragma unroll
        for (int b = 0; b < 2; ++b)
#pragma unroll
            for (int m = 0; m < 4; ++m)
#pragma unroll
                for (int n = 0; n < 2; ++n) acc[a][b][m][n] = (f32x4){0.f, 0.f, 0.f, 0.f};
    bf16x8 At[4][2], B0[2][2], B1[2][2];
    unsigned vC[2][2], vN[2][2];
#pragma unroll
    for (int _h = 0; _h < 2; ++_h)
#pragma unroll
        for (int _i = 0; _i < 2; ++_i) { vC[_h][_i] = 0u; vN[_h][_i] = 0u; }
    if constexpr (GATHER) { PG8_GLOAD(vC, 0); }
    {
        const char* cA = PG8_TA(cur, 0); const char* cB = PG8_TB(cur, 0);
        PG8_STAGE(PG8_SB(0, 0), cB, voffB); PG8_STAGE(PG8_SB(0, 1), cB + hstepB, voffB); PG8_STAGE_A(PG8_SA(0, 0), cA, 0, vC); PG8_STAGE_A(PG8_SA(0, 1), cA, 1, vC);
        if (wr == 1) PG8_BAR;
        PG8_WAIT_V(2); PG8_BAR;
        const char* cA1 = PG8_TA(cur, 1); const char* cB1 = PG8_TB(cur, 1);
        PG8_STAGE(PG8_SB(1, 0), cB1, voffB); PG8_STAGE_A(PG8_SA(1, 0), cA1, 0, vC); PG8_STAGE(PG8_SB(1, 1), cB1 + hstepB, voffB);
        PG8_WAIT_V(6); PG8_BAR;
    }
    for (;;) {
        const bool has_next = S.next(ui + 1, nxt);
        if constexpr (GATHER) { if (has_next) PG8_GLOAD(vN, ui + 1); }
        const int nt = cur.nt;
        for (int t = 0; t < nt; t += 2) {
            const bool last = (t == nt - 2);
            const char* a1 = PG8_TA(cur, t + 1);
            const char* a2; const char* b2;
            if (last) { if (has_next) { a2 = PG8_TA(nxt, 0); b2 = PG8_TB(nxt, 0); } else { a2 = PG8_TA(cur, 0); b2 = PG8_TB(cur, 0); } }
            else { a2 = PG8_TA(cur, t + 2); b2 = PG8_TB(cur, t + 2); }
            const char* a3 = a2 + kstep; const char* b3 = b2 + kstep;
            unsigned vS[2][2];
#pragma unroll
            for (int _h = 0; _h < 2; ++_h)
#pragma unroll
                for (int _i = 0; _i < 2; ++_i) vS[_h][_i] = (last && has_next) ? vN[_h][_i] : vC[_h][_i];
            if constexpr (Epi::HAS_MID) { if (t > 0 && (t & 7) == 0) { if (wr == 0) PG8_BAR; E.mid(acc, cur, t >> 3, wr, wc, fr, fq); if (wr == 1) PG8_BAR; } }
            PG8_LDB(B0, 0, 0); PG8_LDB(B1, 0, 1); PG8_SCHED; PG8_LDA(At, 0, 0); PG8_STAGE_A(PG8_SA(1, 1), a1, 1, vC);
            PG8_WAIT_V(8); PG8_WAIT_L(0); PG8_BAR; PG8_MMA(0, 0, At, B0); PG8_MMA(0, 1, At, B1); PG8_BAR; PG8_SCHED;
            PG8_LDA(At, 0, 1); PG8_STAGE(PG8_SB(0, 0), b2, voffB); PG8_STAGE(PG8_SB(0, 1), b2 + hstepB, voffB); PG8_STAGE_A(PG8_SA(0, 0), a2, 0, vS);
            PG8_WAIT_V(8); PG8_WAIT_L(0); PG8_BAR; PG8_MMA(1, 0, At, B0); PG8_MMA(1, 1, At, B1); PG8_BAR; PG8_SCHED;
            PG8_LDB(B0, 1, 0); PG8_LDB(B1, 1, 1); PG8_SCHED; PG8_LDA(At, 1, 0); PG8_STAGE_A(PG8_SA(0, 1), a2, 1, vS);
            PG8_WAIT_V(8); PG8_WAIT_L(0); PG8_BAR; PG8_MMA(0, 0, At, B0); PG8_MMA(0, 1, At, B1); PG8_BAR; PG8_SCHED;
            PG8_LDA(At, 1, 1); PG8_STAGE(PG8_SB(1, 0), b3, voffB); PG8_STAGE(PG8_SB(1, 1), b3 + hstepB, voffB); PG8_STAGE_A(PG8_SA(1, 0), a3, 0, vS);
            PG8_WAIT_V(8); PG8_WAIT_L(0); PG8_BAR; PG8_MMA(1, 0, At, B0); PG8_MMA(1, 1, At, B1); PG8_BAR; PG8_SCHED;
        }
        if (wr == 0) PG8_BAR;
        E(acc, cur, wr, wc, fr, fq);
        if (!has_next) break;
#pragma unroll
        for (int a = 0; a < 2; ++a)
#pragma unroll
            for (int b = 0; b < 2; ++b)
#pragma unroll
                for (int m = 0; m < 4; ++m)
#pragma unroll
                    for (int n = 0; n < 2; ++n) acc[a][b][m][n] = (f32x4){0.f, 0.f, 0.f, 0.f};
        cur = nxt; ++ui;
#pragma unroll
        for (int _h = 0; _h < 2; ++_h)
#pragma unroll
            for (int _i = 0; _i < 2; ++_i) vC[_h][_i] = vN[_h][_i];
        if (wr == 1) PG8_BAR;
    }
    PG8_WAIT_V(0);
    PG8_BAR;
#undef PG8_SA
#undef PG8_SB
#undef PG8_STAGE
#undef PG8_STAGE_A
#undef PG8_GLOAD
#undef PG8_LDA
#undef PG8_LDB
#undef PG8_MMA
#undef PG8_WAIT_V
#undef PG8_WAIT_L
#undef PG8_BAR
#undef PG8_SCHED
#undef PG8_TA
#undef PG8_TB
}
}

__device__ __forceinline__ u32x4 pack8(const f32x4 v0, const f32x4 v1) { u32x4 w; w.x = cvt_pk_bf16(v0[0], v0[1]); w.y = cvt_pk_bf16(v0[2], v0[3]); w.z = cvt_pk_bf16(v1[0], v1[1]); w.w = cvt_pk_bf16(v1[2], v1[3]); return w; }
__device__ __forceinline__ void rope8(f32x4& v0, f32x4& v1, int row, int fq, const float* rope) {
    const int t = row & (S_ - 1); const int pos = (fq >> 1) ? (t & 63) : (t >> 6);
    const f32x4* cs = (const f32x4*)(rope + (pos * 8 + 4 * (fq & 1)) * 2);
    const f32x4 c01 = cs[0], c23 = cs[1];
    float a, b;
    a = v0[0]; b = v0[1]; v0[0] = a * c01[0] - b * c01[1]; v0[1] = a * c01[1] + b * c01[0];
    a = v0[2]; b = v0[3]; v0[2] = a * c01[2] - b * c01[3]; v0[3] = a * c01[3] + b * c01[2];
    a = v1[0]; b = v1[1]; v1[0] = a * c23[0] - b * c23[1]; v1[1] = a * c23[1] + b * c23[0];
    a = v1[2]; b = v1[3]; v1[2] = a * c23[2] - b * c23[3]; v1[3] = a * c23[3] + b * c23[2];
}

__device__ __forceinline__ float sig_den(float x) { x = fminf(fmaxf(x, -30.f), 30.f); return 1.0f + fast_exp2(-LOG2E * x); }
struct EpiP1 {
    static constexpr bool PERM = true, HAS_MID = false;
    const float* rstd_x; const float* rstd_m; bf16_t* na; bf16_t* zc; bf16_t* zqm; bf16_t* zg; bf16_t* kvmem; bf16_t* kpe; float* ssq_q; float* ssq_kv; const float* rope;
    __device__ __forceinline__ void operator()(const f32x4 (&acc)[2][2][4][2], const pg8::Unit& u, int wr, int wc, int fr, int fq) const {
        const int row0 = u.pm * 256 + wr * 64 + fr; const int pn = u.pn;
        bf16_t* base; int ld, colt; const float* rsp;
        if (u.kind == 0) { rsp = rstd_x;
            if (pn < 6) { base = na + (size_t)(pn >> 1) * T_ * 512; ld = 512; colt = (pn & 1) * 256; }
            else if (pn < 9) { base = zc; ld = 768; colt = (pn - 6) * 256; }
            else if (pn < 11) { base = zqm; ld = 512; colt = (pn - 9) * 256; }
            else { base = zg; ld = 3072; colt = (pn - 11) * 256; } }
        else { rsp = rstd_m; base = kvmem; ld = 1024; colt = pn * 256; }
        const int col0 = colt + wc * 32 + 8 * fq;
        const bool stats = (u.kind == 0) && (pn >= 6) && (pn < 9); const bool isgate = (u.kind == 0) && (pn >= 11);
#pragma unroll
        for (int ai = 0; ai < 2; ++ai)
#pragma unroll
            for (int m = 0; m < 4; ++m) { const int row = row0 + ai * 128 + m * 16; const float rs = rsp[row]; bf16_t* rowp = base + (size_t)row * ld + col0;
#pragma unroll
                for (int bj = 0; bj < 2; ++bj) { f32x4 v0 = acc[ai][bj][m][0] * rs, v1 = acc[ai][bj][m][1] * rs;
                    if (isgate) {
#pragma unroll
                        for (int e = 0; e < 4; ++e) { v0[e] = sig_den(v0[e]); v1[e] = sig_den(v1[e]); } }
                    *(u32x4*)(rowp + bj * 128) = pack8(v0, v1);
                    if (stats) { const int idx = (pn - 6) * 2 + bj;
                        if (idx < 5) { float s = (v0[0] * v0[0] + v0[1] * v0[1]) + (v0[2] * v0[2] + v0[3] * v0[3]) + (v1[0] * v1[0] + v1[1] * v1[1]) + (v1[2] * v1[2] + v1[3] * v1[3]);
                            s += __shfl_xor(s, 16); s += __shfl_xor(s, 32);
                            if (fq == 0) { if (idx < 3) ssq_q[(size_t)row * 12 + idx * 4 + wc] = s; else ssq_kv[(size_t)row * 8 + (idx - 3) * 4 + wc] = s; } }
                        else if (wc == 0) { rope8(v0, v1, row, fq, rope); *(u32x4*)(kpe + (size_t)row * 32 + 8 * fq) = pack8(v0, v1); } } } }
    }
};
struct SchedP1 {
    int c, G; const char* xb; const char* win; const char* memb; const char* wmk;
    __device__ __forceinline__ bool next(int i, pg8::Unit& u) const {
        const int L = i * G + c; int pm, pn;
        if (L < 2944) { pg8::tile_order(L, 128, 23, pm, pn); u.pm = pm; u.pn = pn; u.kind = 0; u.nt = 16; u.aux = 0; u.A = xb + (size_t)pm * 256 * 2048; u.B = win + (size_t)pn * 256 * 2048; u.A1 = u.A; u.A2 = u.A; return true; }
        if (L < 2976) { pg8::tile_order(L - 2944, 8, 4, pm, pn); u.pm = pm; u.pn = pn; u.kind = 1; u.nt = 16; u.aux = 0; u.A = memb + (size_t)pm * 256 * 2048; u.B = wmk + (size_t)pn * 256 * 2048; u.A1 = u.A; u.A2 = u.A; return true; }
        return false;
    }
};

struct EpiP2 {
    static constexpr bool PERM = true, HAS_MID = false;
    const float* ssq_q; const float* ssq_kv; bf16_t* qmla; bf16_t* kvbuf; const float* rope;
    __device__ __forceinline__ void operator()(const f32x4 (&acc)[2][2][4][2], const pg8::Unit& u, int wr, int wc, int fr, int fq) const {
        const int row0 = u.pm * 256 + wr * 64 + fr; const int pn = u.pn;
        float rs[2][4];
        if (u.kind == 0) {
#pragma unroll
            for (int ai = 0; ai < 2; ++ai)
#pragma unroll
                for (int m = 0; m < 4; ++m) { const f32x4* p = (const f32x4*)(ssq_q + (size_t)(row0 + ai * 128 + m * 16) * 12); const f32x4 a = p[0], b = p[1], c = p[2];
                    const float s = ((a[0] + a[1]) + (a[2] + a[3])) + ((b[0] + b[1]) + (b[2] + b[3])) + ((c[0] + c[1]) + (c[2] + c[3])); rs[ai][m] = rsqrtf(s * (1.0f / 384.0f) + EPS_); }
        } else {
#pragma unroll
            for (int ai = 0; ai < 2; ++ai)
#pragma unroll
                for (int m = 0; m < 4; ++m) { const f32x4* p = (const f32x4*)(ssq_kv + (size_t)(row0 + ai * 128 + m * 16) * 8); const f32x4 a = p[0], b = p[1];
                    const float s = ((a[0] + a[1]) + (a[2] + a[3])) + ((b[0] + b[1]) + (b[2] + b[3])); rs[ai][m] = rsqrtf(s * (1.0f / 256.0f) + EPS_); }
        }
        bf16_t* base = u.kind == 0 ? qmla : kvbuf; const int ld = u.kind == 0 ? 768 : 1024;
        const int col0 = pn * 256 + wc * 32 + 8 * fq;
#pragma unroll
        for (int bj = 0; bj < 2; ++bj) { const bool isrope = (u.kind == 0) && (((8 * pn + 4 * bj + wc) % 3) == 2);
#pragma unroll
            for (int ai = 0; ai < 2; ++ai)
#pragma unroll
                for (int m = 0; m < 4; ++m) { const int row = row0 + ai * 128 + m * 16; f32x4 v0 = acc[ai][bj][m][0] * rs[ai][m], v1 = acc[ai][bj][m][1] * rs[ai][m];
                    if (isrope) rope8(v0, v1, row, fq, rope);
                    *(u32x4*)(base + (size_t)row * ld + col0 + bj * 128) = pack8(v0, v1); } }
    }
};
struct SchedP2 {
    int c, G; const char* zc; const char* wuq; const char* wukv;
    __device__ __forceinline__ bool next(int i, pg8::Unit& u) const {
        const int L = i * G + c; int pm, pn;
        if (L < 384) { pg8::tile_order(L, 128, 3, pm, pn); u.pm = pm; u.pn = pn; u.kind = 0; u.nt = 6; u.aux = 0; u.A = zc + (size_t)pm * 256 * 1536; u.B = wuq + (size_t)pn * 256 * 768; u.A1 = u.A; u.A2 = u.A; return true; }
        if (L < 896) { pg8::tile_order(L - 384, 128, 4, pm, pn); u.pm = pm; u.pn = pn; u.kind = 1; u.nt = 4; u.aux = 0; u.A = zc + (size_t)pm * 256 * 1536 + 768; u.B = wukv + (size_t)pn * 256 * 768; u.A1 = u.A; u.A2 = u.A; return true; }
        return false;
    }
};

struct EpiP4 {
    static constexpr bool PERM = true, HAS_MID = true;
    const bf16_t* zg; bf16_t* merged;
    __device__ __forceinline__ void mid(f32x4 (&acc)[2][2][4][2], const pg8::Unit& u, int seg, int wr, int wc, int fr, int fq) const {
        const int row0 = u.pm * 256 + wr * 64 + fr; const int col0 = u.pn * 256 + wc * 32 + 8 * fq;
#pragma unroll
        for (int ai = 0; ai < 2; ++ai) {
            u32x4 ga[4][2], gb[4][2];
#pragma unroll
            for (int m = 0; m < 4; ++m) { const bf16_t* gp = zg + (size_t)(row0 + ai * 128 + m * 16) * 3072 + col0 + (seg - 1) * 1024;
#pragma unroll
                for (int bj = 0; bj < 2; ++bj) { ga[m][bj] = *(const u32x4*)(gp + bj * 128); gb[m][bj] = *(const u32x4*)(gp + 1024 + bj * 128); } }
#pragma unroll
            for (int m = 0; m < 4; ++m)
#pragma unroll
                for (int bj = 0; bj < 2; ++bj)
#pragma unroll
                    for (int e = 0; e < 4; ++e) { const unsigned wa = ga[m][bj][e], wb = gb[m][bj][e];
                        const float r0 = bflo(wb) * fast_rcp(bflo(wa)), r1 = bfhi(wb) * fast_rcp(bfhi(wa));
                        acc[ai][bj][m][e >> 1][(e & 1) * 2] *= r0; acc[ai][bj][m][e >> 1][(e & 1) * 2 + 1] *= r1; }
        }
    }
    __device__ __forceinline__ void operator()(const f32x4 (&acc)[2][2][4][2], const pg8::Unit& u, int wr, int wc, int fr, int fq) const {
        const int row0 = u.pm * 256 + wr * 64 + fr; const int col0 = u.pn * 256 + wc * 32 + 8 * fq;
#pragma unroll
        for (int ai = 0; ai < 2; ++ai) {
            u32x4 gg[4][2];
#pragma unroll
            for (int m = 0; m < 4; ++m) { const bf16_t* gp = zg + (size_t)(row0 + ai * 128 + m * 16) * 3072 + col0 + 2048;
#pragma unroll
                for (int bj = 0; bj < 2; ++bj) gg[m][bj] = *(const u32x4*)(gp + bj * 128); }
#pragma unroll
            for (int m = 0; m < 4; ++m) { const int row = row0 + ai * 128 + m * 16;
#pragma unroll
                for (int bj = 0; bj < 2; ++bj) { const u32x4 g = gg[m][bj]; f32x4 v0 = acc[ai][bj][m][0], v1 = acc[ai][bj][m][1];
                    v0[0] *= fast_rcp(bflo(g[0])); v0[1] *= fast_rcp(bfhi(g[0])); v0[2] *= fast_rcp(bflo(g[1])); v0[3] *= fast_rcp(bfhi(g[1]));
                    v1[0] *= fast_rcp(bflo(g[2])); v1[1] *= fast_rcp(bfhi(g[2])); v1[2] *= fast_rcp(bflo(g[3])); v1[3] *= fast_rcp(bfhi(g[3]));
                    *(u32x4*)(merged + (size_t)row * 1024 + col0 + bj * 128) = pack8(v0, v1); } }
        }
    }
};
struct SchedP4 {
    int c, G; const char* yna; const char* ymla; const char* ymem; const char* wo;
    __device__ __forceinline__ bool next(int i, pg8::Unit& u) const {
        const int L = i * G + c; int pm, pn; if (L >= 512) return false;
        pg8::tile_order(L, 128, 4, pm, pn); u.pm = pm; u.pn = pn; u.kind = 0; u.nt = 24; u.aux = 0;
        u.A = yna + (size_t)pm * 256 * 1024; u.A1 = ymla + (size_t)pm * 256 * 1024; u.A2 = ymem + (size_t)pm * 256 * 1024; u.B = wo + (size_t)pn * 256 * 3072; return true;
    }
};

struct EpiP5 {
    static constexpr bool PERM = false, HAS_MID = false;
    const float* x; float* h;
    __device__ __forceinline__ void operator()(const f32x4 (&acc)[2][2][4][2], const pg8::Unit& u, int wr, int wc, int fr, int fq) const {
        const int row0 = u.pm * 256 + wr * 64 + fr; const int col0 = u.pn * 256 + wc * 32 + 4 * fq;
#pragma unroll
        for (int ai = 0; ai < 2; ++ai)
#pragma unroll
            for (int m = 0; m < 4; ++m) { const size_t off = (size_t)(row0 + ai * 128 + m * 16) * 1024 + col0;
#pragma unroll
                for (int bj = 0; bj < 2; ++bj)
#pragma unroll
                    for (int n = 0; n < 2; ++n) { const f32x4 xv = *(const f32x4*)(x + off + bj * 128 + n * 16); *(f32x4*)(h + off + bj * 128 + n * 16) = xv + acc[ai][bj][m][n]; } }
    }
};
struct SchedP5 {
    int c, G; const char* merged; const char* wout;
    __device__ __forceinline__ bool next(int i, pg8::Unit& u) const {
        const int L = i * G + c; int pm, pn; if (L >= 512) return false;
        pg8::tile_order(L, 128, 4, pm, pn); u.pm = pm; u.pn = pn; u.kind = 0; u.nt = 16; u.aux = 0;
        u.A = merged + (size_t)pm * 256 * 2048; u.A1 = u.A; u.A2 = u.A; u.B = wout + (size_t)pn * 256 * 2048; return true;
    }
};

struct EpiP8 {
    static constexpr bool PERM = true, HAS_MID = false;
    const float* rstd_xs; bf16_t* act;
    __device__ __forceinline__ void operator()(const f32x4 (&acc)[2][2][4][2], const pg8::Unit& u, int wr, int wc, int fr, int fq) const {
        const int row0 = u.pm * 256 + wr * 64 + fr; const int col0 = u.pn * 128 + wc * 32 + 8 * fq;
#pragma unroll
        for (int ai = 0; ai < 2; ++ai)
#pragma unroll
            for (int m = 0; m < 4; ++m) { const int row = row0 + ai * 128 + m * 16; const float rs = rstd_xs[row]; f32x4 o[2];
#pragma unroll
                for (int n = 0; n < 2; ++n)
#pragma unroll
                    for (int e = 0; e < 4; ++e) { const float hg = acc[ai][0][m][n][e] * rs, hu = acc[ai][1][m][n][e] * rs; o[n][e] = hg * fast_rcp(1.0f + fast_exp2(-LOG2E * hg)) * hu; }
                *(u32x4*)(act + (size_t)row * 1024 + col0) = pack8(o[0], o[1]); }
    }
};
struct SchedP8 {
    int c, G; const char* xs; const char* wgu;
    __device__ __forceinline__ bool next(int i, pg8::Unit& u) const {
        const int L = i * G + c; int pm, pn; if (L >= 2048) return false;
        const int e = L >> 7; pg8::tile_order(L & 127, 16, 8, pm, pn); const int b = pm >> 1, half = pm & 1; const int grow0 = (b * 16 + e) * 512 + half * 256;
        u.pm = grow0 >> 8; u.pn = pn; u.kind = 0; u.nt = 16; u.aux = e; u.A = xs; u.A1 = u.A; u.A2 = u.A; u.B = wgu + (size_t)(e * 2048 + pn * 256) * 2048; return true;
    }
};
struct EpiP9 {
    static constexpr bool PERM = true, HAS_MID = false;
    const float* gsel; bf16_t* ybuf;
    __device__ __forceinline__ void operator()(const f32x4 (&acc)[2][2][4][2], const pg8::Unit& u, int wr, int wc, int fr, int fq) const {
        const int row0 = u.pm * 256 + wr * 64 + fr; const int col0 = u.pn * 256 + wc * 32 + 8 * fq;
#pragma unroll
        for (int ai = 0; ai < 2; ++ai)
#pragma unroll
            for (int m = 0; m < 4; ++m) { const int row = row0 + ai * 128 + m * 16; const float gs = gsel[row];
#pragma unroll
                for (int bj = 0; bj < 2; ++bj) *(u32x4*)(ybuf + (size_t)row * 1024 + col0 + bj * 128) = pack8(acc[ai][bj][m][0] * gs, acc[ai][bj][m][1] * gs); }
    }
};
struct SchedP9 {
    int c, G; const char* act; const char* wd;
    __device__ __forceinline__ bool next(int i, pg8::Unit& u) const {
        const int L = i * G + c; int pm, pn; if (L >= 1024) return false;
        const int e = L >> 6; pg8::tile_order(L & 63, 16, 4, pm, pn); const int b = pm >> 1, half = pm & 1; const int grow0 = (b * 16 + e) * 512 + half * 256;
        u.pm = grow0 >> 8; u.pn = pn; u.kind = 0; u.nt = 16; u.aux = e; u.A = act + (size_t)grow0 * 2048; u.A1 = u.A; u.A2 = u.A; u.B = wd + (size_t)(e * 1024 + pn * 256) * 2048; return true;
    }
};

namespace att {
typedef short v4i16_t __attribute__((ext_vector_type(4)));
struct AttnArgs { const bf16_t* q; const bf16_t* k0; const bf16_t* k1; const bf16_t* v; bf16_t* o; const float* rpb; };
__device__ __forceinline__ s16x4 vtr(unsigned addr) { return __builtin_bit_cast(s16x4, __builtin_amdgcn_ds_read_tr16_b64_v4i16((LAS v4i16_t*)(uintptr_t)addr)); }
__device__ __forceinline__ float max3f(float a, float b, float c) { float r; asm("v_max3_f32 %0, %1, %2, %3" : "=v"(r) : "v"(a), "v"(b), "v"(c)); return r; }

template <int DQK, int DV, int MODE, bool PIPE>
__device__ __forceinline__ void attn_unit(LAS unsigned char* lds, const AttnArgs& A, const int b, const int h, const int ub) {
    constexpr int PK = DQK * 2 + 16, PV = DV * 2 + 64, KB = 64 * PK, VB = 64 * PV;
    constexpr int OFF_K = 0, OFF_V = 2 * KB, OFF_SCR = OFF_V + 2 * VB, OFF_OST = OFF_SCR + 8 * 256, OFF_END = OFF_OST + 8 * 32 * DV * 2;
    static_assert(OFF_END <= LDS_BYTES - 64, "attention LDS");
    constexpr int KCH = DQK / 8, VCH = DV / 8, NKC = 64 * KCH, NVC = 64 * VCH, KPT = (NKC + 511) / 512, VPT = (NVC + 511) / 512;
    constexpr int LDQ = (MODE == 0) ? 768 : 512, LDO = 512;
    constexpr int NDS = DQK / 16, ND0 = DV / 32;
    constexpr int NT = (MODE == 0) ? 64 : 4;
    constexpr float THR = 8.0f;
    int tid_ = threadIdx.x; asm volatile("" : "+v"(tid_));
    const int tid = tid_, lane = tid & 63, r32 = lane & 31, hi = lane >> 5; const int wid = __builtin_amdgcn_readfirstlane(tid >> 6);
    const int wave_tok0 = b * S_ + ub * 256 + wid * 32;
    bf16x8 qf[NDS];
    { const bf16_t* qp = A.q + (size_t)(wave_tok0 + r32) * LDQ + h * DQK + hi * 8;
#pragma unroll
      for (int ds = 0; ds < NDS; ++ds) qf[ds] = *(const bf16x8*)(qp + ds * 16); }
    const bf16_t* ksrc[KPT]; int kstr[KPT]; unsigned kdst[KPT]; bool kval[KPT];
    const bf16_t* vsrc[VPT]; unsigned vdst[VPT];
    constexpr int KSTRIDE = 64 * 1024;
#pragma unroll
    for (int j = 0; j < KPT; ++j) { const int ci = tid + 512 * j; kval[j] = ci < NKC; const int cic = kval[j] ? ci : 0; const int row = cic / KCH, cc = cic % KCH;
        kdst[j] = (unsigned)(OFF_K + row * PK + cc * 16); kstr[j] = KSTRIDE;
        if (MODE == 0) { const size_t kt = (size_t)b * S_ + row; if (cc < 8) ksrc[j] = A.k0 + kt * 1024 + h * 64 + cc * 8; else { ksrc[j] = A.k1 + kt * 32 + (cc - 8) * 8; kstr[j] = 64 * 32; } }
        else { const size_t kr = (size_t)b * 256 + row; ksrc[j] = A.k0 + kr * 1024 + h * 128 + cc * 8; } }
#pragma unroll
    for (int j = 0; j < VPT; ++j) { const int ci = tid + 512 * j; const int row = ci / VCH, cc = ci % VCH;
        vdst[j] = (unsigned)(OFF_V + row * PV + cc * 16);
        if (MODE == 0) { const size_t kt = (size_t)b * S_ + row; vsrc[j] = A.v + kt * 1024 + h * 64 + cc * 8; }
        else { const size_t kr = (size_t)b * 256 + row; vsrc[j] = A.v + kr * 1024 + h * 128 + cc * 8; } }
    u32x4 kst[KPT], vst[VPT];
#define ATT_LOADK(tile) do { _Pragma("unroll") for (int j = 0; j < KPT; ++j) if (kval[j]) kst[j] = *(const u32x4*)(ksrc[j] + (size_t)(tile) * kstr[j]); } while (0)
#define ATT_LOADV(tile) do { _Pragma("unroll") for (int j = 0; j < VPT; ++j) vst[j] = *(const u32x4*)(vsrc[j] + (size_t)(tile) * KSTRIDE); } while (0)
#define ATT_STOREK(buf) do { _Pragma("unroll") for (int j = 0; j < KPT; ++j) if (kval[j]) *(LAS u32x4*)(lds + kdst[j] + (buf) * KB) = kst[j]; } while (0)
#define ATT_STOREV(buf) do { _Pragma("unroll") for (int j = 0; j < VPT; ++j) *(LAS u32x4*)(lds + vdst[j] + (buf) * VB) = vst[j]; } while (0)
    LAS float* scr = (LAS float*)(lds + OFF_SCR) + wid * 64;
#define ATT_QK(P0, P1, buf) do { const LAS unsigned char* kb_ = lds + OFF_K + (buf) * KB + r32 * PK + hi * 16; P0 = negm; P1 = negm; __builtin_amdgcn_s_setprio(1); \
        _Pragma("unroll") for (int ds = 0; ds < NDS; ++ds) { const bf16x8 a0_ = *(const LAS bf16x8*)(kb_ + ds * 32), a1_ = *(const LAS bf16x8*)(kb_ + 32 * PK + ds * 32); \
            P0 = __builtin_amdgcn_mfma_f32_32x32x16_bf16(a0_, qf[ds], P0, 0, 0, 0); P1 = __builtin_amdgcn_mfma_f32_32x32x16_bf16(a1_, qf[ds], P1, 0, 0, 0); } __builtin_amdgcn_s_setprio(0); } while (0)
#define ATT_ROWMAX(P0, P1, rm) do { float a_ = max3f(P0[0], P0[1], P1[0]), b_ = max3f(P0[2], P0[3], P1[1]); a_ = max3f(a_, P1[2], P1[3]); \
        _Pragma("unroll") for (int r = 4; r < 16; r += 4) { a_ = max3f(a_, P0[r], P0[r + 1]); b_ = max3f(b_, P0[r + 2], P0[r + 3]); a_ = max3f(a_, P1[r], P1[r + 1]); b_ = max3f(b_, P1[r + 2], P1[r + 3]); } \
        rm = fmaxf(a_, b_); rm = fmaxf(rm, __shfl_xor(rm, 32)); } while (0)
    f32x16 o[ND0], negm;
#pragma unroll
    for (int r = 0; r < 16; ++r) negm[r] = 0.f;
#pragma unroll
    for (int d0 = 0; d0 < ND0; ++d0)
#pragma unroll
        for (int r = 0; r < 16; ++r) o[d0][r] = 0.f;
    float lsum = 0.f;
    f32x16 pA0, pA1, pB0, pB1;
    ATT_LOADK(0); ATT_LOADV(0); ATT_STOREK(0); ATT_STOREV(0); ATT_LOADK(1); ATT_STOREK(1);
    __syncthreads();
    ATT_QK(pA0, pA1, 0);
    { float rm; ATT_ROWMAX(pA0, pA1, rm);
#pragma unroll
      for (int r = 0; r < 16; ++r) { pA0[r] -= rm; pA1[r] -= rm; negm[r] = -rm; } }
    __syncthreads();
#ifndef ATT_SGB
#define ATT_SGB 1
#endif
#define ATT_STEP(PC0, PC1, PN0, PN1, t) do { const int buf_ = (t) & 1; \
        if ((t) + 2 < NT) ATT_LOADK((t) + 2); if ((t) + 1 < NT) ATT_LOADV((t) + 1); \
        if constexpr (!PIPE) { if ((t) > 0) { ATT_QK(PC0, PC1, buf_); float rm0_; ATT_ROWMAX(PC0, PC1, rm0_); \
            if (__any(rm0_ > THR)) { const float dl_ = fmaxf(rm0_, 0.f); const float f_ = fast_exp2(-dl_); lsum *= f_; \
                _Pragma("unroll") for (int r = 0; r < 16; ++r) { PC0[r] -= dl_; PC1[r] -= dl_; negm[r] -= dl_; } \
                if (hi == 0) scr[r32] = f_; \
                _Pragma("unroll") for (int r = 0; r < 16; ++r) { const float fr_ = scr[crow(r, hi)]; _Pragma("unroll") for (int d0 = 0; d0 < ND0; ++d0) o[d0][r] *= fr_; } } } } \
          \
        if constexpr (PIPE) { if ((t) + 1 < NT) ATT_QK(PN0, PN1, buf_ ^ 1); } \
        float ps_ = 0.f; \
        _Pragma("unroll") for (int r = 0; r < 16; ++r) { PC0[r] = fast_exp2(PC0[r]); PC1[r] = fast_exp2(PC1[r]); ps_ += PC0[r] + PC1[r]; } \
        lsum += ps_; \
        bf16x8 pa_[4]; \
        _Pragma("unroll") for (int s = 0; s < 2; ++s) { u32x4 w_; \
            w_.x = cvt_pk_bf16(PC0[8 * s + 0], PC0[8 * s + 1]); w_.y = cvt_pk_bf16(PC0[8 * s + 2], PC0[8 * s + 3]); w_.z = cvt_pk_bf16(PC0[8 * s + 4], PC0[8 * s + 5]); w_.w = cvt_pk_bf16(PC0[8 * s + 6], PC0[8 * s + 7]); pa_[s] = __builtin_bit_cast(bf16x8, w_); \
            w_.x = cvt_pk_bf16(PC1[8 * s + 0], PC1[8 * s + 1]); w_.y = cvt_pk_bf16(PC1[8 * s + 2], PC1[8 * s + 3]); w_.z = cvt_pk_bf16(PC1[8 * s + 4], PC1[8 * s + 5]); w_.w = cvt_pk_bf16(PC1[8 * s + 6], PC1[8 * s + 7]); pa_[2 + s] = __builtin_bit_cast(bf16x8, w_); } \
          \
        { const unsigned vb_ = (unsigned)(uintptr_t)(lds + OFF_V + buf_ * VB) + (unsigned)((4 * hi + ((lane & 15) >> 2)) * PV + ((((lane >> 4) & 1) * 16 + (lane & 3) * 4) * 2)); \
          __builtin_amdgcn_s_setprio(1); \
          _Pragma("unroll") for (int d0 = 0; d0 < ND0; ++d0) _Pragma("unroll") for (int s = 0; s < 4; ++s) { \
              const s16x4 lo_ = vtr(vb_ + (unsigned)(16 * s * PV + d0 * 64)), hh_ = vtr(vb_ + (unsigned)(16 * s * PV + 8 * PV + d0 * 64)); \
              const bf16x8 vf_ = (bf16x8){lo_[0], lo_[1], lo_[2], lo_[3], hh_[0], hh_[1], hh_[2], hh_[3]}; \
              o[d0] = __builtin_amdgcn_mfma_f32_32x32x16_bf16(pa_[s], vf_, o[d0], 0, 0, 0); } \
          __builtin_amdgcn_s_setprio(0); } \
        float rm_ = 0.f; \
        if constexpr (PIPE) { if ((t) + 1 < NT) ATT_ROWMAX(PN0, PN1, rm_); } \
        if (ATT_SGB && PIPE) { _Pragma("unroll") for (int g_ = 0; g_ < 12 + 4 * ND0; ++g_) { __builtin_amdgcn_sched_group_barrier(0x008, 1, 0); __builtin_amdgcn_sched_group_barrier(0x100, 2, 0); __builtin_amdgcn_sched_group_barrier(0x002, 6, 0); } } \
          \
        if constexpr (PIPE) { if (__any(rm_ > THR)) { const float dl_ = fmaxf(rm_, 0.f); const float f_ = fast_exp2(-dl_); lsum *= f_; \
            _Pragma("unroll") for (int r = 0; r < 16; ++r) { PN0[r] -= dl_; PN1[r] -= dl_; negm[r] -= dl_; } \
            if (hi == 0) scr[r32] = f_; \
            _Pragma("unroll") for (int r = 0; r < 16; ++r) { const float fr_ = scr[crow(r, hi)]; _Pragma("unroll") for (int d0 = 0; d0 < ND0; ++d0) o[d0][r] *= fr_; } } } \
        if ((t) + 2 < NT) ATT_STOREK(buf_); if ((t) + 1 < NT) ATT_STOREV(buf_ ^ 1); \
        __syncthreads(); } while (0)
    if constexpr (PIPE) { for (int t = 0; t < NT; t += 2) { ATT_STEP(pA0, pA1, pB0, pB1, t); ATT_STEP(pB0, pB1, pA0, pA1, t + 1); } }
    else { for (int t = 0; t < NT; ++t) { ATT_STEP(pA0, pA1, pB0, pB1, t); } }
    lsum += __shfl_xor(lsum, 32);
    if (hi == 0) scr[r32] = fast_rcp(lsum);
    LAS bf16_t* ost = (LAS bf16_t*)(lds + OFF_OST) + wid * 32 * DV;
#pragma unroll
    for (int r = 0; r < 16; ++r) { const int q = crow(r, hi); const float ri = scr[q];
#pragma unroll
        for (int d0 = 0; d0 < ND0; ++d0) { const float val = o[d0][r] * ri; ost[q * DV + d0 * 32 + r32] = (bf16_t)(cvt_pk_bf16(val, val) & 0xffffu); } }
    asm volatile("s_waitcnt lgkmcnt(0)" ::: "memory");
    { bf16_t* og = A.o + (size_t)wave_tok0 * LDO + h * DV;
#pragma unroll
      for (int i = 0; i < DV / 16; ++i) { const int id = i * 64 + lane; const int row = id / VCH, ch = id % VCH;
          const u32x4 v = *(const LAS u32x4*)(ost + row * DV + ch * 8); *(u32x4*)(og + (size_t)row * LDO + ch * 8) = v; } }
    __syncthreads();
#undef ATT_LOADK
#undef ATT_LOADV
#undef ATT_STOREK
#undef ATT_STOREV
#undef ATT_QK
#undef ATT_ROWMAX
#undef ATT_STEP
}
}

namespace att {
__device__ __forceinline__ void attn_unit_mla(LAS unsigned char* lds, const AttnArgs& A, const int b, const int h, const int ub) {
    constexpr int DQK = 96, DV = 64;
    constexpr int PK = DQK * 2 + 16, PV = DV * 2 + 64, KB = 64 * PK, VB = 64 * PV;
    constexpr int OFF_K = 0, OFF_V = 3 * KB, OFF_SCR = OFF_V + 3 * VB, OFF_OST = OFF_SCR + 8 * 256, OFF_END = OFF_OST + 8 * 32 * DV * 2;
    static_assert(OFF_END <= LDS_BYTES - 64, "attention LDS");
    constexpr int KCH = DQK / 8, VCH = DV / 8, NKC = 64 * KCH, KPT = 2, VPT = 1;
    constexpr int LDQ = 768, LDO = 512, NDS = DQK / 16, ND0 = DV / 32, NT = 64;
    constexpr float THR = 8.0f;
    int tid_ = threadIdx.x; asm volatile("" : "+v"(tid_));
    const int tid = tid_, lane = tid & 63, r32 = lane & 31, hi = lane >> 5; const int wid = __builtin_amdgcn_readfirstlane(tid >> 6);
    const int grp = wid >> 2;
    const int wave_tok0 = b * S_ + ub * 256 + wid * 32;
    bf16x8 qf[NDS];
    { const bf16_t* qp = A.q + (size_t)(wave_tok0 + r32) * LDQ + h * DQK + hi * 8;
#pragma unroll
      for (int ds = 0; ds < NDS; ++ds) qf[ds] = *(const bf16x8*)(qp + ds * 16); }
    const bf16_t* ksrc[KPT]; int kstr[KPT]; unsigned kdst[KPT]; bool kval[KPT];
    const bf16_t* vsrc; unsigned vdst;
    constexpr int KSTRIDE = 64 * 1024;
#pragma unroll
    for (int j = 0; j < KPT; ++j) { const int ci = tid + 512 * j; kval[j] = ci < NKC; const int cic = kval[j] ? ci : 0; const int row = cic / KCH, cc = cic % KCH;
        kdst[j] = (unsigned)(OFF_K + row * PK + cc * 16); kstr[j] = KSTRIDE; const size_t kt = (size_t)b * S_ + row;
        if (cc < 8) ksrc[j] = A.k0 + kt * 1024 + h * 64 + cc * 8; else { ksrc[j] = A.k1 + kt * 32 + (cc - 8) * 8; kstr[j] = 64 * 32; } }
    { const int row = tid / VCH, cc = tid % VCH; vdst = (unsigned)(OFF_V + row * PV + cc * 16); vsrc = A.v + ((size_t)b * S_ + row) * 1024 + h * 64 + cc * 8; }
    u32x4 kst[KPT], vst;
#define MLA_LOADK(tile) do { _Pragma("unroll") for (int j = 0; j < KPT; ++j) if (kval[j]) kst[j] = *(const u32x4*)(ksrc[j] + (size_t)(tile) * kstr[j]); } while (0)
#define MLA_LOADV(tile) do { vst = *(const u32x4*)(vsrc + (size_t)(tile) * KSTRIDE); } while (0)
#define MLA_STOREK(boff) do { _Pragma("unroll") for (int j = 0; j < KPT; ++j) if (kval[j]) *(LAS u32x4*)(lds + kdst[j] + (boff)) = kst[j]; } while (0)
#define MLA_STOREV(boff) do { *(LAS u32x4*)(lds + vdst + (boff)) = vst; } while (0)
    LAS float* scr = (LAS float*)(lds + OFF_SCR) + wid * 64;
#define MLA_QK(P0, P1, boff) do { const LAS unsigned char* kb_ = lds + OFF_K + (boff) + r32 * PK + hi * 16; P0 = negm; P1 = negm; __builtin_amdgcn_s_setprio(1); \
        _Pragma("unroll") for (int ds = 0; ds < NDS; ++ds) { const bf16x8 a0_ = *(const LAS bf16x8*)(kb_ + ds * 32), a1_ = *(const LAS bf16x8*)(kb_ + 32 * PK + ds * 32); \
            P0 = __builtin_amdgcn_mfma_f32_32x32x16_bf16(a0_, qf[ds], P0, 0, 0, 0); P1 = __builtin_amdgcn_mfma_f32_32x32x16_bf16(a1_, qf[ds], P1, 0, 0, 0); } __builtin_amdgcn_s_setprio(0); } while (0)
#define MLA_ROWMAX(P0, P1, rm) do { float a_ = max3f(P0[0], P0[1], P1[0]), b_ = max3f(P0[2], P0[3], P1[1]); a_ = max3f(a_, P1[2], P1[3]); \
        _Pragma("unroll") for (int r = 4; r < 16; r += 4) { a_ = max3f(a_, P0[r], P0[r + 1]); b_ = max3f(b_, P0[r + 2], P0[r + 3]); a_ = max3f(a_, P1[r], P1[r + 1]); b_ = max3f(b_, P1[r + 2], P1[r + 3]); } \
        rm = fmaxf(a_, b_); rm = fmaxf(rm, __shfl_xor(rm, 32)); } while (0)
    f32x16 o[ND0], negm;
#pragma unroll
    for (int r = 0; r < 16; ++r) negm[r] = 0.f;
#pragma unroll
    for (int d0 = 0; d0 < ND0; ++d0)
#pragma unroll
        for (int r = 0; r < 16; ++r) o[d0][r] = 0.f;
    float lsum = 0.f;
    f32x16 pA0, pA1, pB0, pB1;
    MLA_LOADK(0); MLA_LOADV(0); MLA_STOREK(0); MLA_STOREV(0);
    MLA_LOADK(1); MLA_LOADV(1); MLA_STOREK(KB); MLA_STOREV(VB);
    MLA_LOADK(2); MLA_STOREK(2 * KB);
    __syncthreads();
    MLA_QK(pA0, pA1, 0);
    { float rm; MLA_ROWMAX(pA0, pA1, rm);
#pragma unroll
      for (int r = 0; r < 16; ++r) { pA0[r] -= rm; pA1[r] -= rm; negm[r] = -rm; } }
    __syncthreads();
    if (grp == 1) asm volatile("s_barrier" ::: "memory");
    int kb0 = 0, kb1 = KB, kb2 = 2 * KB;
    int vb0 = 0, vb1 = VB, vb2 = 2 * VB;
#define MLA_STEP(PC0, PC1, PN0, PN1, t) do { \
          \
        if ((t) + 3 < NT) MLA_LOADK((t) + 3); if ((t) + 2 < NT) MLA_LOADV((t) + 2); \
        if ((t) + 1 < NT) MLA_QK(PN0, PN1, kb1); \
        float ps_ = 0.f; \
        _Pragma("unroll") for (int r = 0; r < 16; ++r) { PC0[r] = fast_exp2(PC0[r]); PC1[r] = fast_exp2(PC1[r]); ps_ += PC0[r] + PC1[r]; } \
        lsum += ps_; \
        bf16x8 pa_[4]; \
        _Pragma("unroll") for (int s = 0; s < 2; ++s) { u32x4 w_; \
            w_.x = cvt_pk_bf16(PC0[8 * s + 0], PC0[8 * s + 1]); w_.y = cvt_pk_bf16(PC0[8 * s + 2], PC0[8 * s + 3]); w_.z = cvt_pk_bf16(PC0[8 * s + 4], PC0[8 * s + 5]); w_.w = cvt_pk_bf16(PC0[8 * s + 6], PC0[8 * s + 7]); pa_[s] = __builtin_bit_cast(bf16x8, w_); \
            w_.x = cvt_pk_bf16(PC1[8 * s + 0], PC1[8 * s + 1]); w_.y = cvt_pk_bf16(PC1[8 * s + 2], PC1[8 * s + 3]); w_.z = cvt_pk_bf16(PC1[8 * s + 4], PC1[8 * s + 5]); w_.w = cvt_pk_bf16(PC1[8 * s + 6], PC1[8 * s + 7]); pa_[2 + s] = __builtin_bit_cast(bf16x8, w_); } \
        _Pragma("unroll") for (int s = 0; s < 4; ++s) asm volatile("" : "+v"(pa_[s])); \
        asm volatile("s_barrier" ::: "memory"); \
          \
        { const unsigned vb_ = (unsigned)(uintptr_t)(lds + OFF_V + vb0) + (unsigned)((4 * hi + ((lane & 15) >> 2)) * PV + ((((lane >> 4) & 1) * 16 + (lane & 3) * 4) * 2)); \
          __builtin_amdgcn_s_setprio(1); \
          _Pragma("unroll") for (int d0 = 0; d0 < ND0; ++d0) _Pragma("unroll") for (int s = 0; s < 4; ++s) { \
              const s16x4 lo_ = vtr(vb_ + (unsigned)(16 * s * PV + d0 * 64)), hh_ = vtr(vb_ + (unsigned)(16 * s * PV + 8 * PV + d0 * 64)); \
              const bf16x8 vf_ = (bf16x8){lo_[0], lo_[1], lo_[2], lo_[3], hh_[0], hh_[1], hh_[2], hh_[3]}; \
              o[d0] = __builtin_amdgcn_mfma_f32_32x32x16_bf16(pa_[s], vf_, o[d0], 0, 0, 0); } \
          __builtin_amdgcn_s_setprio(0); } \
        float rm_ = 0.f; \
        if ((t) + 1 < NT) MLA_ROWMAX(PN0, PN1, rm_); \
        if (__any(rm_ > THR)) { const float dl_ = fmaxf(rm_, 0.f); const float f_ = fast_exp2(-dl_); lsum *= f_; \
            _Pragma("unroll") for (int r = 0; r < 16; ++r) { PN0[r] -= dl_; PN1[r] -= dl_; negm[r] -= dl_; } \
            if (hi == 0) scr[r32] = f_; \
            _Pragma("unroll") for (int r = 0; r < 16; ++r) { const float fr_ = scr[crow(r, hi)]; _Pragma("unroll") for (int d0 = 0; d0 < ND0; ++d0) o[d0][r] *= fr_; } } \
        if ((t) + 3 < NT) MLA_STOREK(kb0); if ((t) + 2 < NT) MLA_STOREV(vb2); \
        { const int k_ = kb0; kb0 = kb1; kb1 = kb2; kb2 = k_; const int v_ = vb2; vb2 = vb0; vb0 = vb1; vb1 = v_; } \
        asm volatile("s_waitcnt lgkmcnt(0)\n\ts_barrier" ::: "memory"); } while (0)
    for (int t = 0; t < NT; t += 2) { MLA_STEP(pA0, pA1, pB0, pB1, t); MLA_STEP(pB0, pB1, pA0, pA1, t + 1); }
    if (grp == 0) asm volatile("s_barrier" ::: "memory");
    lsum += __shfl_xor(lsum, 32);
    if (hi == 0) scr[r32] = fast_rcp(lsum);
    LAS bf16_t* ost = (LAS bf16_t*)(lds + OFF_OST) + wid * 32 * DV;
#pragma unroll
    for (int r = 0; r < 16; ++r) { const int q = crow(r, hi); const float ri = scr[q];
#pragma unroll
        for (int d0 = 0; d0 < ND0; ++d0) { const float val = o[d0][r] * ri; ost[q * DV + d0 * 32 + r32] = (bf16_t)(cvt_pk_bf16(val, val) & 0xffffu); } }
    asm volatile("s_waitcnt lgkmcnt(0)" ::: "memory");
    { bf16_t* og = A.o + (size_t)wave_tok0 * LDO + h * DV;
#pragma unroll
      for (int i = 0; i < DV / 16; ++i) { const int id = i * 64 + lane; const int row = id / VCH, ch = id % VCH;
          const u32x4 v = *(const LAS u32x4*)(ost + row * DV + ch * 8); *(u32x4*)(og + (size_t)row * LDO + ch * 8) = v; } }
    __syncthreads();
#undef MLA_LOADK
#undef MLA_LOADV
#undef MLA_STOREK
#undef MLA_STOREV
#undef MLA_QK
#undef MLA_ROWMAX
#undef MLA_STEP
}
}

namespace na2 {
typedef short v4i16_t __attribute__((ext_vector_type(4)));
constexpr int NS = 6, DPF = 5, TILE = 16384;
constexpr int OFF_RING = 0, OFF_OST = NS * TILE, OFF_TAB = OFF_OST + 8 * 2048, TAB_FLOATS = 8 * 465;
static_assert(OFF_TAB + TAB_FLOATS * 4 <= LDS_BYTES - 64, "na2 LDS");
__device__ __forceinline__ void glds16(const void* gsrc, unsigned lds_dst) { unsigned keep;
    asm volatile("s_mov_b32 %0, m0\n\ts_mov_b32 m0, %2\n\ts_nop 0\n\tglobal_load_lds_dwordx4 %1, off\n\ts_mov_b32 m0, %0" : "=&s"(keep) : "v"(gsrc), "s"(lds_dst) : "memory"); }
__device__ __forceinline__ s16x4 vtr(unsigned addr) { return __builtin_bit_cast(s16x4, __builtin_amdgcn_ds_read_tr16_b64_v4i16((LAS v4i16_t*)(uintptr_t)addr)); }
__device__ __forceinline__ int clampi(int v, int lo, int hi) { return v < lo ? lo : (v > hi ? hi : v); }
#define NA_WAITBAR(N) asm volatile("s_waitcnt vmcnt(" #N ") lgkmcnt(0)\n\ts_barrier" ::: "memory")

__device__ __forceinline__ void na_phase(LAS unsigned char* lds, const bf16_t* qn, const bf16_t* kn, const bf16_t* vn, bf16_t* on, const float* rpb, const int vcu, const int G) {
    int tid_ = threadIdx.x; asm volatile("" : "+v"(tid_));
    const int tid = tid_, lane = tid & 63, lj = lane & 15, fq = lane >> 4; const int wid = __builtin_amdgcn_readfirstlane(tid >> 6);
    const int hl = wid >> 2, g = wid & 3; const int csg = (g == 0) ? 0 : (g == 1 ? 8 : (g == 2 ? 24 : 32));
    LAS float* tab = (LAS float*)(lds + OFF_TAB);
    for (int i = tid; i < TAB_FLOATS; i += NTHREADS) tab[i] = rpb[i] * LOG2E;
    const unsigned lds0 = (unsigned)(uintptr_t)lds;
    if (vcu >= 2048) { __syncthreads(); return; }
    const int nunits = (2048 - vcu + G - 1) / G; const int total = nunits * 17;
    unsigned offK[2], offV[2], dstw[2];
#pragma unroll
    for (int p = 0; p < 2; ++p) { const int ii = wid * 2 + p, row = 4 * ii + (lane >> 4), cp = lane & 15;
        offK[p] = (unsigned)(row * 1024 + ((cp ^ (row & 15)) << 4)); offV[p] = (unsigned)(row * 1024 + ((cp ^ ((row & 7) << 1)) << 4)); dstw[p] = lds0 + OFF_RING + ii * 1024; }
#define NA_ISSUE(tau, slot) do { const int n_ = (tau) / 17, i_ = (tau) - 17 * n_; const int U_ = vcu + n_ * G; const int b_ = U_ >> 8, hp_ = (U_ >> 6) & 3, r_ = U_ & 63; \
        const int kr_ = (i_ == 0) ? r_ : clampi(r_ - 4, 0, 56) + ((i_ - 1) & 7); const bf16_t* src_ = (i_ == 0) ? qn : (i_ < 9 ? kn : vn); \
        const char* base_ = (const char*)(src_ + ((size_t)(b_ * S_ + kr_ * 64) * 512 + hp_ * 128)); \
        _Pragma("unroll") for (int p = 0; p < 2; ++p) glds16(base_ + (i_ < 9 ? offK[p] : offV[p]), (unsigned)__builtin_amdgcn_readfirstlane(dstw[p] + (slot) * TILE)); } while (0)
    int islot = 0;
#pragma unroll
    for (int d = 0; d < DPF; ++d) { if (d < total) { NA_ISSUE(d, islot); islot = (islot + 1 == NS) ? 0 : islot + 1; } }
    int cslot = 0;
    for (int n = 0; n < nunits; ++n) {
        const int U = vcu + n * G; const int b = U >> 8, hp = (U >> 6) & 3, r = U & 63; const int rs = clampi(r - 4, 0, 56); const int head = hp * 2 + hl;
        const int tok0 = b * S_ + r * 64 + 16 * g;
        bf16x8 qf[2];
        f32x4 s[8][2]; bf16x8 pa[8]; f32x4 o[4]; float lsum = 0.f;
#pragma unroll
        for (int dt = 0; dt < 4; ++dt) o[dt] = (f32x4){0.f, 0.f, 0.f, 0.f};
#pragma clang loop unroll(full)
        for (int i0 = 0; i0 < 17; ++i0) {
            const int tau = n * 17 + i0; const int i = i0 - 1;
            if (tau + DPF <= total) NA_WAITBAR(8); else NA_WAITBAR(0);
            if (tau + DPF < total) { NA_ISSUE(tau + DPF, islot); islot = (islot + 1 == NS) ? 0 : islot + 1; }
            const unsigned sbase = lds0 + OFF_RING + cslot * TILE; cslot = (cslot + 1 == NS) ? 0 : cslot + 1;
            if (i0 == 0) {
                const int kc = 16 * g + lj;
#pragma unroll
                for (int ds = 0; ds < 2; ++ds) { const int c = hl * 8 + ds * 4 + fq; qf[ds] = *(const LAS bf16x8*)(uintptr_t)(sbase + kc * 256 + ((c ^ (kc & 15)) << 4)); }
            } else if (i < 8) {
#pragma unroll
                for (int ct = 0; ct < 2; ++ct) { s[i][ct] = (f32x4){0.f, 0.f, 0.f, 0.f}; const int kc = csg + 16 * ct + lj;
#pragma unroll
                    for (int ds = 0; ds < 2; ++ds) { const int c = hl * 8 + ds * 4 + fq; const bf16x8 a = *(const LAS bf16x8*)(uintptr_t)(sbase + kc * 256 + ((c ^ (kc & 15)) << 4));
                        s[i][ct] = __builtin_amdgcn_mfma_f32_16x16x32_bf16(a, qf[ds], s[i][ct], 0, 0, 0); } }
                if (i == 7) {
                    const int c = 16 * g + lj, cs = clampi(c - 8, 0, 48); float m = -1e30f;
#pragma unroll
                    for (int t = 0; t < 8; ++t) { const LAS float* trow = tab + head * 465 + (rs + t - r + 7) * 31;
#pragma unroll
                        for (int ct = 0; ct < 2; ++ct)
#pragma unroll
                            for (int e = 0; e < 4; ++e) { const int kc = csg + 16 * ct + 4 * fq + e; const bool v = (unsigned)(kc - cs) < 16u; const float bias = trow[v ? (kc - c + 15) : 0];
                                const float x = v ? s[t][ct][e] + bias : -1e30f; s[t][ct][e] = x; m = fmaxf(m, x); } }
                    m = fmaxf(m, __shfl_xor(m, 16)); m = fmaxf(m, __shfl_xor(m, 32));
#pragma unroll
                    for (int t = 0; t < 8; ++t) {
#pragma unroll
                        for (int ct = 0; ct < 2; ++ct)
#pragma unroll
                            for (int e = 0; e < 4; ++e) { const float p = fast_exp2(s[t][ct][e] - m); s[t][ct][e] = p; lsum += p; }
                        u32x4 w; w.x = cvt_pk_bf16(s[t][0][0], s[t][0][1]); w.y = cvt_pk_bf16(s[t][0][2], s[t][0][3]); w.z = cvt_pk_bf16(s[t][1][0], s[t][1][1]); w.w = cvt_pk_bf16(s[t][1][2], s[t][1][3]);
                        pa[t] = __builtin_bit_cast(bf16x8, w); }
                    lsum += __shfl_xor(lsum, 16); lsum += __shfl_xor(lsum, 32);
                }
            } else {
                const int t = i - 8; const int q = lj >> 2, p = lj & 3;
#pragma unroll
                for (int dt = 0; dt < 4; ++dt) { const int c = hl * 8 + 2 * dt + (p >> 1); s16x4 tr[2];
#pragma unroll
                    for (int ct = 0; ct < 2; ++ct) { const int kc = csg + 16 * ct + 4 * fq + q; tr[ct] = vtr(sbase + kc * 256 + ((c ^ ((kc & 7) << 1)) << 4) + (p & 1) * 8); }
                    const bf16x8 vf = (bf16x8){tr[0][0], tr[0][1], tr[0][2], tr[0][3], tr[1][0], tr[1][1], tr[1][2], tr[1][3]};
                    o[dt] = __builtin_amdgcn_mfma_f32_16x16x32_bf16(pa[t], vf, o[dt], 0, 0, 0); }
                if (i == 15) {
                    const float linv = fast_rcp(lsum); float li[4];
#pragma unroll
                    for (int e = 0; e < 4; ++e) li[e] = __shfl(linv, 4 * fq + e);
                    LAS bf16_t* ost = (LAS bf16_t*)(lds + OFF_OST) + wid * 1024;
#pragma unroll
                    for (int dt = 0; dt < 4; ++dt)
#pragma unroll
                        for (int e = 0; e < 4; ++e) { const float val = o[dt][e] * li[e]; ost[(4 * fq + e) * 64 + 16 * dt + lj] = (bf16_t)(cvt_pk_bf16(val, val) & 0xffffu); }
                    asm volatile("s_waitcnt lgkmcnt(0)" ::: "memory");
                    bf16_t* og = on + (size_t)tok0 * 512 + head * 64;
#pragma unroll
                    for (int k = 0; k < 2; ++k) { const int id = lane + 64 * k, row = id >> 3, ch = id & 7; const u32x4 v = *(const LAS u32x4*)(ost + row * 64 + ch * 8); *(u32x4*)(og + (size_t)row * 512 + ch * 8) = v; }
                }
            }
        }
    }
    asm volatile("s_waitcnt vmcnt(0) lgkmcnt(0)" ::: "memory");
    __syncthreads();
#undef NA_ISSUE
}
#undef NA_WAITBAR
}

struct HalfMap { int drow; float cs; bool rp; bool valid; };
__device__ __forceinline__ void p0_item64(const float* W, int ldw, int k0, int n0, bf16_t* WT, int ldwt, const HalfMap h0, const HalfMap h1, int dk0, const float* g, LAS float* scr, int lane) {
    const int n4 = (lane & 15) * 4, kq = lane >> 4; const bool hv = (n4 < 32) ? h0.valid : h1.valid; const float cs = (n4 < 32) ? h0.cs : h1.cs;
    f32x4 v[16];
#pragma unroll
    for (int j = 0; j < 16; ++j) { v[j] = (f32x4){0.f, 0.f, 0.f, 0.f}; if (hv) v[j] = *(const f32x4*)(W + (size_t)(k0 + 4 * j + kq) * ldw + n0 + n4); }
#pragma unroll
    for (int j = 0; j < 16; ++j) { const int k = 4 * j + kq; float sc = cs; if (g) sc *= g[k0 + k];
#pragma unroll
        for (int e = 0; e < 4; ++e) scr[(n4 + e) * 65 + k] = v[j][e] * sc; }
    asm volatile("s_waitcnt lgkmcnt(0)" ::: "memory");
    const int c = lane & 7;
#pragma unroll
    for (int j = 0; j < 8; ++j) { const int nn = 8 * j + (lane >> 3); const LAS float* s = scr + nn * 65 + 8 * c;
        u32x4 o; o.x = cvt_pk_bf16(s[0], s[1]); o.y = cvt_pk_bf16(s[2], s[3]); o.z = cvt_pk_bf16(s[4], s[5]); o.w = cvt_pk_bf16(s[6], s[7]);
        const bool hi_ = nn >= 32; const int w = nn & 31; const bool rp = hi_ ? h1.rp : h0.rp; const int nd = rp ? ((w & 16) + 2 * (w & 7) + ((w >> 3) & 1)) : w;
        const int drow = (hi_ ? h1.drow : h0.drow) + nd;
        if (hi_ ? h1.valid : h0.valid) *(u32x4*)(WT + (size_t)drow * ldwt + dk0 + k0 + 8 * c) = o; }
    asm volatile("s_waitcnt lgkmcnt(0)" ::: "memory");
}
__device__ __forceinline__ void p0_row(const float* xrow, bf16_t* orow, float* rstd, int lane) {
    const f32x4* xr = (const f32x4*)xrow + lane; f32x4 v[4]; float s = 0.f;
#pragma unroll
    for (int j = 0; j < 4; ++j) { v[j] = xr[64 * j]; s += (v[j][0] * v[j][0] + v[j][1] * v[j][1]) + (v[j][2] * v[j][2] + v[j][3] * v[j][3]); }
    s = wave_sum(s);
    u32x2* o8 = (u32x2*)orow + lane;
#pragma unroll
    for (int j = 0; j < 4; ++j) { u32x2 w; w.x = cvt_pk_bf16(v[j][0], v[j][1]); w.y = cvt_pk_bf16(v[j][2], v[j][3]); o8[64 * j] = w; }
    if (lane == 0) *rstd = rsqrtf(s * (1.0f / 1024.0f) + EPS_);
}

#define PX(P) ((P).in[0])
#define PMEM(P) ((P).in[1])
#define PGMIX(P) ((P).in[2])
#define PWIN(P) ((P).in[3])
#define PRPB(P) ((P).in[4])
#define PQN(P) ((P).in[5])
#define PWUQ(P) ((P).in[6])
#define PKVN(P) ((P).in[7])
#define PWUKV(P) ((P).in[8])
#define PGMEM(P) ((P).in[9])
#define PWMEMKV(P) ((P).in[10])
#define PWOUT(P) ((P).in[14])
#define PGFFN(P) ((P).in[15])
#define PWROUTER(P) ((P).in[16])
#define PBROUTER(P) ((P).in[17])
#define PWGATE(P) ((P).in[18])
#define PWUP(P) ((P).in[19])
#define PWDOWN(P) ((P).in[20])
#define PGFINAL(P) ((P).in[21])
typedef Args Ptrs;

__device__ __forceinline__ void phase0(const Ptrs& P, LAS unsigned char* lds, int gw, int NGW, int wave, int lane) {
    LAS float* scr = (LAS float*)(lds + wave * 16640);
    bf16_t* win = (bf16_t*)(P.ws + WS_WIN); bf16_t* wuq = (bf16_t*)(P.ws + WS_WUQ); bf16_t* wukv = (bf16_t*)(P.ws + WS_WUKV); bf16_t* wmk = (bf16_t*)(P.ws + WS_WMK);
    bf16_t* wo = (bf16_t*)(P.ws + WS_WO); bf16_t* wout = (bf16_t*)(P.ws + WS_WOUT); bf16_t* wgu = (bf16_t*)(P.ws + WS_WGU); bf16_t* wd = (bf16_t*)(P.ws + WS_WD);
    constexpr int I_E = 16 * 16, I_IN = 16 * 91, I_UQ = 6 * 12, I_UKV = 4 * 16, I_MK = 16 * 16, I_O = 8 * 16, I_OUT = 16 * 16;
    constexpr int NITEMS = 3 * 16 * I_E + I_IN + I_UQ + I_UKV + I_MK + 3 * I_O + I_OUT;
    for (int it = gw; it < NITEMS; it += NGW) {
        int r = it;
        if (r < 16 * I_E) { const int e = r / I_E, q = r % I_E, kb = q / 16, n0 = (q % 16) * 64; const int d0 = (n0 >> 7) * 256 + (n0 & 127);
            p0_item64(PWGATE(P) + (size_t)e * 1048576, 1024, kb * 64, n0, wgu + (size_t)e * 2097152, 1024, HalfMap{d0, 1.0f, false, true}, HalfMap{d0 + 32, 1.0f, false, true}, 0, PGFFN(P), scr, lane); continue; } r -= 16 * I_E;
        if (r < 16 * I_E) { const int e = r / I_E, q = r % I_E, kb = q / 16, n0 = (q % 16) * 64; const int d0 = (n0 >> 7) * 256 + 128 + (n0 & 127);
            p0_item64(PWUP(P) + (size_t)e * 1048576, 1024, kb * 64, n0, wgu + (size_t)e * 2097152, 1024, HalfMap{d0, 1.0f, false, true}, HalfMap{d0 + 32, 1.0f, false, true}, 0, PGFFN(P), scr, lane); continue; } r -= 16 * I_E;
        if (r < 16 * I_E) { const int e = r / I_E, q = r % I_E, kb = q / 16, n0 = (q % 16) * 64;
            p0_item64(PWDOWN(P) + (size_t)e * 1048576, 1024, kb * 64, n0, wd + (size_t)e * 1048576, 1024, HalfMap{n0, 1.0f, false, true}, HalfMap{n0 + 32, 1.0f, false, true}, 0, nullptr, scr, lane); continue; } r -= 16 * I_E;
        if (r < I_IN) { const int kb = r / 91, n0 = (r % 91) * 64; HalfMap hm[2];
#pragma unroll
            for (int hh = 0; hh < 2; ++hh) { const int n = n0 + 32 * hh; hm[hh].valid = n < INC_; hm[hh].drow = n < 2208 ? n : n + 96; hm[hh].cs = n < 512 ? C_NA : ((n >= 2208 && n < 2720) ? C_MEM : 1.0f); hm[hh].rp = (n == 2176); }
            p0_item64(PWIN(P), INC_, kb * 64, n0, win, 1024, hm[0], hm[1], 0, PGMIX(P), scr, lane); continue; } r -= I_IN;
        if (r < I_UQ) { const int kb = r / 12, nb = (r % 12) * 2, n0 = nb * 32;
            p0_item64(PWUQ(P), 768, kb * 64, n0, wuq, 384, HalfMap{n0, C_MLA, (nb % 3) == 2, true}, HalfMap{n0 + 32, C_MLA, ((nb + 1) % 3) == 2, true}, 0, PQN(P), scr, lane); continue; } r -= I_UQ;
        if (r < I_UKV) { const int kb = r / 16, nb = (r % 16) * 2, n0 = nb * 32; const int hh = nb >> 2, part = nb & 3; const int dr = (part < 2) ? (hh * 64 + part * 32) : (512 + hh * 64 + (part - 2) * 32);
            p0_item64(PWUKV(P), 1024, kb * 64, n0, wukv, 384, HalfMap{dr, 1.0f, false, true}, HalfMap{dr + 32, 1.0f, false, true}, 0, PKVN(P), scr, lane); continue; } r -= I_UKV;
        if (r < I_MK) { const int kb = r / 16, n0 = (r % 16) * 64; p0_item64(PWMEMKV(P), 1024, kb * 64, n0, wmk, 1024, HalfMap{n0, 1.0f, false, true}, HalfMap{n0 + 32, 1.0f, false, true}, 0, PGMEM(P), scr, lane); continue; } r -= I_MK;
        if (r < 3 * I_O) { const int br = r / I_O, q = r % I_O, kb = q / 16, n0 = (q % 16) * 64; p0_item64(P.in[11 + br], 1024, kb * 64, n0, wo, 1536, HalfMap{n0, 1.0f, false, true}, HalfMap{n0 + 32, 1.0f, false, true}, br * 512, nullptr, scr, lane); continue; } r -= 3 * I_O;
        { const int kb = r / 16, n0 = (r % 16) * 64; p0_item64(PWOUT(P), 1024, kb * 64, n0, wout, 1024, HalfMap{n0, 1.0f, false, true}, HalfMap{n0 + 32, 1.0f, false, true}, 0, nullptr, scr, lane); }
    }
    for (int i = gw * 64 + lane; i < 12288; i += NGW * 64) ((u32x4*)(win + (size_t)2208 * 1024))[i] = (u32x4){0u, 0u, 0u, 0u};
    bf16_t* xb = (bf16_t*)(((unsigned char*)P.out) + DO_XB); float* rstd_x = (float*)(P.ws + WS_RSTDX);
    for (int m = gw; m < T_; m += NGW) p0_row(PX(P) + (size_t)m * D_, xb + (size_t)m * D_, rstd_x + m, lane);
    bf16_t* memb = (bf16_t*)(P.ws + WS_MEMB); float* rstd_m = (float*)(P.ws + WS_RSTDM);
    for (int m = gw; m < 2048; m += NGW) p0_row(PMEM(P) + (size_t)m * D_, memb + (size_t)m * D_, rstd_m + m, lane);
    if (gw == NGW - 1) { float* rope = (float*)(P.ws + WS_ROPE);
        for (int i = lane; i < 512; i += 64) { const int pos = i >> 3, fi = i & 7; const float inv = exp2f(-(float)fi * 1.6609640474436813f); const float ang = (float)pos * inv;
            float rev = ang * 0.15915494309189535f; rev -= floorf(rev); rope[2 * i] = __builtin_amdgcn_cosf(rev); rope[2 * i + 1] = __builtin_amdgcn_sinf(rev); } }
}

__device__ __forceinline__ void phase6(const Ptrs& P, LAS unsigned char* lds, int gw, int NGW, int lane) {
    LAS float* wrT = (LAS float*)lds;
#pragma unroll 2
    for (int i = threadIdx.x; i < 16384; i += NTHREADS) { const int d = i >> 4, e = i & 15; wrT[e * 1024 + d] = PWROUTER(P)[i] * PGFFN(P)[d]; }
    __syncthreads();
    const float* hbuf = (const float*)(P.ws + WS_H); bf16_t* hb = (bf16_t*)(P.ws + WS_HB); float* rstd_h = (float*)(P.ws + WS_RSTDH); float* aff = (float*)(P.ws + WS_AFF);
    const int b5 = (lane >> 5) & 1, b4 = (lane >> 4) & 1, b3 = (lane >> 3) & 1, b2 = (lane >> 2) & 1; const int e_me = 8 * b5 + 4 * b4 + 2 * b3 + b2;
    const float bias = PBROUTER(P)[e_me];
    for (int row = gw; row < T_; row += NGW) {
        asm volatile("" ::: "memory");
        const f32x4* hr = (const f32x4*)(hbuf + (size_t)row * D_) + lane; f32x4 v[4]; float ss = 0.f;
#pragma unroll
        for (int j = 0; j < 4; ++j) { v[j] = hr[64 * j]; ss += (v[j][0] * v[j][0] + v[j][1] * v[j][1]) + (v[j][2] * v[j][2] + v[j][3] * v[j][3]); }
        u32x2* o8 = (u32x2*)(hb + (size_t)row * D_) + lane;
#pragma unroll
        for (int j = 0; j < 4; ++j) { u32x2 w; w.x = cvt_pk_bf16(v[j][0], v[j][1]); w.y = cvt_pk_bf16(v[j][2], v[j][3]); o8[64 * j] = w; }
        float a[16];
#pragma unroll
        for (int e = 0; e < 16; ++e) { float s = 0.f;
#pragma unroll
            for (int j = 0; j < 4; ++j) { const f32x4 w = *(const LAS f32x4*)(wrT + e * 1024 + 4 * lane + 256 * j); s += (v[j][0] * w[0] + v[j][1] * w[1]) + (v[j][2] * w[2] + v[j][3] * w[3]); }
            asm volatile("" : "+v"(s) :: "memory"); a[e] = s; }
        ss = wave_sum(ss); const float rstd = rsqrtf(ss * (1.0f / 1024.0f) + EPS_);
        if (lane == 0) rstd_h[row] = rstd;
        float a8[8], a4[4], a2[2], a1;
#pragma unroll
        for (int k = 0; k < 8; ++k) { const float send = b5 ? a[k] : a[k + 8]; const float recv = __shfl_xor(send, 32); a8[k] = (b5 ? a[k + 8] : a[k]) + recv; }
#pragma unroll
        for (int k = 0; k < 4; ++k) { const float send = b4 ? a8[k] : a8[k + 4]; const float recv = __shfl_xor(send, 16); a4[k] = (b4 ? a8[k + 4] : a8[k]) + recv; }
#pragma unroll
        for (int k = 0; k < 2; ++k) { const float send = b3 ? a4[k] : a4[k + 2]; const float recv = __shfl_xor(send, 8); a2[k] = (b3 ? a4[k + 2] : a4[k]) + recv; }
        { const float send = b2 ? a2[0] : a2[1]; const float recv = __shfl_xor(send, 4); a1 = (b2 ? a2[1] : a2[0]) + recv; }
        a1 += __shfl_xor(a1, 2); a1 += __shfl_xor(a1, 1);
        const float logit = a1 * rstd + bias;
        float mx = logit; mx = fmaxf(mx, __shfl_xor(mx, 4)); mx = fmaxf(mx, __shfl_xor(mx, 8)); mx = fmaxf(mx, __shfl_xor(mx, 16)); mx = fmaxf(mx, __shfl_xor(mx, 32));
        const float pe = expf(logit - mx); float sm = pe; sm += __shfl_xor(sm, 4); sm += __shfl_xor(sm, 8); sm += __shfl_xor(sm, 16); sm += __shfl_xor(sm, 32);
        if ((lane & 3) == 0) aff[(size_t)row * 16 + e_me] = pe / sm;
    }
    __syncthreads();
}

__device__ __forceinline__ void phase7(const Ptrs& P, LAS unsigned char* lds, int G) {
    LAS unsigned* keys = (LAS unsigned*)lds;
    LAS unsigned* hist = keys + 4096;
    LAS unsigned* misc = hist + 256;
    LAS int* tokl = (LAS int*)(misc + 32);
    const int tid = threadIdx.x, lane = tid & 63, wid = tid >> 6;
    const float* aff = (const float*)(P.ws + WS_AFF); int* idx = (int*)(P.ws + WS_IDX); float* gsel = (float*)(P.ws + WS_GSEL); int* sel = (int*)(P.ws + WS_SEL);
    const bf16_t* hb = (const bf16_t*)(P.ws + WS_HB); bf16_t* xs = (bf16_t*)(P.ws + WS_XS); const float* rstd_h = (const float*)(P.ws + WS_RSTDH); float* rstd_xs = (float*)(P.ws + WS_RSTDXS);
    for (int task = blockIdx.x; task < 128; task += G) {
        const int b = task >> 4, e = task & 15;
        for (int i = tid; i < 4096; i += NTHREADS) keys[i] = __float_as_uint(aff[((size_t)b * S_ + i) * 16 + e]);
        if (tid == 0) { misc[0] = 0u; misc[1] = 512u; }
        __syncthreads();
        for (int shift = 24; shift >= 0; shift -= 8) {
            if (tid < 256) hist[tid] = 0u;
            __syncthreads();
            const unsigned prefix = misc[0];
#pragma unroll
            for (int j = 0; j < 8; ++j) { const unsigned k = keys[tid * 8 + j]; if (shift == 24 || (k >> (shift + 8)) == prefix) __hip_atomic_fetch_add(&hist[(k >> shift) & 255u], 1u, __ATOMIC_RELAXED, __HIP_MEMORY_SCOPE_WORKGROUP); }
            __syncthreads();
            if (wid == 0) {
                const unsigned kk = misc[1];
                const unsigned h0 = hist[4 * lane], h1 = hist[4 * lane + 1], h2 = hist[4 * lane + 2], h3 = hist[4 * lane + 3];
                const unsigned s = h0 + h1 + h2 + h3;
                unsigned incl = s;
#pragma unroll
                for (int o = 1; o < 64; o <<= 1) { const unsigned t = __shfl_down(incl, o); if (lane + o < 64) incl += t; }
                const unsigned excl = incl - s;
                if (excl < kk && kk <= incl) {
                    unsigned rem = kk - excl; unsigned bin;
                    if (rem <= h3) { bin = 3; } else { rem -= h3; if (rem <= h2) { bin = 2; } else { rem -= h2; if (rem <= h1) { bin = 1; } else { rem -= h1; bin = 0; } } }
                    misc[0] = (prefix << 8) | (unsigned)(4 * lane + bin); misc[1] = rem;
                }
            }
            __syncthreads();
        }
        const unsigned thr = misc[0], kk = misc[1];
        unsigned kv[8]; unsigned cg_ = 0, ce = 0;
#pragma unroll
        for (int j = 0; j < 8; ++j) { kv[j] = keys[tid * 8 + j]; cg_ += kv[j] > thr ? 1u : 0u; ce += kv[j] == thr ? 1u : 0u; }
        unsigned ig = cg_, ie = ce;
#pragma unroll
        for (int o = 1; o < 64; o <<= 1) { const unsigned tg = __shfl_up(ig, o), te = __shfl_up(ie, o); if (lane >= o) { ig += tg; ie += te; } }
        if (lane == 63) { misc[8 + wid] = ig; misc[16 + wid] = ie; }
        __syncthreads();
        unsigned bg = ig - cg_, be = ie - ce;
        for (int w = 0; w < wid; ++w) { bg += misc[8 + w]; be += misc[16 + w]; }
#pragma unroll
        for (int j = 0; j < 8; ++j) { const int t = tid * 8 + j; const bool isg = kv[j] > thr, ise = kv[j] == thr; const bool s_ = isg || (ise && be < kk);
            const unsigned slot = bg + (be < kk ? be : kk);
            if (s_) { idx[task * 512 + slot] = t; gsel[task * 512 + slot] = __uint_as_float(kv[j]); tokl[slot] = t; }
            sel[((size_t)b * S_ + t) * 16 + e] = s_ ? (int)slot : -1;
            bg += isg ? 1u : 0u; be += ise ? 1u : 0u; }
        __syncthreads();
        { const int t = tokl[tid]; rstd_xs[(size_t)task * 512 + tid] = rstd_h[(size_t)b * S_ + t]; }
        __syncthreads();
    }
}

__device__ __forceinline__ void phase10(const Ptrs& P, int gw, int NGW, int lane) {
    const float* hbuf = (const float*)(P.ws + WS_H); const bf16_t* ybuf = (const bf16_t*)(P.ws + WS_XS); const int* sel = (const int*)(P.ws + WS_SEL);
    f32x4 gf[4];
#pragma unroll
    for (int j = 0; j < 4; ++j) gf[j] = ((const f32x4*)PGFINAL(P))[lane + 64 * j];
    for (int row = gw; row < T_; row += NGW) {
        const f32x4* hr = (const f32x4*)(hbuf + (size_t)row * D_) + lane; f32x4 v[4];
#pragma unroll
        for (int j = 0; j < 4; ++j) v[j] = hr[64 * j];
        const int sv = sel[(size_t)row * 16 + (lane & 15)]; const int b = row >> 12;
#pragma unroll
        for (int e = 0; e < 16; ++e) { const int s = __builtin_amdgcn_readlane(sv, e);
            if (s >= 0) { const u32x2* yp = (const u32x2*)(ybuf + ((size_t)(b * 16 + e) * 512 + s) * D_) + lane;
#pragma unroll
                for (int j = 0; j < 4; ++j) { const u32x2 w = yp[64 * j]; v[j][0] += bflo(w.x); v[j][1] += bfhi(w.x); v[j][2] += bflo(w.y); v[j][3] += bfhi(w.y); } } }
        float ss = 0.f;
#pragma unroll
        for (int j = 0; j < 4; ++j) ss += (v[j][0] * v[j][0] + v[j][1] * v[j][1]) + (v[j][2] * v[j][2] + v[j][3] * v[j][3]);
        ss = wave_sum(ss); const float rs = rsqrtf(ss * (1.0f / 1024.0f) + EPS_);
        f32x4* orow = (f32x4*)(P.out + (size_t)row * D_) + lane;
#pragma unroll
        for (int j = 0; j < 4; ++j) orow[64 * j] = v[j] * rs * gf[j];
    }
}

#ifndef MK_LAUNCHES
#define MK_LAUNCHES 1
#endif
constexpr int NPHASES = 11;

__global__ void __launch_bounds__(NTHREADS, 2) mk_fwd(Args args) {
    extern __shared__ __attribute__((aligned(16))) unsigned char lds_raw[];
    LAS unsigned char* lds = (LAS unsigned char*)lds_raw;
    cg::grid_group grid = cg::this_grid();
    const int tid = threadIdx.x, lane = tid & 63; const int wave = __builtin_amdgcn_readfirstlane(tid >> 6);
    const int G = gridDim.x, bx = blockIdx.x; const int vcu = (G % 8 == 0) ? (bx % 8) * (G / 8) + bx / 8 : bx;
    const int gw = vcu * 8 + wave, NGW = G * 8;
    const Args& P = args;
    unsigned char* ws = args.ws; unsigned char* dob = (unsigned char*)args.out;
    const int lo = args.ph_lo, hi = args.ph_hi;
    volatile LAS unsigned* xst = (volatile LAS unsigned*)(lds + LDS_BYTES - 16);
    if (tid < 4) xst[tid] = 0u;
    __syncthreads();
    XcdBarrier xbar; xbar.bar = (unsigned*)(args.ws + WS_CTL); xbar.x = 0; xbar.st = xst;
    if (args.coop) xbar = xcd_barrier_post((unsigned*)(args.ws + WS_CTL), xst);
#ifndef MK_ONLY
#define MK_ONLY -1
#endif
#define IN(k) ((MK_ONLY < 0 || MK_ONLY == (k)) && lo <= (k) && (k) < hi)
#ifndef MK_REPEAT
#define MK_REPEAT -1
#endif
#define REPS(k) ((MK_REPEAT == (k)) ? 2 : 1)
#ifndef MLA_CALL
#define MLA_CALL att::attn_unit<96, 64, 0, true>(lds, A, bh >> 3, bh & 7, U & 15)
#endif
#ifndef ATT_MEM_CALL
#define ATT_MEM_CALL att::attn_unit<128, 128, 1, false>(lds, A, bh >> 2, bh & 3, U & 15)
#endif
#ifndef MK_NA_V1
#define MK_NA_V1 0
#endif
#ifndef MK_CG_SEAMS
#define MK_CG_SEAMS 0
#endif
#define SEAM(k) do { if (IN(k) && IN((k) + 1)) { if ((k) < MK_CG_SEAMS) grid.sync(); else xcd_barrier(xbar); } } while (0)

    if (args.pad == 0x5eed) grid.sync();
    if (IN(0)) for (int rep = 0; rep < REPS(0); ++rep) { if (rep) xcd_barrier(xbar); phase0(P, lds, gw, NGW, wave, lane); }
    SEAM(0);
    if (IN(1)) for (int rep = 0; rep < REPS(1); ++rep) { if (rep) xcd_barrier(xbar);
        SchedP1 S{bx, G, (const char*)(dob + DO_XB), (const char*)(ws + WS_WIN), (const char*)(ws + WS_MEMB), (const char*)(ws + WS_WMK)};
        EpiP1 E{(const float*)(ws + WS_RSTDX), (const float*)(ws + WS_RSTDM), (bf16_t*)(ws + WS_NA), (bf16_t*)(ws + WS_ZC), (bf16_t*)(ws + WS_ZQM), (bf16_t*)(ws + WS_ZG), (bf16_t*)(ws + WS_KVMEM),
                (bf16_t*)(dob + DO_KPE), (float*)(ws + WS_SSQQ), (float*)(ws + WS_SSQKV), (const float*)(ws + WS_ROPE)};
        pg8::gemm_phase<EpiP1, SchedP1, false>(lds, 1024, 1024, S, E);
    }
    SEAM(1);
    if (IN(2)) for (int rep = 0; rep < REPS(2); ++rep) { if (rep) xcd_barrier(xbar);
        SchedP2 S{bx, G, (const char*)(ws + WS_ZC), (const char*)(ws + WS_WUQ), (const char*)(ws + WS_WUKV)};
        EpiP2 E{(const float*)(ws + WS_SSQQ), (const float*)(ws + WS_SSQKV), (bf16_t*)(dob + DO_QMLA), (bf16_t*)(dob + DO_KVBUF), (const float*)(ws + WS_ROPE)};
        pg8::gemm_phase<EpiP2, SchedP2, false>(lds, 768, 384, S, E);
    }
    SEAM(2);
    if (IN(3)) {
        if (REPS(31) == 2 && !MK_NA_V1) { na2::na_phase(lds, (const bf16_t*)(ws + WS_NA), (const bf16_t*)(ws + WS_NA) + (size_t)T_ * 512, (const bf16_t*)(ws + WS_NA) + (size_t)2 * T_ * 512, (bf16_t*)(ws + WS_ZC), args.in[4], vcu, G); xcd_barrier(xbar); }
        if (REPS(32) == 2) { att::AttnArgs A{(const bf16_t*)(ws + WS_ZQM), (const bf16_t*)(ws + WS_KVMEM), nullptr, (const bf16_t*)(ws + WS_KVMEM) + 512, (bf16_t*)(ws + WS_ZC), nullptr};
          for (int U = vcu; U < 512; U += G) { const int bh = U >> 4; ATT_MEM_CALL; } grid.sync(); }
        { att::AttnArgs A{(const bf16_t*)(dob + DO_QMLA), (const bf16_t*)(dob + DO_KVBUF), (const bf16_t*)(dob + DO_KPE), (const bf16_t*)(dob + DO_KVBUF) + 512, (bf16_t*)(ws + WS_ZC), nullptr};
          for (int rep = 0; rep < REPS(30); ++rep) { if (rep) xcd_barrier(xbar);
          for (int U = vcu; U < 1024; U += G) { const int bh = U >> 4; MLA_CALL; } } }
#if 0
#else
        na2::na_phase(lds, (const bf16_t*)(ws + WS_NA), (const bf16_t*)(ws + WS_NA) + (size_t)T_ * 512, (const bf16_t*)(ws + WS_NA) + (size_t)2 * T_ * 512, (bf16_t*)(ws + WS_NA), args.in[4], vcu, G);
#endif
        { att::AttnArgs A{(const bf16_t*)(ws + WS_ZQM), (const bf16_t*)(ws + WS_KVMEM), nullptr, (const bf16_t*)(ws + WS_KVMEM) + 512, (bf16_t*)(ws + WS_ZQM), nullptr};
          for (int U = vcu; U < 512; U += G) { const int bh = U >> 4; ATT_MEM_CALL; } }
    }
    SEAM(3);
    if (IN(4)) for (int rep = 0; rep < REPS(4); ++rep) { if (rep) xcd_barrier(xbar);
        SchedP4 S{bx, G, (const char*)(ws + WS_NA), (const char*)(ws + WS_ZC), (const char*)(ws + WS_ZQM), (const char*)(ws + WS_WO)};
        EpiP4 E{(const bf16_t*)(ws + WS_ZG), (bf16_t*)(dob + DO_MERGED)};
        pg8::gemm_phase<EpiP4, SchedP4, true>(lds, 512, 1536, S, E);
    }
    SEAM(4);
    if (IN(5)) for (int rep = 0; rep < REPS(5); ++rep) { if (rep) xcd_barrier(xbar);
        SchedP5 S{bx, G, (const char*)(dob + DO_MERGED), (const char*)(ws + WS_WOUT)};
        EpiP5 E{args.in[0], (float*)(ws + WS_H)};
        pg8::gemm_phase<EpiP5, SchedP5, false>(lds, 1024, 1024, S, E);
    }
    SEAM(5);
    if (IN(6)) for (int rep = 0; rep < REPS(6); ++rep) { if (rep) xcd_barrier(xbar); phase6(P, lds, gw, NGW, lane); }
    SEAM(6);
    if (IN(7)) for (int rep = 0; rep < REPS(7); ++rep) { if (rep) xcd_barrier(xbar); phase7(P, lds, G); }
    SEAM(7);
    if (IN(8)) for (int rep = 0; rep < REPS(8); ++rep) { if (rep) xcd_barrier(xbar);
        SchedP8 S{bx, G, (const char*)(ws + WS_HB), (const char*)(ws + WS_WGU)};
        EpiP8 E{(const float*)(ws + WS_RSTDXS), (bf16_t*)(dob + DO_ACT)};
        LAS int* gtab = (LAS int*)(lds + pg8::STAGE_BYTES);
        { const int* idxg = (const int*)(ws + WS_IDX); pg8::Unit u_;
          for (int i = 0; S.next(i, u_); ++i) { if (i < 14) { if (tid < 256) { const int row = u_.pm * 256 + tid; gtab[i * 256 + tid] = idxg[row] + (row >> 13) * S_; } } }
          __syncthreads(); }
        pg8::gemm_phase<EpiP8, SchedP8, false, true>(lds, 1024, 1024, S, E, gtab);
    }
    SEAM(8);
    if (IN(9)) for (int rep = 0; rep < REPS(9); ++rep) { if (rep) xcd_barrier(xbar);
        SchedP9 S{bx, G, (const char*)(dob + DO_ACT), (const char*)(ws + WS_WD)};
        EpiP9 E{(const float*)(ws + WS_GSEL), (bf16_t*)(ws + WS_XS)};
        pg8::gemm_phase<EpiP9, SchedP9, false>(lds, 1024, 1024, S, E);
    }
    SEAM(9);
    if (IN(10)) for (int rep = 0; rep < REPS(10); ++rep) { if (rep) xcd_barrier(xbar); phase10(P, gw, NGW, lane); }
#undef IN
#undef SEAM
}

extern "C" void kernel_launch(void* const* d_in, const int* in_sizes, int n_in, void* d_out, int out_size, void* d_ws, size_t ws_size, hipStream_t stream) {
    static int grid = 0;
    if (grid == 0) {
        if (n_in != 22 || out_size != T_ * D_ || ws_size < WS_END) { fprintf(stderr, "kernel_launch: unexpected shapes (n_in %d out %d ws %zu)\n", n_in, out_size, ws_size); grid = -1; return; }
        int dev = 0, cus = 0, per_cu = 0;
        hipGetDevice(&dev); hipDeviceGetAttribute(&cus, hipDeviceAttributeMultiprocessorCount, dev);
        if (hipFuncSetAttribute((const void*)mk_fwd, hipFuncAttributeMaxDynamicSharedMemorySize, LDS_BYTES) != hipSuccess) { fprintf(stderr, "kernel_launch: hipFuncSetAttribute failed\n"); grid = -1; return; }
        hipOccupancyMaxActiveBlocksPerMultiprocessor(&per_cu, (const void*)mk_fwd, NTHREADS, LDS_BYTES);
        (void)hipGetLastError();
        if (per_cu < 1) { fprintf(stderr, "kernel_launch: occupancy query says %d blocks per CU\n", per_cu); per_cu = 1; }
        grid = cus * 1;
        fprintf(stderr, "kernel_launch: cus %d per_cu %d grid %d ws %zu\n", cus, per_cu, grid, ws_size);
    }
    if (grid < 0) return;
    if (hipMemsetAsync((char*)d_ws + WS_CTL, 0, CTL_BYTES, stream) != hipSuccess) { fprintf(stderr, "kernel_launch: memset failed\n"); return; }
    Args a{};
    for (int i = 0; i < 22; ++i) a.in[i] = (const float*)d_in[i];
    a.out = (float*)d_out; a.ws = (unsigned char*)d_ws;
#if MK_LAUNCHES == 1
    a.ph_lo = 0; a.ph_hi = NPHASES; a.coop = 1;
    void* kargs[] = {&a};
    hipError_t e = hipLaunchCooperativeKernel((const void*)mk_fwd, dim3(grid), dim3(NTHREADS), kargs, LDS_BYTES, stream);
    if (e != hipSuccess) fprintf(stderr, "kernel_launch: cooperative launch failed: %s (grid %d)\n", hipGetErrorString(e), grid);
#else
    for (int p = 0; p < NPHASES; ++p) { a.ph_lo = p; a.ph_hi = p + 1; a.coop = 0; hipLaunchKernelGGL(mk_fwd, dim3(grid), dim3(NTHREADS), LDS_BYTES, stream, a); }
#endif
}
```

```cpp
#include <hip/hip_runtime.h>
#include <hip/hip_cooperative_groups.h>
#include <cstdio>
#include <cstdint>
namespace cg = cooperative_groups;

#define LAS __attribute__((address_space(3)))
typedef unsigned short bf16_t;
typedef short bf16x8 __attribute__((ext_vector_type(8)));
typedef short s16x4 __attribute__((ext_vector_type(4)));
typedef float f32x2 __attribute__((ext_vector_type(2)));
typedef float f32x4 __attribute__((ext_vector_type(4)));
typedef float f32x16 __attribute__((ext_vector_type(16)));
typedef unsigned u32x2 __attribute__((ext_vector_type(2)));
typedef unsigned u32x4 __attribute__((ext_vector_type(4)));

constexpr int T_ = 32768, S_ = 4096, D_ = 1024, NB_ = 8, INC_ = 5792, NZ_ = 5888;
constexpr float EPS_ = 1e-6f;
constexpr float LOG2E = 1.4426950408889634f;
constexpr float C_NA = 0.125f * LOG2E, C_MLA = 0.10206207261596577f * LOG2E, C_MEM = 0.08838834764831845f * LOG2E;

constexpr size_t MiB = (size_t)1 << 20;
constexpr size_t WS_WIN = 0;
constexpr size_t WS_WUQ = 12 * MiB;
constexpr size_t WS_WUKV = 13 * MiB;
constexpr size_t WS_WMK = 14 * MiB;
constexpr size_t WS_WO = 16 * MiB;
constexpr size_t WS_WOUT = 19 * MiB;
constexpr size_t WS_WGU = 21 * MiB;
constexpr size_t WS_WD = 85 * MiB;
constexpr size_t WS_RSTDX = 117 * MiB;
constexpr size_t WS_RSTDM = WS_RSTDX + 128 * 1024;
constexpr size_t WS_RSTDH = WS_RSTDM + 128 * 1024;
constexpr size_t WS_ROPE = WS_RSTDH + 128 * 1024;
constexpr size_t WS_RSTDXS = WS_ROPE + 128 * 1024;
constexpr size_t WS_GSEL = WS_RSTDXS + 256 * 1024;
constexpr size_t WS_IDX = WS_GSEL + 256 * 1024;
constexpr size_t WS_SSQQ = 119 * MiB;
constexpr size_t WS_SSQKV = 121 * MiB;
constexpr size_t WS_AFF = 122 * MiB;
constexpr size_t WS_SEL = 124 * MiB;
constexpr size_t WS_MEMB = 126 * MiB;
constexpr size_t WS_KVMEM = 130 * MiB;
constexpr size_t WS_ZG = 134 * MiB;
constexpr size_t WS_H = 134 * MiB;
constexpr size_t WS_HB = 262 * MiB;
constexpr size_t WS_NA = 326 * MiB;
constexpr size_t WS_XS = 326 * MiB;
constexpr size_t WS_ZC = 422 * MiB;
constexpr size_t WS_ZQM = 470 * MiB;
constexpr size_t WS_CTL = 502 * MiB;
constexpr size_t CTL_BYTES = 16384;
constexpr size_t WS_END = 503 * MiB;
constexpr size_t DO_XB = 0, DO_QMLA = 0, DO_KVBUF = 48 * MiB, DO_KPE = 112 * MiB, DO_MERGED = 0, DO_ACT = 0;

constexpr int LDS_BYTES = 147456;
constexpr int NTHREADS = 512;

__device__ __forceinline__ unsigned cvt_pk_bf16(float lo, float hi) { unsigned r; asm volatile("v_cvt_pk_bf16_f32 %0, %1, %2" : "=v"(r) : "v"(lo), "v"(hi)); return r; }
__device__ __forceinline__ float bf2f(unsigned short b) { return __uint_as_float(((unsigned)b) << 16); }
__device__ __forceinline__ float bflo(unsigned w) { return __uint_as_float(w << 16); }
__device__ __forceinline__ float bfhi(unsigned w) { return __uint_as_float(w & 0xffff0000u); }
__device__ __forceinline__ float wave_sum(float v) {
#pragma unroll
    for (int o = 1; o < 64; o <<= 1) v += __shfl_xor(v, o);
    return v;
}
__device__ __forceinline__ float fast_exp2(float x) { return __builtin_amdgcn_exp2f(x); }
__device__ __forceinline__ float fast_rcp(float x) { return __builtin_amdgcn_rcpf(x); }
__device__ __forceinline__ int crow(int r, int hi) { return (r & 3) + 8 * (r >> 2) + 4 * hi; }


#define XB_TMO      128
#define XB_XCNT(j)  (256  + 64 * (j))
#define XB_XSUB(j)  (1280 + 64 * (j))
#define XB_XGEN(j)  (2304 + 64 * (j))
#define XB_TOP      3328
#define XB_TOPGEN   3392
#define XCD_BAR_WORDS 3456
#define XB_SPIN_CAP (1u << 18)
__device__ __forceinline__ unsigned xb_ld(unsigned* p)              { return __hip_atomic_load(p, __ATOMIC_RELAXED, __HIP_MEMORY_SCOPE_AGENT); }
__device__ __forceinline__ unsigned xb_add(unsigned* p, unsigned v) { return __hip_atomic_fetch_add(p, v, __ATOMIC_RELAXED, __HIP_MEMORY_SCOPE_AGENT); }
__device__ __forceinline__ unsigned xb_xcc_id() { return (unsigned)__builtin_amdgcn_s_getreg((3 << 11) | 20) & 0xFu; }
#define XB_SPIN(cond, bar) do { unsigned _sp = 0; while (cond) { __builtin_amdgcn_s_sleep(1); \
    if ((++_sp & 255u) == 0u) { if (xb_ld(&(bar)[XB_TMO])) break; if (_sp > XB_SPIN_CAP) { atomicAdd(&(bar)[XB_TMO], 1u); break; } } } } while (0)
struct XcdBarrier { unsigned* bar; unsigned x; volatile LAS unsigned* st; };
__device__ __forceinline__ XcdBarrier xcd_barrier_post(unsigned* bar, volatile LAS unsigned* st) {
    XcdBarrier b; b.bar = bar; b.x = xb_xcc_id(); b.st = st;
    if (threadIdx.x == 0) (void)xb_add(&bar[XB_XCNT(b.x)], 1u);
    return b;
}
__device__ __forceinline__ void xcd_barrier_complete(unsigned* bar, unsigned x, unsigned& nloc, unsigned& nx) {
    const unsigned G = gridDim.x * gridDim.y * gridDim.z;
    unsigned sum, cnt, mine, sp = 0u;
    for (;;) {
        sum = 0u; cnt = 0u; mine = 0u;
#pragma unroll
        for (unsigned j = 0; j < 16; ++j) { const unsigned c = xb_ld(&bar[XB_XCNT(j)]); sum += c; cnt += (c > 0u) ? 1u : 0u; mine = (j == x) ? c : mine; }
        if (sum == G) break;
        __builtin_amdgcn_s_sleep(1);
        if ((++sp & 255u) == 0u) { if (xb_ld(&bar[XB_TMO])) break; if (sp > XB_SPIN_CAP) { atomicAdd(&bar[XB_TMO], 1u); break; } }
    }
    nloc = mine > 0u ? mine : 1u; nx = cnt > 0u ? cnt : 1u;
}
__device__ __forceinline__ void xcd_barrier(const XcdBarrier& b) {
    asm volatile("s_waitcnt vmcnt(0)" ::: "memory");
    __syncthreads();
    if (threadIdx.x == 0) {
        unsigned* bar = b.bar;
        __builtin_amdgcn_s_waitcnt(0);
        unsigned nloc = b.st[0], nx = b.st[1];
        if (nloc == 0u) { xcd_barrier_complete(bar, b.x, nloc, nx); b.st[0] = nloc; b.st[1] = nx; }
        const unsigned old = xb_add(&bar[XB_XSUB(b.x)], 1u);
        const unsigned gen = old / nloc;
        if (old + 1u == (gen + 1u) * nloc) {
            __builtin_amdgcn_fence(__ATOMIC_RELEASE, "agent");
            asm volatile("s_waitcnt vmcnt(0)" ::: "memory");
            const unsigned og = xb_add(&bar[XB_TOP], 1u);
            const unsigned tg = og / nx;
            if (og + 1u == (tg + 1u) * nx) xb_add(&bar[XB_TOPGEN], 1u);
            else XB_SPIN(xb_ld(&bar[XB_TOPGEN]) == tg, bar);
            __builtin_amdgcn_fence(__ATOMIC_ACQUIRE, "agent");
            xb_add(&bar[XB_XGEN(b.x)], 1u);
            asm volatile("s_waitcnt vmcnt(0)" ::: "memory");
        } else {
            XB_SPIN(xb_ld(&bar[XB_XGEN(b.x)]) == gen, bar);
            __builtin_amdgcn_fence(__ATOMIC_ACQUIRE, "agent");
            asm volatile("s_waitcnt vmcnt(0)" ::: "memory");
        }
    }
    __syncthreads();
}

struct Args { const float* in[22]; float* out; unsigned char* ws; int ph_lo, ph_hi, coop, pad; };

namespace pg8 {
constexpr int BM = 256, BK = 64, HALF = 128, HTB = HALF * BK * 2, STAGE_BYTES = 8 * HTB, NXCD = 8, WGM = 8;
__device__ __forceinline__ int lds_byte(int r, int c) { const int st = (r >> 4) * 2 + (c >> 5), rr = r & 15, cc = c & 31, ob = rr * 64 + cc * 2; return st * 1024 + (ob ^ (((ob >> 9) & 1) << 5)); }
__device__ __forceinline__ void stage_rc(int b, int& R, int& C) { const int st = b / 1024, sb = b % 1024, swz = sb ^ (((sb >> 9) & 1) << 5); R = (st >> 1) * 16 + swz / 64; C = (st & 1) * 32 + (swz % 64) / 2; }
__device__ __forceinline__ int perm32(int rho) { const int n = rho >> 4, i = rho & 15; return 8 * (i >> 2) + 4 * n + (i & 3); }

struct Unit { int pm, pn, kind, nt, aux; const char* A; const char* A1; const char* A2; const char* B; };

__device__ __forceinline__ void tile_order(int L, int nM, int nN, int& pm, int& pn) {
    const int nwg = nM * nN; int wgid = L;
    { const int q = nwg / NXCD, r = nwg % NXCD, xcd = wgid % NXCD, off = wgid / NXCD; wgid = (xcd < r ? xcd * (q + 1) : r * (q + 1) + (xcd - r) * q) + off; }
    const int nig = WGM * nN, gid = wgid / nig, fm = gid * WGM, gsz = (nM - fm) < WGM ? (nM - fm) : WGM;
    pm = fm + ((wgid % nig) % gsz); pn = (wgid % nig) / gsz;
}

template <class Epi, class Sched, bool SEG3, bool GATHER = false>
__device__ __forceinline__ void gemm_phase(LAS unsigned char* lds, const int lda, const int ldb, const Sched& S, const Epi& E, const LAS int* gtab = nullptr) {
    int tid_ = threadIdx.x; asm volatile("" : "+v"(tid_));
    const int tid = tid_, wid = __builtin_amdgcn_readfirstlane(tid >> 6), lane = tid & 63, wr = wid >> 2, wc = wid & 3, fr = lane & 15, fq = lane >> 4;
    unsigned voffA[2], voffB[2]; int gR[2]; unsigned gC[2];
#pragma unroll
    for (int i = 0; i < 2; ++i) { int R, C; stage_rc(tid * 16 + i * 8192, R, C); gR[i] = R; gC[i] = (unsigned)C * 2u; const int Rb = Epi::PERM ? ((R & ~31) + perm32(R & 31)) : R;
        voffA[i] = (unsigned)(R * lda + C) * 2u; voffB[i] = (unsigned)(Rb * ldb + C) * 2u; }
    const size_t kstep = (size_t)(BK * 2);
    const size_t hstepA = (size_t)HALF * lda * 2, hstepB = (size_t)HALF * ldb * 2;
    const unsigned ldsw = (unsigned)wid * 1024u;
    const int aoff = lds_byte(wr * 64 + fr, fq * 8), boff = lds_byte(wc * 32 + fr, fq * 8);
#define PG8_SA(b, h) (((b) * 2 + (h)) * HTB)
#define PG8_SB(b, h) ((4 + (b) * 2 + (h)) * HTB)
#define PG8_STAGE(bufoff, gbase, voff) do { _Pragma("unroll") for (int _i = 0; _i < 2; ++_i) \
        __builtin_amdgcn_global_load_lds((const unsigned*)((const char*)(gbase) + (voff)[_i]), (LAS unsigned*)(lds + (bufoff) + ldsw + _i * 8192), 16, 0, 0); } while (0)
#define PG8_GLOAD(dst, ord) do { _Pragma("unroll") for (int _h = 0; _h < 2; ++_h) _Pragma("unroll") for (int _i = 0; _i < 2; ++_i) dst[_h][_i] = (unsigned)gtab[(ord) * 256 + _h * 128 + gR[_i]] * (unsigned)(lda * 2) + gC[_i]; } while (0)
#define PG8_STAGE_A(bufoff, kptr, h, VS) do { if constexpr (GATHER) { PG8_STAGE(bufoff, kptr, VS[h]); } else { PG8_STAGE(bufoff, (kptr) + (h) * hstepA, voffA); } } while (0)
#define PG8_LDA(dst, b, h) do { _Pragma("unroll") for (int m = 0; m < 4; ++m) _Pragma("unroll") for (int k = 0; k < 2; ++k) dst[m][k] = *(const LAS bf16x8*)(lds + PG8_SA(b, h) + aoff + m * 2048 + k * 1024); } while (0)
#define PG8_LDB(dst, b, h) do { _Pragma("unroll") for (int n = 0; n < 2; ++n) _Pragma("unroll") for (int k = 0; k < 2; ++k) dst[n][k] = *(const LAS bf16x8*)(lds + PG8_SB(b, h) + boff + n * 2048 + k * 1024); } while (0)
#define PG8_MMA(ai, bj, At, Bt) do { __builtin_amdgcn_s_setprio(1); _Pragma("unroll") for (int m = 0; m < 4; ++m) _Pragma("unroll") for (int n = 0; n < 2; ++n) _Pragma("unroll") for (int k = 0; k < 2; ++k) \
        acc[ai][bj][m][n] = __builtin_amdgcn_mfma_f32_16x16x32_bf16(Bt[n][k], At[m][k], acc[ai][bj][m][n], 0, 0, 0); __builtin_amdgcn_s_setprio(0); } while (0)
#define PG8_WAIT_V(n) asm volatile("s_waitcnt vmcnt(" #n ")" ::: "memory")
#define PG8_WAIT_L(n) asm volatile("s_waitcnt lgkmcnt(" #n ")" ::: "memory")
#define PG8_BAR __builtin_amdgcn_s_barrier()
#define PG8_SCHED __builtin_amdgcn_sched_barrier(0)
#define PG8_TA(u, kt) (SEG3 ? (((kt) < 8 ? (u).A : ((kt) < 16 ? (u).A1 : (u).A2)) + (size_t)((kt) & 7) * kstep) : ((u).A + (size_t)(kt) * kstep))
#define PG8_TB(u, kt) ((u).B + (size_t)(kt) * kstep)
    Unit cur, nxt; int ui = 0;
    if (!S.next(0, cur)) return;
    f32x4 acc[2][2][4][2];
#pragma unroll
    for (int a = 0; a < 2; ++a)
#pragma unroll
        for (int b = 0; b < 2; ++b)
#pragma unroll
            for (int m = 0; m < 4; ++m)
#pragma unroll
                for (int n = 0; n < 2; ++n) acc[a][b][m][n] = (f32x4){0.f, 0.f, 0.f, 0.f};
    bf16x8 At[4][2], B0[2][2], B1[2][2];
    unsigned vC[2][2], vN[2][2];
#pragma unroll
    for (int _h = 0; _h < 2; ++_h)
#pragma unroll
        for (int _i = 0; _i < 2; ++_i) { vC[_h][_i] = 0u; vN[_h][_i] = 0u; }
    if constexpr (GATHER) { PG8_GLOAD(vC, 0); }
    {
        const char* cA = PG8_TA(cur, 0); const char* cB = PG8_TB(cur, 0);
        PG8_STAGE(PG8_SB(0, 0), cB, voffB); PG8_STAGE(PG8_SB(0, 1), cB + hstepB, voffB); PG8_STAGE_A(PG8_SA(0, 0), cA, 0, vC); PG8_STAGE_A(PG8_SA(0, 1), cA, 1, vC);
        if (wr == 1) PG8_BAR;
        PG8_WAIT_V(2); PG8_BAR;
        const char* cA1 = PG8_TA(cur, 1); const char* cB1 = PG8_TB(cur, 1);
        PG8_STAGE(PG8_SB(1, 0), cB1, voffB); PG8_STAGE_A(PG8_SA(1, 0), cA1, 0, vC); PG8_STAGE(PG8_SB(1, 1), cB1 + hstepB, voffB);
        PG8_WAIT_V(6); PG8_BAR;
    }
    for (;;) {
        const bool has_next = S.next(ui + 1, nxt);
        if constexpr (GATHER) { if (has_next) PG8_GLOAD(vN, ui + 1); }
        const int nt = cur.nt;
        for (int t = 0; t < nt; t += 2) {
            const bool last = (t == nt - 2);
            const char* a1 = PG8_TA(cur, t + 1);
            const char* a2; const char* b2;
            if (last) { if (has_next) { a2 = PG8_TA(nxt, 0); b2 = PG8_TB(nxt, 0); } else { a2 = PG8_TA(cur, 0); b2 = PG8_TB(cur, 0); } }
            else { a2 = PG8_TA(cur, t + 2); b2 = PG8_TB(cur, t + 2); }
            const char* a3 = a2 + kstep; const char* b3 = b2 + kstep;
            unsigned vS[2][2];
#pragma unroll
            for (int _h = 0; _h < 2; ++_h)
#pragma unroll
                for (int _i = 0; _i < 2; ++_i) vS[_h][_i] = (last && has_next) ? vN[_h][_i] : vC[_h][_i];
            if constexpr (Epi::HAS_MID) { if (t > 0 && (t & 7) == 0) E.mid(acc, cur, t >> 3, wr, wc, fr, fq); }
            PG8_LDB(B0, 0, 0); PG8_LDB(B1, 0, 1); PG8_SCHED; PG8_LDA(At, 0, 0); PG8_STAGE_A(PG8_SA(1, 1), a1, 1, vC);
            PG8_WAIT_V(8); PG8_WAIT_L(0); PG8_BAR; PG8_MMA(0, 0, At, B0); PG8_MMA(0, 1, At, B1); PG8_BAR; PG8_SCHED;
            PG8_LDA(At, 0, 1); PG8_STAGE(PG8_SB(0, 0), b2, voffB); PG8_STAGE(PG8_SB(0, 1), b2 + hstepB, voffB); PG8_STAGE_A(PG8_SA(0, 0), a2, 0, vS);
            PG8_WAIT_V(8); PG8_WAIT_L(0); PG8_BAR; PG8_MMA(1, 0, At, B0); PG8_MMA(1, 1, At, B1); PG8_BAR; PG8_SCHED;
            PG8_LDB(B0, 1, 0); PG8_LDB(B1, 1, 1); PG8_SCHED; PG8_LDA(At, 1, 0); PG8_STAGE_A(PG8_SA(0, 1), a2, 1, vS);
            PG8_WAIT_V(8); PG8_WAIT_L(0); PG8_BAR; PG8_MMA(0, 0, At, B0); PG8_MMA(0, 1, At, B1); PG8_BAR; PG8_SCHED;
            PG8_LDA(At, 1, 1); PG8_STAGE(PG8_SB(1, 0), b3, voffB); PG8_STAGE(PG8_SB(1, 1), b3 + hstepB, voffB); PG8_STAGE_A(PG8_SA(1, 0), a3, 0, vS);
            PG8_WAIT_V(8); PG8_WAIT_L(0); PG8_BAR; PG8_MMA(1, 0, At, B0); PG8_MMA(1, 1, At, B1); PG8_BAR; PG8_SCHED;
        }
        if (wr == 0) PG8_BAR;
        E(acc, cur, wr, wc, fr, fq);
        if (!has_next) break;
#pragma unroll
        for (int a = 0; a < 2; ++a)
#pragma unroll
            for (int b = 0; b < 2; ++b)
#pragma unroll
                for (int m = 0; m < 4; ++m)
#pragma unroll
                    for (int n = 0; n < 2; ++n) acc[a][b][m][n] = (f32x4){0.f, 0.f, 0.f, 0.f};
        cur = nxt; ++ui;
#pragma unroll
        for (int _h = 0; _h < 2; ++_h)
#pragma unroll
            for (int _i = 0; _i < 2; ++_i) vC[_h][_i] = vN[_h][_i];
        if (wr == 1) PG8_BAR;
    }
    PG8_WAIT_V(0);
    PG8_BAR;
#undef PG8_SA
#undef PG8_SB
#undef PG8_STAGE
#undef PG8_STAGE_A
#undef PG8_GLOAD
#undef PG8_LDA
#undef PG8_LDB
#undef PG8_MMA
#undef PG8_WAIT_V
#undef PG8_WAIT_L
#undef PG8_BAR
#undef PG8_SCHED
#undef PG8_TA
#undef PG8_TB
}
}

__device__ __forceinline__ u32x4 pack8(const f32x4 v0, const f32x4 v1) { u32x4 w; w.x = cvt_pk_bf16(v0[0], v0[1]); w.y = cvt_pk_bf16(v0[2], v0[3]); w.z = cvt_pk_bf16(v1[0], v1[1]); w.w = cvt_pk_bf16(v1[2], v1[3]); return w; }
__device__ __forceinline__ void rope8(f32x4& v0, f32x4& v1, int row, int fq, const float* rope) {
    const int t = row & (S_ - 1); const int pos = (fq >> 1) ? (t & 63) : (t >> 6);
    const f32x4* cs = (const f32x4*)(rope + (pos * 8 + 4 * (fq & 1)) * 2);
    const f32x4 c01 = cs[0], c23 = cs[1];
    float a, b;
    a = v0[0]; b = v0[1]; v0[0] = a * c01[0] - b * c01[1]; v0[1] = a * c01[1] + b * c01[0];
    a = v0[2]; b = v0[3]; v0[2] = a * c01[2] - b * c01[3]; v0[3] = a * c01[3] + b * c01[2];
    a = v1[0]; b = v1[1]; v1[0] = a * c23[0] - b * c23[1]; v1[1] = a * c23[1] + b * c23[0];
    a = v1[2]; b = v1[3]; v1[2] = a * c23[2] - b * c23[3]; v1[3] = a * c23[3] + b * c23[2];
}

__device__ __forceinline__ float sig_den(float x) { x = fminf(fmaxf(x, -30.f), 30.f); return 1.0f + fast_exp2(-LOG2E * x); }
struct EpiP1 {
    static constexpr bool PERM = true, HAS_MID = false;
    const float* rstd_x; const float* rstd_m; bf16_t* na; bf16_t* zc; bf16_t* zqm; bf16_t* zg; bf16_t* kvmem; bf16_t* kpe; float* ssq_q; float* ssq_kv; const float* rope;
    __device__ __forceinline__ void operator()(const f32x4 (&acc)[2][2][4][2], const pg8::Unit& u, int wr, int wc, int fr, int fq) const {
        const int row0 = u.pm * 256 + wr * 64 + fr; const int pn = u.pn;
        bf16_t* base; int ld, colt; const float* rsp;
        if (u.kind == 0) { rsp = rstd_x;
            if (pn < 6) { base = na + (size_t)(pn >> 1) * T_ * 512; ld = 512; colt = (pn & 1) * 256; }
            else if (pn < 9) { base = zc; ld = 768; colt = (pn - 6) * 256; }
            else if (pn < 11) { base = zqm; ld = 512; colt = (pn - 9) * 256; }
            else { base = zg; ld = 3072; colt = (pn - 11) * 256; } }
        else { rsp = rstd_m; base = kvmem; ld = 1024; colt = pn * 256; }
        const int col0 = colt + wc * 32 + 8 * fq;
        const bool stats = (u.kind == 0) && (pn >= 6) && (pn < 9); const bool isgate = (u.kind == 0) && (pn >= 11);
#pragma unroll
        for (int ai = 0; ai < 2; ++ai)
#pragma unroll
            for (int m = 0; m < 4; ++m) { const int row = row0 + ai * 128 + m * 16; const float rs = rsp[row]; bf16_t* rowp = base + (size_t)row * ld + col0;
#pragma unroll
                for (int bj = 0; bj < 2; ++bj) { f32x4 v0 = acc[ai][bj][m][0] * rs, v1 = acc[ai][bj][m][1] * rs;
                    if (isgate) {
#pragma unroll
                        for (int e = 0; e < 4; ++e) { v0[e] = sig_den(v0[e]); v1[e] = sig_den(v1[e]); } }
                    *(u32x4*)(rowp + bj * 128) = pack8(v0, v1);
                    if (stats) { const int idx = (pn - 6) * 2 + bj;
                        if (idx < 5) { float s = (v0[0] * v0[0] + v0[1] * v0[1]) + (v0[2] * v0[2] + v0[3] * v0[3]) + (v1[0] * v1[0] + v1[1] * v1[1]) + (v1[2] * v1[2] + v1[3] * v1[3]);
                            s += __shfl_xor(s, 16); s += __shfl_xor(s, 32);
                            if (fq == 0) { if (idx < 3) ssq_q[(size_t)row * 12 + idx * 4 + wc] = s; else ssq_kv[(size_t)row * 8 + (idx - 3) * 4 + wc] = s; } }
                        else if (wc == 0) { rope8(v0, v1, row, fq, rope); *(u32x4*)(kpe + (size_t)row * 32 + 8 * fq) = pack8(v0, v1); } } } }
    }
};
struct SchedP1 {
    int c, G; const char* xb; const char* win; const char* memb; const char* wmk;
    __device__ __forceinline__ bool next(int i, pg8::Unit& u) const {
        const int L = i * G + c; int pm, pn;
        if (L < 2944) { pg8::tile_order(L, 128, 23, pm, pn); u.pm = pm; u.pn = pn; u.kind = 0; u.nt = 16; u.aux = 0; u.A = xb + (size_t)pm * 256 * 2048; u.B = win + (size_t)pn * 256 * 2048; u.A1 = u.A; u.A2 = u.A; return true; }
        if (L < 2976) { pg8::tile_order(L - 2944, 8, 4, pm, pn); u.pm = pm; u.pn = pn; u.kind = 1; u.nt = 16; u.aux = 0; u.A = memb + (size_t)pm * 256 * 2048; u.B = wmk + (size_t)pn * 256 * 2048; u.A1 = u.A; u.A2 = u.A; return true; }
        return false;
    }
};

struct EpiP2 {
    static constexpr bool PERM = true, HAS_MID = false;
    const float* ssq_q; const float* ssq_kv; bf16_t* qmla; bf16_t* kvbuf; const float* rope;
    __device__ __forceinline__ void operator()(const f32x4 (&acc)[2][2][4][2], const pg8::Unit& u, int wr, int wc, int fr, int fq) const {
        const int row0 = u.pm * 256 + wr * 64 + fr; const int pn = u.pn;
        float rs[2][4];
        if (u.kind == 0) {
#pragma unroll
            for (int ai = 0; ai < 2; ++ai)
#pragma unroll
                for (int m = 0; m < 4; ++m) { const f32x4* p = (const f32x4*)(ssq_q + (size_t)(row0 + ai * 128 + m * 16) * 12); const f32x4 a = p[0], b = p[1], c = p[2];
                    const float s = ((a[0] + a[1]) + (a[2] + a[3])) + ((b[0] + b[1]) + (b[2] + b[3])) + ((c[0] + c[1]) + (c[2] + c[3])); rs[ai][m] = rsqrtf(s * (1.0f / 384.0f) + EPS_); }
        } else {
#pragma unroll
            for (int ai = 0; ai < 2; ++ai)
#pragma unroll
                for (int m = 0; m < 4; ++m) { const f32x4* p = (const f32x4*)(ssq_kv + (size_t)(row0 + ai * 128 + m * 16) * 8); const f32x4 a = p[0], b = p[1];
                    const float s = ((a[0] + a[1]) + (a[2] + a[3])) + ((b[0] + b[1]) + (b[2] + b[3])); rs[ai][m] = rsqrtf(s * (1.0f / 256.0f) + EPS_); }
        }
        bf16_t* base = u.kind == 0 ? qmla : kvbuf; const int ld = u.kind == 0 ? 768 : 1024;
        const int col0 = pn * 256 + wc * 32 + 8 * fq;
#pragma unroll
        for (int bj = 0; bj < 2; ++bj) { const bool isrope = (u.kind == 0) && (((8 * pn + 4 * bj + wc) % 3) == 2);
#pragma unroll
            for (int ai = 0; ai < 2; ++ai)
#pragma unroll
                for (int m = 0; m < 4; ++m) { const int row = row0 + ai * 128 + m * 16; f32x4 v0 = acc[ai][bj][m][0] * rs[ai][m], v1 = acc[ai][bj][m][1] * rs[ai][m];
                    if (isrope) rope8(v0, v1, row, fq, rope);
                    *(u32x4*)(base + (size_t)row * ld + col0 + bj * 128) = pack8(v0, v1); } }
    }
};
struct SchedP2 {
    int c, G; const char* zc; const char* wuq; const char* wukv;
    __device__ __forceinline__ bool next(int i, pg8::Unit& u) const {
        const int L = i * G + c; int pm, pn;
        if (L < 384) { pg8::tile_order(L, 128, 3, pm, pn); u.pm = pm; u.pn = pn; u.kind = 0; u.nt = 6; u.aux = 0; u.A = zc + (size_t)pm * 256 * 1536; u.B = wuq + (size_t)pn * 256 * 768; u.A1 = u.A; u.A2 = u.A; return true; }
        if (L < 896) { pg8::tile_order(L - 384, 128, 4, pm, pn); u.pm = pm; u.pn = pn; u.kind = 1; u.nt = 4; u.aux = 0; u.A = zc + (size_t)pm * 256 * 1536 + 768; u.B = wukv + (size_t)pn * 256 * 768; u.A1 = u.A; u.A2 = u.A; return true; }
        return false;
    }
};

struct EpiP4 {
    static constexpr bool PERM = true, HAS_MID = true;
    const bf16_t* zg; bf16_t* merged;
    __device__ __forceinline__ void mid(f32x4 (&acc)[2][2][4][2], const pg8::Unit& u, int seg, int wr, int wc, int fr, int fq) const {
        const int row0 = u.pm * 256 + wr * 64 + fr; const int col0 = u.pn * 256 + wc * 32 + 8 * fq;
#pragma unroll
        for (int ai = 0; ai < 2; ++ai) {
            u32x4 ga[4][2], gb[4][2];
#pragma unroll
            for (int m = 0; m < 4; ++m) { const bf16_t* gp = zg + (size_t)(row0 + ai * 128 + m * 16) * 3072 + col0 + (seg - 1) * 1024;
#pragma unroll
                for (int bj = 0; bj < 2; ++bj) { ga[m][bj] = *(const u32x4*)(gp + bj * 128); gb[m][bj] = *(const u32x4*)(gp + 1024 + bj * 128); } }
#pragma unroll
            for (int m = 0; m < 4; ++m)
#pragma unroll
                for (int bj = 0; bj < 2; ++bj)
#pragma unroll
                    for (int e = 0; e < 4; ++e) { const unsigned wa = ga[m][bj][e], wb = gb[m][bj][e];
                        const float r0 = bflo(wb) * fast_rcp(bflo(wa)), r1 = bfhi(wb) * fast_rcp(bfhi(wa));
                        acc[ai][bj][m][e >> 1][(e & 1) * 2] *= r0; acc[ai][bj][m][e >> 1][(e & 1) * 2 + 1] *= r1; }
        }
    }
    __device__ __forceinline__ void operator()(const f32x4 (&acc)[2][2][4][2], const pg8::Unit& u, int wr, int wc, int fr, int fq) const {
        const int row0 = u.pm * 256 + wr * 64 + fr; const int col0 = u.pn * 256 + wc * 32 + 8 * fq;
#pragma unroll
        for (int ai = 0; ai < 2; ++ai) {
            u32x4 gg[4][2];
#pragma unroll
            for (int m = 0; m < 4; ++m) { const bf16_t* gp = zg + (size_t)(row0 + ai * 128 + m * 16) * 3072 + col0 + 2048;
#pragma unroll
                for (int bj = 0; bj < 2; ++bj) gg[m][bj] = *(const u32x4*)(gp + bj * 128); }
#pragma unroll
            for (int m = 0; m < 4; ++m) { const int row = row0 + ai * 128 + m * 16;
#pragma unroll
                for (int bj = 0; bj < 2; ++bj) { const u32x4 g = gg[m][bj]; f32x4 v0 = acc[ai][bj][m][0], v1 = acc[ai][bj][m][1];
                    v0[0] *= fast_rcp(bflo(g[0])); v0[1] *= fast_rcp(bfhi(g[0])); v0[2] *= fast_rcp(bflo(g[1])); v0[3] *= fast_rcp(bfhi(g[1]));
                    v1[0] *= fast_rcp(bflo(g[2])); v1[1] *= fast_rcp(bfhi(g[2])); v1[2] *= fast_rcp(bflo(g[3])); v1[3] *= fast_rcp(bfhi(g[3]));
                    *(u32x4*)(merged + (size_t)row * 1024 + col0 + bj * 128) = pack8(v0, v1); } }
        }
    }
};
struct SchedP4 {
    int c, G; const char* yna; const char* ymla; const char* ymem; const char* wo;
    __device__ __forceinline__ bool next(int i, pg8::Unit& u) const {
        const int L = i * G + c; int pm, pn; if (L >= 512) return false;
        pg8::tile_order(L, 128, 4, pm, pn); u.pm = pm; u.pn = pn; u.kind = 0; u.nt = 24; u.aux = 0;
        u.A = yna + (size_t)pm * 256 * 1024; u.A1 = ymla + (size_t)pm * 256 * 1024; u.A2 = ymem + (size_t)pm * 256 * 1024; u.B = wo + (size_t)pn * 256 * 3072; return true;
    }
};

struct EpiP5 {
    static constexpr bool PERM = true, HAS_MID = false;
    bf16_t* delta;
    __device__ __forceinline__ void operator()(const f32x4 (&acc)[2][2][4][2], const pg8::Unit& u, int wr, int wc, int fr, int fq) const {
        const int row0 = u.pm * 256 + wr * 64 + fr; const int col0 = u.pn * 256 + wc * 32 + 8 * fq;
#pragma unroll
        for (int ai = 0; ai < 2; ++ai)
#pragma unroll
            for (int m = 0; m < 4; ++m) { bf16_t* rowp = delta + (size_t)(row0 + ai * 128 + m * 16) * 1024 + col0;
#pragma unroll
                for (int bj = 0; bj < 2; ++bj) *(u32x4*)(rowp + bj * 128) = pack8(acc[ai][bj][m][0], acc[ai][bj][m][1]); }
    }
};
struct SchedP5 {
    int c, G; const char* merged; const char* wout;
    __device__ __forceinline__ bool next(int i, pg8::Unit& u) const {
        const int L = i * G + c; int pm, pn; if (L >= 512) return false;
        pg8::tile_order(L, 128, 4, pm, pn); u.pm = pm; u.pn = pn; u.kind = 0; u.nt = 16; u.aux = 0;
        u.A = merged + (size_t)pm * 256 * 2048; u.A1 = u.A; u.A2 = u.A; u.B = wout + (size_t)pn * 256 * 2048; return true;
    }
};

struct EpiP8 {
    static constexpr bool PERM = true, HAS_MID = false;
    const float* rstd_xs; bf16_t* act;
    __device__ __forceinline__ void operator()(const f32x4 (&acc)[2][2][4][2], const pg8::Unit& u, int wr, int wc, int fr, int fq) const {
        const int row0 = u.pm * 256 + wr * 64 + fr; const int col0 = u.pn * 128 + wc * 32 + 8 * fq;
#pragma unroll
        for (int ai = 0; ai < 2; ++ai)
#pragma unroll
            for (int m = 0; m < 4; ++m) { const int row = row0 + ai * 128 + m * 16; const float rs = rstd_xs[row]; f32x4 o[2];
#pragma unroll
                for (int n = 0; n < 2; ++n)
#pragma unroll
                    for (int e = 0; e < 4; ++e) { const float hg = acc[ai][0][m][n][e] * rs, hu = acc[ai][1][m][n][e] * rs; o[n][e] = hg * fast_rcp(1.0f + fast_exp2(-LOG2E * hg)) * hu; }
                *(u32x4*)(act + (size_t)row * 1024 + col0) = pack8(o[0], o[1]); }
    }
};
struct SchedP8 {
    int c, G; const char* xs; const char* wgu;
    __device__ __forceinline__ bool next(int i, pg8::Unit& u) const {
        const int L = i * G + c; int pm, pn; if (L >= 2048) return false;
        const int e = L >> 7; pg8::tile_order(L & 127, 16, 8, pm, pn); const int b = pm >> 1, half = pm & 1; const int grow0 = (b * 16 + e) * 512 + half * 256;
        u.pm = grow0 >> 8; u.pn = pn; u.kind = 0; u.nt = 16; u.aux = e; u.A = xs; u.A1 = u.A; u.A2 = u.A; u.B = wgu + (size_t)(e * 2048 + pn * 256) * 2048; return true;
    }
};
struct EpiP9 {
    static constexpr bool PERM = true, HAS_MID = false;
    const float* gsel; bf16_t* ybuf;
    __device__ __forceinline__ void operator()(const f32x4 (&acc)[2][2][4][2], const pg8::Unit& u, int wr, int wc, int fr, int fq) const {
        const int row0 = u.pm * 256 + wr * 64 + fr; const int col0 = u.pn * 256 + wc * 32 + 8 * fq;
#pragma unroll
        for (int ai = 0; ai < 2; ++ai)
#pragma unroll
            for (int m = 0; m < 4; ++m) { const int row = row0 + ai * 128 + m * 16; const float gs = gsel[row];
#pragma unroll
                for (int bj = 0; bj < 2; ++bj) *(u32x4*)(ybuf + (size_t)row * 1024 + col0 + bj * 128) = pack8(acc[ai][bj][m][0] * gs, acc[ai][bj][m][1] * gs); }
    }
};
struct SchedP9 {
    int c, G; const char* act; const char* wd;
    __device__ __forceinline__ bool next(int i, pg8::Unit& u) const {
        const int L = i * G + c; int pm, pn; if (L >= 1024) return false;
        const int e = L >> 6; pg8::tile_order(L & 63, 16, 4, pm, pn); const int b = pm >> 1, half = pm & 1; const int grow0 = (b * 16 + e) * 512 + half * 256;
        u.pm = grow0 >> 8; u.pn = pn; u.kind = 0; u.nt = 16; u.aux = e; u.A = act + (size_t)grow0 * 2048; u.A1 = u.A; u.A2 = u.A; u.B = wd + (size_t)(e * 1024 + pn * 256) * 2048; return true;
    }
};

namespace att {
typedef short v4i16_t __attribute__((ext_vector_type(4)));
struct AttnArgs { const bf16_t* q; const bf16_t* k0; const bf16_t* k1; const bf16_t* v; bf16_t* o; const float* rpb; };
__device__ __forceinline__ s16x4 vtr(unsigned addr) { return __builtin_bit_cast(s16x4, __builtin_amdgcn_ds_read_tr16_b64_v4i16((LAS v4i16_t*)(uintptr_t)addr)); }
__device__ __forceinline__ float max3f(float a, float b, float c) { float r; asm("v_max3_f32 %0, %1, %2, %3" : "=v"(r) : "v"(a), "v"(b), "v"(c)); return r; }

template <int DQK, int DV, int MODE, bool PIPE>
__device__ __forceinline__ void attn_unit(LAS unsigned char* lds, const AttnArgs& A, const int b, const int h, const int ub) {
    constexpr int PK = DQK * 2 + 16, PV = DV * 2 + 64, KB = 64 * PK, VB = 64 * PV;
    constexpr int OFF_K = 0, OFF_V = 2 * KB, OFF_SCR = OFF_V + 2 * VB, OFF_OST = OFF_SCR + 8 * 256, OFF_END = OFF_OST + 8 * 32 * DV * 2;
    static_assert(OFF_END <= LDS_BYTES - 64, "attention LDS");
    constexpr int KCH = DQK / 8, VCH = DV / 8, NKC = 64 * KCH, NVC = 64 * VCH, KPT = (NKC + 511) / 512, VPT = (NVC + 511) / 512;
    constexpr int LDQ = (MODE == 0) ? 768 : 512, LDO = 512;
    constexpr int NDS = DQK / 16, ND0 = DV / 32;
    constexpr int NT = (MODE == 0) ? 64 : 4;
    constexpr float THR = 8.0f;
    int tid_ = threadIdx.x; asm volatile("" : "+v"(tid_));
    const int tid = tid_, lane = tid & 63, r32 = lane & 31, hi = lane >> 5; const int wid = __builtin_amdgcn_readfirstlane(tid >> 6);
    const int wave_tok0 = b * S_ + ub * 256 + wid * 32;
    bf16x8 qf[NDS];
    { const bf16_t* qp = A.q + (size_t)(wave_tok0 + r32) * LDQ + h * DQK + hi * 8;
#pragma unroll
      for (int ds = 0; ds < NDS; ++ds) qf[ds] = *(const bf16x8*)(qp + ds * 16); }
    const bf16_t* ksrc[KPT]; int kstr[KPT]; unsigned kdst[KPT]; bool kval[KPT];
    const bf16_t* vsrc[VPT]; unsigned vdst[VPT];
    constexpr int KSTRIDE = 64 * 1024;
#pragma unroll
    for (int j = 0; j < KPT; ++j) { const int ci = tid + 512 * j; kval[j] = ci < NKC; const int cic = kval[j] ? ci : 0; const int row = cic / KCH, cc = cic % KCH;
        kdst[j] = (unsigned)(OFF_K + row * PK + cc * 16); kstr[j] = KSTRIDE;
        if (MODE == 0) { const size_t kt = (size_t)b * S_ + row; if (cc < 8) ksrc[j] = A.k0 + kt * 1024 + h * 64 + cc * 8; else { ksrc[j] = A.k1 + kt * 32 + (cc - 8) * 8; kstr[j] = 64 * 32; } }
        else { const size_t kr = (size_t)b * 256 + row; ksrc[j] = A.k0 + kr * 1024 + h * 128 + cc * 8; } }
#pragma unroll
    for (int j = 0; j < VPT; ++j) { const int ci = tid + 512 * j; const int row = ci / VCH, cc = ci % VCH;
        vdst[j] = (unsigned)(OFF_V + row * PV + cc * 16);
        if (MODE == 0) { const size_t kt = (size_t)b * S_ + row; vsrc[j] = A.v + kt * 1024 + h * 64 + cc * 8; }
        else { const size_t kr = (size_t)b * 256 + row; vsrc[j] = A.v + kr * 1024 + h * 128 + cc * 8; } }
    u32x4 kst[KPT], vst[VPT];
#define ATT_LOADK(tile) do { _Pragma("unroll") for (int j = 0; j < KPT; ++j) if (kval[j]) kst[j] = *(const u32x4*)(ksrc[j] + (size_t)(tile) * kstr[j]); } while (0)
#define ATT_LOADV(tile) do { _Pragma("unroll") for (int j = 0; j < VPT; ++j) vst[j] = *(const u32x4*)(vsrc[j] + (size_t)(tile) * KSTRIDE); } while (0)
#define ATT_STOREK(buf) do { _Pragma("unroll") for (int j = 0; j < KPT; ++j) if (kval[j]) *(LAS u32x4*)(lds + kdst[j] + (buf) * KB) = kst[j]; } while (0)
#define ATT_STOREV(buf) do { _Pragma("unroll") for (int j = 0; j < VPT; ++j) *(LAS u32x4*)(lds + vdst[j] + (buf) * VB) = vst[j]; } while (0)
    LAS float* scr = (LAS float*)(lds + OFF_SCR) + wid * 64;
#define ATT_QK(P0, P1, buf) do { const LAS unsigned char* kb_ = lds + OFF_K + (buf) * KB + r32 * PK + hi * 16; P0 = negm; P1 = negm; __builtin_amdgcn_s_setprio(1); \
        _Pragma("unroll") for (int ds = 0; ds < NDS; ++ds) { const bf16x8 a0_ = *(const LAS bf16x8*)(kb_ + ds * 32), a1_ = *(const LAS bf16x8*)(kb_ + 32 * PK + ds * 32); \
            P0 = __builtin_amdgcn_mfma_f32_32x32x16_bf16(a0_, qf[ds], P0, 0, 0, 0); P1 = __builtin_amdgcn_mfma_f32_32x32x16_bf16(a1_, qf[ds], P1, 0, 0, 0); } __builtin_amdgcn_s_setprio(0); } while (0)
#define ATT_ROWMAX(P0, P1, rm) do { float a_ = max3f(P0[0], P0[1], P1[0]), b_ = max3f(P0[2], P0[3], P1[1]); a_ = max3f(a_, P1[2], P1[3]); \
        _Pragma("unroll") for (int r = 4; r < 16; r += 4) { a_ = max3f(a_, P0[r], P0[r + 1]); b_ = max3f(b_, P0[r + 2], P0[r + 3]); a_ = max3f(a_, P1[r], P1[r + 1]); b_ = max3f(b_, P1[r + 2], P1[r + 3]); } \
        rm = fmaxf(a_, b_); rm = fmaxf(rm, __shfl_xor(rm, 32)); } while (0)
    f32x16 o[ND0], negm;
#pragma unroll
    for (int r = 0; r < 16; ++r) negm[r] = 0.f;
#pragma unroll
    for (int d0 = 0; d0 < ND0; ++d0)
#pragma unroll
        for (int r = 0; r < 16; ++r) o[d0][r] = 0.f;
    float lsum = 0.f;
    f32x16 pA0, pA1, pB0, pB1;
    ATT_LOADK(0); ATT_LOADV(0); ATT_STOREK(0); ATT_STOREV(0); ATT_LOADK(1); ATT_STOREK(1);
    __syncthreads();
    ATT_QK(pA0, pA1, 0);
    { float rm; ATT_ROWMAX(pA0, pA1, rm);
#pragma unroll
      for (int r = 0; r < 16; ++r) { pA0[r] -= rm; pA1[r] -= rm; negm[r] = -rm; } }
    __syncthreads();
#ifndef ATT_SGB
#define ATT_SGB 1
#endif
#define ATT_STEP(PC0, PC1, PN0, PN1, t) do { const int buf_ = (t) & 1; \
        if ((t) + 2 < NT) ATT_LOADK((t) + 2); if ((t) + 1 < NT) ATT_LOADV((t) + 1); \
        if constexpr (!PIPE) { if ((t) > 0) { ATT_QK(PC0, PC1, buf_); float rm0_; ATT_ROWMAX(PC0, PC1, rm0_); \
            if (__any(rm0_ > THR)) { const float dl_ = fmaxf(rm0_, 0.f); const float f_ = fast_exp2(-dl_); lsum *= f_; \
                _Pragma("unroll") for (int r = 0; r < 16; ++r) { PC0[r] -= dl_; PC1[r] -= dl_; negm[r] -= dl_; } \
                if (hi == 0) scr[r32] = f_; \
                _Pragma("unroll") for (int r = 0; r < 16; ++r) { const float fr_ = scr[crow(r, hi)]; _Pragma("unroll") for (int d0 = 0; d0 < ND0; ++d0) o[d0][r] *= fr_; } } } } \
          \
        if constexpr (PIPE) { if ((t) + 1 < NT) ATT_QK(PN0, PN1, buf_ ^ 1); } \
        float ps_ = 0.f; \
        _Pragma("unroll") for (int r = 0; r < 16; ++r) { PC0[r] = fast_exp2(PC0[r]); PC1[r] = fast_exp2(PC1[r]); ps_ += PC0[r] + PC1[r]; } \
        lsum += ps_; \
        bf16x8 pa_[4]; \
        _Pragma("unroll") for (int s = 0; s < 2; ++s) { u32x4 w_; \
            w_.x = cvt_pk_bf16(PC0[8 * s + 0], PC0[8 * s + 1]); w_.y = cvt_pk_bf16(PC0[8 * s + 2], PC0[8 * s + 3]); w_.z = cvt_pk_bf16(PC0[8 * s + 4], PC0[8 * s + 5]); w_.w = cvt_pk_bf16(PC0[8 * s + 6], PC0[8 * s + 7]); pa_[s] = __builtin_bit_cast(bf16x8, w_); \
            w_.x = cvt_pk_bf16(PC1[8 * s + 0], PC1[8 * s + 1]); w_.y = cvt_pk_bf16(PC1[8 * s + 2], PC1[8 * s + 3]); w_.z = cvt_pk_bf16(PC1[8 * s + 4], PC1[8 * s + 5]); w_.w = cvt_pk_bf16(PC1[8 * s + 6], PC1[8 * s + 7]); pa_[2 + s] = __builtin_bit_cast(bf16x8, w_); } \
          \
        { const unsigned vb_ = (unsigned)(uintptr_t)(lds + OFF_V + buf_ * VB) + (unsigned)((4 * hi + ((lane & 15) >> 2)) * PV + ((((lane >> 4) & 1) * 16 + (lane & 3) * 4) * 2)); \
          __builtin_amdgcn_s_setprio(1); \
          _Pragma("unroll") for (int d0 = 0; d0 < ND0; ++d0) _Pragma("unroll") for (int s = 0; s < 4; ++s) { \
              const s16x4 lo_ = vtr(vb_ + (unsigned)(16 * s * PV + d0 * 64)), hh_ = vtr(vb_ + (unsigned)(16 * s * PV + 8 * PV + d0 * 64)); \
              const bf16x8 vf_ = (bf16x8){lo_[0], lo_[1], lo_[2], lo_[3], hh_[0], hh_[1], hh_[2], hh_[3]}; \
              o[d0] = __builtin_amdgcn_mfma_f32_32x32x16_bf16(pa_[s], vf_, o[d0], 0, 0, 0); } \
          __builtin_amdgcn_s_setprio(0); } \
        float rm_ = 0.f; \
        if constexpr (PIPE) { if ((t) + 1 < NT) ATT_ROWMAX(PN0, PN1, rm_); } \
        if (ATT_SGB && PIPE) { _Pragma("unroll") for (int g_ = 0; g_ < 12 + 4 * ND0; ++g_) { __builtin_amdgcn_sched_group_barrier(0x008, 1, 0); __builtin_amdgcn_sched_group_barrier(0x100, 2, 0); __builtin_amdgcn_sched_group_barrier(0x002, 6, 0); } } \
          \
        if constexpr (PIPE) { if (__any(rm_ > THR)) { const float dl_ = fmaxf(rm_, 0.f); const float f_ = fast_exp2(-dl_); lsum *= f_; \
            _Pragma("unroll") for (int r = 0; r < 16; ++r) { PN0[r] -= dl_; PN1[r] -= dl_; negm[r] -= dl_; } \
            if (hi == 0) scr[r32] = f_; \
            _Pragma("unroll") for (int r = 0; r < 16; ++r) { const float fr_ = scr[crow(r, hi)]; _Pragma("unroll") for (int d0 = 0; d0 < ND0; ++d0) o[d0][r] *= fr_; } } } \
        if ((t) + 2 < NT) ATT_STOREK(buf_); if ((t) + 1 < NT) ATT_STOREV(buf_ ^ 1); \
        __syncthreads(); } while (0)
    if constexpr (PIPE) { for (int t = 0; t < NT; t += 2) { ATT_STEP(pA0, pA1, pB0, pB1, t); ATT_STEP(pB0, pB1, pA0, pA1, t + 1); } }
    else { for (int t = 0; t < NT; ++t) { ATT_STEP(pA0, pA1, pB0, pB1, t); } }
    lsum += __shfl_xor(lsum, 32);
    if (hi == 0) scr[r32] = fast_rcp(lsum);
    LAS bf16_t* ost = (LAS bf16_t*)(lds + OFF_OST) + wid * 32 * DV;
#pragma unroll
    for (int r = 0; r < 16; ++r) { const int q = crow(r, hi); const float ri = scr[q];
#pragma unroll
        for (int d0 = 0; d0 < ND0; ++d0) { const float val = o[d0][r] * ri; ost[q * DV + d0 * 32 + r32] = (bf16_t)(cvt_pk_bf16(val, val) & 0xffffu); } }
    asm volatile("s_waitcnt lgkmcnt(0)" ::: "memory");
    { bf16_t* og = A.o + (size_t)wave_tok0 * LDO + h * DV;
#pragma unroll
      for (int i = 0; i < DV / 16; ++i) { const int id = i * 64 + lane; const int row = id / VCH, ch = id % VCH;
          const u32x4 v = *(const LAS u32x4*)(ost + row * DV + ch * 8); *(u32x4*)(og + (size_t)row * LDO + ch * 8) = v; } }
    __syncthreads();
#undef ATT_LOADK
#undef ATT_LOADV
#undef ATT_STOREK
#undef ATT_STOREV
#undef ATT_QK
#undef ATT_ROWMAX
#undef ATT_STEP
}
}

namespace att {
__device__ __forceinline__ void attn_unit_mla(LAS unsigned char* lds, const AttnArgs& A, const int b, const int h, const int ub) {
    constexpr int DQK = 96, DV = 64;
    constexpr int PK = DQK * 2 + 16, PV = DV * 2 + 64, KB = 64 * PK, VB = 64 * PV;
    constexpr int OFF_K = 0, OFF_V = 3 * KB, OFF_SCR = OFF_V + 3 * VB, OFF_OST = OFF_SCR + 8 * 256, OFF_END = OFF_OST + 8 * 32 * DV * 2;
    static_assert(OFF_END <= LDS_BYTES - 64, "attention LDS");
    constexpr int KCH = DQK / 8, VCH = DV / 8, NKC = 64 * KCH, KPT = 2, VPT = 1;
    constexpr int LDQ = 768, LDO = 512, NDS = DQK / 16, ND0 = DV / 32, NT = 64;
    constexpr float THR = 8.0f;
    int tid_ = threadIdx.x; asm volatile("" : "+v"(tid_));
    const int tid = tid_, lane = tid & 63, r32 = lane & 31, hi = lane >> 5; const int wid = __builtin_amdgcn_readfirstlane(tid >> 6);
    const int grp = wid >> 2;
    const int wave_tok0 = b * S_ + ub * 256 + wid * 32;
    bf16x8 qf[NDS];
    { const bf16_t* qp = A.q + (size_t)(wave_tok0 + r32) * LDQ + h * DQK + hi * 8;
#pragma unroll
      for (int ds = 0; ds < NDS; ++ds) qf[ds] = *(const bf16x8*)(qp + ds * 16); }
    const bf16_t* ksrc[KPT]; int kstr[KPT]; unsigned kdst[KPT]; bool kval[KPT];
    const bf16_t* vsrc; unsigned vdst;
    constexpr int KSTRIDE = 64 * 1024;
#pragma unroll
    for (int j = 0; j < KPT; ++j) { const int ci = tid + 512 * j; kval[j] = ci < NKC; const int cic = kval[j] ? ci : 0; const int row = cic / KCH, cc = cic % KCH;
        kdst[j] = (unsigned)(OFF_K + row * PK + cc * 16); kstr[j] = KSTRIDE; const size_t kt = (size_t)b * S_ + row;
        if (cc < 8) ksrc[j] = A.k0 + kt * 1024 + h * 64 + cc * 8; else { ksrc[j] = A.k1 + kt * 32 + (cc - 8) * 8; kstr[j] = 64 * 32; } }
    { const int row = tid / VCH, cc = tid % VCH; vdst = (unsigned)(OFF_V + row * PV + cc * 16); vsrc = A.v + ((size_t)b * S_ + row) * 1024 + h * 64 + cc * 8; }
    u32x4 kst[KPT], vst;
#define MLA_LOADK(tile) do { _Pragma("unroll") for (int j = 0; j < KPT; ++j) if (kval[j]) kst[j] = *(const u32x4*)(ksrc[j] + (size_t)(tile) * kstr[j]); } while (0)
#define MLA_LOADV(tile) do { vst = *(const u32x4*)(vsrc + (size_t)(tile) * KSTRIDE); } while (0)
#define MLA_STOREK(boff) do { _Pragma("unroll") for (int j = 0; j < KPT; ++j) if (kval[j]) *(LAS u32x4*)(lds + kdst[j] + (boff)) = kst[j]; } while (0)
#define MLA_STOREV(boff) do { *(LAS u32x4*)(lds + vdst + (boff)) = vst; } while (0)
    LAS float* scr = (LAS float*)(lds + OFF_SCR) + wid * 64;
#define MLA_QK(P0, P1, boff) do { const LAS unsigned char* kb_ = lds + OFF_K + (boff) + r32 * PK + hi * 16; P0 = negm; P1 = negm; __builtin_amdgcn_s_setprio(1); \
        _Pragma("unroll") for (int ds = 0; ds < NDS; ++ds) { const bf16x8 a0_ = *(const LAS bf16x8*)(kb_ + ds * 32), a1_ = *(const LAS bf16x8*)(kb_ + 32 * PK + ds * 32); \
            P0 = __builtin_amdgcn_mfma_f32_32x32x16_bf16(a0_, qf[ds], P0, 0, 0, 0); P1 = __builtin_amdgcn_mfma_f32_32x32x16_bf16(a1_, qf[ds], P1, 0, 0, 0); } __builtin_amdgcn_s_setprio(0); } while (0)
#define MLA_ROWMAX(P0, P1, rm) do { float a_ = max3f(P0[0], P0[1], P1[0]), b_ = max3f(P0[2], P0[3], P1[1]); a_ = max3f(a_, P1[2], P1[3]); \
        _Pragma("unroll") for (int r = 4; r < 16; r += 4) { a_ = max3f(a_, P0[r], P0[r + 1]); b_ = max3f(b_, P0[r + 2], P0[r + 3]); a_ = max3f(a_, P1[r], P1[r + 1]); b_ = max3f(b_, P1[r + 2], P1[r + 3]); } \
        rm = fmaxf(a_, b_); rm = fmaxf(rm, __shfl_xor(rm, 32)); } while (0)
    f32x16 o[ND0], negm;
#pragma unroll
    for (int r = 0; r < 16; ++r) negm[r] = 0.f;
#pragma unroll
    for (int d0 = 0; d0 < ND0; ++d0)
#pragma unroll
        for (int r = 0; r < 16; ++r) o[d0][r] = 0.f;
    float lsum = 0.f;
    f32x16 pA0, pA1, pB0, pB1;
    MLA_LOADK(0); MLA_LOADV(0); MLA_STOREK(0); MLA_STOREV(0);
    MLA_LOADK(1); MLA_LOADV(1); MLA_STOREK(KB); MLA_STOREV(VB);
    MLA_LOADK(2); MLA_STOREK(2 * KB);
    __syncthreads();
    MLA_QK(pA0, pA1, 0);
    { float rm; MLA_ROWMAX(pA0, pA1, rm);
#pragma unroll
      for (int r = 0; r < 16; ++r) { pA0[r] -= rm; pA1[r] -= rm; negm[r] = -rm; } }
    __syncthreads();
    if (grp == 1) asm volatile("s_barrier" ::: "memory");
    int kb0 = 0, kb1 = KB, kb2 = 2 * KB;
    int vb0 = 0, vb1 = VB, vb2 = 2 * VB;
#define MLA_STEP(PC0, PC1, PN0, PN1, t) do { \
          \
        if ((t) + 3 < NT) MLA_LOADK((t) + 3); if ((t) + 2 < NT) MLA_LOADV((t) + 2); \
        if ((t) + 1 < NT) MLA_QK(PN0, PN1, kb1); \
        float ps_ = 0.f; \
        _Pragma("unroll") for (int r = 0; r < 16; ++r) { PC0[r] = fast_exp2(PC0[r]); PC1[r] = fast_exp2(PC1[r]); ps_ += PC0[r] + PC1[r]; } \
        lsum += ps_; \
        bf16x8 pa_[4]; \
        _Pragma("unroll") for (int s = 0; s < 2; ++s) { u32x4 w_; \
            w_.x = cvt_pk_bf16(PC0[8 * s + 0], PC0[8 * s + 1]); w_.y = cvt_pk_bf16(PC0[8 * s + 2], PC0[8 * s + 3]); w_.z = cvt_pk_bf16(PC0[8 * s + 4], PC0[8 * s + 5]); w_.w = cvt_pk_bf16(PC0[8 * s + 6], PC0[8 * s + 7]); pa_[s] = __builtin_bit_cast(bf16x8, w_); \
            w_.x = cvt_pk_bf16(PC1[8 * s + 0], PC1[8 * s + 1]); w_.y = cvt_pk_bf16(PC1[8 * s + 2], PC1[8 * s + 3]); w_.z = cvt_pk_bf16(PC1[8 * s + 4], PC1[8 * s + 5]); w_.w = cvt_pk_bf16(PC1[8 * s + 6], PC1[8 * s + 7]); pa_[2 + s] = __builtin_bit_cast(bf16x8, w_); } \
        _Pragma("unroll") for (int s = 0; s < 4; ++s) asm volatile("" : "+v"(pa_[s])); \
        asm volatile("s_barrier" ::: "memory"); \
          \
        { const unsigned vb_ = (unsigned)(uintptr_t)(lds + OFF_V + vb0) + (unsigned)((4 * hi + ((lane & 15) >> 2)) * PV + ((((lane >> 4) & 1) * 16 + (lane & 3) * 4) * 2)); \
          __builtin_amdgcn_s_setprio(1); \
          _Pragma("unroll") for (int d0 = 0; d0 < ND0; ++d0) _Pragma("unroll") for (int s = 0; s < 4; ++s) { \
              const s16x4 lo_ = vtr(vb_ + (unsigned)(16 * s * PV + d0 * 64)), hh_ = vtr(vb_ + (unsigned)(16 * s * PV + 8 * PV + d0 * 64)); \
              const bf16x8 vf_ = (bf16x8){lo_[0], lo_[1], lo_[2], lo_[3], hh_[0], hh_[1], hh_[2], hh_[3]}; \
              o[d0] = __builtin_amdgcn_mfma_f32_32x32x16_bf16(pa_[s], vf_, o[d0], 0, 0, 0); } \
          __builtin_amdgcn_s_setprio(0); } \
        float rm_ = 0.f; \
        if ((t) + 1 < NT) MLA_ROWMAX(PN0, PN1, rm_); \
        if (__any(rm_ > THR)) { const float dl_ = fmaxf(rm_, 0.f); const float f_ = fast_exp2(-dl_); lsum *= f_; \
            _Pragma("unroll") for (int r = 0; r < 16; ++r) { PN0[r] -= dl_; PN1[r] -= dl_; negm[r] -= dl_; } \
            if (hi == 0) scr[r32] = f_; \
            _Pragma("unroll") for (int r = 0; r < 16; ++r) { const float fr_ = scr[crow(r, hi)]; _Pragma("unroll") for (int d0 = 0; d0 < ND0; ++d0) o[d0][r] *= fr_; } } \
        if ((t) + 3 < NT) MLA_STOREK(kb0); if ((t) + 2 < NT) MLA_STOREV(vb2); \
        { const int k_ = kb0; kb0 = kb1; kb1 = kb2; kb2 = k_; const int v_ = vb2; vb2 = vb0; vb0 = vb1; vb1 = v_; } \
        asm volatile("s_waitcnt lgkmcnt(0)\n\ts_barrier" ::: "memory"); } while (0)
    for (int t = 0; t < NT; t += 2) { MLA_STEP(pA0, pA1, pB0, pB1, t); MLA_STEP(pB0, pB1, pA0, pA1, t + 1); }
    if (grp == 0) asm volatile("s_barrier" ::: "memory");
    lsum += __shfl_xor(lsum, 32);
    if (hi == 0) scr[r32] = fast_rcp(lsum);
    LAS bf16_t* ost = (LAS bf16_t*)(lds + OFF_OST) + wid * 32 * DV;
#pragma unroll
    for (int r = 0; r < 16; ++r) { const int q = crow(r, hi); const float ri = scr[q];
#pragma unroll
        for (int d0 = 0; d0 < ND0; ++d0) { const float val = o[d0][r] * ri; ost[q * DV + d0 * 32 + r32] = (bf16_t)(cvt_pk_bf16(val, val) & 0xffffu); } }
    asm volatile("s_waitcnt lgkmcnt(0)" ::: "memory");
    { bf16_t* og = A.o + (size_t)wave_tok0 * LDO + h * DV;
#pragma unroll
      for (int i = 0; i < DV / 16; ++i) { const int id = i * 64 + lane; const int row = id / VCH, ch = id % VCH;
          const u32x4 v = *(const LAS u32x4*)(ost + row * DV + ch * 8); *(u32x4*)(og + (size_t)row * LDO + ch * 8) = v; } }
    __syncthreads();
#undef MLA_LOADK
#undef MLA_LOADV
#undef MLA_STOREK
#undef MLA_STOREV
#undef MLA_QK
#undef MLA_ROWMAX
#undef MLA_STEP
}
}

namespace na2 {
typedef short v4i16_t __attribute__((ext_vector_type(4)));
constexpr int NS = 6, DPF = 5, TILE = 16384;
constexpr int OFF_RING = 0, OFF_OST = NS * TILE, OFF_TAB = OFF_OST + 8 * 2048, TAB_FLOATS = 8 * 465;
static_assert(OFF_TAB + TAB_FLOATS * 4 <= LDS_BYTES - 64, "na2 LDS");
__device__ __forceinline__ void glds16(const void* gsrc, unsigned lds_dst) { unsigned keep;
    asm volatile("s_mov_b32 %0, m0\n\ts_mov_b32 m0, %2\n\ts_nop 0\n\tglobal_load_lds_dwordx4 %1, off\n\ts_mov_b32 m0, %0" : "=&s"(keep) : "v"(gsrc), "s"(lds_dst) : "memory"); }
__device__ __forceinline__ s16x4 vtr(unsigned addr) { return __builtin_bit_cast(s16x4, __builtin_amdgcn_ds_read_tr16_b64_v4i16((LAS v4i16_t*)(uintptr_t)addr)); }
__device__ __forceinline__ int clampi(int v, int lo, int hi) { return v < lo ? lo : (v > hi ? hi : v); }
#define NA_WAITBAR(N) asm volatile("s_waitcnt vmcnt(" #N ") lgkmcnt(0)\n\ts_barrier" ::: "memory")

__device__ __forceinline__ void na_phase(LAS unsigned char* lds, const bf16_t* qn, const bf16_t* kn, const bf16_t* vn, bf16_t* on, const float* rpb, const int vcu, const int G) {
    int tid_ = threadIdx.x; asm volatile("" : "+v"(tid_));
    const int tid = tid_, lane = tid & 63, lj = lane & 15, fq = lane >> 4; const int wid = __builtin_amdgcn_readfirstlane(tid >> 6);
    const int hl = wid >> 2, g = wid & 3; const int csg = (g == 0) ? 0 : (g == 1 ? 8 : (g == 2 ? 24 : 32));
    LAS float* tab = (LAS float*)(lds + OFF_TAB);
    for (int i = tid; i < TAB_FLOATS; i += NTHREADS) tab[i] = rpb[i] * LOG2E;
    const unsigned lds0 = (unsigned)(uintptr_t)lds;
    if (vcu >= 2048) { __syncthreads(); return; }
    const int nunits = (2048 - vcu + G - 1) / G; const int total = nunits * 17;
    unsigned offK[2], offV[2], dstw[2];
#pragma unroll
    for (int p = 0; p < 2; ++p) { const int ii = wid * 2 + p, row = 4 * ii + (lane >> 4), cp = lane & 15;
        offK[p] = (unsigned)(row * 1024 + ((cp ^ (row & 15)) << 4)); offV[p] = (unsigned)(row * 1024 + ((cp ^ ((row & 7) << 1)) << 4)); dstw[p] = lds0 + OFF_RING + ii * 1024; }
#define NA_ISSUE(tau, slot) do { const int n_ = (tau) / 17, i_ = (tau) - 17 * n_; const int U_ = vcu + n_ * G; const int b_ = U_ >> 8, hp_ = (U_ >> 6) & 3, r_ = U_ & 63; \
        const int kr_ = (i_ == 0) ? r_ : clampi(r_ - 4, 0, 56) + ((i_ - 1) & 7); const bf16_t* src_ = (i_ == 0) ? qn : (i_ < 9 ? kn : vn); \
        const char* base_ = (const char*)(src_ + ((size_t)(b_ * S_ + kr_ * 64) * 512 + hp_ * 128)); \
        _Pragma("unroll") for (int p = 0; p < 2; ++p) glds16(base_ + (i_ < 9 ? offK[p] : offV[p]), (unsigned)__builtin_amdgcn_readfirstlane(dstw[p] + (slot) * TILE)); } while (0)
    int islot = 0;
#pragma unroll
    for (int d = 0; d < DPF; ++d) { if (d < total) { NA_ISSUE(d, islot); islot = (islot + 1 == NS) ? 0 : islot + 1; } }
    int cslot = 0;
    for (int n = 0; n < nunits; ++n) {
        const int U = vcu + n * G; const int b = U >> 8, hp = (U >> 6) & 3, r = U & 63; const int rs = clampi(r - 4, 0, 56); const int head = hp * 2 + hl;
        const int tok0 = b * S_ + r * 64 + 16 * g;
        bf16x8 qf[2];
        f32x4 s[8][2]; bf16x8 pa[8]; f32x4 o[4]; float lsum = 0.f;
#pragma unroll
        for (int dt = 0; dt < 4; ++dt) o[dt] = (f32x4){0.f, 0.f, 0.f, 0.f};
#pragma clang loop unroll(full)
        for (int i0 = 0; i0 < 17; ++i0) {
            const int tau = n * 17 + i0; const int i = i0 - 1;
            if (tau + DPF <= total) NA_WAITBAR(8); else NA_WAITBAR(0);
            if (tau + DPF < total) { NA_ISSUE(tau + DPF, islot); islot = (islot + 1 == NS) ? 0 : islot + 1; }
            const unsigned sbase = lds0 + OFF_RING + cslot * TILE; cslot = (cslot + 1 == NS) ? 0 : cslot + 1;
            if (i0 == 0) {
                const int kc = 16 * g + lj;
#pragma unroll
                for (int ds = 0; ds < 2; ++ds) { const int c = hl * 8 + ds * 4 + fq; qf[ds] = *(const LAS bf16x8*)(uintptr_t)(sbase + kc * 256 + ((c ^ (kc & 15)) << 4)); }
            } else if (i < 8) {
#pragma unroll
                for (int ct = 0; ct < 2; ++ct) { s[i][ct] = (f32x4){0.f, 0.f, 0.f, 0.f}; const int kc = csg + 16 * ct + lj;
#pragma unroll
                    for (int ds = 0; ds < 2; ++ds) { const int c = hl * 8 + ds * 4 + fq; const bf16x8 a = *(const LAS bf16x8*)(uintptr_t)(sbase + kc * 256 + ((c ^ (kc & 15)) << 4));
                        s[i][ct] = __builtin_amdgcn_mfma_f32_16x16x32_bf16(a, qf[ds], s[i][ct], 0, 0, 0); } }
                if (i == 7) {
                    const int c = 16 * g + lj, cs = clampi(c - 8, 0, 48); float m = -1e30f;
#pragma unroll
                    for (int t = 0; t < 8; ++t) { const LAS float* trow = tab + head * 465 + (rs + t - r + 7) * 31;
#pragma unroll
                        for (int ct = 0; ct < 2; ++ct)
#pragma unroll
                            for (int e = 0; e < 4; ++e) { const int kc = csg + 16 * ct + 4 * fq + e; const bool v = (unsigned)(kc - cs) < 16u; const float bias = trow[v ? (kc - c + 15) : 0];
                                const float x = v ? s[t][ct][e] + bias : -1e30f; s[t][ct][e] = x; m = fmaxf(m, x); } }
                    m = fmaxf(m, __shfl_xor(m, 16)); m = fmaxf(m, __shfl_xor(m, 32));
#pragma unroll
                    for (int t = 0; t < 8; ++t) {
#pragma unroll
                        for (int ct = 0; ct < 2; ++ct)
#pragma unroll
                            for (int e = 0; e < 4; ++e) { const float p = fast_exp2(s[t][ct][e] - m); s[t][ct][e] = p; lsum += p; }
                        u32x4 w; w.x = cvt_pk_bf16(s[t][0][0], s[t][0][1]); w.y = cvt_pk_bf16(s[t][0][2], s[t][0][3]); w.z = cvt_pk_bf16(s[t][1][0], s[t][1][1]); w.w = cvt_pk_bf16(s[t][1][2], s[t][1][3]);
                        pa[t] = __builtin_bit_cast(bf16x8, w); }
                    lsum += __shfl_xor(lsum, 16); lsum += __shfl_xor(lsum, 32);
                }
            } else {
                const int t = i - 8; const int q = lj >> 2, p = lj & 3;
#pragma unroll
                for (int dt = 0; dt < 4; ++dt) { const int c = hl * 8 + 2 * dt + (p >> 1); s16x4 tr[2];
#pragma unroll
                    for (int ct = 0; ct < 2; ++ct) { const int kc = csg + 16 * ct + 4 * fq + q; tr[ct] = vtr(sbase + kc * 256 + ((c ^ ((kc & 7) << 1)) << 4) + (p & 1) * 8); }
                    const bf16x8 vf = (bf16x8){tr[0][0], tr[0][1], tr[0][2], tr[0][3], tr[1][0], tr[1][1], tr[1][2], tr[1][3]};
                    o[dt] = __builtin_amdgcn_mfma_f32_16x16x32_bf16(pa[t], vf, o[dt], 0, 0, 0); }
                if (i == 15) {
                    const float linv = fast_rcp(lsum); float li[4];
#pragma unroll
                    for (int e = 0; e < 4; ++e) li[e] = __shfl(linv, 4 * fq + e);
                    LAS bf16_t* ost = (LAS bf16_t*)(lds + OFF_OST) + wid * 1024;
#pragma unroll
                    for (int dt = 0; dt < 4; ++dt)
#pragma unroll
                        for (int e = 0; e < 4; ++e) { const float val = o[dt][e] * li[e]; ost[(4 * fq + e) * 64 + 16 * dt + lj] = (bf16_t)(cvt_pk_bf16(val, val) & 0xffffu); }
                    asm volatile("s_waitcnt lgkmcnt(0)" ::: "memory");
                    bf16_t* og = on + (size_t)tok0 * 512 + head * 64;
#pragma unroll
                    for (int k = 0; k < 2; ++k) { const int id = lane + 64 * k, row = id >> 3, ch = id & 7; const u32x4 v = *(const LAS u32x4*)(ost + row * 64 + ch * 8); *(u32x4*)(og + (size_t)row * 512 + ch * 8) = v; }
                }
            }
        }
    }
    asm volatile("s_waitcnt vmcnt(0) lgkmcnt(0)" ::: "memory");
    __syncthreads();
#undef NA_ISSUE
}
#undef NA_WAITBAR
}

struct HalfMap { int drow; float cs; bool rp; bool valid; };
__device__ __forceinline__ void p0_item64(const float* W, int ldw, int k0, int n0, bf16_t* WT, int ldwt, const HalfMap h0, const HalfMap h1, int dk0, const float* g, LAS float* scr, int lane) {
    const int n4 = (lane & 15) * 4, kq = lane >> 4; const bool hv = (n4 < 32) ? h0.valid : h1.valid; const float cs = (n4 < 32) ? h0.cs : h1.cs;
    f32x4 v[16];
#pragma unroll
    for (int j = 0; j < 16; ++j) { v[j] = (f32x4){0.f, 0.f, 0.f, 0.f}; if (hv) v[j] = *(const f32x4*)(W + (size_t)(k0 + 4 * j + kq) * ldw + n0 + n4); }
#pragma unroll
    for (int j = 0; j < 16; ++j) { const int k = 4 * j + kq; float sc = cs; if (g) sc *= g[k0 + k];
#pragma unroll
        for (int e = 0; e < 4; ++e) scr[(n4 + e) * 65 + k] = v[j][e] * sc; }
    asm volatile("s_waitcnt lgkmcnt(0)" ::: "memory");
    const int c = lane & 7;
#pragma unroll
    for (int j = 0; j < 8; ++j) { const int nn = 8 * j + (lane >> 3); const LAS float* s = scr + nn * 65 + 8 * c;
        u32x4 o; o.x = cvt_pk_bf16(s[0], s[1]); o.y = cvt_pk_bf16(s[2], s[3]); o.z = cvt_pk_bf16(s[4], s[5]); o.w = cvt_pk_bf16(s[6], s[7]);
        const bool hi_ = nn >= 32; const int w = nn & 31; const bool rp = hi_ ? h1.rp : h0.rp; const int nd = rp ? ((w & 16) + 2 * (w & 7) + ((w >> 3) & 1)) : w;
        const int drow = (hi_ ? h1.drow : h0.drow) + nd;
        if (hi_ ? h1.valid : h0.valid) *(u32x4*)(WT + (size_t)drow * ldwt + dk0 + k0 + 8 * c) = o; }
    asm volatile("s_waitcnt lgkmcnt(0)" ::: "memory");
}
__device__ __forceinline__ void p0_row(const float* xrow, bf16_t* orow, float* rstd, int lane) {
    const f32x4* xr = (const f32x4*)xrow + lane; f32x4 v[4]; float s = 0.f;
#pragma unroll
    for (int j = 0; j < 4; ++j) { v[j] = xr[64 * j]; s += (v[j][0] * v[j][0] + v[j][1] * v[j][1]) + (v[j][2] * v[j][2] + v[j][3] * v[j][3]); }
    s = wave_sum(s);
    u32x2* o8 = (u32x2*)orow + lane;
#pragma unroll
    for (int j = 0; j < 4; ++j) { u32x2 w; w.x = cvt_pk_bf16(v[j][0], v[j][1]); w.y = cvt_pk_bf16(v[j][2], v[j][3]); o8[64 * j] = w; }
    if (lane == 0) *rstd = rsqrtf(s * (1.0f / 1024.0f) + EPS_);
}

#define PX(P) ((P).in[0])
#define PMEM(P) ((P).in[1])
#define PGMIX(P) ((P).in[2])
#define PWIN(P) ((P).in[3])
#define PRPB(P) ((P).in[4])
#define PQN(P) ((P).in[5])
#define PWUQ(P) ((P).in[6])
#define PKVN(P) ((P).in[7])
#define PWUKV(P) ((P).in[8])
#define PGMEM(P) ((P).in[9])
#define PWMEMKV(P) ((P).in[10])
#define PWOUT(P) ((P).in[14])
#define PGFFN(P) ((P).in[15])
#define PWROUTER(P) ((P).in[16])
#define PBROUTER(P) ((P).in[17])
#define PWGATE(P) ((P).in[18])
#define PWUP(P) ((P).in[19])
#define PWDOWN(P) ((P).in[20])
#define PGFINAL(P) ((P).in[21])
typedef Args Ptrs;

__device__ __forceinline__ void phase0(const Ptrs& P, LAS unsigned char* lds, int gw, int NGW, int wave, int lane) {
    LAS float* scr = (LAS float*)(lds + wave * 16640);
    bf16_t* win = (bf16_t*)(P.ws + WS_WIN); bf16_t* wuq = (bf16_t*)(P.ws + WS_WUQ); bf16_t* wukv = (bf16_t*)(P.ws + WS_WUKV); bf16_t* wmk = (bf16_t*)(P.ws + WS_WMK);
    bf16_t* wo = (bf16_t*)(P.ws + WS_WO); bf16_t* wout = (bf16_t*)(P.ws + WS_WOUT); bf16_t* wgu = (bf16_t*)(P.ws + WS_WGU); bf16_t* wd = (bf16_t*)(P.ws + WS_WD);
    constexpr int I_E = 16 * 16, I_IN = 16 * 91, I_UQ = 6 * 12, I_UKV = 4 * 16, I_MK = 16 * 16, I_O = 8 * 16, I_OUT = 16 * 16;
    constexpr int NITEMS = 3 * 16 * I_E + I_IN + I_UQ + I_UKV + I_MK + 3 * I_O + I_OUT;
    for (int it = gw; it < NITEMS; it += NGW) {
        int r = it;
        if (r < 16 * I_E) { const int e = r / I_E, q = r % I_E, kb = q / 16, n0 = (q % 16) * 64; const int d0 = (n0 >> 7) * 256 + (n0 & 127);
            p0_item64(PWGATE(P) + (size_t)e * 1048576, 1024, kb * 64, n0, wgu + (size_t)e * 2097152, 1024, HalfMap{d0, 1.0f, false, true}, HalfMap{d0 + 32, 1.0f, false, true}, 0, PGFFN(P), scr, lane); continue; } r -= 16 * I_E;
        if (r < 16 * I_E) { const int e = r / I_E, q = r % I_E, kb = q / 16, n0 = (q % 16) * 64; const int d0 = (n0 >> 7) * 256 + 128 + (n0 & 127);
            p0_item64(PWUP(P) + (size_t)e * 1048576, 1024, kb * 64, n0, wgu + (size_t)e * 2097152, 1024, HalfMap{d0, 1.0f, false, true}, HalfMap{d0 + 32, 1.0f, false, true}, 0, PGFFN(P), scr, lane); continue; } r -= 16 * I_E;
        if (r < 16 * I_E) { const int e = r / I_E, q = r % I_E, kb = q / 16, n0 = (q % 16) * 64;
            p0_item64(PWDOWN(P) + (size_t)e * 1048576, 1024, kb * 64, n0, wd + (size_t)e * 1048576, 1024, HalfMap{n0, 1.0f, false, true}, HalfMap{n0 + 32, 1.0f, false, true}, 0, nullptr, scr, lane); continue; } r -= 16 * I_E;
        if (r < I_IN) { const int kb = r / 91, n0 = (r % 91) * 64; HalfMap hm[2];
#pragma unroll
            for (int hh = 0; hh < 2; ++hh) { const int n = n0 + 32 * hh; hm[hh].valid = n < INC_; hm[hh].drow = n < 2208 ? n : n + 96; hm[hh].cs = n < 512 ? C_NA : ((n >= 2208 && n < 2720) ? C_MEM : 1.0f); hm[hh].rp = (n == 2176); }
            p0_item64(PWIN(P), INC_, kb * 64, n0, win, 1024, hm[0], hm[1], 0, PGMIX(P), scr, lane); continue; } r -= I_IN;
        if (r < I_UQ) { const int kb = r / 12, nb = (r % 12) * 2, n0 = nb * 32;
            p0_item64(PWUQ(P), 768, kb * 64, n0, wuq, 384, HalfMap{n0, C_MLA, (nb % 3) == 2, true}, HalfMap{n0 + 32, C_MLA, ((nb + 1) % 3) == 2, true}, 0, PQN(P), scr, lane); continue; } r -= I_UQ;
        if (r < I_UKV) { const int kb = r / 16, nb = (r % 16) * 2, n0 = nb * 32; const int hh = nb >> 2, part = nb & 3; const int dr = (part < 2) ? (hh * 64 + part * 32) : (512 + hh * 64 + (part - 2) * 32);
            p0_item64(PWUKV(P), 1024, kb * 64, n0, wukv, 384, HalfMap{dr, 1.0f, false, true}, HalfMap{dr + 32, 1.0f, false, true}, 0, PKVN(P), scr, lane); continue; } r -= I_UKV;
        if (r < I_MK) { const int kb = r / 16, n0 = (r % 16) * 64; p0_item64(PWMEMKV(P), 1024, kb * 64, n0, wmk, 1024, HalfMap{n0, 1.0f, false, true}, HalfMap{n0 + 32, 1.0f, false, true}, 0, PGMEM(P), scr, lane); continue; } r -= I_MK;
        if (r < 3 * I_O) { const int br = r / I_O, q = r % I_O, kb = q / 16, n0 = (q % 16) * 64; p0_item64(P.in[11 + br], 1024, kb * 64, n0, wo, 1536, HalfMap{n0, 1.0f, false, true}, HalfMap{n0 + 32, 1.0f, false, true}, br * 512, nullptr, scr, lane); continue; } r -= 3 * I_O;
        { const int kb = r / 16, n0 = (r % 16) * 64; p0_item64(PWOUT(P), 1024, kb * 64, n0, wout, 1024, HalfMap{n0, 1.0f, false, true}, HalfMap{n0 + 32, 1.0f, false, true}, 0, nullptr, scr, lane); }
    }
    for (int i = gw * 64 + lane; i < 12288; i += NGW * 64) ((u32x4*)(win + (size_t)2208 * 1024))[i] = (u32x4){0u, 0u, 0u, 0u};
    bf16_t* xb = (bf16_t*)(((unsigned char*)P.out) + DO_XB); float* rstd_x = (float*)(P.ws + WS_RSTDX);
    for (int m = gw; m < T_; m += NGW) p0_row(PX(P) + (size_t)m * D_, xb + (size_t)m * D_, rstd_x + m, lane);
    bf16_t* memb = (bf16_t*)(P.ws + WS_MEMB); float* rstd_m = (float*)(P.ws + WS_RSTDM);
    for (int m = gw; m < 2048; m += NGW) p0_row(PMEM(P) + (size_t)m * D_, memb + (size_t)m * D_, rstd_m + m, lane);
    if (gw == NGW - 1) { float* rope = (float*)(P.ws + WS_ROPE);
        for (int i = lane; i < 512; i += 64) { const int pos = i >> 3, fi = i & 7; const float inv = exp2f(-(float)fi * 1.6609640474436813f); const float ang = (float)pos * inv;
            float rev = ang * 0.15915494309189535f; rev -= floorf(rev); rope[2 * i] = __builtin_amdgcn_cosf(rev); rope[2 * i + 1] = __builtin_amdgcn_sinf(rev); } }
}

__device__ __forceinline__ void phase6(const Ptrs& P, LAS unsigned char* lds, int gw, int NGW, int lane) {
    LAS float* wrT = (LAS float*)lds;
#pragma unroll 2
    for (int i = threadIdx.x; i < 16384; i += NTHREADS) { const int d = i >> 4, e = i & 15; wrT[e * 1024 + d] = PWROUTER(P)[i] * PGFFN(P)[d]; }
    __syncthreads();
    const bf16_t* dbuf = (const bf16_t*)(P.ws + WS_H); bf16_t* hb = (bf16_t*)(P.ws + WS_HB); float* rstd_h = (float*)(P.ws + WS_RSTDH); float* aff = (float*)(P.ws + WS_AFF);
    const int b5 = (lane >> 5) & 1, b4 = (lane >> 4) & 1, b3 = (lane >> 3) & 1, b2 = (lane >> 2) & 1; const int e_me = 8 * b5 + 4 * b4 + 2 * b3 + b2;
    const float bias = PBROUTER(P)[e_me];
    for (int row = gw; row < T_; row += NGW) {
        asm volatile("" ::: "memory");
        const f32x4* xr = (const f32x4*)(PX(P) + (size_t)row * D_) + lane; const u32x2* dr = (const u32x2*)(dbuf + (size_t)row * D_) + lane; f32x4 v[4]; float ss = 0.f;
#pragma unroll
        for (int j = 0; j < 4; ++j) { v[j] = xr[64 * j]; const u32x2 w = dr[64 * j]; v[j][0] += bflo(w.x); v[j][1] += bfhi(w.x); v[j][2] += bflo(w.y); v[j][3] += bfhi(w.y);
            ss += (v[j][0] * v[j][0] + v[j][1] * v[j][1]) + (v[j][2] * v[j][2] + v[j][3] * v[j][3]); }
        u32x2* o8 = (u32x2*)(hb + (size_t)row * D_) + lane;
#pragma unroll
        for (int j = 0; j < 4; ++j) { u32x2 w; w.x = cvt_pk_bf16(v[j][0], v[j][1]); w.y = cvt_pk_bf16(v[j][2], v[j][3]); o8[64 * j] = w; }
        float a[16];
#pragma unroll
        for (int e = 0; e < 16; ++e) { float s = 0.f;
#pragma unroll
            for (int j = 0; j < 4; ++j) { const f32x4 w = *(const LAS f32x4*)(wrT + e * 1024 + 4 * lane + 256 * j); s += (v[j][0] * w[0] + v[j][1] * w[1]) + (v[j][2] * w[2] + v[j][3] * w[3]); }
            asm volatile("" : "+v"(s) :: "memory"); a[e] = s; }
        ss = wave_sum(ss); const float rstd = rsqrtf(ss * (1.0f / 1024.0f) + EPS_);
        if (lane == 0) rstd_h[row] = rstd;
        float a8[8], a4[4], a2[2], a1;
#pragma unroll
        for (int k = 0; k < 8; ++k) { const float send = b5 ? a[k] : a[k + 8]; const float recv = __shfl_xor(send, 32); a8[k] = (b5 ? a[k + 8] : a[k]) + recv; }
#pragma unroll
        for (int k = 0; k < 4; ++k) { const float send = b4 ? a8[k] : a8[k + 4]; const float recv = __shfl_xor(send, 16); a4[k] = (b4 ? a8[k + 4] : a8[k]) + recv; }
#pragma unroll
        for (int k = 0; k < 2; ++k) { const float send = b3 ? a4[k] : a4[k + 2]; const float recv = __shfl_xor(send, 8); a2[k] = (b3 ? a4[k + 2] : a4[k]) + recv; }
        { const float send = b2 ? a2[0] : a2[1]; const float recv = __shfl_xor(send, 4); a1 = (b2 ? a2[1] : a2[0]) + recv; }
        a1 += __shfl_xor(a1, 2); a1 += __shfl_xor(a1, 1);
        const float logit = a1 * rstd + bias;
        float mx = logit; mx = fmaxf(mx, __shfl_xor(mx, 4)); mx = fmaxf(mx, __shfl_xor(mx, 8)); mx = fmaxf(mx, __shfl_xor(mx, 16)); mx = fmaxf(mx, __shfl_xor(mx, 32));
        const float pe = expf(logit - mx); float sm = pe; sm += __shfl_xor(sm, 4); sm += __shfl_xor(sm, 8); sm += __shfl_xor(sm, 16); sm += __shfl_xor(sm, 32);
        if ((lane & 3) == 0) aff[(size_t)row * 16 + e_me] = pe / sm;
    }
    __syncthreads();
}

__device__ __forceinline__ void phase7(const Ptrs& P, LAS unsigned char* lds, int G) {
    LAS unsigned* keys = (LAS unsigned*)lds;
    LAS unsigned* hist = keys + 4096;
    LAS unsigned* misc = hist + 256;
    LAS int* tokl = (LAS int*)(misc + 32);
    const int tid = threadIdx.x, lane = tid & 63, wid = tid >> 6;
    const float* aff = (const float*)(P.ws + WS_AFF); int* idx = (int*)(P.ws + WS_IDX); float* gsel = (float*)(P.ws + WS_GSEL); int* sel = (int*)(P.ws + WS_SEL);
    const bf16_t* hb = (const bf16_t*)(P.ws + WS_HB); bf16_t* xs = (bf16_t*)(P.ws + WS_XS); const float* rstd_h = (const float*)(P.ws + WS_RSTDH); float* rstd_xs = (float*)(P.ws + WS_RSTDXS);
    for (int task = blockIdx.x; task < 128; task += G) {
        const int b = task >> 4, e = task & 15;
        for (int i = tid; i < 4096; i += NTHREADS) keys[i] = __float_as_uint(aff[((size_t)b * S_ + i) * 16 + e]);
        if (tid == 0) { misc[0] = 0u; misc[1] = 512u; }
        __syncthreads();
        for (int shift = 24; shift >= 0; shift -= 8) {
            if (tid < 256) hist[tid] = 0u;
            __syncthreads();
            const unsigned prefix = misc[0];
#pragma unroll
            for (int j = 0; j < 8; ++j) { const unsigned k = keys[tid * 8 + j]; if (shift == 24 || (k >> (shift + 8)) == prefix) __hip_atomic_fetch_add(&hist[(k >> shift) & 255u], 1u, __ATOMIC_RELAXED, __HIP_MEMORY_SCOPE_WORKGROUP); }
            __syncthreads();
            if (wid == 0) {
                const unsigned kk = misc[1];
                const unsigned h0 = hist[4 * lane], h1 = hist[4 * lane + 1], h2 = hist[4 * lane + 2], h3 = hist[4 * lane + 3];
                const unsigned s = h0 + h1 + h2 + h3;
                unsigned incl = s;
#pragma unroll
                for (int o = 1; o < 64; o <<= 1) { const unsigned t = __shfl_down(incl, o); if (lane + o < 64) incl += t; }
                const unsigned excl = incl - s;
                if (excl < kk && kk <= incl) {
                    unsigned rem = kk - excl; unsigned bin;
                    if (rem <= h3) { bin = 3; } else { rem -= h3; if (rem <= h2) { bin = 2; } else { rem -= h2; if (rem <= h1) { bin = 1; } else { rem -= h1; bin = 0; } } }
                    misc[0] = (prefix << 8) | (unsigned)(4 * lane + bin); misc[1] = rem;
                }
            }
            __syncthreads();
        }
        const unsigned thr = misc[0], kk = misc[1];
        unsigned kv[8]; unsigned cg_ = 0, ce = 0;
#pragma unroll
        for (int j = 0; j < 8; ++j) { kv[j] = keys[tid * 8 + j]; cg_ += kv[j] > thr ? 1u : 0u; ce += kv[j] == thr ? 1u : 0u; }
        unsigned ig = cg_, ie = ce;
#pragma unroll
        for (int o = 1; o < 64; o <<= 1) { const unsigned tg = __shfl_up(ig, o), te = __shfl_up(ie, o); if (lane >= o) { ig += tg; ie += te; } }
        if (lane == 63) { misc[8 + wid] = ig; misc[16 + wid] = ie; }
        __syncthreads();
        unsigned bg = ig - cg_, be = ie - ce;
        for (int w = 0; w < wid; ++w) { bg += misc[8 + w]; be += misc[16 + w]; }
#pragma unroll
        for (int j = 0; j < 8; ++j) { const int t = tid * 8 + j; const bool isg = kv[j] > thr, ise = kv[j] == thr; const bool s_ = isg || (ise && be < kk);
            const unsigned slot = bg + (be < kk ? be : kk);
            if (s_) { idx[task * 512 + slot] = t; gsel[task * 512 + slot] = __uint_as_float(kv[j]); tokl[slot] = t; }
            sel[((size_t)b * S_ + t) * 16 + e] = s_ ? (int)slot : -1;
            bg += isg ? 1u : 0u; be += ise ? 1u : 0u; }
        __syncthreads();
        { const int t = tokl[tid]; rstd_xs[(size_t)task * 512 + tid] = rstd_h[(size_t)b * S_ + t]; }
        __syncthreads();
    }
}

__device__ __forceinline__ void phase10(const Ptrs& P, int gw, int NGW, int lane) {
    const bf16_t* dbuf = (const bf16_t*)(P.ws + WS_H); const bf16_t* ybuf = (const bf16_t*)(P.ws + WS_XS); const int* sel = (const int*)(P.ws + WS_SEL);
    f32x4 gf[4];
#pragma unroll
    for (int j = 0; j < 4; ++j) gf[j] = ((const f32x4*)PGFINAL(P))[lane + 64 * j];
    for (int row = gw; row < T_; row += NGW) {
        const f32x4* xr = (const f32x4*)(PX(P) + (size_t)row * D_) + lane; const u32x2* dr = (const u32x2*)(dbuf + (size_t)row * D_) + lane; f32x4 v[4];
#pragma unroll
        for (int j = 0; j < 4; ++j) { v[j] = xr[64 * j]; const u32x2 w = dr[64 * j]; v[j][0] += bflo(w.x); v[j][1] += bfhi(w.x); v[j][2] += bflo(w.y); v[j][3] += bfhi(w.y); }
        const int sv = sel[(size_t)row * 16 + (lane & 15)]; const int b = row >> 12;
#pragma unroll
        for (int e = 0; e < 16; ++e) { const int s = __builtin_amdgcn_readlane(sv, e);
            if (s >= 0) { const u32x2* yp = (const u32x2*)(ybuf + ((size_t)(b * 16 + e) * 512 + s) * D_) + lane;
#pragma unroll
                for (int j = 0; j < 4; ++j) { const u32x2 w = yp[64 * j]; v[j][0] += bflo(w.x); v[j][1] += bfhi(w.x); v[j][2] += bflo(w.y); v[j][3] += bfhi(w.y); } } }
        float ss = 0.f;
#pragma unroll
        for (int j = 0; j < 4; ++j) ss += (v[j][0] * v[j][0] + v[j][1] * v[j][1]) + (v[j][2] * v[j][2] + v[j][3] * v[j][3]);
        ss = wave_sum(ss); const float rs = rsqrtf(ss * (1.0f / 1024.0f) + EPS_);
        f32x4* orow = (f32x4*)(P.out + (size_t)row * D_) + lane;
#pragma unroll
        for (int j = 0; j < 4; ++j) orow[64 * j] = v[j] * rs * gf[j];
    }
}

#ifndef MK_LAUNCHES
#define MK_LAUNCHES 1
#endif
constexpr int NPHASES = 11;

__global__ void __launch_bounds__(NTHREADS, 2) mk_fwd(Args args) {
    extern __shared__ __attribute__((aligned(16))) unsigned char lds_raw[];
    LAS unsigned char* lds = (LAS unsigned char*)lds_raw;
    cg::grid_group grid = cg::this_grid();
    const int tid = threadIdx.x, lane = tid & 63; const int wave = __builtin_amdgcn_readfirstlane(tid >> 6);
    const int G = gridDim.x, bx = blockIdx.x; const int vcu = (G % 8 == 0) ? (bx % 8) * (G / 8) + bx / 8 : bx;
    const int gw = vcu * 8 + wave, NGW = G * 8;
    const Args& P = args;
    unsigned char* ws = args.ws; unsigned char* dob = (unsigned char*)args.out;
    const int lo = args.ph_lo, hi = args.ph_hi;
    volatile LAS unsigned* xst = (volatile LAS unsigned*)(lds + LDS_BYTES - 16);
    if (tid < 4) xst[tid] = 0u;
    __syncthreads();
    XcdBarrier xbar; xbar.bar = (unsigned*)(args.ws + WS_CTL); xbar.x = 0; xbar.st = xst;
    if (args.coop) xbar = xcd_barrier_post((unsigned*)(args.ws + WS_CTL), xst);
#ifndef MK_ONLY
#define MK_ONLY -1
#endif
#define IN(k) ((MK_ONLY < 0 || MK_ONLY == (k)) && lo <= (k) && (k) < hi)
#ifndef MK_REPEAT
#define MK_REPEAT -1
#endif
#define REPS(k) ((MK_REPEAT == (k)) ? 2 : 1)
#ifndef MLA_CALL
#define MLA_CALL att::attn_unit<96, 64, 0, true>(lds, A, bh >> 3, bh & 7, U & 15)
#endif
#ifndef ATT_MEM_CALL
#define ATT_MEM_CALL att::attn_unit<128, 128, 1, false>(lds, A, bh >> 2, bh & 3, U & 15)
#endif
#ifndef MK_NA_V1
#define MK_NA_V1 0
#endif
#ifndef MK_CG_SEAMS
#define MK_CG_SEAMS 0
#endif
#define SEAM(k) do { if (IN(k) && IN((k) + 1)) { if ((k) < MK_CG_SEAMS) grid.sync(); else xcd_barrier(xbar); } } while (0)

    if (args.pad == 0x5eed) grid.sync();
    if (IN(0)) for (int rep = 0; rep < REPS(0); ++rep) { if (rep) xcd_barrier(xbar); phase0(P, lds, gw, NGW, wave, lane); }
    SEAM(0);
    if (IN(1)) for (int rep = 0; rep < REPS(1); ++rep) { if (rep) xcd_barrier(xbar);
        SchedP1 S{bx, G, (const char*)(dob + DO_XB), (const char*)(ws + WS_WIN), (const char*)(ws + WS_MEMB), (const char*)(ws + WS_WMK)};
        EpiP1 E{(const float*)(ws + WS_RSTDX), (const float*)(ws + WS_RSTDM), (bf16_t*)(ws + WS_NA), (bf16_t*)(ws + WS_ZC), (bf16_t*)(ws + WS_ZQM), (bf16_t*)(ws + WS_ZG), (bf16_t*)(ws + WS_KVMEM),
                (bf16_t*)(dob + DO_KPE), (float*)(ws + WS_SSQQ), (float*)(ws + WS_SSQKV), (const float*)(ws + WS_ROPE)};
        pg8::gemm_phase<EpiP1, SchedP1, false>(lds, 1024, 1024, S, E);
    }
    SEAM(1);
    if (IN(2)) for (int rep = 0; rep < REPS(2); ++rep) { if (rep) xcd_barrier(xbar);
        SchedP2 S{bx, G, (const char*)(ws + WS_ZC), (const char*)(ws + WS_WUQ), (const char*)(ws + WS_WUKV)};
        EpiP2 E{(const float*)(ws + WS_SSQQ), (const float*)(ws + WS_SSQKV), (bf16_t*)(dob + DO_QMLA), (bf16_t*)(dob + DO_KVBUF), (const float*)(ws + WS_ROPE)};
        pg8::gemm_phase<EpiP2, SchedP2, false>(lds, 768, 384, S, E);
    }
    SEAM(2);
    if (IN(3)) {
        if (REPS(31) == 2 && !MK_NA_V1) { na2::na_phase(lds, (const bf16_t*)(ws + WS_NA), (const bf16_t*)(ws + WS_NA) + (size_t)T_ * 512, (const bf16_t*)(ws + WS_NA) + (size_t)2 * T_ * 512, (bf16_t*)(ws + WS_ZC), args.in[4], vcu, G); xcd_barrier(xbar); }
        if (REPS(32) == 2) { att::AttnArgs A{(const bf16_t*)(ws + WS_ZQM), (const bf16_t*)(ws + WS_KVMEM), nullptr, (const bf16_t*)(ws + WS_KVMEM) + 512, (bf16_t*)(ws + WS_ZC), nullptr};
          for (int U = vcu; U < 512; U += G) { const int bh = U >> 4; ATT_MEM_CALL; } grid.sync(); }
        { att::AttnArgs A{(const bf16_t*)(dob + DO_QMLA), (const bf16_t*)(dob + DO_KVBUF), (const bf16_t*)(dob + DO_KPE), (const bf16_t*)(dob + DO_KVBUF) + 512, (bf16_t*)(ws + WS_ZC), nullptr};
          for (int rep = 0; rep < REPS(30); ++rep) { if (rep) xcd_barrier(xbar);
          for (int U = vcu; U < 1024; U += G) { const int bh = U >> 4; MLA_CALL; } } }
#if 0
#else
        na2::na_phase(lds, (const bf16_t*)(ws + WS_NA), (const bf16_t*)(ws + WS_NA) + (size_t)T_ * 512, (const bf16_t*)(ws + WS_NA) + (size_t)2 * T_ * 512, (bf16_t*)(ws + WS_NA), args.in[4], vcu, G);
#endif
        { att::AttnArgs A{(const bf16_t*)(ws + WS_ZQM), (const bf16_t*)(ws + WS_KVMEM), nullptr, (const bf16_t*)(ws + WS_KVMEM) + 512, (bf16_t*)(ws + WS_ZQM), nullptr};
          for (int U = vcu; U < 512; U += G) { const int bh = U >> 4; ATT_MEM_CALL; } }
    }
    SEAM(3);
    if (IN(4)) for (int rep = 0; rep < REPS(4); ++rep) { if (rep) xcd_barrier(xbar);
        SchedP4 S{bx, G, (const char*)(ws + WS_NA), (const char*)(ws + WS_ZC), (const char*)(ws + WS_ZQM), (const char*)(ws + WS_WO)};
        EpiP4 E{(const bf16_t*)(ws + WS_ZG), (bf16_t*)(dob + DO_MERGED)};
        pg8::gemm_phase<EpiP4, SchedP4, true>(lds, 512, 1536, S, E);
    }
    SEAM(4);
    if (IN(5)) for (int rep = 0; rep < REPS(5); ++rep) { if (rep) xcd_barrier(xbar);
        SchedP5 S{bx, G, (const char*)(dob + DO_MERGED), (const char*)(ws + WS_WOUT)};
        EpiP5 E{(bf16_t*)(ws + WS_H)};
        pg8::gemm_phase<EpiP5, SchedP5, false>(lds, 1024, 1024, S, E);
    }
    SEAM(5);
    if (IN(6)) for (int rep = 0; rep < REPS(6); ++rep) { if (rep) xcd_barrier(xbar); phase6(P, lds, gw, NGW, lane); }
    SEAM(6);
    if (IN(7)) for (int rep = 0; rep < REPS(7); ++rep) { if (rep) xcd_barrier(xbar); phase7(P, lds, G); }
    SEAM(7);
    if (IN(8)) for (int rep = 0; rep < REPS(8); ++rep) { if (rep) xcd_barrier(xbar);
        SchedP8 S{bx, G, (const char*)(ws + WS_HB), (const char*)(ws + WS_WGU)};
        EpiP8 E{(const float*)(ws + WS_RSTDXS), (bf16_t*)(dob + DO_ACT)};
        LAS int* gtab = (LAS int*)(lds + pg8::STAGE_BYTES);
        { const int* idxg = (const int*)(ws + WS_IDX); pg8::Unit u_;
          for (int i = 0; S.next(i, u_); ++i) { if (i < 14) { if (tid < 256) { const int row = u_.pm * 256 + tid; gtab[i * 256 + tid] = idxg[row] + (row >> 13) * S_; } } }
          __syncthreads(); }
        pg8::gemm_phase<EpiP8, SchedP8, false, true>(lds, 1024, 1024, S, E, gtab);
    }
    SEAM(8);
    if (IN(9)) for (int rep = 0; rep < REPS(9); ++rep) { if (rep) xcd_barrier(xbar);
        SchedP9 S{bx, G, (const char*)(dob + DO_ACT), (const char*)(ws + WS_WD)};
        EpiP9 E{(const float*)(ws + WS_GSEL), (bf16_t*)(ws + WS_XS)};
        pg8::gemm_phase<EpiP9, SchedP9, false>(lds, 1024, 1024, S, E);
    }
    SEAM(9);
    if (IN(10)) for (int rep = 0; rep < REPS(10); ++rep) { if (rep) xcd_barrier(xbar); phase10(P, gw, NGW, lane); }
#undef IN
#undef SEAM
}

extern "C" void kernel_launch(void* const* d_in, const int* in_sizes, int n_in, void* d_out, int out_size, void* d_ws, size_t ws_size, hipStream_t stream) {
    static int grid = 0;
    if (grid == 0) {
        if (n_in != 22 || out_size != T_ * D_ || ws_size < WS_END) { fprintf(stderr, "kernel_launch: unexpected shapes (n_in %d out %d ws %zu)\n", n_in, out_size, ws_size); grid = -1; return; }
        int dev = 0, cus = 0, per_cu = 0;
        hipGetDevice(&dev); hipDeviceGetAttribute(&cus, hipDeviceAttributeMultiprocessorCount, dev);
        if (hipFuncSetAttribute((const void*)mk_fwd, hipFuncAttributeMaxDynamicSharedMemorySize, LDS_BYTES) != hipSuccess) { fprintf(stderr, "kernel_launch: hipFuncSetAttribute failed\n"); grid = -1; return; }
        hipOccupancyMaxActiveBlocksPerMultiprocessor(&per_cu, (const void*)mk_fwd, NTHREADS, LDS_BYTES);
        (void)hipGetLastError();
        if (per_cu < 1) { fprintf(stderr, "kernel_launch: occupancy query says %d blocks per CU\n", per_cu); per_cu = 1; }
        grid = cus * 1;
        fprintf(stderr, "kernel_launch: cus %d per_cu %d grid %d ws %zu\n", cus, per_cu, grid, ws_size);
    }
    if (grid < 0) return;
    if (hipMemsetAsync((char*)d_ws + WS_CTL, 0, CTL_BYTES, stream) != hipSuccess) { fprintf(stderr, "kernel_launch: memset failed\n"); return; }
    Args a{};
    for (int i = 0; i < 22; ++i) a.in[i] = (const float*)d_in[i];
    a.out = (float*)d_out; a.ws = (unsigned char*)d_ws;
#if MK_LAUNCHES == 1
    a.ph_lo = 0; a.ph_hi = NPHASES; a.coop = 1;
    void* kargs[] = {&a};
    hipError_t e = hipLaunchCooperativeKernel((const void*)mk_fwd, dim3(grid), dim3(NTHREADS), kargs, LDS_BYTES, stream);
    if (e != hipSuccess) fprintf(stderr, "kernel_launch: cooperative launch failed: %s (grid %d)\n", hipGetErrorString(e), grid);
#else
    for (int p = 0; p < NPHASES; ++p) { a.ph_lo = p; a.ph_hi = p + 1; a.coop = 0; hipLaunchKernelGGL(mk_fwd, dim3(grid), dim3(NTHREADS), LDS_BYTES, stream, a); }
#endif
}
```

```cpp
#include <hip/hip_runtime.h>
#include <hip/hip_cooperative_groups.h>
#include <cstdio>
#include <cstdint>
namespace cg = cooperative_groups;

#define LAS __attribute__((address_space(3)))
typedef unsigned short bf16_t;
typedef short bf16x8 __attribute__((ext_vector_type(8)));
typedef short s16x4 __attribute__((ext_vector_type(4)));
typedef float f32x2 __attribute__((ext_vector_type(2)));
typedef float f32x4 __attribute__((ext_vector_type(4)));
typedef float f32x16 __attribute__((ext_vector_type(16)));
typedef unsigned u32x2 __attribute__((ext_vector_type(2)));
typedef unsigned u32x4 __attribute__((ext_vector_type(4)));

constexpr int T_ = 32768, S_ = 4096, D_ = 1024, NB_ = 8, INC_ = 5792, NZ_ = 5888;
constexpr float EPS_ = 1e-6f;
constexpr float LOG2E = 1.4426950408889634f;
constexpr float C_NA = 0.125f * LOG2E, C_MLA = 0.10206207261596577f * LOG2E, C_MEM = 0.08838834764831845f * LOG2E;

constexpr size_t MiB = (size_t)1 << 20;
constexpr size_t WS_WIN = 0;
constexpr size_t WS_WUQ = 12 * MiB;
constexpr size_t WS_WUKV = 13 * MiB;
constexpr size_t WS_WMK = 14 * MiB;
constexpr size_t WS_WO = 16 * MiB;
constexpr size_t WS_WOUT = 19 * MiB;
constexpr size_t WS_WGU = 21 * MiB;
constexpr size_t WS_WD = 85 * MiB;
constexpr size_t WS_RSTDX = 117 * MiB;
constexpr size_t WS_RSTDM = WS_RSTDX + 128 * 1024;
constexpr size_t WS_RSTDH = WS_RSTDM + 128 * 1024;
constexpr size_t WS_ROPE = WS_RSTDH + 128 * 1024;
constexpr size_t WS_RSTDXS = WS_ROPE + 128 * 1024;
constexpr size_t WS_GSEL = WS_RSTDXS + 256 * 1024;
constexpr size_t WS_IDX = WS_GSEL + 256 * 1024;
constexpr size_t WS_SSQQ = 119 * MiB;
constexpr size_t WS_SSQKV = 121 * MiB;
constexpr size_t WS_AFF = 122 * MiB;
constexpr size_t WS_SEL = 124 * MiB;
constexpr size_t WS_MEMB = 126 * MiB;
constexpr size_t WS_KVMEM = 130 * MiB;
constexpr size_t WS_ZG = 134 * MiB;
constexpr size_t WS_H = 134 * MiB;
constexpr size_t WS_HB = 262 * MiB;
constexpr size_t WS_NA = 326 * MiB;
constexpr size_t WS_XS = 326 * MiB;
constexpr size_t WS_ZC = 422 * MiB;
constexpr size_t WS_ZQM = 470 * MiB;
constexpr size_t WS_CTL = 502 * MiB;
constexpr size_t CTL_BYTES = 16384;
constexpr size_t WS_END = 503 * MiB;
constexpr size_t DO_XB = 0, DO_QMLA = 0, DO_KVBUF = 48 * MiB, DO_KPE = 112 * MiB, DO_MERGED = 0, DO_ACT = 0;

constexpr int LDS_BYTES = 147456;
constexpr int NTHREADS = 512;

__device__ __forceinline__ unsigned cvt_pk_bf16(float lo, float hi) { unsigned r; asm volatile("v_cvt_pk_bf16_f32 %0, %1, %2" : "=v"(r) : "v"(lo), "v"(hi)); return r; }
__device__ __forceinline__ float bf2f(unsigned short b) { return __uint_as_float(((unsigned)b) << 16); }
__device__ __forceinline__ float bflo(unsigned w) { return __uint_as_float(w << 16); }
__device__ __forceinline__ float bfhi(unsigned w) { return __uint_as_float(w & 0xffff0000u); }
__device__ __forceinline__ float wave_sum(float v) {
#pragma unroll
    for (int o = 1; o < 64; o <<= 1) v += __shfl_xor(v, o);
    return v;
}
__device__ __forceinline__ float fast_exp2(float x) { return __builtin_amdgcn_exp2f(x); }
__device__ __forceinline__ float fast_rcp(float x) { return __builtin_amdgcn_rcpf(x); }
__device__ __forceinline__ int crow(int r, int hi) { return (r & 3) + 8 * (r >> 2) + 4 * hi; }


#define XB_TMO      128
#define XB_XCNT(j)  (256  + 64 * (j))
#define XB_XSUB(j)  (1280 + 64 * (j))
#define XB_XGEN(j)  (2304 + 64 * (j))
#define XB_TOP      3328
#define XB_TOPGEN   3392
#define XCD_BAR_WORDS 3456
#define XB_SPIN_CAP (1u << 18)
__device__ __forceinline__ unsigned xb_ld(unsigned* p)              { return __hip_atomic_load(p, __ATOMIC_RELAXED, __HIP_MEMORY_SCOPE_AGENT); }
__device__ __forceinline__ unsigned xb_add(unsigned* p, unsigned v) { return __hip_atomic_fetch_add(p, v, __ATOMIC_RELAXED, __HIP_MEMORY_SCOPE_AGENT); }
__device__ __forceinline__ unsigned xb_xcc_id() { return (unsigned)__builtin_amdgcn_s_getreg((3 << 11) | 20) & 0xFu; }
#define XB_SPIN(cond, bar) do { unsigned _sp = 0; while (cond) { __builtin_amdgcn_s_sleep(1); \
    if ((++_sp & 255u) == 0u) { if (xb_ld(&(bar)[XB_TMO])) break; if (_sp > XB_SPIN_CAP) { atomicAdd(&(bar)[XB_TMO], 1u); break; } } } } while (0)
struct XcdBarrier { unsigned* bar; unsigned x; volatile LAS unsigned* st; };
__device__ __forceinline__ XcdBarrier xcd_barrier_post(unsigned* bar, volatile LAS unsigned* st) {
    XcdBarrier b; b.bar = bar; b.x = xb_xcc_id(); b.st = st;
    if (threadIdx.x == 0) (void)xb_add(&bar[XB_XCNT(b.x)], 1u);
    return b;
}
__device__ __forceinline__ void xcd_barrier_complete(unsigned* bar, unsigned x, unsigned& nloc, unsigned& nx) {
    const unsigned G = gridDim.x * gridDim.y * gridDim.z;
    unsigned sum, cnt, mine, sp = 0u;
    for (;;) {
        sum = 0u; cnt = 0u; mine = 0u;
#pragma unroll
        for (unsigned j = 0; j < 16; ++j) { const unsigned c = xb_ld(&bar[XB_XCNT(j)]); sum += c; cnt += (c > 0u) ? 1u : 0u; mine = (j == x) ? c : mine; }
        if (sum == G) break;
        __builtin_amdgcn_s_sleep(1);
        if ((++sp & 255u) == 0u) { if (xb_ld(&bar[XB_TMO])) break; if (sp > XB_SPIN_CAP) { atomicAdd(&bar[XB_TMO], 1u); break; } }
    }
    nloc = mine > 0u ? mine : 1u; nx = cnt > 0u ? cnt : 1u;
}
__device__ __forceinline__ void xcd_barrier(const XcdBarrier& b) {
    asm volatile("s_waitcnt vmcnt(0)" ::: "memory");
    __syncthreads();
    if (threadIdx.x == 0) {
        unsigned* bar = b.bar;
        __builtin_amdgcn_s_waitcnt(0);
        unsigned nloc = b.st[0], nx = b.st[1];
        if (nloc == 0u) { xcd_barrier_complete(bar, b.x, nloc, nx); b.st[0] = nloc; b.st[1] = nx; }
        const unsigned old = xb_add(&bar[XB_XSUB(b.x)], 1u);
        const unsigned gen = old / nloc;
        if (old + 1u == (gen + 1u) * nloc) {
            __builtin_amdgcn_fence(__ATOMIC_RELEASE, "agent");
            asm volatile("s_waitcnt vmcnt(0)" ::: "memory");
            const unsigned og = xb_add(&bar[XB_TOP], 1u);
            const unsigned tg = og / nx;
            if (og + 1u == (tg + 1u) * nx) xb_add(&bar[XB_TOPGEN], 1u);
            else XB_SPIN(xb_ld(&bar[XB_TOPGEN]) == tg, bar);
            __builtin_amdgcn_fence(__ATOMIC_ACQUIRE, "agent");
            xb_add(&bar[XB_XGEN(b.x)], 1u);
            asm volatile("s_waitcnt vmcnt(0)" ::: "memory");
        } else {
            XB_SPIN(xb_ld(&bar[XB_XGEN(b.x)]) == gen, bar);
            __builtin_amdgcn_fence(__ATOMIC_ACQUIRE, "agent");
            asm volatile("s_waitcnt vmcnt(0)" ::: "memory");
        }
    }
    __syncthreads();
}

struct Args { const float* in[22]; float* out; unsigned char* ws; int ph_lo, ph_hi, coop, pad; };

namespace pg8 {
constexpr int BM = 256, BK = 64, HALF = 128, HTB = HALF * BK * 2, STAGE_BYTES = 8 * HTB, NXCD = 8, WGM = 8;
__device__ __forceinline__ int lds_byte(int r, int c) { const int st = (r >> 4) * 2 + (c >> 5), rr = r & 15, cc = c & 31, ob = rr * 64 + cc * 2; return st * 1024 + (ob ^ (((ob >> 9) & 1) << 5)); }
__device__ __forceinline__ void stage_rc(int b, int& R, int& C) { const int st = b / 1024, sb = b % 1024, swz = sb ^ (((sb >> 9) & 1) << 5); R = (st >> 1) * 16 + swz / 64; C = (st & 1) * 32 + (swz % 64) / 2; }
__device__ __forceinline__ int perm32(int rho) { const int n = rho >> 4, i = rho & 15; return 8 * (i >> 2) + 4 * n + (i & 3); }

struct Unit { int pm, pn, kind, nt, aux; const char* A; const char* A1; const char* A2; const char* B; };

__device__ __forceinline__ void tile_order(int L, int nM, int nN, int& pm, int& pn) {
    const int nwg = nM * nN; int wgid = L;
    { const int q = nwg / NXCD, r = nwg % NXCD, xcd = wgid % NXCD, off = wgid / NXCD; wgid = (xcd < r ? xcd * (q + 1) : r * (q + 1) + (xcd - r) * q) + off; }
    const int nig = WGM * nN, gid = wgid / nig, fm = gid * WGM, gsz = (nM - fm) < WGM ? (nM - fm) : WGM;
    pm = fm + ((wgid % nig) % gsz); pn = (wgid % nig) / gsz;
}

template <class Epi, class Sched, bool SEG3, bool GATHER = false>
__device__ __forceinline__ void gemm_phase(LAS unsigned char* lds, const int lda, const int ldb, const Sched& S, const Epi& E, const LAS int* gtab = nullptr) {
    int tid_ = threadIdx.x; asm volatile("" : "+v"(tid_));
    const int tid = tid_, wid = __builtin_amdgcn_readfirstlane(tid >> 6), lane = tid & 63, wr = wid >> 2, wc = wid & 3, fr = lane & 15, fq = lane >> 4;
    unsigned voffA[2], voffB[2]; int gR[2]; unsigned gC[2];
#pragma unroll
    for (int i = 0; i < 2; ++i) { int R, C; stage_rc(tid * 16 + i * 8192, R, C); gR[i] = R; gC[i] = (unsigned)C * 2u; const int Rb = Epi::PERM ? ((R & ~31) + perm32(R & 31)) : R;
        voffA[i] = (unsigned)(R * lda + C) * 2u; voffB[i] = (unsigned)(Rb * ldb + C) * 2u; }
    const size_t kstep = (size_t)(BK * 2);
    const size_t hstepA = (size_t)HALF * lda * 2, hstepB = (size_t)HALF * ldb * 2;
    const unsigned ldsw = (unsigned)wid * 1024u;
    const int aoff = lds_byte(wr * 64 + fr, fq * 8), boff = lds_byte(wc * 32 + fr, fq * 8);
#define PG8_SA(b, h) (((b) * 2 + (h)) * HTB)
#define PG8_SB(b, h) ((4 + (b) * 2 + (h)) * HTB)
#define PG8_STAGE(bufoff, gbase, voff) do { _Pragma("unroll") for (int _i = 0; _i < 2; ++_i) \
        __builtin_amdgcn_global_load_lds((const unsigned*)((const char*)(gbase) + (voff)[_i]), (LAS unsigned*)(lds + (bufoff) + ldsw + _i * 8192), 16, 0, 0); } while (0)
#define PG8_GLOAD(dst, ord) do { _Pragma("unroll") for (int _h = 0; _h < 2; ++_h) _Pragma("unroll") for (int _i = 0; _i < 2; ++_i) dst[_h][_i] = (unsigned)gtab[(ord) * 256 + _h * 128 + gR[_i]] * (unsigned)(lda * 2) + gC[_i]; } while (0)
#define PG8_STAGE_A(bufoff, kptr, h, VS) do { if constexpr (GATHER) { PG8_STAGE(bufoff, kptr, VS[h]); } else { PG8_STAGE(bufoff, (kptr) + (h) * hstepA, voffA); } } while (0)
#define PG8_LDA(dst, b, h) do { _Pragma("unroll") for (int m = 0; m < 4; ++m) _Pragma("unroll") for (int k = 0; k < 2; ++k) dst[m][k] = *(const LAS bf16x8*)(lds + PG8_SA(b, h) + aoff + m * 2048 + k * 1024); } while (0)
#define PG8_LDB(dst, b, h) do { _Pragma("unroll") for (int n = 0; n < 2; ++n) _Pragma("unroll") for (int k = 0; k < 2; ++k) dst[n][k] = *(const LAS bf16x8*)(lds + PG8_SB(b, h) + boff + n * 2048 + k * 1024); } while (0)
#define PG8_MMA(ai, bj, At, Bt) do { __builtin_amdgcn_s_setprio(1); _Pragma("unroll") for (int m = 0; m < 4; ++m) _Pragma("unroll") for (int n = 0; n < 2; ++n) _Pragma("unroll") for (int k = 0; k < 2; ++k) \
        acc[ai][bj][m][n] = __builtin_amdgcn_mfma_f32_16x16x32_bf16(Bt[n][k], At[m][k], acc[ai][bj][m][n], 0, 0, 0); __builtin_amdgcn_s_setprio(0); } while (0)
#define PG8_WAIT_V(n) asm volatile("s_waitcnt vmcnt(" #n ")" ::: "memory")
#define PG8_WAIT_L(n) asm volatile("s_waitcnt lgkmcnt(" #n ")" ::: "memory")
#define PG8_BAR __builtin_amdgcn_s_barrier()
#define PG8_SCHED __builtin_amdgcn_sched_barrier(0)
#define PG8_TA(u, kt) (SEG3 ? (((kt) < 8 ? (u).A : ((kt) < 16 ? (u).A1 : (u).A2)) + (size_t)((kt) & 7) * kstep) : ((u).A + (size_t)(kt) * kstep))
#define PG8_TB(u, kt) ((u).B + (size_t)(kt) * kstep)
    Unit cur, nxt; int ui = 0;
    if (!S.next(0, cur)) return;
    f32x4 acc[2][2][4][2];
#pragma unroll
    for (int a = 0; a < 2; ++a)
#pragma unroll
        for (int b = 0; b < 2; ++b)
#pragma unroll
            for (int m = 0; m < 4; ++m)
#pragma unroll
                for (int n = 0; n < 2; ++n) acc[a][b][m][n] = (f32x4){0.f, 0.f, 0.f, 0.f};
    bf16x8 At[4][2], B0[2][2], B1[2][2];
    unsigned vC[2][2], vN[2][2];
#pragma unroll
    for (int _h = 0; _h < 2; ++_h)
#pragma unroll
        for (int _i = 0; _i < 2; ++_i) { vC[_h][_i] = 0u; vN[_h][_i] = 0u; }
    if constexpr (GATHER) { PG8_GLOAD(vC, 0); }
    {
        const char* cA = PG8_TA(cur, 0); const char* cB = PG8_TB(cur, 0);
        PG8_STAGE(PG8_SB(0, 0), cB, voffB); PG8_STAGE(PG8_SB(0, 1), cB + hstepB, voffB); PG8_STAGE_A(PG8_SA(0, 0), cA, 0, vC); PG8_STAGE_A(PG8_SA(0, 1), cA, 1, vC);
        if (wr == 1) PG8_BAR;
        PG8_WAIT_V(2); PG8_BAR;
        const char* cA1 = PG8_TA(cur, 1); const char* cB1 = PG8_TB(cur, 1);
        PG8_STAGE(PG8_SB(1, 0), cB1, voffB); PG8_STAGE_A(PG8_SA(1, 0), cA1, 0, vC); PG8_STAGE(PG8_SB(1, 1), cB1 + hstepB, voffB);
        PG8_WAIT_V(6); PG8_BAR;
    }
    for (;;) {
        const bool has_next = S.next(ui + 1, nxt);
        if constexpr (GATHER) { if (has_next) PG8_GLOAD(vN, ui + 1); }
        const int nt = cur.nt;
        for (int t = 0; t < nt; t += 2) {
            const bool last = (t == nt - 2);
            const char* a1 = PG8_TA(cur, t + 1);
            const char* a2; const char* b2;
            if (last) { if (has_next) { a2 = PG8_TA(nxt, 0); b2 = PG8_TB(nxt, 0); } else { a2 = PG8_TA(cur, 0); b2 = PG8_TB(cur, 0); } }
            else { a2 = PG8_TA(cur, t + 2); b2 = PG8_TB(cur, t + 2); }
            const char* a3 = a2 + kstep; const char* b3 = b2 + kstep;
            unsigned vS[2][2];
#pragma unroll
            for (int _h = 0; _h < 2; ++_h)
#pragma unroll
                for (int _i = 0; _i < 2; ++_i) vS[_h][_i] = (last && has_next) ? vN[_h][_i] : vC[_h][_i];
            if constexpr (Epi::HAS_MID) { if (t > 0 && (t & 7) == 0) E.mid(acc, cur, t >> 3, wr, wc, fr, fq); }
            PG8_LDB(B0, 0, 0); PG8_LDB(B1, 0, 1); PG8_SCHED; PG8_LDA(At, 0, 0); PG8_STAGE_A(PG8_SA(1, 1), a1, 1, vC);
            PG8_WAIT_V(8); PG8_WAIT_L(0); PG8_BAR; PG8_MMA(0, 0, At, B0); PG8_MMA(0, 1, At, B1); PG8_BAR; PG8_SCHED;
            PG8_LDA(At, 0, 1); PG8_STAGE(PG8_SB(0, 0), b2, voffB); PG8_STAGE(PG8_SB(0, 1), b2 + hstepB, voffB); PG8_STAGE_A(PG8_SA(0, 0), a2, 0, vS);
            PG8_WAIT_V(8); PG8_WAIT_L(0); PG8_BAR; PG8_MMA(1, 0, At, B0); PG8_MMA(1, 1, At, B1); PG8_BAR; PG8_SCHED;
            PG8_LDB(B0, 1, 0); PG8_LDB(B1, 1, 1); PG8_SCHED; PG8_LDA(At, 1, 0); PG8_STAGE_A(PG8_SA(0, 1), a2, 1, vS);
            PG8_WAIT_V(8); PG8_WAIT_L(0); PG8_BAR; PG8_MMA(0, 0, At, B0); PG8_MMA(0, 1, At, B1); PG8_BAR; PG8_SCHED;
            PG8_LDA(At, 1, 1); PG8_STAGE(PG8_SB(1, 0), b3, voffB); PG8_STAGE(PG8_SB(1, 1), b3 + hstepB, voffB); PG8_STAGE_A(PG8_SA(1, 0), a3, 0, vS);
            PG8_WAIT_V(8); PG8_WAIT_L(0); PG8_BAR; PG8_MMA(1, 0, At, B0); PG8_MMA(1, 1, At, B1); PG8_BAR; PG8_SCHED;
        }
        if (wr == 0) PG8_BAR;
        E(acc, cur, wr, wc, fr, fq);
        if (!has_next) break;
#pragma unroll
        for (int a = 0; a < 2; ++a)
#pragma unroll
            for (int b = 0; b < 2; ++b)
#pragma unroll
                for (int m = 0; m < 4; ++m)
#pragma unroll
                    for (int n = 0; n < 2; ++n) acc[a][b][m][n] = (f32x4){0.f, 0.f, 0.f, 0.f};
        cur = nxt; ++ui;
#pragma unroll
        for (int _h = 0; _h < 2; ++_h)
#pragma unroll
            for (int _i = 0; _i < 2; ++_i) vC[_h][_i] = vN[_h][_i];
        if (wr == 1) PG8_BAR;
    }
    PG8_WAIT_V(0);
    PG8_BAR;
#undef PG8_SA
#undef PG8_SB
#undef PG8_STAGE
#undef PG8_STAGE_A
#undef PG8_GLOAD
#undef PG8_LDA
#undef PG8_LDB
#undef PG8_MMA
#undef PG8_WAIT_V
#undef PG8_WAIT_L
#undef PG8_BAR
#undef PG8_SCHED
#undef PG8_TA
#undef PG8_TB
}
}

__device__ __forceinline__ u32x4 pack8(const f32x4 v0, const f32x4 v1) { u32x4 w; w.x = cvt_pk_bf16(v0[0], v0[1]); w.y = cvt_pk_bf16(v0[2], v0[3]); w.z = cvt_pk_bf16(v1[0], v1[1]); w.w = cvt_pk_bf16(v1[2], v1[3]); return w; }
__device__ __forceinline__ void rope8(f32x4& v0, f32x4& v1, int row, int fq, const float* rope) {
    const int t = row & (S_ - 1); const int pos = (fq >> 1) ? (t & 63) : (t >> 6);
    const f32x4* cs = (const f32x4*)(rope + (pos * 8 + 4 * (fq & 1)) * 2);
    const f32x4 c01 = cs[0], c23 = cs[1];
    float a, b;
    a = v0[0]; b = v0[1]; v0[0] = a * c01[0] - b * c01[1]; v0[1] = a * c01[1] + b * c01[0];
    a = v0[2]; b = v0[3]; v0[2] = a * c01[2] - b * c01[3]; v0[3] = a * c01[3] + b * c01[2];
    a = v1[0]; b = v1[1]; v1[0] = a * c23[0] - b * c23[1]; v1[1] = a * c23[1] + b * c23[0];
    a = v1[2]; b = v1[3]; v1[2] = a * c23[2] - b * c23[3]; v1[3] = a * c23[3] + b * c23[2];
}

__device__ __forceinline__ float sig_den(float x) { x = fminf(fmaxf(x, -30.f), 30.f); return 1.0f + fast_exp2(-LOG2E * x); }
struct EpiP1 {
    static constexpr bool PERM = true, HAS_MID = false;
    const float* rstd_x; const float* rstd_m; bf16_t* na; bf16_t* zc; bf16_t* zqm; bf16_t* zg; bf16_t* kvmem; bf16_t* kpe; float* ssq_q; float* ssq_kv; const float* rope;
    __device__ __forceinline__ void operator()(const f32x4 (&acc)[2][2][4][2], const pg8::Unit& u, int wr, int wc, int fr, int fq) const {
        const int row0 = u.pm * 256 + wr * 64 + fr; const int pn = u.pn;
        bf16_t* base; int ld, colt; const float* rsp;
        if (u.kind == 0) { rsp = rstd_x;
            if (pn < 6) { base = na + (size_t)(pn >> 1) * T_ * 512; ld = 512; colt = (pn & 1) * 256; }
            else if (pn < 9) { base = zc; ld = 768; colt = (pn - 6) * 256; }
            else if (pn < 11) { base = zqm; ld = 512; colt = (pn - 9) * 256; }
            else { base = zg; ld = 3072; colt = (pn - 11) * 256; } }
        else { rsp = rstd_m; base = kvmem; ld = 1024; colt = pn * 256; }
        const int col0 = colt + wc * 32 + 8 * fq;
        const bool stats = (u.kind == 0) && (pn >= 6) && (pn < 9); const bool isgate = (u.kind == 0) && (pn >= 11);
#pragma unroll
        for (int ai = 0; ai < 2; ++ai)
#pragma unroll
            for (int m = 0; m < 4; ++m) { const int row = row0 + ai * 128 + m * 16; const float rs = rsp[row]; bf16_t* rowp = base + (size_t)row * ld + col0;
#pragma unroll
                for (int bj = 0; bj < 2; ++bj) { f32x4 v0 = acc[ai][bj][m][0] * rs, v1 = acc[ai][bj][m][1] * rs;
                    if (isgate) {
#pragma unroll
                        for (int e = 0; e < 4; ++e) { v0[e] = sig_den(v0[e]); v1[e] = sig_den(v1[e]); } }
                    *(u32x4*)(rowp + bj * 128) = pack8(v0, v1);
                    if (stats) { const int idx = (pn - 6) * 2 + bj;
                        if (idx < 5) { float s = (v0[0] * v0[0] + v0[1] * v0[1]) + (v0[2] * v0[2] + v0[3] * v0[3]) + (v1[0] * v1[0] + v1[1] * v1[1]) + (v1[2] * v1[2] + v1[3] * v1[3]);
                            s += __shfl_xor(s, 16); s += __shfl_xor(s, 32);
                            if (fq == 0) { if (idx < 3) ssq_q[(size_t)row * 12 + idx * 4 + wc] = s; else ssq_kv[(size_t)row * 8 + (idx - 3) * 4 + wc] = s; } }
                        else if (wc == 0) { rope8(v0, v1, row, fq, rope); *(u32x4*)(kpe + (size_t)row * 32 + 8 * fq) = pack8(v0, v1); } } } }
    }
};
struct SchedP1 {
    int c, G; const char* xb; const char* win; const char* memb; const char* wmk;
    __device__ __forceinline__ bool next(int i, pg8::Unit& u) const {
        const int L = i * G + c; int pm, pn;
        if (L < 2944) { pg8::tile_order(L, 128, 23, pm, pn); u.pm = pm; u.pn = pn; u.kind = 0; u.nt = 16; u.aux = 0; u.A = xb + (size_t)pm * 256 * 2048; u.B = win + (size_t)pn * 256 * 2048; u.A1 = u.A; u.A2 = u.A; return true; }
        if (L < 2976) { pg8::tile_order(L - 2944, 8, 4, pm, pn); u.pm = pm; u.pn = pn; u.kind = 1; u.nt = 16; u.aux = 0; u.A = memb + (size_t)pm * 256 * 2048; u.B = wmk + (size_t)pn * 256 * 2048; u.A1 = u.A; u.A2 = u.A; return true; }
        return false;
    }
};

struct EpiP2 {
    static constexpr bool PERM = true, HAS_MID = false;
    const float* ssq_q; const float* ssq_kv; bf16_t* qmla; bf16_t* kvbuf; const float* rope;
    __device__ __forceinline__ void operator()(const f32x4 (&acc)[2][2][4][2], const pg8::Unit& u, int wr, int wc, int fr, int fq) const {
        const int row0 = u.pm * 256 + wr * 64 + fr; const int pn = u.pn;
        float rs[2][4];
        if (u.kind == 0) {
#pragma unroll
            for (int ai = 0; ai < 2; ++ai)
#pragma unroll
                for (int m = 0; m < 4; ++m) { const f32x4* p = (const f32x4*)(ssq_q + (size_t)(row0 + ai * 128 + m * 16) * 12); const f32x4 a = p[0], b = p[1], c = p[2];
                    const float s = ((a[0] + a[1]) + (a[2] + a[3])) + ((b[0] + b[1]) + (b[2] + b[3])) + ((c[0] + c[1]) + (c[2] + c[3])); rs[ai][m] = rsqrtf(s * (1.0f / 384.0f) + EPS_); }
        } else {
#pragma unroll
            for (int ai = 0; ai < 2; ++ai)
#pragma unroll
                for (int m = 0; m < 4; ++m) { const f32x4* p = (const f32x4*)(ssq_kv + (size_t)(row0 + ai * 128 + m * 16) * 8); const f32x4 a = p[0], b = p[1];
                    const float s = ((a[0] + a[1]) + (a[2] + a[3])) + ((b[0] + b[1]) + (b[2] + b[3])); rs[ai][m] = rsqrtf(s * (1.0f / 256.0f) + EPS_); }
        }
        bf16_t* base = u.kind == 0 ? qmla : kvbuf; const int ld = u.kind == 0 ? 768 : 1024;
        const int col0 = pn * 256 + wc * 32 + 8 * fq;
#pragma unroll
        for (int bj = 0; bj < 2; ++bj) { const bool isrope = (u.kind == 0) && (((8 * pn + 4 * bj + wc) % 3) == 2);
#pragma unroll
            for (int ai = 0; ai < 2; ++ai)
#pragma unroll
                for (int m = 0; m < 4; ++m) { const int row = row0 + ai * 128 + m * 16; f32x4 v0 = acc[ai][bj][m][0] * rs[ai][m], v1 = acc[ai][bj][m][1] * rs[ai][m];
                    if (isrope) rope8(v0, v1, row, fq, rope);
                    *(u32x4*)(base + (size_t)row * ld + col0 + bj * 128) = pack8(v0, v1); } }
    }
};
struct SchedP2 {
    int c, G; const char* zc; const char* wuq; const char* wukv;
    __device__ __forceinline__ bool next(int i, pg8::Unit& u) const {
        const int L = i * G + c; int pm, pn;
        if (L < 384) { pg8::tile_order(L, 128, 3, pm, pn); u.pm = pm; u.pn = pn; u.kind = 0; u.nt = 6; u.aux = 0; u.A = zc + (size_t)pm * 256 * 1536; u.B = wuq + (size_t)pn * 256 * 768; u.A1 = u.A; u.A2 = u.A; return true; }
        if (L < 896) { pg8::tile_order(L - 384, 128, 4, pm, pn); u.pm = pm; u.pn = pn; u.kind = 1; u.nt = 4; u.aux = 0; u.A = zc + (size_t)pm * 256 * 1536 + 768; u.B = wukv + (size_t)pn * 256 * 768; u.A1 = u.A; u.A2 = u.A; return true; }
        return false;
    }
};

struct EpiP4 {
    static constexpr bool PERM = true, HAS_MID = true;
    const bf16_t* zg; bf16_t* merged;
    __device__ __forceinline__ void mid(f32x4 (&acc)[2][2][4][2], const pg8::Unit& u, int seg, int wr, int wc, int fr, int fq) const {
        const int row0 = u.pm * 256 + wr * 64 + fr; const int col0 = u.pn * 256 + wc * 32 + 8 * fq;
#pragma unroll
        for (int ai = 0; ai < 2; ++ai) {
            u32x4 ga[4][2], gb[4][2];
#pragma unroll
            for (int m = 0; m < 4; ++m) { const bf16_t* gp = zg + (size_t)(row0 + ai * 128 + m * 16) * 3072 + col0 + (seg - 1) * 1024;
#pragma unroll
                for (int bj = 0; bj < 2; ++bj) { ga[m][bj] = *(const u32x4*)(gp + bj * 128); gb[m][bj] = *(const u32x4*)(gp + 1024 + bj * 128); } }
#pragma unroll
            for (int m = 0; m < 4; ++m)
#pragma unroll
                for (int bj = 0; bj < 2; ++bj)
#pragma unroll
                    for (int e = 0; e < 4; ++e) { const unsigned wa = ga[m][bj][e], wb = gb[m][bj][e];
                        const float r0 = bflo(wb) * fast_rcp(bflo(wa)), r1 = bfhi(wb) * fast_rcp(bfhi(wa));
                        acc[ai][bj][m][e >> 1][(e & 1) * 2] *= r0; acc[ai][bj][m][e >> 1][(e & 1) * 2 + 1] *= r1; }
        }
    }
    __device__ __forceinline__ void operator()(const f32x4 (&acc)[2][2][4][2], const pg8::Unit& u, int wr, int wc, int fr, int fq) const {
        const int row0 = u.pm * 256 + wr * 64 + fr; const int col0 = u.pn * 256 + wc * 32 + 8 * fq;
#pragma unroll
        for (int ai = 0; ai < 2; ++ai) {
            u32x4 gg[4][2];
#pragma unroll
            for (int m = 0; m < 4; ++m) { const bf16_t* gp = zg + (size_t)(row0 + ai * 128 + m * 16) * 3072 + col0 + 2048;
#pragma unroll
                for (int bj = 0; bj < 2; ++bj) gg[m][bj] = *(const u32x4*)(gp + bj * 128); }
#pragma unroll
            for (int m = 0; m < 4; ++m) { const int row = row0 + ai * 128 + m * 16;
#pragma unroll
                for (int bj = 0; bj < 2; ++bj) { const u32x4 g = gg[m][bj]; f32x4 v0 = acc[ai][bj][m][0], v1 = acc[ai][bj][m][1];
                    v0[0] *= fast_rcp(bflo(g[0])); v0[1] *= fast_rcp(bfhi(g[0])); v0[2] *= fast_rcp(bflo(g[1])); v0[3] *= fast_rcp(bfhi(g[1]));
                    v1[0] *= fast_rcp(bflo(g[2])); v1[1] *= fast_rcp(bfhi(g[2])); v1[2] *= fast_rcp(bflo(g[3])); v1[3] *= fast_rcp(bfhi(g[3]));
                    *(u32x4*)(merged + (size_t)row * 1024 + col0 + bj * 128) = pack8(v0, v1); } }
        }
    }
};
struct SchedP4 {
    int c, G; const char* yna; const char* ymla; const char* ymem; const char* wo;
    __device__ __forceinline__ bool next(int i, pg8::Unit& u) const {
        const int L = i * G + c; int pm, pn; if (L >= 512) return false;
        pg8::tile_order(L, 128, 4, pm, pn); u.pm = pm; u.pn = pn; u.kind = 0; u.nt = 24; u.aux = 0;
        u.A = yna + (size_t)pm * 256 * 1024; u.A1 = ymla + (size_t)pm * 256 * 1024; u.A2 = ymem + (size_t)pm * 256 * 1024; u.B = wo + (size_t)pn * 256 * 3072; return true;
    }
};

struct EpiP5 {
    static constexpr bool PERM = true, HAS_MID = false;
    bf16_t* delta;
    __device__ __forceinline__ void operator()(const f32x4 (&acc)[2][2][4][2], const pg8::Unit& u, int wr, int wc, int fr, int fq) const {
        const int row0 = u.pm * 256 + wr * 64 + fr; const int col0 = u.pn * 256 + wc * 32 + 8 * fq;
#pragma unroll
        for (int ai = 0; ai < 2; ++ai)
#pragma unroll
            for (int m = 0; m < 4; ++m) { bf16_t* rowp = delta + (size_t)(row0 + ai * 128 + m * 16) * 1024 + col0;
#pragma unroll
                for (int bj = 0; bj < 2; ++bj) *(u32x4*)(rowp + bj * 128) = pack8(acc[ai][bj][m][0], acc[ai][bj][m][1]); }
    }
};
struct SchedP5 {
    int c, G; const char* merged; const char* wout;
    __device__ __forceinline__ bool next(int i, pg8::Unit& u) const {
        const int L = i * G + c; int pm, pn; if (L >= 512) return false;
        pg8::tile_order(L, 128, 4, pm, pn); u.pm = pm; u.pn = pn; u.kind = 0; u.nt = 16; u.aux = 0;
        u.A = merged + (size_t)pm * 256 * 2048; u.A1 = u.A; u.A2 = u.A; u.B = wout + (size_t)pn * 256 * 2048; return true;
    }
};

struct EpiP8 {
    static constexpr bool PERM = true, HAS_MID = false;
    const float* rstd_xs; bf16_t* act;
    __device__ __forceinline__ void operator()(const f32x4 (&acc)[2][2][4][2], const pg8::Unit& u, int wr, int wc, int fr, int fq) const {
        const int row0 = u.pm * 256 + wr * 64 + fr; const int col0 = u.pn * 128 + wc * 32 + 8 * fq;
#pragma unroll
        for (int ai = 0; ai < 2; ++ai)
#pragma unroll
            for (int m = 0; m < 4; ++m) { const int row = row0 + ai * 128 + m * 16; const float rs = rstd_xs[row]; f32x4 o[2];
#pragma unroll
                for (int n = 0; n < 2; ++n)
#pragma unroll
                    for (int e = 0; e < 4; ++e) { const float hg = acc[ai][0][m][n][e] * rs, hu = acc[ai][1][m][n][e] * rs; o[n][e] = hg * fast_rcp(1.0f + fast_exp2(-LOG2E * hg)) * hu; }
                *(u32x4*)(act + (size_t)row * 1024 + col0) = pack8(o[0], o[1]); }
    }
};
struct SchedP8 {
    int c, G; const char* xs; const char* wgu;
    __device__ __forceinline__ bool next(int i, pg8::Unit& u) const {
        const int L = i * G + c; int pm, pn; if (L >= 2048) return false;
        const int e = L >> 7; pg8::tile_order(L & 127, 16, 8, pm, pn); const int b = pm >> 1, half = pm & 1; const int grow0 = (b * 16 + e) * 512 + half * 256;
        u.pm = grow0 >> 8; u.pn = pn; u.kind = 0; u.nt = 16; u.aux = e; u.A = xs; u.A1 = u.A; u.A2 = u.A; u.B = wgu + (size_t)(e * 2048 + pn * 256) * 2048; return true;
    }
};
struct EpiP9 {
    static constexpr bool PERM = true, HAS_MID = false;
    const float* gsel; bf16_t* ybuf;
    __device__ __forceinline__ void operator()(const f32x4 (&acc)[2][2][4][2], const pg8::Unit& u, int wr, int wc, int fr, int fq) const {
        const int row0 = u.pm * 256 + wr * 64 + fr; const int col0 = u.pn * 256 + wc * 32 + 8 * fq;
#pragma unroll
        for (int ai = 0; ai < 2; ++ai)
#pragma unroll
            for (int m = 0; m < 4; ++m) { const int row = row0 + ai * 128 + m * 16; const float gs = gsel[row];
#pragma unroll
                for (int bj = 0; bj < 2; ++bj) *(u32x4*)(ybuf + (size_t)row * 1024 + col0 + bj * 128) = pack8(acc[ai][bj][m][0] * gs, acc[ai][bj][m][1] * gs); }
    }
};
struct SchedP9 {
    int c, G; const char* act; const char* wd;
    __device__ __forceinline__ bool next(int i, pg8::Unit& u) const {
        const int L = i * G + c; int pm, pn; if (L >= 1024) return false;
        const int e = L >> 6; pg8::tile_order(L & 63, 16, 4, pm, pn); const int b = pm >> 1, half = pm & 1; const int grow0 = (b * 16 + e) * 512 + half * 256;
        u.pm = grow0 >> 8; u.pn = pn; u.kind = 0; u.nt = 16; u.aux = e; u.A = act + (size_t)grow0 * 2048; u.A1 = u.A; u.A2 = u.A; u.B = wd + (size_t)(e * 1024 + pn * 256) * 2048; return true;
    }
};

namespace att {
typedef short v4i16_t __attribute__((ext_vector_type(4)));
struct AttnArgs { const bf16_t* q; const bf16_t* k0; const bf16_t* k1; const bf16_t* v; bf16_t* o; const float* rpb; };
__device__ __forceinline__ s16x4 vtr(unsigned addr) { return __builtin_bit_cast(s16x4, __builtin_amdgcn_ds_read_tr16_b64_v4i16((LAS v4i16_t*)(uintptr_t)addr)); }
__device__ __forceinline__ float max3f(float a, float b, float c) { float r; asm("v_max3_f32 %0, %1, %2, %3" : "=v"(r) : "v"(a), "v"(b), "v"(c)); return r; }

template <int DQK, int DV, int MODE, bool PIPE>
__device__ __forceinline__ void attn_unit(LAS unsigned char* lds, const AttnArgs& A, const int b, const int h, const int ub) {
    constexpr int PK = DQK * 2 + 16, PV = DV * 2 + 64, KB = 64 * PK, VB = 64 * PV;
    constexpr int OFF_K = 0, OFF_V = 2 * KB, OFF_SCR = OFF_V + 2 * VB, OFF_OST = OFF_SCR + 8 * 256, OFF_END = OFF_OST + 8 * 32 * DV * 2;
    static_assert(OFF_END <= LDS_BYTES - 64, "attention LDS");
    constexpr int KCH = DQK / 8, VCH = DV / 8, NKC = 64 * KCH, NVC = 64 * VCH, KPT = (NKC + 511) / 512, VPT = (NVC + 511) / 512;
    constexpr int LDQ = (MODE == 0) ? 768 : 512, LDO = 512;
    constexpr int NDS = DQK / 16, ND0 = DV / 32;
    constexpr int NT = (MODE == 0) ? 64 : 4;
    constexpr float THR = 8.0f;
    int tid_ = threadIdx.x; asm volatile("" : "+v"(tid_));
    const int tid = tid_, lane = tid & 63, r32 = lane & 31, hi = lane >> 5; const int wid = __builtin_amdgcn_readfirstlane(tid >> 6);
    const int wave_tok0 = b * S_ + ub * 256 + wid * 32;
    bf16x8 qf[NDS];
    { const bf16_t* qp = A.q + (size_t)(wave_tok0 + r32) * LDQ + h * DQK + hi * 8;
#pragma unroll
      for (int ds = 0; ds < NDS; ++ds) qf[ds] = *(const bf16x8*)(qp + ds * 16); }
    const bf16_t* ksrc[KPT]; int kstr[KPT]; unsigned kdst[KPT]; bool kval[KPT];
    const bf16_t* vsrc[VPT]; unsigned vdst[VPT];
    constexpr int KSTRIDE = 64 * 1024;
#pragma unroll
    for (int j = 0; j < KPT; ++j) { const int ci = tid + 512 * j; kval[j] = ci < NKC; const int cic = kval[j] ? ci : 0; const int row = cic / KCH, cc = cic % KCH;
        kdst[j] = (unsigned)(OFF_K + row * PK + cc * 16); kstr[j] = KSTRIDE;
        if (MODE == 0) { const size_t kt = (size_t)b * S_ + row; if (cc < 8) ksrc[j] = A.k0 + kt * 1024 + h * 64 + cc * 8; else { ksrc[j] = A.k1 + kt * 32 + (cc - 8) * 8; kstr[j] = 64 * 32; } }
        else { const size_t kr = (size_t)b * 256 + row; ksrc[j] = A.k0 + kr * 1024 + h * 128 + cc * 8; } }
#pragma unroll
    for (int j = 0; j < VPT; ++j) { const int ci = tid + 512 * j; const int row = ci / VCH, cc = ci % VCH;
        vdst[j] = (unsigned)(OFF_V + row * PV + cc * 16);
        if (MODE == 0) { const size_t kt = (size_t)b * S_ + row; vsrc[j] = A.v + kt * 1024 + h * 64 + cc * 8; }
        else { const size_t kr = (size_t)b * 256 + row; vsrc[j] = A.v + kr * 1024 + h * 128 + cc * 8; } }
    u32x4 kst[KPT], vst[VPT];
#define ATT_LOADK(tile) do { _Pragma("unroll") for (int j = 0; j < KPT; ++j) if (kval[j]) kst[j] = *(const u32x4*)(ksrc[j] + (size_t)(tile) * kstr[j]); } while (0)
#define ATT_LOADV(tile) do { _Pragma("unroll") for (int j = 0; j < VPT; ++j) vst[j] = *(const u32x4*)(vsrc[j] + (size_t)(tile) * KSTRIDE); } while (0)
#define ATT_STOREK(buf) do { _Pragma("unroll") for (int j = 0; j < KPT; ++j) if (kval[j]) *(LAS u32x4*)(lds + kdst[j] + (buf) * KB) = kst[j]; } while (0)
#define ATT_STOREV(buf) do { _Pragma("unroll") for (int j = 0; j < VPT; ++j) *(LAS u32x4*)(lds + vdst[j] + (buf) * VB) = vst[j]; } while (0)
    LAS float* scr = (LAS float*)(lds + OFF_SCR) + wid * 64;
#define ATT_QK(P0, P1, buf) do { const LAS unsigned char* kb_ = lds + OFF_K + (buf) * KB + r32 * PK + hi * 16; P0 = negm; P1 = negm; __builtin_amdgcn_s_setprio(1); \
        _Pragma("unroll") for (int ds = 0; ds < NDS; ++ds) { const bf16x8 a0_ = *(const LAS bf16x8*)(kb_ + ds * 32), a1_ = *(const LAS bf16x8*)(kb_ + 32 * PK + ds * 32); \
            P0 = __builtin_amdgcn_mfma_f32_32x32x16_bf16(a0_, qf[ds], P0, 0, 0, 0); P1 = __builtin_amdgcn_mfma_f32_32x32x16_bf16(a1_, qf[ds], P1, 0, 0, 0); } __builtin_amdgcn_s_setprio(0); } while (0)
#define ATT_ROWMAX(P0, P1, rm) do { float a_ = max3f(P0[0], P0[1], P1[0]), b_ = max3f(P0[2], P0[3], P1[1]); a_ = max3f(a_, P1[2], P1[3]); \
        _Pragma("unroll") for (int r = 4; r < 16; r += 4) { a_ = max3f(a_, P0[r], P0[r + 1]); b_ = max3f(b_, P0[r + 2], P0[r + 3]); a_ = max3f(a_, P1[r], P1[r + 1]); b_ = max3f(b_, P1[r + 2], P1[r + 3]); } \
        rm = fmaxf(a_, b_); rm = fmaxf(rm, __shfl_xor(rm, 32)); } while (0)
    f32x16 o[ND0], negm;
#pragma unroll
    for (int r = 0; r < 16; ++r) negm[r] = 0.f;
#pragma unroll
    for (int d0 = 0; d0 < ND0; ++d0)
#pragma unroll
        for (int r = 0; r < 16; ++r) o[d0][r] = 0.f;
    float lsum = 0.f;
    f32x16 pA0, pA1, pB0, pB1;
    ATT_LOADK(0); ATT_LOADV(0); ATT_STOREK(0); ATT_STOREV(0); ATT_LOADK(1); ATT_STOREK(1);
    __syncthreads();
    ATT_QK(pA0, pA1, 0);
    { float rm; ATT_ROWMAX(pA0, pA1, rm);
#pragma unroll
      for (int r = 0; r < 16; ++r) { pA0[r] -= rm; pA1[r] -= rm; negm[r] = -rm; } }
    __syncthreads();
#ifndef ATT_SGB
#define ATT_SGB 1
#endif
#define ATT_STEP(PC0, PC1, PN0, PN1, t) do { const int buf_ = (t) & 1; \
        if ((t) + 2 < NT) ATT_LOADK((t) + 2); if ((t) + 1 < NT) ATT_LOADV((t) + 1); \
        if constexpr (!PIPE) { if ((t) > 0) { ATT_QK(PC0, PC1, buf_); float rm0_; ATT_ROWMAX(PC0, PC1, rm0_); \
            if (__any(rm0_ > THR)) { const float dl_ = fmaxf(rm0_, 0.f); const float f_ = fast_exp2(-dl_); lsum *= f_; \
                _Pragma("unroll") for (int r = 0; r < 16; ++r) { PC0[r] -= dl_; PC1[r] -= dl_; negm[r] -= dl_; } \
                if (hi == 0) scr[r32] = f_; \
                _Pragma("unroll") for (int r = 0; r < 16; ++r) { const float fr_ = scr[crow(r, hi)]; _Pragma("unroll") for (int d0 = 0; d0 < ND0; ++d0) o[d0][r] *= fr_; } } } } \
          \
        if constexpr (PIPE) { if ((t) + 1 < NT) ATT_QK(PN0, PN1, buf_ ^ 1); } \
        float ps_ = 0.f; \
        _Pragma("unroll") for (int r = 0; r < 16; ++r) { PC0[r] = fast_exp2(PC0[r]); PC1[r] = fast_exp2(PC1[r]); ps_ += PC0[r] + PC1[r]; } \
        lsum += ps_; \
        bf16x8 pa_[4]; \
        _Pragma("unroll") for (int s = 0; s < 2; ++s) { u32x4 w_; \
            w_.x = cvt_pk_bf16(PC0[8 * s + 0], PC0[8 * s + 1]); w_.y = cvt_pk_bf16(PC0[8 * s + 2], PC0[8 * s + 3]); w_.z = cvt_pk_bf16(PC0[8 * s + 4], PC0[8 * s + 5]); w_.w = cvt_pk_bf16(PC0[8 * s + 6], PC0[8 * s + 7]); pa_[s] = __builtin_bit_cast(bf16x8, w_); \
            w_.x = cvt_pk_bf16(PC1[8 * s + 0], PC1[8 * s + 1]); w_.y = cvt_pk_bf16(PC1[8 * s + 2], PC1[8 * s + 3]); w_.z = cvt_pk_bf16(PC1[8 * s + 4], PC1[8 * s + 5]); w_.w = cvt_pk_bf16(PC1[8 * s + 6], PC1[8 * s + 7]); pa_[2 + s] = __builtin_bit_cast(bf16x8, w_); } \
          \
        { const unsigned vb_ = (unsigned)(uintptr_t)(lds + OFF_V + buf_ * VB) + (unsigned)((4 * hi + ((lane & 15) >> 2)) * PV + ((((lane >> 4) & 1) * 16 + (lane & 3) * 4) * 2)); \
          __builtin_amdgcn_s_setprio(1); \
          _Pragma("unroll") for (int d0 = 0; d0 < ND0; ++d0) _Pragma("unroll") for (int s = 0; s < 4; ++s) { \
              const s16x4 lo_ = vtr(vb_ + (unsigned)(16 * s * PV + d0 * 64)), hh_ = vtr(vb_ + (unsigned)(16 * s * PV + 8 * PV + d0 * 64)); \
              const bf16x8 vf_ = (bf16x8){lo_[0], lo_[1], lo_[2], lo_[3], hh_[0], hh_[1], hh_[2], hh_[3]}; \
              o[d0] = __builtin_amdgcn_mfma_f32_32x32x16_bf16(pa_[s], vf_, o[d0], 0, 0, 0); } \
          __builtin_amdgcn_s_setprio(0); } \
        float rm_ = 0.f; \
        if constexpr (PIPE) { if ((t) + 1 < NT) ATT_ROWMAX(PN0, PN1, rm_); } \
        if (ATT_SGB && PIPE) { _Pragma("unroll") for (int g_ = 0; g_ < 12 + 4 * ND0; ++g_) { __builtin_amdgcn_sched_group_barrier(0x008, 1, 0); __builtin_amdgcn_sched_group_barrier(0x100, 2, 0); __builtin_amdgcn_sched_group_barrier(0x002, 6, 0); } } \
          \
        if constexpr (PIPE) { if (__any(rm_ > THR)) { const float dl_ = fmaxf(rm_, 0.f); const float f_ = fast_exp2(-dl_); lsum *= f_; \
            _Pragma("unroll") for (int r = 0; r < 16; ++r) { PN0[r] -= dl_; PN1[r] -= dl_; negm[r] -= dl_; } \
            if (hi == 0) scr[r32] = f_; \
            _Pragma("unroll") for (int r = 0; r < 16; ++r) { const float fr_ = scr[crow(r, hi)]; _Pragma("unroll") for (int d0 = 0; d0 < ND0; ++d0) o[d0][r] *= fr_; } } } \
        if ((t) + 2 < NT) ATT_STOREK(buf_); if ((t) + 1 < NT) ATT_STOREV(buf_ ^ 1); \
        __syncthreads(); } while (0)
    if constexpr (PIPE) { for (int t = 0; t < NT; t += 2) { ATT_STEP(pA0, pA1, pB0, pB1, t); ATT_STEP(pB0, pB1, pA0, pA1, t + 1); } }
    else { for (int t = 0; t < NT; ++t) { ATT_STEP(pA0, pA1, pB0, pB1, t); } }
    lsum += __shfl_xor(lsum, 32);
    if (hi == 0) scr[r32] = fast_rcp(lsum);
    LAS bf16_t* ost = (LAS bf16_t*)(lds + OFF_OST) + wid * 32 * DV;
#pragma unroll
    for (int r = 0; r < 16; ++r) { const int q = crow(r, hi); const float ri = scr[q];
#pragma unroll
        for (int d0 = 0; d0 < ND0; ++d0) { const float val = o[d0][r] * ri; ost[q * DV + d0 * 32 + r32] = (bf16_t)(cvt_pk_bf16(val, val) & 0xffffu); } }
    asm volatile("s_waitcnt lgkmcnt(0)" ::: "memory");
    { bf16_t* og = A.o + (size_t)wave_tok0 * LDO + h * DV;
#pragma unroll
      for (int i = 0; i < DV / 16; ++i) { const int id = i * 64 + lane; const int row = id / VCH, ch = id % VCH;
          const u32x4 v = *(const LAS u32x4*)(ost + row * DV + ch * 8); *(u32x4*)(og + (size_t)row * LDO + ch * 8) = v; } }
    __syncthreads();
#undef ATT_LOADK
#undef ATT_LOADV
#undef ATT_STOREK
#undef ATT_STOREV
#undef ATT_QK
#undef ATT_ROWMAX
#undef ATT_STEP
}
}

namespace att {
__device__ __forceinline__ void attn_unit_mla(LAS unsigned char* lds, const AttnArgs& A, const int b, const int h, const int ub) {
    constexpr int DQK = 96, DV = 64;
    constexpr int PK = DQK * 2 + 16, PV = DV * 2 + 64, KB = 64 * PK, VB = 64 * PV;
    constexpr int OFF_K = 0, OFF_V = 3 * KB, OFF_SCR = OFF_V + 3 * VB, OFF_OST = OFF_SCR + 8 * 256, OFF_END = OFF_OST + 8 * 32 * DV * 2;
    static_assert(OFF_END <= LDS_BYTES - 64, "attention LDS");
    constexpr int KCH = DQK / 8, VCH = DV / 8, NKC = 64 * KCH, KPT = 2, VPT = 1;
    constexpr int LDQ = 768, LDO = 512, NDS = DQK / 16, ND0 = DV / 32, NT = 64;
    constexpr float THR = 8.0f;
    int tid_ = threadIdx.x; asm volatile("" : "+v"(tid_));
    const int tid = tid_, lane = tid & 63, r32 = lane & 31, hi = lane >> 5; const int wid = __builtin_amdgcn_readfirstlane(tid >> 6);
    const int grp = wid >> 2;
    const int wave_tok0 = b * S_ + ub * 256 + wid * 32;
    bf16x8 qf[NDS];
    { const bf16_t* qp = A.q + (size_t)(wave_tok0 + r32) * LDQ + h * DQK + hi * 8;
#pragma unroll
      for (int ds = 0; ds < NDS; ++ds) qf[ds] = *(const bf16x8*)(qp + ds * 16); }
    const bf16_t* ksrc[KPT]; int kstr[KPT]; unsigned kdst[KPT]; bool kval[KPT];
    const bf16_t* vsrc; unsigned vdst;
    constexpr int KSTRIDE = 64 * 1024;
#pragma unroll
    for (int j = 0; j < KPT; ++j) { const int ci = tid + 512 * j; kval[j] = ci < NKC; const int cic = kval[j] ? ci : 0; const int row = cic / KCH, cc = cic % KCH;
        kdst[j] = (unsigned)(OFF_K + row * PK + cc * 16); kstr[j] = KSTRIDE; const size_t kt = (size_t)b * S_ + row;
        if (cc < 8) ksrc[j] = A.k0 + kt * 1024 + h * 64 + cc * 8; else { ksrc[j] = A.k1 + kt * 32 + (cc - 8) * 8; kstr[j] = 64 * 32; } }
    { const int row = tid / VCH, cc = tid % VCH; vdst = (unsigned)(OFF_V + row * PV + cc * 16); vsrc = A.v + ((size_t)b * S_ + row) * 1024 + h * 64 + cc * 8; }
    u32x4 kst[KPT], vst;
#define MLA_LOADK(tile) do { _Pragma("unroll") for (int j = 0; j < KPT; ++j) if (kval[j]) kst[j] = *(const u32x4*)(ksrc[j] + (size_t)(tile) * kstr[j]); } while (0)
#define MLA_LOADV(tile) do { vst = *(const u32x4*)(vsrc + (size_t)(tile) * KSTRIDE); } while (0)
#define MLA_STOREK(boff) do { _Pragma("unroll") for (int j = 0; j < KPT; ++j) if (kval[j]) *(LAS u32x4*)(lds + kdst[j] + (boff)) = kst[j]; } while (0)
#define MLA_STOREV(boff) do { *(LAS u32x4*)(lds + vdst + (boff)) = vst; } while (0)
    LAS float* scr = (LAS float*)(lds + OFF_SCR) + wid * 64;
#define MLA_QK(P0, P1, boff) do { const LAS unsigned char* kb_ = lds + OFF_K + (boff) + r32 * PK + hi * 16; P0 = negm; P1 = negm; __builtin_amdgcn_s_setprio(1); \
        _Pragma("unroll") for (int ds = 0; ds < NDS; ++ds) { const bf16x8 a0_ = *(const LAS bf16x8*)(kb_ + ds * 32), a1_ = *(const LAS bf16x8*)(kb_ + 32 * PK + ds * 32); \
            P0 = __builtin_amdgcn_mfma_f32_32x32x16_bf16(a0_, qf[ds], P0, 0, 0, 0); P1 = __builtin_amdgcn_mfma_f32_32x32x16_bf16(a1_, qf[ds], P1, 0, 0, 0); } __builtin_amdgcn_s_setprio(0); } while (0)
#define MLA_ROWMAX(P0, P1, rm) do { float a_ = max3f(P0[0], P0[1], P1[0]), b_ = max3f(P0[2], P0[3], P1[1]); a_ = max3f(a_, P1[2], P1[3]); \
        _Pragma("unroll") for (int r = 4; r < 16; r += 4) { a_ = max3f(a_, P0[r], P0[r + 1]); b_ = max3f(b_, P0[r + 2], P0[r + 3]); a_ = max3f(a_, P1[r], P1[r + 1]); b_ = max3f(b_, P1[r + 2], P1[r + 3]); } \
        rm = fmaxf(a_, b_); rm = fmaxf(rm, __shfl_xor(rm, 32)); } while (0)
    f32x16 o[ND0], negm;
#pragma unroll
    for (int r = 0; r < 16; ++r) negm[r] = 0.f;
#pragma unroll
    for (int d0 = 0; d0 < ND0; ++d0)
#pragma unroll
        for (int r = 0; r < 16; ++r) o[d0][r] = 0.f;
    float lsum = 0.f;
    f32x16 pA0, pA1, pB0, pB1;
    MLA_LOADK(0); MLA_LOADV(0); MLA_STOREK(0); MLA_STOREV(0);
    MLA_LOADK(1); MLA_LOADV(1); MLA_STOREK(KB); MLA_STOREV(VB);
    MLA_LOADK(2); MLA_STOREK(2 * KB);
    __syncthreads();
    MLA_QK(pA0, pA1, 0);
    { float rm; MLA_ROWMAX(pA0, pA1, rm);
#pragma unroll
      for (int r = 0; r < 16; ++r) { pA0[r] -= rm; pA1[r] -= rm; negm[r] = -rm; } }
    __syncthreads();
    if (grp == 1) asm volatile("s_barrier" ::: "memory");
    int kb0 = 0, kb1 = KB, kb2 = 2 * KB;
    int vb0 = 0, vb1 = VB, vb2 = 2 * VB;
#define MLA_STEP(PC0, PC1, PN0, PN1, t) do { \
          \
        if ((t) + 3 < NT) MLA_LOADK((t) + 3); if ((t) + 2 < NT) MLA_LOADV((t) + 2); \
        if ((t) + 1 < NT) MLA_QK(PN0, PN1, kb1); \
        float ps_ = 0.f; \
        _Pragma("unroll") for (int r = 0; r < 16; ++r) { PC0[r] = fast_exp2(PC0[r]); PC1[r] = fast_exp2(PC1[r]); ps_ += PC0[r] + PC1[r]; } \
        lsum += ps_; \
        bf16x8 pa_[4]; \
        _Pragma("unroll") for (int s = 0; s < 2; ++s) { u32x4 w_; \
            w_.x = cvt_pk_bf16(PC0[8 * s + 0], PC0[8 * s + 1]); w_.y = cvt_pk_bf16(PC0[8 * s + 2], PC0[8 * s + 3]); w_.z = cvt_pk_bf16(PC0[8 * s + 4], PC0[8 * s + 5]); w_.w = cvt_pk_bf16(PC0[8 * s + 6], PC0[8 * s + 7]); pa_[s] = __builtin_bit_cast(bf16x8, w_); \
            w_.x = cvt_pk_bf16(PC1[8 * s + 0], PC1[8 * s + 1]); w_.y = cvt_pk_bf16(PC1[8 * s + 2], PC1[8 * s + 3]); w_.z = cvt_pk_bf16(PC1[8 * s + 4], PC1[8 * s + 5]); w_.w = cvt_pk_bf16(PC1[8 * s + 6], PC1[8 * s + 7]); pa_[2 + s] = __builtin_bit_cast(bf16x8, w_); } \
        _Pragma("unroll") for (int s = 0; s < 4; ++s) asm volatile("" : "+v"(pa_[s])); \
        asm volatile("s_barrier" ::: "memory"); \
          \
        { const unsigned vb_ = (unsigned)(uintptr_t)(lds + OFF_V + vb0) + (unsigned)((4 * hi + ((lane & 15) >> 2)) * PV + ((((lane >> 4) & 1) * 16 + (lane & 3) * 4) * 2)); \
          __builtin_amdgcn_s_setprio(1); \
          _Pragma("unroll") for (int d0 = 0; d0 < ND0; ++d0) _Pragma("unroll") for (int s = 0; s < 4; ++s) { \
              const s16x4 lo_ = vtr(vb_ + (unsigned)(16 * s * PV + d0 * 64)), hh_ = vtr(vb_ + (unsigned)(16 * s * PV + 8 * PV + d0 * 64)); \
              const bf16x8 vf_ = (bf16x8){lo_[0], lo_[1], lo_[2], lo_[3], hh_[0], hh_[1], hh_[2], hh_[3]}; \
              o[d0] = __builtin_amdgcn_mfma_f32_32x32x16_bf16(pa_[s], vf_, o[d0], 0, 0, 0); } \
          __builtin_amdgcn_s_setprio(0); } \
        float rm_ = 0.f; \
        if ((t) + 1 < NT) MLA_ROWMAX(PN0, PN1, rm_); \
        if (__any(rm_ > THR)) { const float dl_ = fmaxf(rm_, 0.f); const float f_ = fast_exp2(-dl_); lsum *= f_; \
            _Pragma("unroll") for (int r = 0; r < 16; ++r) { PN0[r] -= dl_; PN1[r] -= dl_; negm[r] -= dl_; } \
            if (hi == 0) scr[r32] = f_; \
            _Pragma("unroll") for (int r = 0; r < 16; ++r) { const float fr_ = scr[crow(r, hi)]; _Pragma("unroll") for (int d0 = 0; d0 < ND0; ++d0) o[d0][r] *= fr_; } } \
        if ((t) + 3 < NT) MLA_STOREK(kb0); if ((t) + 2 < NT) MLA_STOREV(vb2); \
        { const int k_ = kb0; kb0 = kb1; kb1 = kb2; kb2 = k_; const int v_ = vb2; vb2 = vb0; vb0 = vb1; vb1 = v_; } \
        asm volatile("s_waitcnt lgkmcnt(0)\n\ts_barrier" ::: "memory"); } while (0)
    for (int t = 0; t < NT; t += 2) { MLA_STEP(pA0, pA1, pB0, pB1, t); MLA_STEP(pB0, pB1, pA0, pA1, t + 1); }
    if (grp == 0) asm volatile("s_barrier" ::: "memory");
    lsum += __shfl_xor(lsum, 32);
    if (hi == 0) scr[r32] = fast_rcp(lsum);
    LAS bf16_t* ost = (LAS bf16_t*)(lds + OFF_OST) + wid * 32 * DV;
#pragma unroll
    for (int r = 0; r < 16; ++r) { const int q = crow(r, hi); const float ri = scr[q];
#pragma unroll
        for (int d0 = 0; d0 < ND0; ++d0) { const float val = o[d0][r] * ri; ost[q * DV + d0 * 32 + r32] = (bf16_t)(cvt_pk_bf16(val, val) & 0xffffu); } }
    asm volatile("s_waitcnt lgkmcnt(0)" ::: "memory");
    { bf16_t* og = A.o + (size_t)wave_tok0 * LDO + h * DV;
#pragma unroll
      for (int i = 0; i < DV / 16; ++i) { const int id = i * 64 + lane; const int row = id / VCH, ch = id % VCH;
          const u32x4 v = *(const LAS u32x4*)(ost + row * DV + ch * 8); *(u32x4*)(og + (size_t)row * LDO + ch * 8) = v; } }
    __syncthreads();
#undef MLA_LOADK
#undef MLA_LOADV
#undef MLA_STOREK
#undef MLA_STOREV
#undef MLA_QK
#undef MLA_ROWMAX
#undef MLA_STEP
}
}

namespace na2 {
typedef short v4i16_t __attribute__((ext_vector_type(4)));
constexpr int NS = 6, DPF = 5, TILE = 16384;
constexpr int OFF_RING = 0, OFF_OST = NS * TILE, OFF_TAB = OFF_OST + 8 * 2048, TAB_FLOATS = 8 * 465;
static_assert(OFF_TAB + TAB_FLOATS * 4 <= LDS_BYTES - 64, "na2 LDS");
__device__ __forceinline__ void glds16(const void* gsrc, unsigned lds_dst) { unsigned keep;
    asm volatile("s_mov_b32 %0, m0\n\ts_mov_b32 m0, %2\n\ts_nop 0\n\tglobal_load_lds_dwordx4 %1, off\n\ts_mov_b32 m0, %0" : "=&s"(keep) : "v"(gsrc), "s"(lds_dst) : "memory"); }
__device__ __forceinline__ s16x4 vtr(unsigned addr) { return __builtin_bit_cast(s16x4, __builtin_amdgcn_ds_read_tr16_b64_v4i16((LAS v4i16_t*)(uintptr_t)addr)); }
__device__ __forceinline__ int clampi(int v, int lo, int hi) { return v < lo ? lo : (v > hi ? hi : v); }
#define NA_WAITBAR(N) asm volatile("s_waitcnt vmcnt(" #N ") lgkmcnt(0)\n\ts_barrier" ::: "memory")

__device__ __forceinline__ void na_phase(LAS unsigned char* lds, const bf16_t* qn, const bf16_t* kn, const bf16_t* vn, bf16_t* on, const float* rpb, const int vcu, const int G) {
    int tid_ = threadIdx.x; asm volatile("" : "+v"(tid_));
    const int tid = tid_, lane = tid & 63, lj = lane & 15, fq = lane >> 4; const int wid = __builtin_amdgcn_readfirstlane(tid >> 6);
    const int hl = wid >> 2, g = wid & 3; const int csg = (g == 0) ? 0 : (g == 1 ? 8 : (g == 2 ? 24 : 32));
    LAS float* tab = (LAS float*)(lds + OFF_TAB);
    for (int i = tid; i < TAB_FLOATS; i += NTHREADS) tab[i] = rpb[i] * LOG2E;
    const unsigned lds0 = (unsigned)(uintptr_t)lds;
    if (vcu >= 2048) { __syncthreads(); return; }
    const int nunits = (2048 - vcu + G - 1) / G; const int total = nunits * 17;
    unsigned offK[2], offV[2], dstw[2];
#pragma unroll
    for (int p = 0; p < 2; ++p) { const int ii = wid * 2 + p, row = 4 * ii + (lane >> 4), cp = lane & 15;
        offK[p] = (unsigned)(row * 1024 + ((cp ^ (row & 15)) << 4)); offV[p] = (unsigned)(row * 1024 + ((cp ^ ((row & 7) << 1)) << 4)); dstw[p] = lds0 + OFF_RING + ii * 1024; }
#define NA_ISSUE(tau, slot) do { const int n_ = (tau) / 17, i_ = (tau) - 17 * n_; const int U_ = vcu + n_ * G; const int b_ = U_ >> 8, hp_ = (U_ >> 6) & 3, r_ = U_ & 63; \
        const int kr_ = (i_ == 0) ? r_ : clampi(r_ - 4, 0, 56) + ((i_ - 1) & 7); const bf16_t* src_ = (i_ == 0) ? qn : (i_ < 9 ? kn : vn); \
        const char* base_ = (const char*)(src_ + ((size_t)(b_ * S_ + kr_ * 64) * 512 + hp_ * 128)); \
        _Pragma("unroll") for (int p = 0; p < 2; ++p) glds16(base_ + (i_ < 9 ? offK[p] : offV[p]), (unsigned)__builtin_amdgcn_readfirstlane(dstw[p] + (slot) * TILE)); } while (0)
    int islot = 0;
#pragma unroll
    for (int d = 0; d < DPF; ++d) { if (d < total) { NA_ISSUE(d, islot); islot = (islot + 1 == NS) ? 0 : islot + 1; } }
    int cslot = 0;
    for (int n = 0; n < nunits; ++n) {
        const int U = vcu + n * G; const int b = U >> 8, hp = (U >> 6) & 3, r = U & 63; const int rs = clampi(r - 4, 0, 56); const int head = hp * 2 + hl;
        const int tok0 = b * S_ + r * 64 + 16 * g;
        bf16x8 qf[2];
        f32x4 s[8][2]; bf16x8 pa[8]; f32x4 o[4]; float lsum = 0.f;
#pragma unroll
        for (int dt = 0; dt < 4; ++dt) o[dt] = (f32x4){0.f, 0.f, 0.f, 0.f};
#pragma clang loop unroll(full)
        for (int i0 = 0; i0 < 17; ++i0) {
            const int tau = n * 17 + i0; const int i = i0 - 1;
            if (tau + DPF <= total) NA_WAITBAR(8); else NA_WAITBAR(0);
            if (tau + DPF < total) { NA_ISSUE(tau + DPF, islot); islot = (islot + 1 == NS) ? 0 : islot + 1; }
            const unsigned sbase = lds0 + OFF_RING + cslot * TILE; cslot = (cslot + 1 == NS) ? 0 : cslot + 1;
            if (i0 == 0) {
                const int kc = 16 * g + lj;
#pragma unroll
                for (int ds = 0; ds < 2; ++ds) { const int c = hl * 8 + ds * 4 + fq; qf[ds] = *(const LAS bf16x8*)(uintptr_t)(sbase + kc * 256 + ((c ^ (kc & 15)) << 4)); }
            } else if (i < 8) {
#pragma unroll
                for (int ct = 0; ct < 2; ++ct) { s[i][ct] = (f32x4){0.f, 0.f, 0.f, 0.f}; const int kc = csg + 16 * ct + lj;
#pragma unroll
                    for (int ds = 0; ds < 2; ++ds) { const int c = hl * 8 + ds * 4 + fq; const bf16x8 a = *(const LAS bf16x8*)(uintptr_t)(sbase + kc * 256 + ((c ^ (kc & 15)) << 4));
                        s[i][ct] = __builtin_amdgcn_mfma_f32_16x16x32_bf16(a, qf[ds], s[i][ct], 0, 0, 0); } }
                if (i == 7) {
                    const int c = 16 * g + lj, cs = clampi(c - 8, 0, 48); float m = -1e30f;
#pragma unroll
                    for (int t = 0; t < 8; ++t) { const LAS float* trow = tab + head * 465 + (rs + t - r + 7) * 31;
#pragma unroll
                        for (int ct = 0; ct < 2; ++ct)
#pragma unroll
                            for (int e = 0; e < 4; ++e) { const int kc = csg + 16 * ct + 4 * fq + e; const bool v = (unsigned)(kc - cs) < 16u; const float bias = trow[v ? (kc - c + 15) : 0];
                                const float x = v ? s[t][ct][e] + bias : -1e30f; s[t][ct][e] = x; m = fmaxf(m, x); } }
                    m = fmaxf(m, __shfl_xor(m, 16)); m = fmaxf(m, __shfl_xor(m, 32));
#pragma unroll
                    for (int t = 0; t < 8; ++t) {
#pragma unroll
                        for (int ct = 0; ct < 2; ++ct)
#pragma unroll
                            for (int e = 0; e < 4; ++e) { const float p = fast_exp2(s[t][ct][e] - m); s[t][ct][e] = p; lsum += p; }
                        u32x4 w; w.x = cvt_pk_bf16(s[t][0][0], s[t][0][1]); w.y = cvt_pk_bf16(s[t][0][2], s[t][0][3]); w.z = cvt_pk_bf16(s[t][1][0], s[t][1][1]); w.w = cvt_pk_bf16(s[t][1][2], s[t][1][3]);
                        pa[t] = __builtin_bit_cast(bf16x8, w); }
                    lsum += __shfl_xor(lsum, 16); lsum += __shfl_xor(lsum, 32);
                }
            } else {
                const int t = i - 8; const int q = lj >> 2, p = lj & 3;
#pragma unroll
                for (int dt = 0; dt < 4; ++dt) { const int c = hl * 8 + 2 * dt + (p >> 1); s16x4 tr[2];
#pragma unroll
                    for (int ct = 0; ct < 2; ++ct) { const int kc = csg + 16 * ct + 4 * fq + q; tr[ct] = vtr(sbase + kc * 256 + ((c ^ ((kc & 7) << 1)) << 4) + (p & 1) * 8); }
                    const bf16x8 vf = (bf16x8){tr[0][0], tr[0][1], tr[0][2], tr[0][3], tr[1][0], tr[1][1], tr[1][2], tr[1][3]};
                    o[dt] = __builtin_amdgcn_mfma_f32_16x16x32_bf16(pa[t], vf, o[dt], 0, 0, 0); }
                if (i == 15) {
                    const float linv = fast_rcp(lsum); float li[4];
#pragma unroll
                    for (int e = 0; e < 4; ++e) li[e] = __shfl(linv, 4 * fq + e);
                    LAS bf16_t* ost = (LAS bf16_t*)(lds + OFF_OST) + wid * 1024;
#pragma unroll
                    for (int dt = 0; dt < 4; ++dt)
#pragma unroll
                        for (int e = 0; e < 4; ++e) { const float val = o[dt][e] * li[e]; ost[(4 * fq + e) * 64 + 16 * dt + lj] = (bf16_t)(cvt_pk_bf16(val, val) & 0xffffu); }
                    asm volatile("s_waitcnt lgkmcnt(0)" ::: "memory");
                    bf16_t* og = on + (size_t)tok0 * 512 + head * 64;
#pragma unroll
                    for (int k = 0; k < 2; ++k) { const int id = lane + 64 * k, row = id >> 3, ch = id & 7; const u32x4 v = *(const LAS u32x4*)(ost + row * 64 + ch * 8); *(u32x4*)(og + (size_t)row * 512 + ch * 8) = v; }
                }
            }
        }
    }
    asm volatile("s_waitcnt vmcnt(0) lgkmcnt(0)" ::: "memory");
    __syncthreads();
#undef NA_ISSUE
}
#undef NA_WAITBAR
}

struct HalfMap { int drow; float cs; bool rp; bool valid; };
__device__ __forceinline__ void p0_item64(const float* W, int ldw, int k0, int n0, bf16_t* WT, int ldwt, const HalfMap h0, const HalfMap h1, int dk0, const float* g, LAS float* scr, int lane) {
    const int n4 = (lane & 15) * 4, kq = lane >> 4; const bool hv = (n4 < 32) ? h0.valid : h1.valid; const float cs = (n4 < 32) ? h0.cs : h1.cs;
    f32x4 v[16];
#pragma unroll
    for (int j = 0; j < 16; ++j) { v[j] = (f32x4){0.f, 0.f, 0.f, 0.f}; if (hv) v[j] = *(const f32x4*)(W + (size_t)(k0 + 4 * j + kq) * ldw + n0 + n4); }
#pragma unroll
    for (int j = 0; j < 16; ++j) { const int k = 4 * j + kq; float sc = cs; if (g) sc *= g[k0 + k];
#pragma unroll
        for (int e = 0; e < 4; ++e) scr[(n4 + e) * 65 + k] = v[j][e] * sc; }
    asm volatile("s_waitcnt lgkmcnt(0)" ::: "memory");
    const int c = lane & 7;
#pragma unroll
    for (int j = 0; j < 8; ++j) { const int nn = 8 * j + (lane >> 3); const LAS float* s = scr + nn * 65 + 8 * c;
        u32x4 o; o.x = cvt_pk_bf16(s[0], s[1]); o.y = cvt_pk_bf16(s[2], s[3]); o.z = cvt_pk_bf16(s[4], s[5]); o.w = cvt_pk_bf16(s[6], s[7]);
        const bool hi_ = nn >= 32; const int w = nn & 31; const bool rp = hi_ ? h1.rp : h0.rp; const int nd = rp ? ((w & 16) + 2 * (w & 7) + ((w >> 3) & 1)) : w;
        const int drow = (hi_ ? h1.drow : h0.drow) + nd;
        if (hi_ ? h1.valid : h0.valid) *(u32x4*)(WT + (size_t)drow * ldwt + dk0 + k0 + 8 * c) = o; }
    asm volatile("s_waitcnt lgkmcnt(0)" ::: "memory");
}
__device__ __forceinline__ void p0_row(const float* xrow, bf16_t* orow, float* rstd, int lane) {
    const f32x4* xr = (const f32x4*)xrow + lane; f32x4 v[4]; float s = 0.f;
#pragma unroll
    for (int j = 0; j < 4; ++j) { v[j] = xr[64 * j]; s += (v[j][0] * v[j][0] + v[j][1] * v[j][1]) + (v[j][2] * v[j][2] + v[j][3] * v[j][3]); }
    s = wave_sum(s);
    u32x2* o8 = (u32x2*)orow + lane;
#pragma unroll
    for (int j = 0; j < 4; ++j) { u32x2 w; w.x = cvt_pk_bf16(v[j][0], v[j][1]); w.y = cvt_pk_bf16(v[j][2], v[j][3]); o8[64 * j] = w; }
    if (lane == 0) *rstd = rsqrtf(s * (1.0f / 1024.0f) + EPS_);
}

#define PX(P) ((P).in[0])
#define PMEM(P) ((P).in[1])
#define PGMIX(P) ((P).in[2])
#define PWIN(P) ((P).in[3])
#define PRPB(P) ((P).in[4])
#define PQN(P) ((P).in[5])
#define PWUQ(P) ((P).in[6])
#define PKVN(P) ((P).in[7])
#define PWUKV(P) ((P).in[8])
#define PGMEM(P) ((P).in[9])
#define PWMEMKV(P) ((P).in[10])
#define PWOUT(P) ((P).in[14])
#define PGFFN(P) ((P).in[15])
#define PWROUTER(P) ((P).in[16])
#define PBROUTER(P) ((P).in[17])
#define PWGATE(P) ((P).in[18])
#define PWUP(P) ((P).in[19])
#define PWDOWN(P) ((P).in[20])
#define PGFINAL(P) ((P).in[21])
typedef Args Ptrs;

__device__ __forceinline__ void phase0(const Ptrs& P, LAS unsigned char* lds, int gw, int NGW, int wave, int lane) {
    LAS float* scr = (LAS float*)(lds + wave * 16640);
    bf16_t* win = (bf16_t*)(P.ws + WS_WIN); bf16_t* wuq = (bf16_t*)(P.ws + WS_WUQ); bf16_t* wukv = (bf16_t*)(P.ws + WS_WUKV); bf16_t* wmk = (bf16_t*)(P.ws + WS_WMK);
    bf16_t* wo = (bf16_t*)(P.ws + WS_WO); bf16_t* wout = (bf16_t*)(P.ws + WS_WOUT); bf16_t* wgu = (bf16_t*)(P.ws + WS_WGU); bf16_t* wd = (bf16_t*)(P.ws + WS_WD);
    constexpr int I_E = 16 * 16, I_IN = 16 * 91, I_UQ = 6 * 12, I_UKV = 4 * 16, I_MK = 16 * 16, I_O = 8 * 16, I_OUT = 16 * 16;
    constexpr int NITEMS = 3 * 16 * I_E + I_IN + I_UQ + I_UKV + I_MK + 3 * I_O + I_OUT;
    for (int it = gw; it < NITEMS; it += NGW) {
        int r = it;
        if (r < 16 * I_E) { const int e = r / I_E, q = r % I_E, kb = q / 16, n0 = (q % 16) * 64; const int d0 = (n0 >> 7) * 256 + (n0 & 127);
            p0_item64(PWGATE(P) + (size_t)e * 1048576, 1024, kb * 64, n0, wgu + (size_t)e * 2097152, 1024, HalfMap{d0, 1.0f, false, true}, HalfMap{d0 + 32, 1.0f, false, true}, 0, PGFFN(P), scr, lane); continue; } r -= 16 * I_E;
        if (r < 16 * I_E) { const int e = r / I_E, q = r % I_E, kb = q / 16, n0 = (q % 16) * 64; const int d0 = (n0 >> 7) * 256 + 128 + (n0 & 127);
            p0_item64(PWUP(P) + (size_t)e * 1048576, 1024, kb * 64, n0, wgu + (size_t)e * 2097152, 1024, HalfMap{d0, 1.0f, false, true}, HalfMap{d0 + 32, 1.0f, false, true}, 0, PGFFN(P), scr, lane); continue; } r -= 16 * I_E;
        if (r < 16 * I_E) { const int e = r / I_E, q = r % I_E, kb = q / 16, n0 = (q % 16) * 64;
            p0_item64(PWDOWN(P) + (size_t)e * 1048576, 1024, kb * 64, n0, wd + (size_t)e * 1048576, 1024, HalfMap{n0, 1.0f, false, true}, HalfMap{n0 + 32, 1.0f, false, true}, 0, nullptr, scr, lane); continue; } r -= 16 * I_E;
        if (r < I_IN) { const int kb = r / 91, n0 = (r % 91) * 64; HalfMap hm[2];
#pragma unroll
            for (int hh = 0; hh < 2; ++hh) { const int n = n0 + 32 * hh; hm[hh].valid = n < INC_; hm[hh].drow = n < 2208 ? n : n + 96; hm[hh].cs = n < 512 ? C_NA : ((n >= 2208 && n < 2720) ? C_MEM : 1.0f); hm[hh].rp = (n == 2176); }
            p0_item64(PWIN(P), INC_, kb * 64, n0, win, 1024, hm[0], hm[1], 0, PGMIX(P), scr, lane); continue; } r -= I_IN;
        if (r < I_UQ) { const int kb = r / 12, nb = (r % 12) * 2, n0 = nb * 32;
            p0_item64(PWUQ(P), 768, kb * 64, n0, wuq, 384, HalfMap{n0, C_MLA, (nb % 3) == 2, true}, HalfMap{n0 + 32, C_MLA, ((nb + 1) % 3) == 2, true}, 0, PQN(P), scr, lane); continue; } r -= I_UQ;
        if (r < I_UKV) { const int kb = r / 16, nb = (r % 16) * 2, n0 = nb * 32; const int hh = nb >> 2, part = nb & 3; const int dr = (part < 2) ? (hh * 64 + part * 32) : (512 + hh * 64 + (part - 2) * 32);
            p0_item64(PWUKV(P), 1024, kb * 64, n0, wukv, 384, HalfMap{dr, 1.0f, false, true}, HalfMap{dr + 32, 1.0f, false, true}, 0, PKVN(P), scr, lane); continue; } r -= I_UKV;
        if (r < I_MK) { const int kb = r / 16, n0 = (r % 16) * 64; p0_item64(PWMEMKV(P), 1024, kb * 64, n0, wmk, 1024, HalfMap{n0, 1.0f, false, true}, HalfMap{n0 + 32, 1.0f, false, true}, 0, PGMEM(P), scr, lane); continue; } r -= I_MK;
        if (r < 3 * I_O) { const int br = r / I_O, q = r % I_O, kb = q / 16, n0 = (q % 16) * 64; p0_item64(P.in[11 + br], 1024, kb * 64, n0, wo, 1536, HalfMap{n0, 1.0f, false, true}, HalfMap{n0 + 32, 1.0f, false, true}, br * 512, nullptr, scr, lane); continue; } r -= 3 * I_O;
        { const int kb = r / 16, n0 = (r % 16) * 64; p0_item64(PWOUT(P), 1024, kb * 64, n0, wout, 1024, HalfMap{n0, 1.0f, false, true}, HalfMap{n0 + 32, 1.0f, false, true}, 0, nullptr, scr, lane); }
    }
    for (int i = gw * 64 + lane; i < 12288; i += NGW * 64) ((u32x4*)(win + (size_t)2208 * 1024))[i] = (u32x4){0u, 0u, 0u, 0u};
    bf16_t* xb = (bf16_t*)(((unsigned char*)P.out) + DO_XB); float* rstd_x = (float*)(P.ws + WS_RSTDX);
    for (int m = gw; m < T_; m += NGW) p0_row(PX(P) + (size_t)m * D_, xb + (size_t)m * D_, rstd_x + m, lane);
    bf16_t* memb = (bf16_t*)(P.ws + WS_MEMB); float* rstd_m = (float*)(P.ws + WS_RSTDM);
    for (int m = gw; m < 2048; m += NGW) p0_row(PMEM(P) + (size_t)m * D_, memb + (size_t)m * D_, rstd_m + m, lane);
    if (gw == NGW - 1) { float* rope = (float*)(P.ws + WS_ROPE);
        for (int i = lane; i < 512; i += 64) { const int pos = i >> 3, fi = i & 7; const float inv = exp2f(-(float)fi * 1.6609640474436813f); const float ang = (float)pos * inv;
            float rev = ang * 0.15915494309189535f; rev -= floorf(rev); rope[2 * i] = __builtin_amdgcn_cosf(rev); rope[2 * i + 1] = __builtin_amdgcn_sinf(rev); } }
}

__device__ __forceinline__ void phase6(const Ptrs& P, LAS unsigned char* lds, int gw, int NGW, int lane) {
    LAS float* wrT = (LAS float*)lds;
#pragma unroll 2
    for (int i = threadIdx.x; i < 16384; i += NTHREADS) { const int d = i >> 4, e = i & 15; wrT[e * 1024 + d] = PWROUTER(P)[i] * PGFFN(P)[d]; }
    __syncthreads();
    const bf16_t* dbuf = (const bf16_t*)(P.ws + WS_H); bf16_t* hb = (bf16_t*)(P.ws + WS_HB); float* rstd_h = (float*)(P.ws + WS_RSTDH); float* aff = (float*)(P.ws + WS_AFF);
    const int b5 = (lane >> 5) & 1, b4 = (lane >> 4) & 1, b3 = (lane >> 3) & 1, b2 = (lane >> 2) & 1; const int e_me = 8 * b5 + 4 * b4 + 2 * b3 + b2;
    const float bias = PBROUTER(P)[e_me];
    for (int row = gw; row < T_; row += NGW) {
        asm volatile("" ::: "memory");
        const f32x4* xr = (const f32x4*)(PX(P) + (size_t)row * D_) + lane; const u32x2* dr = (const u32x2*)(dbuf + (size_t)row * D_) + lane; f32x4 v[4]; float ss = 0.f;
#pragma unroll
        for (int j = 0; j < 4; ++j) { v[j] = xr[64 * j]; const u32x2 w = dr[64 * j]; v[j][0] += bflo(w.x); v[j][1] += bfhi(w.x); v[j][2] += bflo(w.y); v[j][3] += bfhi(w.y);
            ss += (v[j][0] * v[j][0] + v[j][1] * v[j][1]) + (v[j][2] * v[j][2] + v[j][3] * v[j][3]); }
        u32x2* o8 = (u32x2*)(hb + (size_t)row * D_) + lane;
#pragma unroll
        for (int j = 0; j < 4; ++j) { u32x2 w; w.x = cvt_pk_bf16(v[j][0], v[j][1]); w.y = cvt_pk_bf16(v[j][2], v[j][3]); o8[64 * j] = w; }
        float a[16];
#pragma unroll
        for (int e = 0; e < 16; ++e) { float s = 0.f;
#pragma unroll
            for (int j = 0; j < 4; ++j) { const f32x4 w = *(const LAS f32x4*)(wrT + e * 1024 + 4 * lane + 256 * j); s += (v[j][0] * w[0] + v[j][1] * w[1]) + (v[j][2] * w[2] + v[j][3] * w[3]); }
            asm volatile("" : "+v"(s) :: "memory"); a[e] = s; }
        ss = wave_sum(ss); const float rstd = rsqrtf(ss * (1.0f / 1024.0f) + EPS_);
        if (lane == 0) rstd_h[row] = rstd;
        float a8[8], a4[4], a2[2], a1;
#pragma unroll
        for (int k = 0; k < 8; ++k) { const float send = b5 ? a[k] : a[k + 8]; const float recv = __shfl_xor(send, 32); a8[k] = (b5 ? a[k + 8] : a[k]) + recv; }
#pragma unroll
        for (int k = 0; k < 4; ++k) { const float send = b4 ? a8[k] : a8[k + 4]; const float recv = __shfl_xor(send, 16); a4[k] = (b4 ? a8[k + 4] : a8[k]) + recv; }
#pragma unroll
        for (int k = 0; k < 2; ++k) { const float send = b3 ? a4[k] : a4[k + 2]; const float recv = __shfl_xor(send, 8); a2[k] = (b3 ? a4[k + 2] : a4[k]) + recv; }
        { const float send = b2 ? a2[0] : a2[1]; const float recv = __shfl_xor(send, 4); a1 = (b2 ? a2[1] : a2[0]) + recv; }
        a1 += __shfl_xor(a1, 2); a1 += __shfl_xor(a1, 1);
        const float logit = a1 * rstd + bias;
        float mx = logit; mx = fmaxf(mx, __shfl_xor(mx, 4)); mx = fmaxf(mx, __shfl_xor(mx, 8)); mx = fmaxf(mx, __shfl_xor(mx, 16)); mx = fmaxf(mx, __shfl_xor(mx, 32));
        const float pe = expf(logit - mx); float sm = pe; sm += __shfl_xor(sm, 4); sm += __shfl_xor(sm, 8); sm += __shfl_xor(sm, 16); sm += __shfl_xor(sm, 32);
        if ((lane & 3) == 0) aff[(size_t)row * 16 + e_me] = pe / sm;
    }
    __syncthreads();
}

__device__ __forceinline__ void phase7(const Ptrs& P, LAS unsigned char* lds, int G) {
    LAS unsigned* keys = (LAS unsigned*)lds;
    LAS unsigned* hist = keys + 4096;
    LAS unsigned* misc = hist + 256;
    LAS int* tokl = (LAS int*)(misc + 32);
    const int tid = threadIdx.x, lane = tid & 63, wid = tid >> 6;
    const float* aff = (const float*)(P.ws + WS_AFF); int* idx = (int*)(P.ws + WS_IDX); float* gsel = (float*)(P.ws + WS_GSEL); int* sel = (int*)(P.ws + WS_SEL);
    const bf16_t* hb = (const bf16_t*)(P.ws + WS_HB); bf16_t* xs = (bf16_t*)(P.ws + WS_XS); const float* rstd_h = (const float*)(P.ws + WS_RSTDH); float* rstd_xs = (float*)(P.ws + WS_RSTDXS);
    for (int task = blockIdx.x; task < 128; task += G) {
        const int b = task >> 4, e = task & 15;
        for (int i = tid; i < 4096; i += NTHREADS) keys[i] = __float_as_uint(aff[((size_t)b * S_ + i) * 16 + e]);
        if (tid == 0) { misc[0] = 0u; misc[1] = 512u; }
        __syncthreads();
        for (int shift = 24; shift >= 0; shift -= 8) {
            if (tid < 256) hist[tid] = 0u;
            __syncthreads();
            const unsigned prefix = misc[0];
#pragma unroll
            for (int j = 0; j < 8; ++j) { const unsigned k = keys[tid * 8 + j]; if (shift == 24 || (k >> (shift + 8)) == prefix) __hip_atomic_fetch_add(&hist[(k >> shift) & 255u], 1u, __ATOMIC_RELAXED, __HIP_MEMORY_SCOPE_WORKGROUP); }
            __syncthreads();
            if (wid == 0) {
                const unsigned kk = misc[1];
                const unsigned h0 = hist[4 * lane], h1 = hist[4 * lane + 1], h2 = hist[4 * lane + 2], h3 = hist[4 * lane + 3];
                const unsigned s = h0 + h1 + h2 + h3;
                unsigned incl = s;
#pragma unroll
                for (int o = 1; o < 64; o <<= 1) { const unsigned t = __shfl_down(incl, o); if (lane + o < 64) incl += t; }
                const unsigned excl = incl - s;
                if (excl < kk && kk <= incl) {
                    unsigned rem = kk - excl; unsigned bin;
                    if (rem <= h3) { bin = 3; } else { rem -= h3; if (rem <= h2) { bin = 2; } else { rem -= h2; if (rem <= h1) { bin = 1; } else { rem -= h1; bin = 0; } } }
                    misc[0] = (prefix << 8) | (unsigned)(4 * lane + bin); misc[1] = rem;
                }
            }
            __syncthreads();
        }
        const unsigned thr = misc[0], kk = misc[1];
        unsigned kv[8]; unsigned cg_ = 0, ce = 0;
#pragma unroll
        for (int j = 0; j < 8; ++j) { kv[j] = keys[tid * 8 + j]; cg_ += kv[j] > thr ? 1u : 0u; ce += kv[j] == thr ? 1u : 0u; }
        unsigned ig = cg_, ie = ce;
#pragma unroll
        for (int o = 1; o < 64; o <<= 1) { const unsigned tg = __shfl_up(ig, o), te = __shfl_up(ie, o); if (lane >= o) { ig += tg; ie += te; } }
        if (lane == 63) { misc[8 + wid] = ig; misc[16 + wid] = ie; }
        __syncthreads();
        unsigned bg = ig - cg_, be = ie - ce;
        for (int w = 0; w < wid; ++w) { bg += misc[8 + w]; be += misc[16 + w]; }
#pragma unroll
        for (int j = 0; j < 8; ++j) { const int t = tid * 8 + j; const bool isg = kv[j] > thr, ise = kv[j] == thr; const bool s_ = isg || (ise && be < kk);
            const unsigned slot = bg + (be < kk ? be : kk);
            if (s_) { idx[task * 512 + slot] = t; gsel[task * 512 + slot] = __uint_as_float(kv[j]); tokl[slot] = t; }
            sel[((size_t)b * S_ + t) * 16 + e] = s_ ? (int)slot : -1;
            bg += isg ? 1u : 0u; be += ise ? 1u : 0u; }
        __syncthreads();
        { const int t = tokl[tid]; rstd_xs[(size_t)task * 512 + tid] = rstd_h[(size_t)b * S_ + t]; }
        __syncthreads();
    }
}

__device__ __forceinline__ void phase10(const Ptrs& P, int gw, int NGW, int lane) {
    const bf16_t* hbb = (const bf16_t*)(P.ws + WS_HB); const bf16_t* ybuf = (const bf16_t*)(P.ws + WS_XS); const int* sel = (const int*)(P.ws + WS_SEL);
    f32x4 gf[4];
#pragma unroll
    for (int j = 0; j < 4; ++j) gf[j] = ((const f32x4*)PGFINAL(P))[lane + 64 * j];
    for (int row = gw; row < T_; row += NGW) {
        const u32x2* hr = (const u32x2*)(hbb + (size_t)row * D_) + lane; f32x4 v[4];
#pragma unroll
        for (int j = 0; j < 4; ++j) { const u32x2 w = hr[64 * j]; v[j][0] = bflo(w.x); v[j][1] = bfhi(w.x); v[j][2] = bflo(w.y); v[j][3] = bfhi(w.y); }
        const int sv = sel[(size_t)row * 16 + (lane & 15)]; const int b = row >> 12;
#pragma unroll
        for (int e = 0; e < 16; ++e) { const int s = __builtin_amdgcn_readlane(sv, e);
            if (s >= 0) { const u32x2* yp = (const u32x2*)(ybuf + ((size_t)(b * 16 + e) * 512 + s) * D_) + lane;
#pragma unroll
                for (int j = 0; j < 4; ++j) { const u32x2 w = yp[64 * j]; v[j][0] += bflo(w.x); v[j][1] += bfhi(w.x); v[j][2] += bflo(w.y); v[j][3] += bfhi(w.y); } } }
        float ss = 0.f;
#pragma unroll
        for (int j = 0; j < 4; ++j) ss += (v[j][0] * v[j][0] + v[j][1] * v[j][1]) + (v[j][2] * v[j][2] + v[j][3] * v[j][3]);
        ss = wave_sum(ss); const float rs = rsqrtf(ss * (1.0f / 1024.0f) + EPS_);
        f32x4* orow = (f32x4*)(P.out + (size_t)row * D_) + lane;
#pragma unroll
        for (int j = 0; j < 4; ++j) orow[64 * j] = v[j] * rs * gf[j];
    }
}

#ifndef MK_LAUNCHES
#define MK_LAUNCHES 1
#endif
constexpr int NPHASES = 11;

__global__ void __launch_bounds__(NTHREADS, 2) mk_fwd(Args args) {
    extern __shared__ __attribute__((aligned(16))) unsigned char lds_raw[];
    LAS unsigned char* lds = (LAS unsigned char*)lds_raw;
    cg::grid_group grid = cg::this_grid();
    const int tid = threadIdx.x, lane = tid & 63; const int wave = __builtin_amdgcn_readfirstlane(tid >> 6);
    const int G = gridDim.x, bx = blockIdx.x; const int vcu = (G % 8 == 0) ? (bx % 8) * (G / 8) + bx / 8 : bx;
    const int gw = vcu * 8 + wave, NGW = G * 8;
    const Args& P = args;
    unsigned char* ws = args.ws; unsigned char* dob = (unsigned char*)args.out;
    const int lo = args.ph_lo, hi = args.ph_hi;
    volatile LAS unsigned* xst = (volatile LAS unsigned*)(lds + LDS_BYTES - 16);
    if (tid < 4) xst[tid] = 0u;
    __syncthreads();
    XcdBarrier xbar; xbar.bar = (unsigned*)(args.ws + WS_CTL); xbar.x = 0; xbar.st = xst;
    if (args.coop) xbar = xcd_barrier_post((unsigned*)(args.ws + WS_CTL), xst);
#ifndef MK_ONLY
#define MK_ONLY -1
#endif
#define IN(k) ((MK_ONLY < 0 || MK_ONLY == (k)) && lo <= (k) && (k) < hi)
#ifndef MK_REPEAT
#define MK_REPEAT -1
#endif
#define REPS(k) ((MK_REPEAT == (k)) ? 2 : 1)
#ifndef MLA_CALL
#define MLA_CALL att::attn_unit<96, 64, 0, true>(lds, A, bh >> 3, bh & 7, U & 15)
#endif
#ifndef ATT_MEM_CALL
#define ATT_MEM_CALL att::attn_unit<128, 128, 1, false>(lds, A, bh >> 2, bh & 3, U & 15)
#endif
#ifndef MK_NA_V1
#define MK_NA_V1 0
#endif
#ifndef MK_CG_SEAMS
#define MK_CG_SEAMS 0
#endif
#define SEAM(k) do { if (IN(k) && IN((k) + 1)) { if ((k) < MK_CG_SEAMS) grid.sync(); else xcd_barrier(xbar); } } while (0)

    if (args.pad == 0x5eed) grid.sync();
    if (IN(0)) for (int rep = 0; rep < REPS(0); ++rep) { if (rep) xcd_barrier(xbar); phase0(P, lds, gw, NGW, wave, lane); }
    SEAM(0);
    if (IN(1)) for (int rep = 0; rep < REPS(1); ++rep) { if (rep) xcd_barrier(xbar);
        SchedP1 S{bx, G, (const char*)(dob + DO_XB), (const char*)(ws + WS_WIN), (const char*)(ws + WS_MEMB), (const char*)(ws + WS_WMK)};
        EpiP1 E{(const float*)(ws + WS_RSTDX), (const float*)(ws + WS_RSTDM), (bf16_t*)(ws + WS_NA), (bf16_t*)(ws + WS_ZC), (bf16_t*)(ws + WS_ZQM), (bf16_t*)(ws + WS_ZG), (bf16_t*)(ws + WS_KVMEM),
                (bf16_t*)(dob + DO_KPE), (float*)(ws + WS_SSQQ), (float*)(ws + WS_SSQKV), (const float*)(ws + WS_ROPE)};
        pg8::gemm_phase<EpiP1, SchedP1, false>(lds, 1024, 1024, S, E);
    }
    SEAM(1);
    if (IN(2)) for (int rep = 0; rep < REPS(2); ++rep) { if (rep) xcd_barrier(xbar);
        SchedP2 S{bx, G, (const char*)(ws + WS_ZC), (const char*)(ws + WS_WUQ), (const char*)(ws + WS_WUKV)};
        EpiP2 E{(const float*)(ws + WS_SSQQ), (const float*)(ws + WS_SSQKV), (bf16_t*)(dob + DO_QMLA), (bf16_t*)(dob + DO_KVBUF), (const float*)(ws + WS_ROPE)};
        pg8::gemm_phase<EpiP2, SchedP2, false>(lds, 768, 384, S, E);
    }
    SEAM(2);
    if (IN(3)) {
        if (REPS(31) == 2 && !MK_NA_V1) { na2::na_phase(lds, (const bf16_t*)(ws + WS_NA), (const bf16_t*)(ws + WS_NA) + (size_t)T_ * 512, (const bf16_t*)(ws + WS_NA) + (size_t)2 * T_ * 512, (bf16_t*)(ws + WS_ZC), args.in[4], vcu, G); xcd_barrier(xbar); }
        if (REPS(32) == 2) { att::AttnArgs A{(const bf16_t*)(ws + WS_ZQM), (const bf16_t*)(ws + WS_KVMEM), nullptr, (const bf16_t*)(ws + WS_KVMEM) + 512, (bf16_t*)(ws + WS_ZC), nullptr};
          for (int U = vcu; U < 512; U += G) { const int bh = U >> 4; ATT_MEM_CALL; } grid.sync(); }
        { att::AttnArgs A{(const bf16_t*)(dob + DO_QMLA), (const bf16_t*)(dob + DO_KVBUF), (const bf16_t*)(dob + DO_KPE), (const bf16_t*)(dob + DO_KVBUF) + 512, (bf16_t*)(ws + WS_ZC), nullptr};
          for (int rep = 0; rep < REPS(30); ++rep) { if (rep) xcd_barrier(xbar);
          for (int U = vcu; U < 1024; U += G) { const int bh = U >> 4; MLA_CALL; } } }
#if 0
#else
        na2::na_phase(lds, (const bf16_t*)(ws + WS_NA), (const bf16_t*)(ws + WS_NA) + (size_t)T_ * 512, (const bf16_t*)(ws + WS_NA) + (size_t)2 * T_ * 512, (bf16_t*)(ws + WS_NA), args.in[4], vcu, G);
#endif
        { att::AttnArgs A{(const bf16_t*)(ws + WS_ZQM), (const bf16_t*)(ws + WS_KVMEM), nullptr, (const bf16_t*)(ws + WS_KVMEM) + 512, (bf16_t*)(ws + WS_ZQM), nullptr};
          for (int U = vcu; U < 512; U += G) { const int bh = U >> 4; ATT_MEM_CALL; } }
    }
    SEAM(3);
    if (IN(4)) for (int rep = 0; rep < REPS(4); ++rep) { if (rep) xcd_barrier(xbar);
        SchedP4 S{bx, G, (const char*)(ws + WS_NA), (const char*)(ws + WS_ZC), (const char*)(ws + WS_ZQM), (const char*)(ws + WS_WO)};
        EpiP4 E{(const bf16_t*)(ws + WS_ZG), (bf16_t*)(dob + DO_MERGED)};
        pg8::gemm_phase<EpiP4, SchedP4, true>(lds, 512, 1536, S, E);
    }
    SEAM(4);
    if (IN(5)) for (int rep = 0; rep < REPS(5); ++rep) { if (rep) xcd_barrier(xbar);
        SchedP5 S{bx, G, (const char*)(dob + DO_MERGED), (const char*)(ws + WS_WOUT)};
        EpiP5 E{(bf16_t*)(ws + WS_H)};
        pg8::gemm_phase<EpiP5, SchedP5, false>(lds, 1024, 1024, S, E);
    }
    SEAM(5);
    if (IN(6)) for (int rep = 0; rep < REPS(6); ++rep) { if (rep) xcd_barrier(xbar); phase6(P, lds, gw, NGW, lane); }
    SEAM(6);
    if (IN(7)) for (int rep = 0; rep < REPS(7); ++rep) { if (rep) xcd_barrier(xbar); phase7(P, lds, G); }
    SEAM(7);
    if (IN(8)) for (int rep = 0; rep < REPS(8); ++rep) { if (rep) xcd_barrier(xbar);
        SchedP8 S{bx, G, (const char*)(ws + WS_HB), (const char*)(ws + WS_WGU)};
        EpiP8 E{(const float*)(ws + WS_RSTDXS), (bf16_t*)(dob + DO_ACT)};
        LAS int* gtab = (LAS int*)(lds + pg8::STAGE_BYTES);
        { const int* idxg = (const int*)(ws + WS_IDX); pg8::Unit u_;
          for (int i = 0; S.next(i, u_); ++i) { if (i < 14) { if (tid < 256) { const int row = u_.pm * 256 + tid; gtab[i * 256 + tid] = idxg[row] + (row >> 13) * S_; } } }
          __syncthreads(); }
        pg8::gemm_phase<EpiP8, SchedP8, false, true>(lds, 1024, 1024, S, E, gtab);
    }
    SEAM(8);
    if (IN(9)) for (int rep = 0; rep < REPS(9); ++rep) { if (rep) xcd_barrier(xbar);
        SchedP9 S{bx, G, (const char*)(dob + DO_ACT), (const char*)(ws + WS_WD)};
        EpiP9 E{(const float*)(ws + WS_GSEL), (bf16_t*)(ws + WS_XS)};
        pg8::gemm_phase<EpiP9, SchedP9, false>(lds, 1024, 1024, S, E);
    }
    SEAM(9);
    if (IN(10)) for (int rep = 0; rep < REPS(10); ++rep) { if (rep) xcd_barrier(xbar); phase10(P, gw, NGW, lane); }
#undef IN
#undef SEAM
}

extern "C" void kernel_launch(void* const* d_in, const int* in_sizes, int n_in, void* d_out, int out_size, void* d_ws, size_t ws_size, hipStream_t stream) {
    static int grid = 0;
    if (grid == 0) {
        if (n_in != 22 || out_size != T_ * D_ || ws_size < WS_END) { fprintf(stderr, "kernel_launch: unexpected shapes (n_in %d out %d ws %zu)\n", n_in, out_size, ws_size); grid = -1; return; }
        int dev = 0, cus = 0, per_cu = 0;
        hipGetDevice(&dev); hipDeviceGetAttribute(&cus, hipDeviceAttributeMultiprocessorCount, dev);
        if (hipFuncSetAttribute((const void*)mk_fwd, hipFuncAttributeMaxDynamicSharedMemorySize, LDS_BYTES) != hipSuccess) { fprintf(stderr, "kernel_launch: hipFuncSetAttribute failed\n"); grid = -1; return; }
        hipOccupancyMaxActiveBlocksPerMultiprocessor(&per_cu, (const void*)mk_fwd, NTHREADS, LDS_BYTES);
        (void)hipGetLastError();
        if (per_cu < 1) { fprintf(stderr, "kernel_launch: occupancy query says %d blocks per CU\n", per_cu); per_cu = 1; }
        grid = cus * 1;
        fprintf(stderr, "kernel_launch: cus %d per_cu %d grid %d ws %zu\n", cus, per_cu, grid, ws_size);
    }
    if (grid < 0) return;
    if (hipMemsetAsync((char*)d_ws + WS_CTL, 0, CTL_BYTES, stream) != hipSuccess) { fprintf(stderr, "kernel_launch: memset failed\n"); return; }
    Args a{};
    for (int i = 0; i < 22; ++i) a.in[i] = (const float*)d_in[i];
    a.out = (float*)d_out; a.ws = (unsigned char*)d_ws;
#if MK_LAUNCHES == 1
    a.ph_lo = 0; a.ph_hi = NPHASES; a.coop = 1;
    void* kargs[] = {&a};
    hipError_t e = hipLaunchCooperativeKernel((const void*)mk_fwd, dim3(grid), dim3(NTHREADS), kargs, LDS_BYTES, stream);
    if (e != hipSuccess) fprintf(stderr, "kernel_launch: cooperative launch failed: %s (grid %d)\n", hipGetErrorString(e), grid);
#else
    for (int p = 0; p < NPHASES; ++p) { a.ph_lo = p; a.ph_hi = p + 1; a.coop = 0; hipLaunchKernelGGL(mk_fwd, dim3(grid), dim3(NTHREADS), LDS_BYTES, stream, a); }
#endif
}
```

```cpp
#include <hip/hip_runtime.h>
#include <hip/hip_cooperative_groups.h>
#include <cstdio>
#include <cstdint>
namespace cg = cooperative_groups;

#define LAS __attribute__((address_space(3)))
typedef unsigned short bf16_t;
typedef short bf16x8 __attribute__((ext_vector_type(8)));
typedef short s16x4 __attribute__((ext_vector_type(4)));
typedef float f32x2 __attribute__((ext_vector_type(2)));
typedef float f32x4 __attribute__((ext_vector_type(4)));
typedef float f32x16 __attribute__((ext_vector_type(16)));
typedef unsigned u32x2 __attribute__((ext_vector_type(2)));
typedef unsigned u32x4 __attribute__((ext_vector_type(4)));

constexpr int T_ = 32768, S_ = 4096, D_ = 1024, NB_ = 8, INC_ = 5792, NZ_ = 5888;
constexpr float EPS_ = 1e-6f;
constexpr float LOG2E = 1.4426950408889634f;
constexpr float C_NA = 0.125f * LOG2E, C_MLA = 0.10206207261596577f * LOG2E, C_MEM = 0.08838834764831845f * LOG2E;

constexpr size_t MiB = (size_t)1 << 20;
constexpr size_t WS_WIN = 0;
constexpr size_t WS_WUQ = 12 * MiB;
constexpr size_t WS_WUKV = 13 * MiB;
constexpr size_t WS_WMK = 14 * MiB;
constexpr size_t WS_WO = 16 * MiB;
constexpr size_t WS_WOUT = 19 * MiB;
constexpr size_t WS_WGU = 21 * MiB;
constexpr size_t WS_WD = 85 * MiB;
constexpr size_t WS_RSTDX = 117 * MiB;
constexpr size_t WS_RSTDM = WS_RSTDX + 128 * 1024;
constexpr size_t WS_RSTDH = WS_RSTDM + 128 * 1024;
constexpr size_t WS_ROPE = WS_RSTDH + 128 * 1024;
constexpr size_t WS_RSTDXS = WS_ROPE + 128 * 1024;
constexpr size_t WS_GSEL = WS_RSTDXS + 256 * 1024;
constexpr size_t WS_IDX = WS_GSEL + 256 * 1024;
constexpr size_t WS_SSQQ = 119 * MiB;
constexpr size_t WS_SSQKV = 121 * MiB;
constexpr size_t WS_AFF = 122 * MiB;
constexpr size_t WS_SEL = 124 * MiB;
constexpr size_t WS_MEMB = 126 * MiB;
constexpr size_t WS_KVMEM = 130 * MiB;
constexpr size_t WS_ZG = 134 * MiB;
constexpr size_t WS_H = 134 * MiB;
constexpr size_t WS_HB = 262 * MiB;
constexpr size_t WS_NA = 326 * MiB;
constexpr size_t WS_XS = 326 * MiB;
constexpr size_t WS_ZC = 422 * MiB;
constexpr size_t WS_ZQM = 470 * MiB;
constexpr size_t WS_CTL = 502 * MiB;
constexpr size_t CTL_BYTES = 16384;
constexpr size_t WS_END = 503 * MiB;
constexpr size_t DO_XB = 0, DO_QMLA = 0, DO_KVBUF = 48 * MiB, DO_KPE = 112 * MiB, DO_MERGED = 0, DO_ACT = 0;

constexpr int LDS_BYTES = 147456;
constexpr int NTHREADS = 512;

typedef __bf16 bf16x2_t __attribute__((ext_vector_type(2)));
__device__ __forceinline__ unsigned cvt_pk_bf16(float lo, float hi) { const f32x2 v = {lo, hi}; const bf16x2_t b = __builtin_convertvector(v, bf16x2_t); return __builtin_bit_cast(unsigned, b); }
__device__ __forceinline__ float bf2f(unsigned short b) { return __uint_as_float(((unsigned)b) << 16); }
__device__ __forceinline__ float bflo(unsigned w) { return __uint_as_float(w << 16); }
__device__ __forceinline__ float bfhi(unsigned w) { return __uint_as_float(w & 0xffff0000u); }
__device__ __forceinline__ float wave_sum(float v) {
#pragma unroll
    for (int o = 1; o < 64; o <<= 1) v += __shfl_xor(v, o);
    return v;
}
__device__ __forceinline__ float fast_exp2(float x) { return __builtin_amdgcn_exp2f(x); }
__device__ __forceinline__ float fast_rcp(float x) { return __builtin_amdgcn_rcpf(x); }
__device__ __forceinline__ int crow(int r, int hi) { return (r & 3) + 8 * (r >> 2) + 4 * hi; }


#define XB_TMO      128
#define XB_XCNT(j)  (256  + 64 * (j))
#define XB_XSUB(j)  (1280 + 64 * (j))
#define XB_XGEN(j)  (2304 + 64 * (j))
#define XB_TOP      3328
#define XB_TOPGEN   3392
#define XCD_BAR_WORDS 3456
#define XB_SPIN_CAP (1u << 18)
__device__ __forceinline__ unsigned xb_ld(unsigned* p)              { return __hip_atomic_load(p, __ATOMIC_RELAXED, __HIP_MEMORY_SCOPE_AGENT); }
__device__ __forceinline__ unsigned xb_add(unsigned* p, unsigned v) { return __hip_atomic_fetch_add(p, v, __ATOMIC_RELAXED, __HIP_MEMORY_SCOPE_AGENT); }
__device__ __forceinline__ unsigned xb_xcc_id() { return (unsigned)__builtin_amdgcn_s_getreg((3 << 11) | 20) & 0xFu; }
#define XB_SPIN(cond, bar) do { unsigned _sp = 0; while (cond) { __builtin_amdgcn_s_sleep(1); \
    if ((++_sp & 255u) == 0u) { if (xb_ld(&(bar)[XB_TMO])) break; if (_sp > XB_SPIN_CAP) { atomicAdd(&(bar)[XB_TMO], 1u); break; } } } } while (0)
struct XcdBarrier { unsigned* bar; unsigned x; volatile LAS unsigned* st; };
__device__ __forceinline__ XcdBarrier xcd_barrier_post(unsigned* bar, volatile LAS unsigned* st) {
    XcdBarrier b; b.bar = bar; b.x = xb_xcc_id(); b.st = st;
    if (threadIdx.x == 0) { const unsigned rank = xb_add(&bar[XB_XCNT(b.x)], 1u); st[2] = rank; st[3] = b.x; }
    return b;
}
__device__ __forceinline__ void xcd_barrier_complete(unsigned* bar, unsigned x, unsigned& nloc, unsigned& nx) {
    const unsigned G = gridDim.x * gridDim.y * gridDim.z;
    unsigned sum, cnt, mine, sp = 0u;
    for (;;) {
        sum = 0u; cnt = 0u; mine = 0u;
#pragma unroll
        for (unsigned j = 0; j < 16; ++j) { const unsigned c = xb_ld(&bar[XB_XCNT(j)]); sum += c; cnt += (c > 0u) ? 1u : 0u; mine = (j == x) ? c : mine; }
        if (sum == G) break;
        __builtin_amdgcn_s_sleep(1);
        if ((++sp & 255u) == 0u) { if (xb_ld(&bar[XB_TMO])) break; if (sp > XB_SPIN_CAP) { atomicAdd(&bar[XB_TMO], 1u); break; } }
    }
    nloc = mine > 0u ? mine : 1u; nx = cnt > 0u ? cnt : 1u;
}
__device__ __forceinline__ void xcd_barrier(const XcdBarrier& b) {
    asm volatile("s_waitcnt vmcnt(0)" ::: "memory");
    __syncthreads();
    if (threadIdx.x == 0) {
        unsigned* bar = b.bar;
        __builtin_amdgcn_s_waitcnt(0);
        unsigned nloc = b.st[0], nx = b.st[1];
        if (nloc == 0u) { xcd_barrier_complete(bar, b.x, nloc, nx); b.st[0] = nloc; b.st[1] = nx; }
        const unsigned old = xb_add(&bar[XB_XSUB(b.x)], 1u);
        const unsigned gen = old / nloc;
        if (old + 1u == (gen + 1u) * nloc) {
            __builtin_amdgcn_fence(__ATOMIC_RELEASE, "agent");
            asm volatile("s_waitcnt vmcnt(0)" ::: "memory");
            const unsigned og = xb_add(&bar[XB_TOP], 1u);
            const unsigned tg = og / nx;
            if (og + 1u == (tg + 1u) * nx) xb_add(&bar[XB_TOPGEN], 1u);
            else XB_SPIN(xb_ld(&bar[XB_TOPGEN]) == tg, bar);
            __builtin_amdgcn_fence(__ATOMIC_ACQUIRE, "agent");
            xb_add(&bar[XB_XGEN(b.x)], 1u);
            asm volatile("s_waitcnt vmcnt(0)" ::: "memory");
        } else {
            XB_SPIN(xb_ld(&bar[XB_XGEN(b.x)]) == gen, bar);
            __builtin_amdgcn_fence(__ATOMIC_ACQUIRE, "agent");
            asm volatile("s_waitcnt vmcnt(0)" ::: "memory");
        }
    }
    __syncthreads();
}

struct Args { const float* in[22]; float* out; unsigned char* ws; int ph_lo, ph_hi, coop, pad; };

#ifndef MK_NT
#define MK_NT 0x3001
#endif
template <int BIT, class V> __device__ __forceinline__ void st_g(V* p, const V v) { if constexpr ((MK_NT >> BIT) & 1) __builtin_nontemporal_store(v, p); else *p = v; }
template <int BIT, class V> __device__ __forceinline__ V ld_g(const V* p) { if constexpr ((MK_NT >> BIT) & 1) return __builtin_nontemporal_load(p); else return *p; }
#ifndef MK_XB_HB
#define MK_XB_HB 0
#endif
#if MK_XB_HB
#define XB_PTR(P) ((bf16_t*)((P).ws + WS_HB))
#else
#define XB_PTR(P) ((bf16_t*)(((unsigned char*)(P).out) + DO_XB))
#endif

namespace pg8 {
#ifndef PG8_WGM
#define PG8_WGM 8
#endif
constexpr int BM = 256, BK = 64, HALF = 128, HTB = HALF * BK * 2, STAGE_BYTES = 8 * HTB, NXCD = 8, WGM = PG8_WGM;
__device__ __forceinline__ int lds_byte(int r, int c) { const int st = (r >> 4) * 2 + (c >> 5), rr = r & 15, cc = c & 31, ob = rr * 64 + cc * 2; return st * 1024 + (ob ^ (((ob >> 9) & 1) << 5)); }
__device__ __forceinline__ void stage_rc(int b, int& R, int& C) { const int st = b / 1024, sb = b % 1024, swz = sb ^ (((sb >> 9) & 1) << 5); R = (st >> 1) * 16 + swz / 64; C = (st & 1) * 32 + (swz % 64) / 2; }
__device__ __forceinline__ int perm32(int rho) { const int n = rho >> 4, i = rho & 15; return 8 * (i >> 2) + 4 * n + (i & 3); }

struct Unit { int pm, pn, kind, nt, aux; const char* A; const char* A1; const char* A2; const char* B; };

__device__ __forceinline__ void tile_order(int L, int nM, int nN, int& pm, int& pn) {
    const int nwg = nM * nN; int wgid = L;
    { const int q = nwg / NXCD, r = nwg % NXCD, xcd = wgid % NXCD, off = wgid / NXCD; wgid = (xcd < r ? xcd * (q + 1) : r * (q + 1) + (xcd - r) * q) + off; }
    const int nig = WGM * nN, gid = wgid / nig, fm = gid * WGM, gsz = (nM - fm) < WGM ? (nM - fm) : WGM;
    pm = fm + ((wgid % nig) % gsz); pn = (wgid % nig) / gsz;
}

template <class Epi, class Sched, bool SEG3, bool GATHER = false>
__device__ __forceinline__ void gemm_phase(LAS unsigned char* lds, const int lda, const int ldb, const Sched& S, const Epi& E, const LAS int* gtab = nullptr) {
    int tid_ = threadIdx.x; asm volatile("" : "+v"(tid_));
    const int tid = tid_, wid = __builtin_amdgcn_readfirstlane(tid >> 6), lane = tid & 63, wr = wid >> 2, wc = wid & 3, fr = lane & 15, fq = lane >> 4;
    unsigned voffA[2], voffB[2]; int gR[2]; unsigned gC[2];
#pragma unroll
    for (int i = 0; i < 2; ++i) { int R, C; stage_rc(tid * 16 + i * 8192, R, C); gR[i] = R; gC[i] = (unsigned)C * 2u; const int Rb = Epi::PERM ? ((R & ~31) + perm32(R & 31)) : R;
        voffA[i] = (unsigned)(R * lda + C) * 2u; voffB[i] = (unsigned)(Rb * ldb + C) * 2u; }
    const size_t kstep = (size_t)(BK * 2);
    const size_t hstepA = (size_t)HALF * lda * 2, hstepB = (size_t)HALF * ldb * 2;
    const unsigned ldsw = (unsigned)wid * 1024u;
    const int aoff = lds_byte(wr * 64 + fr, fq * 8), boff = lds_byte(wc * 32 + fr, fq * 8);
#define PG8_SA(b, h) (((b) * 2 + (h)) * HTB)
#define PG8_SB(b, h) ((4 + (b) * 2 + (h)) * HTB)
#define PG8_STAGE(bufoff, gbase, voff) do { _Pragma("unroll") for (int _i = 0; _i < 2; ++_i) \
        __builtin_amdgcn_global_load_lds((const unsigned*)((const char*)(gbase) + (voff)[_i]), (LAS unsigned*)(lds + (bufoff) + ldsw + _i * 8192), 16, 0, 0); } while (0)
#define PG8_GLOAD(dst, ord) do { _Pragma("unroll") for (int _h = 0; _h < 2; ++_h) _Pragma("unroll") for (int _i = 0; _i < 2; ++_i) dst[_h][_i] = (unsigned)gtab[(ord) * 256 + _h * 128 + gR[_i]] * (unsigned)(lda * 2) + gC[_i]; } while (0)
#define PG8_STAGE_A(bufoff, kptr, h, VS) do { if constexpr (GATHER) { PG8_STAGE(bufoff, kptr, VS[h]); } else { PG8_STAGE(bufoff, (kptr) + (h) * hstepA, voffA); } } while (0)
#define PG8_LDA(dst, b, h) do { _Pragma("unroll") for (int m = 0; m < 4; ++m) _Pragma("unroll") for (int k = 0; k < 2; ++k) dst[m][k] = *(const LAS bf16x8*)(lds + PG8_SA(b, h) + aoff + m * 2048 + k * 1024); } while (0)
#define PG8_LDB(dst, b, h) do { _Pragma("unroll") for (int n = 0; n < 2; ++n) _Pragma("unroll") for (int k = 0; k < 2; ++k) dst[n][k] = *(const LAS bf16x8*)(lds + PG8_SB(b, h) + boff + n * 2048 + k * 1024); } while (0)
#define PG8_MMA(ai, bj, At, Bt) do { __builtin_amdgcn_s_setprio(1); _Pragma("unroll") for (int m = 0; m < 4; ++m) _Pragma("unroll") for (int n = 0; n < 2; ++n) _Pragma("unroll") for (int k = 0; k < 2; ++k) \
        acc[ai][bj][m][n] = __builtin_amdgcn_mfma_f32_16x16x32_bf16(Bt[n][k], At[m][k], acc[ai][bj][m][n], 0, 0, 0); __builtin_amdgcn_s_setprio(0); } while (0)
#define PG8_WAIT_V(n) asm volatile("s_waitcnt vmcnt(" #n ")" ::: "memory")
#define PG8_WAIT_L(n) asm volatile("s_waitcnt lgkmcnt(" #n ")" ::: "memory")
#define PG8_BAR __builtin_amdgcn_s_barrier()
#define PG8_SCHED __builtin_amdgcn_sched_barrier(0)
#define PG8_TA(u, kt) (SEG3 ? (((kt) < 8 ? (u).A : ((kt) < 16 ? (u).A1 : (u).A2)) + (size_t)((kt) & 7) * kstep) : ((u).A + (size_t)(kt) * kstep))
#define PG8_TB(u, kt) ((u).B + (size_t)(kt) * kstep)
    Unit cur, nxt; int ui = 0;
    if (!S.next(0, cur)) return;
    f32x4 acc[2][2][4][2];
#pragma unroll
    for (int a = 0; a < 2; ++a)
#pragma unroll
        for (int b = 0; b < 2; ++b)
#pragma unroll
            for (int m = 0; m < 4; ++m)
#pragma unroll
                for (int n = 0; n < 2; ++n) acc[a][b][m][n] = (f32x4){0.f, 0.f, 0.f, 0.f};
    bf16x8 At[4][2], B0[2][2], B1[2][2];
    unsigned vC[2][2], vN[2][2];
#pragma unroll
    for (int _h = 0; _h < 2; ++_h)
#pragma unroll
        for (int _i = 0; _i < 2; ++_i) { vC[_h][_i] = 0u; vN[_h][_i] = 0u; }
    if constexpr (GATHER) { PG8_GLOAD(vC, cur.aux); }
    {
        const char* cA = PG8_TA(cur, 0); const char* cB = PG8_TB(cur, 0);
        PG8_STAGE(PG8_SB(0, 0), cB, voffB); PG8_STAGE(PG8_SB(0, 1), cB + hstepB, voffB); PG8_STAGE_A(PG8_SA(0, 0), cA, 0, vC); PG8_STAGE_A(PG8_SA(0, 1), cA, 1, vC);
        if (wr == 1) PG8_BAR;
        PG8_WAIT_V(2); PG8_BAR;
        const char* cA1 = PG8_TA(cur, 1); const char* cB1 = PG8_TB(cur, 1);
        PG8_STAGE(PG8_SB(1, 0), cB1, voffB); PG8_STAGE_A(PG8_SA(1, 0), cA1, 0, vC); PG8_STAGE(PG8_SB(1, 1), cB1 + hstepB, voffB);
        PG8_WAIT_V(6); PG8_BAR;
    }
    for (;;) {
        const bool has_next = S.next(ui + 1, nxt);
        if constexpr (GATHER) { if (has_next) PG8_GLOAD(vN, nxt.aux); }
        const int nt = cur.nt;
        for (int t = 0; t < nt; t += 2) {
            const bool last = (t == nt - 2);
            const char* a1 = PG8_TA(cur, t + 1);
            const char* a2; const char* b2;
            if (last) { if (has_next) { a2 = PG8_TA(nxt, 0); b2 = PG8_TB(nxt, 0); } else { a2 = PG8_TA(cur, 0); b2 = PG8_TB(cur, 0); } }
            else { a2 = PG8_TA(cur, t + 2); b2 = PG8_TB(cur, t + 2); }
            const char* a3 = a2 + kstep; const char* b3 = b2 + kstep;
            unsigned vS[2][2];
#pragma unroll
            for (int _h = 0; _h < 2; ++_h)
#pragma unroll
                for (int _i = 0; _i < 2; ++_i) vS[_h][_i] = (last && has_next) ? vN[_h][_i] : vC[_h][_i];
            if constexpr (Epi::HAS_MID) { if (t > 0 && (t & 7) == 0) E.mid(acc, cur, t >> 3, wr, wc, fr, fq); }
            PG8_LDB(B0, 0, 0); PG8_LDB(B1, 0, 1); PG8_SCHED; PG8_LDA(At, 0, 0); PG8_STAGE_A(PG8_SA(1, 1), a1, 1, vC);
            PG8_WAIT_V(8); PG8_WAIT_L(0); PG8_BAR; PG8_MMA(0, 0, At, B0); PG8_MMA(0, 1, At, B1); PG8_BAR; PG8_SCHED;
            PG8_LDA(At, 0, 1); PG8_STAGE(PG8_SB(0, 0), b2, voffB); PG8_STAGE(PG8_SB(0, 1), b2 + hstepB, voffB); PG8_STAGE_A(PG8_SA(0, 0), a2, 0, vS);
            PG8_WAIT_V(8); PG8_WAIT_L(0); PG8_BAR; PG8_MMA(1, 0, At, B0); PG8_MMA(1, 1, At, B1); PG8_BAR; PG8_SCHED;
            PG8_LDB(B0, 1, 0); PG8_LDB(B1, 1, 1); PG8_SCHED; PG8_LDA(At, 1, 0); PG8_STAGE_A(PG8_SA(0, 1), a2, 1, vS);
            PG8_WAIT_V(8); PG8_WAIT_L(0); PG8_BAR; PG8_MMA(0, 0, At, B0); PG8_MMA(0, 1, At, B1); PG8_BAR; PG8_SCHED;
            PG8_LDA(At, 1, 1); PG8_STAGE(PG8_SB(1, 0), b3, voffB); PG8_STAGE(PG8_SB(1, 1), b3 + hstepB, voffB); PG8_STAGE_A(PG8_SA(1, 0), a3, 0, vS);
            PG8_WAIT_V(8); PG8_WAIT_L(0); PG8_BAR; PG8_MMA(1, 0, At, B0); PG8_MMA(1, 1, At, B1); PG8_BAR; PG8_SCHED;
        }
        if (wr == 0) PG8_BAR;
        E(acc, cur, wr, wc, fr, fq);
        if (!has_next) break;
#pragma unroll
        for (int a = 0; a < 2; ++a)
#pragma unroll
            for (int b = 0; b < 2; ++b)
#pragma unroll
                for (int m = 0; m < 4; ++m)
#pragma unroll
                    for (int n = 0; n < 2; ++n) acc[a][b][m][n] = (f32x4){0.f, 0.f, 0.f, 0.f};
        cur = nxt; ++ui;
#pragma unroll
        for (int _h = 0; _h < 2; ++_h)
#pragma unroll
            for (int _i = 0; _i < 2; ++_i) vC[_h][_i] = vN[_h][_i];
        if (wr == 1) PG8_BAR;
    }
    PG8_WAIT_V(0);
    PG8_BAR;
#undef PG8_SA
#undef PG8_SB
#undef PG8_STAGE
#undef PG8_STAGE_A
#undef PG8_GLOAD
#undef PG8_LDA
#undef PG8_LDB
#undef PG8_MMA
#undef PG8_WAIT_V
#undef PG8_WAIT_L
#undef PG8_BAR
#undef PG8_SCHED
#undef PG8_TA
#undef PG8_TB
}
}

__device__ __forceinline__ u32x4 pack8(const f32x4 v0, const f32x4 v1) { u32x4 w; w.x = cvt_pk_bf16(v0[0], v0[1]); w.y = cvt_pk_bf16(v0[2], v0[3]); w.z = cvt_pk_bf16(v1[0], v1[1]); w.w = cvt_pk_bf16(v1[2], v1[3]); return w; }
__device__ __forceinline__ void rope8(f32x4& v0, f32x4& v1, int row, int fq, const float* rope) {
    const int t = row & (S_ - 1); const int pos = (fq >> 1) ? (t & 63) : (t >> 6);
    const f32x4* cs = (const f32x4*)(rope + (pos * 8 + 4 * (fq & 1)) * 2);
    const f32x4 c01 = cs[0], c23 = cs[1];
    float a, b;
    a = v0[0]; b = v0[1]; v0[0] = a * c01[0] - b * c01[1]; v0[1] = a * c01[1] + b * c01[0];
    a = v0[2]; b = v0[3]; v0[2] = a * c01[2] - b * c01[3]; v0[3] = a * c01[3] + b * c01[2];
    a = v1[0]; b = v1[1]; v1[0] = a * c23[0] - b * c23[1]; v1[1] = a * c23[1] + b * c23[0];
    a = v1[2]; b = v1[3]; v1[2] = a * c23[2] - b * c23[3]; v1[3] = a * c23[3] + b * c23[2];
}

#ifndef MK_GATE_U8
#define MK_GATE_U8 0
#endif
__device__ __forceinline__ unsigned gate_q(float x) { x = fminf(fmaxf(x, -30.f), 30.f); const float sg = fast_rcp(1.0f + fast_exp2(-LOG2E * x)); return (unsigned)fminf(fmaxf(__builtin_rintf(sg * 255.0f), 1.0f), 255.0f); }
__device__ __forceinline__ u32x2 gate_pack8(const f32x4 v0, const f32x4 v1) { u32x2 w;
    w.x = gate_q(v0[0]) | (gate_q(v0[1]) << 8) | (gate_q(v0[2]) << 16) | (gate_q(v0[3]) << 24); w.y = gate_q(v1[0]) | (gate_q(v1[1]) << 8) | (gate_q(v1[2]) << 16) | (gate_q(v1[3]) << 24); return w; }
__device__ __forceinline__ float ub(unsigned w, int k) { return (float)((w >> (8 * k)) & 0xffu); }
__device__ __forceinline__ float sig_den(float x) { x = fminf(fmaxf(x, -30.f), 30.f); return 1.0f + fast_exp2(-LOG2E * x); }
#ifndef MK_SC1_P1
#define MK_SC1_P1 0
#endif
struct EpiP1 {
    static constexpr bool PERM = true, HAS_MID = false;
    const float* rstd_x; const float* rstd_m; bf16_t* na; bf16_t* zc; bf16_t* zqm; bf16_t* zg; bf16_t* kvmem; bf16_t* kpe; float* ssq_q; float* ssq_kv; const float* rope;
    __amdgpu_buffer_rsrc_t wsr; const char* wsb;
    __device__ __forceinline__ void operator()(const f32x4 (&acc)[2][2][4][2], const pg8::Unit& u, int wr, int wc, int fr, int fq) const {
        const int row0 = u.pm * 256 + wr * 64 + fr; const int pn = u.pn;
        bf16_t* base; int ld, colt; const float* rsp;
        if (u.kind == 0) { rsp = rstd_x;
            if (pn < 6) { base = na + (size_t)(pn >> 1) * T_ * 512; ld = 512; colt = (pn & 1) * 256; }
            else if (pn < 9) { base = zc; ld = 768; colt = (pn - 6) * 256; }
            else if (pn < 11) { base = zqm; ld = 512; colt = (pn - 9) * 256; }
            else { base = zg; ld = 3072; colt = (pn - 11) * 256; } }
        else { rsp = rstd_m; base = kvmem; ld = 1024; colt = pn * 256; }
        const int col0 = colt + wc * 32 + 8 * fq;
        const bool stats = (u.kind == 0) && (pn >= 6) && (pn < 9); const bool isgate = (u.kind == 0) && (pn >= 11);
#pragma unroll
        for (int ai = 0; ai < 2; ++ai)
#pragma unroll
            for (int m = 0; m < 4; ++m) { const int row = row0 + ai * 128 + m * 16; const float rs = rsp[row]; bf16_t* rowp = base + (size_t)row * ld + col0;
#pragma unroll
                for (int bj = 0; bj < 2; ++bj) { f32x4 v0 = acc[ai][bj][m][0] * rs, v1 = acc[ai][bj][m][1] * rs;
#if !MK_GATE_U8
                    if (isgate) {
#pragma unroll
                        for (int e = 0; e < 4; ++e) { v0[e] = sig_den(v0[e]); v1[e] = sig_den(v1[e]); } }
#endif
#if MK_SC1_P1
                    __builtin_amdgcn_raw_buffer_store_b128(pack8(v0, v1), wsr, (int)((const char*)(rowp + bj * 128) - wsb), 0, 16);
#else
#if MK_GATE_U8
                    if (isgate) { st_g<0>((u32x2*)((unsigned char*)zg + (size_t)row * 3072 + col0 + bj * 128), gate_pack8(v0, v1)); continue; }
#endif
                    if (((MK_NT >> 16) & 1) && stats) *(u32x4*)(rowp + bj * 128) = pack8(v0, v1);
                    else st_g<0>((u32x4*)(rowp + bj * 128), pack8(v0, v1));
#endif
                    if (stats) { const int idx = (pn - 6) * 2 + bj;
                        if (idx < 5) { float s = (v0[0] * v0[0] + v0[1] * v0[1]) + (v0[2] * v0[2] + v0[3] * v0[3]) + (v1[0] * v1[0] + v1[1] * v1[1]) + (v1[2] * v1[2] + v1[3] * v1[3]);
                            s += __shfl_xor(s, 16); s += __shfl_xor(s, 32);
                            if (fq == 0) { if (idx < 3) ssq_q[(size_t)row * 12 + idx * 4 + wc] = s; else ssq_kv[(size_t)row * 8 + (idx - 3) * 4 + wc] = s; } }
                        else if (wc == 0) { rope8(v0, v1, row, fq, rope); *(u32x4*)(kpe + (size_t)row * 32 + 8 * fq) = pack8(v0, v1); } } } }
    }
};
struct SchedP1 {
    int c, G; const char* xb; const char* win; const char* memb; const char* wmk;
    __device__ __forceinline__ bool next(int i, pg8::Unit& u) const {
        const int L = i * G + c; int pm, pn;
        if (L < 2944) { pg8::tile_order(L, 128, 23, pm, pn); u.pm = pm; u.pn = pn; u.kind = 0; u.nt = 16; u.aux = 0; u.A = xb + (size_t)pm * 256 * 2048; u.B = win + (size_t)pn * 256 * 2048; u.A1 = u.A; u.A2 = u.A; return true; }
        if (L < 2976) { pg8::tile_order(L - 2944, 8, 4, pm, pn); u.pm = pm; u.pn = pn; u.kind = 1; u.nt = 16; u.aux = 0; u.A = memb + (size_t)pm * 256 * 2048; u.B = wmk + (size_t)pn * 256 * 2048; u.A1 = u.A; u.A2 = u.A; return true; }
        return false;
    }
};

struct EpiP2 {
    static constexpr bool PERM = true, HAS_MID = false;
    const float* ssq_q; const float* ssq_kv; bf16_t* qmla; bf16_t* kvbuf; const float* rope;
    __device__ __forceinline__ void operator()(const f32x4 (&acc)[2][2][4][2], const pg8::Unit& u, int wr, int wc, int fr, int fq) const {
        const int row0 = u.pm * 256 + wr * 64 + fr; const int pn = u.pn;
        float rs[2][4];
        if (u.kind == 0) {
#pragma unroll
            for (int ai = 0; ai < 2; ++ai)
#pragma unroll
                for (int m = 0; m < 4; ++m) { const f32x4* p = (const f32x4*)(ssq_q + (size_t)(row0 + ai * 128 + m * 16) * 12); const f32x4 a = p[0], b = p[1], c = p[2];
                    const float s = ((a[0] + a[1]) + (a[2] + a[3])) + ((b[0] + b[1]) + (b[2] + b[3])) + ((c[0] + c[1]) + (c[2] + c[3])); rs[ai][m] = rsqrtf(s * (1.0f / 384.0f) + EPS_); }
        } else {
#pragma unroll
            for (int ai = 0; ai < 2; ++ai)
#pragma unroll
                for (int m = 0; m < 4; ++m) { const f32x4* p = (const f32x4*)(ssq_kv + (size_t)(row0 + ai * 128 + m * 16) * 8); const f32x4 a = p[0], b = p[1];
                    const float s = ((a[0] + a[1]) + (a[2] + a[3])) + ((b[0] + b[1]) + (b[2] + b[3])); rs[ai][m] = rsqrtf(s * (1.0f / 256.0f) + EPS_); }
        }
        bf16_t* base = u.kind == 0 ? qmla : kvbuf; const int ld = u.kind == 0 ? 768 : 1024;
        const int col0 = pn * 256 + wc * 32 + 8 * fq;
#pragma unroll
        for (int bj = 0; bj < 2; ++bj) { const bool isrope = (u.kind == 0) && (((8 * pn + 4 * bj + wc) % 3) == 2);
#pragma unroll
            for (int ai = 0; ai < 2; ++ai)
#pragma unroll
                for (int m = 0; m < 4; ++m) { const int row = row0 + ai * 128 + m * 16; f32x4 v0 = acc[ai][bj][m][0] * rs[ai][m], v1 = acc[ai][bj][m][1] * rs[ai][m];
                    if (isrope) rope8(v0, v1, row, fq, rope);
                    st_g<1>((u32x4*)(base + (size_t)row * ld + col0 + bj * 128), pack8(v0, v1)); } }
    }
};
struct SchedP2 {
    int c, G; const char* zc; const char* wuq; const char* wukv;
    __device__ __forceinline__ bool next(int i, pg8::Unit& u) const {
        const int L = i * G + c; int pm, pn;
        if (L < 384) { pg8::tile_order(L, 128, 3, pm, pn); u.pm = pm; u.pn = pn; u.kind = 0; u.nt = 6; u.aux = 0; u.A = zc + (size_t)pm * 256 * 1536; u.B = wuq + (size_t)pn * 256 * 768; u.A1 = u.A; u.A2 = u.A; return true; }
        if (L < 896) { pg8::tile_order(L - 384, 128, 4, pm, pn); u.pm = pm; u.pn = pn; u.kind = 1; u.nt = 4; u.aux = 0; u.A = zc + (size_t)pm * 256 * 1536 + 768; u.B = wukv + (size_t)pn * 256 * 768; u.A1 = u.A; u.A2 = u.A; return true; }
        return false;
    }
};

struct EpiP4 {
    static constexpr bool PERM = true, HAS_MID = true;
    const bf16_t* zg; bf16_t* merged; int nohook;
#if MK_GATE_U8
    __device__ __forceinline__ void mid(f32x4 (&acc)[2][2][4][2], const pg8::Unit& u, int seg, int wr, int wc, int fr, int fq) const {
        if (nohook) return;
        const int row0 = u.pm * 256 + wr * 64 + fr; const int col0 = u.pn * 256 + wc * 32 + 8 * fq; const unsigned char* z8 = (const unsigned char*)zg;
        u32x2 ga[2][4][2], gb[2][4][2];
#pragma unroll
        for (int ai = 0; ai < 2; ++ai)
#pragma unroll
            for (int m = 0; m < 4; ++m) { const unsigned char* gp = z8 + (size_t)(row0 + ai * 128 + m * 16) * 3072 + col0 + (seg - 1) * 1024;
#pragma unroll
                for (int bj = 0; bj < 2; ++bj) { ga[ai][m][bj] = ld_g<15>((const u32x2*)(gp + bj * 128)); gb[ai][m][bj] = ld_g<15>((const u32x2*)(gp + 1024 + bj * 128)); } }
#pragma unroll
        for (int ai = 0; ai < 2; ++ai)
#pragma unroll
            for (int m = 0; m < 4; ++m)
#pragma unroll
                for (int bj = 0; bj < 2; ++bj)
#pragma unroll
                    for (int n = 0; n < 2; ++n) { const unsigned wa = ga[ai][m][bj][n], wb = gb[ai][m][bj][n];
#pragma unroll
                        for (int k = 0; k < 4; ++k) acc[ai][bj][m][n][k] *= ub(wa, k) * fast_rcp(ub(wb, k)); }
    }
    __device__ __forceinline__ void operator()(const f32x4 (&acc)[2][2][4][2], const pg8::Unit& u, int wr, int wc, int fr, int fq) const {
        const int row0 = u.pm * 256 + wr * 64 + fr; const int col0 = u.pn * 256 + wc * 32 + 8 * fq; const unsigned char* z8 = (const unsigned char*)zg;
#pragma unroll
        for (int ai = 0; ai < 2; ++ai) {
            u32x2 gg[4][2];
#pragma unroll
            for (int m = 0; m < 4; ++m) { const unsigned char* gp = z8 + (size_t)(row0 + ai * 128 + m * 16) * 3072 + col0 + 2048;
#pragma unroll
                for (int bj = 0; bj < 2; ++bj) gg[m][bj] = ld_g<15>((const u32x2*)(gp + bj * 128)); }
#pragma unroll
            for (int m = 0; m < 4; ++m) { const int row = row0 + ai * 128 + m * 16;
#pragma unroll
                for (int bj = 0; bj < 2; ++bj) { const u32x2 g = gg[m][bj]; f32x4 v0 = acc[ai][bj][m][0], v1 = acc[ai][bj][m][1];
#pragma unroll
                    for (int k = 0; k < 4; ++k) { v0[k] *= ub(g[0], k) * (1.0f / 255.0f); v1[k] *= ub(g[1], k) * (1.0f / 255.0f); }
                    st_g<2>((u32x4*)(merged + (size_t)row * 1024 + col0 + bj * 128), pack8(v0, v1)); } }
        }
    }
#else
    __device__ __forceinline__ void mid(f32x4 (&acc)[2][2][4][2], const pg8::Unit& u, int seg, int wr, int wc, int fr, int fq) const {
        if (nohook) return;
        const int row0 = u.pm * 256 + wr * 64 + fr; const int col0 = u.pn * 256 + wc * 32 + 8 * fq;
#pragma unroll
        for (int ai = 0; ai < 2; ++ai) {
            u32x4 ga[4][2], gb[4][2];
#pragma unroll
            for (int m = 0; m < 4; ++m) { const bf16_t* gp = zg + (size_t)(row0 + ai * 128 + m * 16) * 3072 + col0 + (seg - 1) * 1024;
#pragma unroll
                for (int bj = 0; bj < 2; ++bj) { ga[m][bj] = ld_g<15>((const u32x4*)(gp + bj * 128)); gb[m][bj] = ld_g<15>((const u32x4*)(gp + 1024 + bj * 128)); } }
#pragma unroll
            for (int m = 0; m < 4; ++m)
#pragma unroll
                for (int bj = 0; bj < 2; ++bj)
#pragma unroll
                    for (int e = 0; e < 4; ++e) { const unsigned wa = ga[m][bj][e], wb = gb[m][bj][e];
                        const float r0 = bflo(wb) * fast_rcp(bflo(wa)), r1 = bfhi(wb) * fast_rcp(bfhi(wa));
                        acc[ai][bj][m][e >> 1][(e & 1) * 2] *= r0; acc[ai][bj][m][e >> 1][(e & 1) * 2 + 1] *= r1; }
        }
    }
    __device__ __forceinline__ void operator()(const f32x4 (&acc)[2][2][4][2], const pg8::Unit& u, int wr, int wc, int fr, int fq) const {
        const int row0 = u.pm * 256 + wr * 64 + fr; const int col0 = u.pn * 256 + wc * 32 + 8 * fq;
#pragma unroll
        for (int ai = 0; ai < 2; ++ai) {
            u32x4 gg[4][2];
#pragma unroll
            for (int m = 0; m < 4; ++m) { const bf16_t* gp = zg + (size_t)(row0 + ai * 128 + m * 16) * 3072 + col0 + 2048;
#pragma unroll
                for (int bj = 0; bj < 2; ++bj) gg[m][bj] = ld_g<15>((const u32x4*)(gp + bj * 128)); }
#pragma unroll
            for (int m = 0; m < 4; ++m) { const int row = row0 + ai * 128 + m * 16;
#pragma unroll
                for (int bj = 0; bj < 2; ++bj) { const u32x4 g = gg[m][bj]; f32x4 v0 = acc[ai][bj][m][0], v1 = acc[ai][bj][m][1];
                    v0[0] *= fast_rcp(bflo(g[0])); v0[1] *= fast_rcp(bfhi(g[0])); v0[2] *= fast_rcp(bflo(g[1])); v0[3] *= fast_rcp(bfhi(g[1]));
                    v1[0] *= fast_rcp(bflo(g[2])); v1[1] *= fast_rcp(bfhi(g[2])); v1[2] *= fast_rcp(bflo(g[3])); v1[3] *= fast_rcp(bfhi(g[3]));
                    st_g<2>((u32x4*)(merged + (size_t)row * 1024 + col0 + bj * 128), pack8(v0, v1)); } }
        }
    }
#endif
};
struct SchedP4 {
    int c, G; const char* yna; const char* ymla; const char* ymem; const char* wo;
    __device__ __forceinline__ bool next(int i, pg8::Unit& u) const {
        const int L = i * G + c; int pm, pn; if (L >= 512) return false;
        pg8::tile_order(L, 128, 4, pm, pn); u.pm = pm; u.pn = pn; u.kind = 0; u.nt = 24; u.aux = 0;
        u.A = yna + (size_t)pm * 256 * 1024; u.A1 = ymla + (size_t)pm * 256 * 1024; u.A2 = ymem + (size_t)pm * 256 * 1024; u.B = wo + (size_t)pn * 256 * 3072; return true;
    }
};

struct EpiP5 {
    static constexpr bool PERM = true, HAS_MID = false;
    bf16_t* delta;
    __device__ __forceinline__ void operator()(const f32x4 (&acc)[2][2][4][2], const pg8::Unit& u, int wr, int wc, int fr, int fq) const {
        const int row0 = u.pm * 256 + wr * 64 + fr; const int col0 = u.pn * 256 + wc * 32 + 8 * fq;
#pragma unroll
        for (int ai = 0; ai < 2; ++ai)
#pragma unroll
            for (int m = 0; m < 4; ++m) { bf16_t* rowp = delta + (size_t)(row0 + ai * 128 + m * 16) * 1024 + col0;
#pragma unroll
                for (int bj = 0; bj < 2; ++bj) st_g<3>((u32x4*)(rowp + bj * 128), pack8(acc[ai][bj][m][0], acc[ai][bj][m][1])); }
    }
};
struct SchedP5 {
    int c, G; const char* merged; const char* wout;
    __device__ __forceinline__ bool next(int i, pg8::Unit& u) const {
        const int L = i * G + c; int pm, pn; if (L >= 512) return false;
        pg8::tile_order(L, 128, 4, pm, pn); u.pm = pm; u.pn = pn; u.kind = 0; u.nt = 16; u.aux = 0;
        u.A = merged + (size_t)pm * 256 * 2048; u.A1 = u.A; u.A2 = u.A; u.B = wout + (size_t)pn * 256 * 2048; return true;
    }
};

struct EpiP8 {
    static constexpr bool PERM = true, HAS_MID = false;
    const float* rstd_xs; bf16_t* act;
    __device__ __forceinline__ void operator()(const f32x4 (&acc)[2][2][4][2], const pg8::Unit& u, int wr, int wc, int fr, int fq) const {
        const int row0 = u.pm * 256 + wr * 64 + fr; const int col0 = u.pn * 128 + wc * 32 + 8 * fq;
#pragma unroll
        for (int ai = 0; ai < 2; ++ai)
#pragma unroll
            for (int m = 0; m < 4; ++m) { const int row = row0 + ai * 128 + m * 16; const float rs = rstd_xs[row]; f32x4 o[2];
#pragma unroll
                for (int n = 0; n < 2; ++n)
#pragma unroll
                    for (int e = 0; e < 4; ++e) { const float hg = acc[ai][0][m][n][e] * rs, hu = acc[ai][1][m][n][e] * rs; o[n][e] = hg * fast_rcp(1.0f + fast_exp2(-LOG2E * hg)) * hu; }
                st_g<4>((u32x4*)(act + (size_t)row * 1024 + col0), pack8(o[0], o[1])); }
    }
};
struct SchedP8 {
    int c, G; const char* xs; const char* wgu;
    __device__ __forceinline__ bool next(int i, pg8::Unit& u) const {
        const int L = i * G + c; int pm, pn; if (L >= 2048) return false;
        const int e = L >> 7; pg8::tile_order(L & 127, 16, 8, pm, pn); const int b = pm >> 1, half = pm & 1; const int grow0 = (b * 16 + e) * 512 + half * 256;
        u.pm = grow0 >> 8; u.pn = pn; u.kind = 0; u.nt = 16; u.aux = i; u.A = xs; u.A1 = u.A; u.A2 = u.A; u.B = wgu + (size_t)(e * 2048 + pn * 256) * 2048; return true;
    }
};
struct EpiP9 {
    static constexpr bool PERM = true, HAS_MID = false;
    const float* gsel; bf16_t* ybuf;
    __device__ __forceinline__ void operator()(const f32x4 (&acc)[2][2][4][2], const pg8::Unit& u, int wr, int wc, int fr, int fq) const {
        const int row0 = u.pm * 256 + wr * 64 + fr; const int col0 = u.pn * 256 + wc * 32 + 8 * fq;
#pragma unroll
        for (int ai = 0; ai < 2; ++ai)
#pragma unroll
            for (int m = 0; m < 4; ++m) { const int row = row0 + ai * 128 + m * 16; const float gs = gsel[row];
#pragma unroll
                for (int bj = 0; bj < 2; ++bj) st_g<5>((u32x4*)(ybuf + (size_t)row * 1024 + col0 + bj * 128), pack8(acc[ai][bj][m][0] * gs, acc[ai][bj][m][1] * gs)); }
    }
};
struct SchedP9 {
    int c, G; const char* act; const char* wd;
    __device__ __forceinline__ bool next(int i, pg8::Unit& u) const {
        const int L = i * G + c; int pm, pn; if (L >= 1024) return false;
        const int e = L >> 6; pg8::tile_order(L & 63, 16, 4, pm, pn); const int b = pm >> 1, half = pm & 1; const int grow0 = (b * 16 + e) * 512 + half * 256;
        u.pm = grow0 >> 8; u.pn = pn; u.kind = 0; u.nt = 16; u.aux = e; u.A = act + (size_t)grow0 * 2048; u.A1 = u.A; u.A2 = u.A; u.B = wd + (size_t)(e * 1024 + pn * 256) * 2048; return true;
    }
};

struct EpiMoE {
    static constexpr bool PERM = true, HAS_MID = false;
    EpiP8 e8; EpiP9 e9;
    __device__ __forceinline__ void operator()(const f32x4 (&acc)[2][2][4][2], const pg8::Unit& u, int wr, int wc, int fr, int fq) const { if (u.kind == 0) e8(acc, u, wr, wc, fr, fq); else e9(acc, u, wr, wc, fr, fq); }
};
struct SchedMoE {
    int e, grow0; const char* hb; const char* act; const char* wgu; const char* wd;
    __device__ __forceinline__ bool next(int i, pg8::Unit& u) const {
        if (i >= 12) return false;
        u.pm = grow0 >> 8; u.nt = 16;
        if (i < 8) { u.pn = i; u.kind = 0; u.aux = 0; u.A = hb; u.B = wgu + (size_t)(e * 2048 + i * 256) * 2048; }
        else { u.pn = i - 8; u.kind = 1; u.aux = 1; u.A = act; u.B = wd + (size_t)(e * 1024 + (i - 8) * 256) * 2048; }
        u.A1 = u.A; u.A2 = u.A; return true;
    }
};

namespace att {
typedef short v4i16_t __attribute__((ext_vector_type(4)));
struct AttnArgs { const bf16_t* q; const bf16_t* k0; const bf16_t* k1; const bf16_t* v; bf16_t* o; const float* rpb; };
__device__ __forceinline__ s16x4 vtr(unsigned addr) { return __builtin_bit_cast(s16x4, __builtin_amdgcn_ds_read_tr16_b64_v4i16((LAS v4i16_t*)(uintptr_t)addr)); }
__device__ __forceinline__ float max3f(float a, float b, float c) { return __builtin_fmaxf(__builtin_fmaxf(a, b), c); }

template <int DQK, int DV, int MODE, bool PIPE>
__device__ __forceinline__ void attn_unit(LAS unsigned char* lds, const AttnArgs& A, const int b, const int h, const int ub) {
    constexpr int PK = DQK * 2 + 16, PV = DV * 2 + 64, KB = 64 * PK, VB = 64 * PV;
    constexpr int OFF_K = 0, OFF_V = 2 * KB, OFF_SCR = OFF_V + 2 * VB, OFF_OST = OFF_SCR + 8 * 256, OFF_END = OFF_OST + 8 * 32 * DV * 2;
    static_assert(OFF_END <= LDS_BYTES - 64, "attention LDS");
    constexpr int KCH = DQK / 8, VCH = DV / 8, NKC = 64 * KCH, NVC = 64 * VCH, KPT = (NKC + 511) / 512, VPT = (NVC + 511) / 512;
    constexpr int LDQ = (MODE == 0) ? 768 : 512, LDO = 512;
    constexpr int NDS = DQK / 16, ND0 = DV / 32;
    constexpr int NT = (MODE == 0) ? 64 : 4;
#ifndef ATT_THR
#define ATT_THR 8.0f
#endif
    constexpr float THR = ATT_THR;
    int tid_ = threadIdx.x; asm volatile("" : "+v"(tid_));
    const int tid = tid_, lane = tid & 63, r32 = lane & 31, hi = lane >> 5; const int wid = __builtin_amdgcn_readfirstlane(tid >> 6);
    const int wave_tok0 = b * S_ + ub * 256 + wid * 32;
    bf16x8 qf[NDS];
    { const bf16_t* qp = A.q + (size_t)(wave_tok0 + r32) * LDQ + h * DQK + hi * 8;
#pragma unroll
      for (int ds = 0; ds < NDS; ++ds) qf[ds] = *(const bf16x8*)(qp + ds * 16); }
    const bf16_t* ksrc[KPT]; int kstr[KPT]; unsigned kdst[KPT]; bool kval[KPT];
    const bf16_t* vsrc[VPT]; unsigned vdst[VPT];
    constexpr int KSTRIDE = 64 * 1024;
#pragma unroll
    for (int j = 0; j < KPT; ++j) { const int ci = tid + 512 * j; kval[j] = ci < NKC; const int cic = kval[j] ? ci : 0; const int row = cic / KCH, cc = cic % KCH;
        kdst[j] = (unsigned)(OFF_K + row * PK + cc * 16); kstr[j] = KSTRIDE;
        if (MODE == 0) { const size_t kt = (size_t)b * S_ + row; if (cc < 8) ksrc[j] = A.k0 + kt * 1024 + h * 64 + cc * 8; else { ksrc[j] = A.k1 + kt * 32 + (cc - 8) * 8; kstr[j] = 64 * 32; } }
        else { const size_t kr = (size_t)b * 256 + row; ksrc[j] = A.k0 + kr * 1024 + h * 128 + cc * 8; } }
#pragma unroll
    for (int j = 0; j < VPT; ++j) { const int ci = tid + 512 * j; const int row = ci / VCH, cc = ci % VCH;
        vdst[j] = (unsigned)(OFF_V + row * PV + cc * 16);
        if (MODE == 0) { const size_t kt = (size_t)b * S_ + row; vsrc[j] = A.v + kt * 1024 + h * 64 + cc * 8; }
        else { const size_t kr = (size_t)b * 256 + row; vsrc[j] = A.v + kr * 1024 + h * 128 + cc * 8; } }
    u32x4 kst[KPT], vst[VPT];
#define ATT_LOADK(tile) do { _Pragma("unroll") for (int j = 0; j < KPT; ++j) if (kval[j]) kst[j] = *(const u32x4*)(ksrc[j] + (size_t)(tile) * kstr[j]); } while (0)
#define ATT_LOADV(tile) do { _Pragma("unroll") for (int j = 0; j < VPT; ++j) vst[j] = *(const u32x4*)(vsrc[j] + (size_t)(tile) * KSTRIDE); } while (0)
#define ATT_STOREK(buf) do { _Pragma("unroll") for (int j = 0; j < KPT; ++j) if (kval[j]) *(LAS u32x4*)(lds + kdst[j] + (buf) * KB) = kst[j]; } while (0)
#define ATT_STOREV(buf) do { _Pragma("unroll") for (int j = 0; j < VPT; ++j) *(LAS u32x4*)(lds + vdst[j] + (buf) * VB) = vst[j]; } while (0)
    LAS float* scr = (LAS float*)(lds + OFF_SCR) + wid * 64;
#define ATT_QK(P0, P1, buf) do { const LAS unsigned char* kb_ = lds + OFF_K + (buf) * KB + r32 * PK + hi * 16; P0 = negm; P1 = negm; __builtin_amdgcn_s_setprio(1); \
        _Pragma("unroll") for (int ds = 0; ds < NDS; ++ds) { const bf16x8 a0_ = *(const LAS bf16x8*)(kb_ + ds * 32), a1_ = *(const LAS bf16x8*)(kb_ + 32 * PK + ds * 32); \
            P0 = __builtin_amdgcn_mfma_f32_32x32x16_bf16(a0_, qf[ds], P0, 0, 0, 0); P1 = __builtin_amdgcn_mfma_f32_32x32x16_bf16(a1_, qf[ds], P1, 0, 0, 0); } __builtin_amdgcn_s_setprio(0); } while (0)
#define ATT_ROWMAX(P0, P1, rm) do { float a_ = max3f(P0[0], P0[1], P1[0]), b_ = max3f(P0[2], P0[3], P1[1]); a_ = max3f(a_, P1[2], P1[3]); \
        _Pragma("unroll") for (int r = 4; r < 16; r += 4) { a_ = max3f(a_, P0[r], P0[r + 1]); b_ = max3f(b_, P0[r + 2], P0[r + 3]); a_ = max3f(a_, P1[r], P1[r + 1]); b_ = max3f(b_, P1[r + 2], P1[r + 3]); } \
        rm = fmaxf(a_, b_); rm = fmaxf(rm, __shfl_xor(rm, 32)); } while (0)
    f32x16 o[ND0], negm;
#pragma unroll
    for (int r = 0; r < 16; ++r) negm[r] = 0.f;
#pragma unroll
    for (int d0 = 0; d0 < ND0; ++d0)
#pragma unroll
        for (int r = 0; r < 16; ++r) o[d0][r] = 0.f;
    float lsum = 0.f;
    f32x16 pA0, pA1, pB0, pB1;
    { u32x4 k1st[KPT];
      ATT_LOADK(0); ATT_LOADV(0);
#pragma unroll
      for (int j = 0; j < KPT; ++j) if (kval[j]) k1st[j] = *(const u32x4*)(ksrc[j] + (size_t)kstr[j]);
      ATT_STOREK(0); ATT_STOREV(0);
#pragma unroll
      for (int j = 0; j < KPT; ++j) if (kval[j]) *(LAS u32x4*)(lds + kdst[j] + KB) = k1st[j]; }
    __syncthreads();
    ATT_QK(pA0, pA1, 0);
    { float rm; ATT_ROWMAX(pA0, pA1, rm);
#pragma unroll
      for (int r = 0; r < 16; ++r) { pA0[r] -= rm; pA1[r] -= rm; negm[r] = -rm; } }
    __syncthreads();
#ifndef ATT_SGB
#define ATT_SGB 1
#endif
#define ATT_STEP(PC0, PC1, PN0, PN1, t) do { const int buf_ = (t) & 1; \
        if ((t) + 2 < NT) ATT_LOADK((t) + 2); if ((t) + 1 < NT) ATT_LOADV((t) + 1); \
        if constexpr (!PIPE) { if ((t) > 0) { ATT_QK(PC0, PC1, buf_); float rm0_; ATT_ROWMAX(PC0, PC1, rm0_); \
            if (__any(rm0_ > THR)) { const float dl_ = fmaxf(rm0_, 0.f); const float f_ = fast_exp2(-dl_); lsum *= f_; \
                _Pragma("unroll") for (int r = 0; r < 16; ++r) { PC0[r] -= dl_; PC1[r] -= dl_; negm[r] -= dl_; } \
                if (hi == 0) scr[r32] = f_; \
                _Pragma("unroll") for (int r = 0; r < 16; ++r) { const float fr_ = scr[crow(r, hi)]; _Pragma("unroll") for (int d0 = 0; d0 < ND0; ++d0) o[d0][r] *= fr_; } } } } \
          \
        if constexpr (PIPE) { if ((t) + 1 < NT) ATT_QK(PN0, PN1, buf_ ^ 1); } \
        float ps_ = 0.f; \
        _Pragma("unroll") for (int r = 0; r < 16; ++r) { PC0[r] = fast_exp2(PC0[r]); PC1[r] = fast_exp2(PC1[r]); ps_ += PC0[r] + PC1[r]; } \
        lsum += ps_; \
        bf16x8 pa_[4]; \
        _Pragma("unroll") for (int s = 0; s < 2; ++s) { u32x4 w_; \
            w_.x = cvt_pk_bf16(PC0[8 * s + 0], PC0[8 * s + 1]); w_.y = cvt_pk_bf16(PC0[8 * s + 2], PC0[8 * s + 3]); w_.z = cvt_pk_bf16(PC0[8 * s + 4], PC0[8 * s + 5]); w_.w = cvt_pk_bf16(PC0[8 * s + 6], PC0[8 * s + 7]); pa_[s] = __builtin_bit_cast(bf16x8, w_); \
            w_.x = cvt_pk_bf16(PC1[8 * s + 0], PC1[8 * s + 1]); w_.y = cvt_pk_bf16(PC1[8 * s + 2], PC1[8 * s + 3]); w_.z = cvt_pk_bf16(PC1[8 * s + 4], PC1[8 * s + 5]); w_.w = cvt_pk_bf16(PC1[8 * s + 6], PC1[8 * s + 7]); pa_[2 + s] = __builtin_bit_cast(bf16x8, w_); } \
          \
        { const unsigned vb_ = (unsigned)(uintptr_t)(lds + OFF_V + buf_ * VB) + (unsigned)((4 * hi + ((lane & 15) >> 2)) * PV + ((((lane >> 4) & 1) * 16 + (lane & 3) * 4) * 2)); \
          __builtin_amdgcn_s_setprio(1); \
          _Pragma("unroll") for (int d0 = 0; d0 < ND0; ++d0) _Pragma("unroll") for (int s = 0; s < 4; ++s) { \
              const s16x4 lo_ = vtr(vb_ + (unsigned)(16 * s * PV + d0 * 64)), hh_ = vtr(vb_ + (unsigned)(16 * s * PV + 8 * PV + d0 * 64)); \
              const bf16x8 vf_ = (bf16x8){lo_[0], lo_[1], lo_[2], lo_[3], hh_[0], hh_[1], hh_[2], hh_[3]}; \
              o[d0] = __builtin_amdgcn_mfma_f32_32x32x16_bf16(pa_[s], vf_, o[d0], 0, 0, 0); } \
          __builtin_amdgcn_s_setprio(0); } \
        float rm_ = 0.f; \
        if constexpr (PIPE) { if ((t) + 1 < NT) ATT_ROWMAX(PN0, PN1, rm_); } \
        if (ATT_SGB && PIPE) { _Pragma("unroll") for (int g_ = 0; g_ < 12 + 4 * ND0; ++g_) { __builtin_amdgcn_sched_group_barrier(0x008, 1, 0); __builtin_amdgcn_sched_group_barrier(0x100, 2, 0); __builtin_amdgcn_sched_group_barrier(0x002, 6, 0); } } \
          \
        if constexpr (PIPE) { if (__any(rm_ > THR)) { const float dl_ = fmaxf(rm_, 0.f); const float f_ = fast_exp2(-dl_); lsum *= f_; \
            _Pragma("unroll") for (int r = 0; r < 16; ++r) { PN0[r] -= dl_; PN1[r] -= dl_; negm[r] -= dl_; } \
            if (hi == 0) scr[r32] = f_; \
            _Pragma("unroll") for (int r = 0; r < 16; ++r) { const float fr_ = scr[crow(r, hi)]; _Pragma("unroll") for (int d0 = 0; d0 < ND0; ++d0) o[d0][r] *= fr_; } } } \
        if ((t) + 2 < NT) ATT_STOREK(buf_); if ((t) + 1 < NT) ATT_STOREV(buf_ ^ 1); \
        __syncthreads(); } while (0)
    if constexpr (PIPE) { for (int t = 0; t < NT; t += 2) { ATT_STEP(pA0, pA1, pB0, pB1, t); ATT_STEP(pB0, pB1, pA0, pA1, t + 1); } }
    else { for (int t = 0; t < NT; ++t) { ATT_STEP(pA0, pA1, pB0, pB1, t); } }
    lsum += __shfl_xor(lsum, 32);
    if (hi == 0) scr[r32] = fast_rcp(lsum);
    LAS bf16_t* ost = (LAS bf16_t*)(lds + OFF_OST) + wid * 32 * DV;
#pragma unroll
    for (int r = 0; r < 16; ++r) { const int q = crow(r, hi); const float ri = scr[q];
#pragma unroll
        for (int d0 = 0; d0 < ND0; ++d0) { const float val = o[d0][r] * ri; ost[q * DV + d0 * 32 + r32] = (bf16_t)(cvt_pk_bf16(val, val) & 0xffffu); } }
    asm volatile("s_waitcnt lgkmcnt(0)" ::: "memory");
    { bf16_t* og = A.o + (size_t)wave_tok0 * LDO + h * DV;
#pragma unroll
      for (int i = 0; i < DV / 16; ++i) { const int id = i * 64 + lane; const int row = id / VCH, ch = id % VCH;
          const u32x4 v = *(const LAS u32x4*)(ost + row * DV + ch * 8); st_g<6>((u32x4*)(og + (size_t)row * LDO + ch * 8), v); } }
    __syncthreads();
#undef ATT_LOADK
#undef ATT_LOADV
#undef ATT_STOREK
#undef ATT_STOREV
#undef ATT_QK
#undef ATT_ROWMAX
#undef ATT_STEP
}
}

namespace att {
#define SBAR_ __builtin_amdgcn_sched_barrier(0)
template <int ABL>
__device__ __forceinline__ void attn_unit_mla3(LAS unsigned char* lds, const AttnArgs& A, const int b, const int h, const int ub) {
    constexpr int DQK = 96, DV = 64;
    constexpr int PK = DQK * 2 + 16, PV = DV * 2 + 64, KB = 64 * PK, VB = 64 * PV;
    constexpr int OFF_K = 0, OFF_V = 2 * KB, OFF_SCR = OFF_V + 2 * VB, OFF_OST = OFF_SCR + 8 * 256, OFF_END = OFF_OST + 8 * 32 * DV * 2;
    static_assert(OFF_END <= LDS_BYTES - 64, "attention LDS");
    constexpr int KCH = DQK / 8, VCH = DV / 8, NKC = 64 * KCH, KPT = 2;
    constexpr int LDQ = 768, LDO = 512, NDS = DQK / 16, ND0 = DV / 32, NT = 64;
#ifndef ATT_THR
#define ATT_THR 8.0f
#endif
    constexpr float THR = ATT_THR;
    int tid_ = threadIdx.x; asm volatile("" : "+v"(tid_));
    const int tid = tid_, lane = tid & 63, r32 = lane & 31, hi = lane >> 5; const int wid = __builtin_amdgcn_readfirstlane(tid >> 6);
    const int wave_tok0 = b * S_ + ub * 256 + wid * 32;
    bf16x8 qf[NDS];
    { const bf16_t* qp = A.q + (size_t)(wave_tok0 + r32) * LDQ + h * DQK + hi * 8;
#pragma unroll
      for (int ds = 0; ds < NDS; ++ds) qf[ds] = ld_g<17>((const bf16x8*)(qp + ds * 16)); }
    const bf16_t* ksrc[KPT]; int kstr[KPT]; unsigned kdst[KPT]; bool kval[KPT];
    const bf16_t* vsrc; unsigned vdst;
    constexpr int KSTRIDE = 64 * 1024;
#pragma unroll
    for (int j = 0; j < KPT; ++j) { const int ci = tid + 512 * j; kval[j] = ci < NKC; const int cic = kval[j] ? ci : 0; const int row = cic / KCH, cc = cic % KCH;
        kdst[j] = (unsigned)(OFF_K + row * PK + cc * 16); kstr[j] = KSTRIDE; const size_t kt = (size_t)b * S_ + row;
        if (cc < 8) ksrc[j] = A.k0 + kt * 1024 + h * 64 + cc * 8; else { ksrc[j] = A.k1 + kt * 32 + (cc - 8) * 8; kstr[j] = 64 * 32; } }
    { const int row = tid / VCH, cc = tid % VCH; vdst = (unsigned)(OFF_V + row * PV + cc * 16); vsrc = A.v + ((size_t)b * S_ + row) * 1024 + h * 64 + cc * 8; }
    u32x4 kst[KPT], vst;
#define M3_LOADK(tile) do { _Pragma("unroll") for (int j = 0; j < KPT; ++j) if (kval[j]) kst[j] = *(const u32x4*)(ksrc[j] + (size_t)(tile) * kstr[j]); } while (0)
#define M3_LOADV(tile) do { vst = *(const u32x4*)(vsrc + (size_t)(tile) * KSTRIDE); } while (0)
#define M3_STOREK(buf) do { _Pragma("unroll") for (int j = 0; j < KPT; ++j) if (kval[j]) *(LAS u32x4*)(lds + kdst[j] + (buf) * KB) = kst[j]; } while (0)
#define M3_STOREV(buf) do { *(LAS u32x4*)(lds + vdst + (buf) * VB) = vst; } while (0)
    LAS float* scr = (LAS float*)(lds + OFF_SCR) + wid * 64;
#define M3_ROWMAX(P0, P1, rm) do { float a_ = max3f(P0[0], P0[1], P1[0]), b_ = max3f(P0[2], P0[3], P1[1]); a_ = max3f(a_, P1[2], P1[3]); \
        _Pragma("unroll") for (int r = 4; r < 16; r += 4) { a_ = max3f(a_, P0[r], P0[r + 1]); b_ = max3f(b_, P0[r + 2], P0[r + 3]); a_ = max3f(a_, P1[r], P1[r + 1]); b_ = max3f(b_, P1[r + 2], P1[r + 3]); } \
        rm = fmaxf(a_, b_); rm = fmaxf(rm, __shfl_xor(rm, 32)); } while (0)
    f32x16 o[ND0], negm;
#pragma unroll
    for (int r = 0; r < 16; ++r) negm[r] = 0.f;
#pragma unroll
    for (int d0 = 0; d0 < ND0; ++d0)
#pragma unroll
        for (int r = 0; r < 16; ++r) o[d0][r] = 0.f;
    float lsum = 0.f;
    f32x16 pA0, pA1, pB0, pB1;
    { u32x4 k1st[KPT];
      M3_LOADK(0); M3_LOADV(0);
#pragma unroll
      for (int j = 0; j < KPT; ++j) if (kval[j]) k1st[j] = *(const u32x4*)(ksrc[j] + (size_t)kstr[j]);
      M3_STOREK(0); M3_STOREV(0);
#pragma unroll
      for (int j = 0; j < KPT; ++j) if (kval[j]) *(LAS u32x4*)(lds + kdst[j] + KB) = k1st[j]; }
    __syncthreads();
    { const LAS unsigned char* kb_ = lds + OFF_K + r32 * PK + hi * 16; pA0 = negm; pA1 = negm;
#pragma unroll
      for (int ds = 0; ds < NDS; ++ds) { const bf16x8 a0_ = *(const LAS bf16x8*)(kb_ + ds * 32), a1_ = *(const LAS bf16x8*)(kb_ + 32 * PK + ds * 32);
          pA0 = __builtin_amdgcn_mfma_f32_32x32x16_bf16(a0_, qf[ds], pA0, 0, 0, 0); pA1 = __builtin_amdgcn_mfma_f32_32x32x16_bf16(a1_, qf[ds], pA1, 0, 0, 0); } }
    { float rm; M3_ROWMAX(pA0, pA1, rm);
#pragma unroll
      for (int r = 0; r < 16; ++r) { pA0[r] -= rm; pA1[r] -= rm; negm[r] = -rm; } }
    __syncthreads();
#define M3_KF(i, kb_) (*(const LAS bf16x8*)((kb_) + ((i) >> 1) * 32 + ((i) & 1) * 32 * PK))
#define M3_EXPAIR(P, r, S, W) do { if (ABL != 1) { P[r] = fast_exp2(P[r]); P[(r) + 1] = fast_exp2(P[(r) + 1]); } sacc_ += P[r] + P[(r) + 1]; pw_[S][W] = cvt_pk_bf16(P[r], P[(r) + 1]); } while (0)
#define M3_EXPK(P, r, S, W) do { if (ABL != 1) { P[r] = fast_exp2(P[r]); P[(r) + 1] = fast_exp2(P[(r) + 1]); } pw_[S][W] = cvt_pk_bf16(P[r], P[(r) + 1]); } while (0)
#define M3_VF(i, vb_, dst) do { const s16x4 lo_ = vtr((vb_) + (unsigned)(16 * ((i) & 3) * PV + ((i) >> 2) * 64)), hh_ = vtr((vb_) + (unsigned)(16 * ((i) & 3) * PV + 8 * PV + ((i) >> 2) * 64)); \
        dst = (bf16x8){lo_[0], lo_[1], lo_[2], lo_[3], hh_[0], hh_[1], hh_[2], hh_[3]}; } while (0)

#define M3_MX3(a, b, c) __builtin_fmaxf(__builtin_fmaxf((a), (b)), (c))
#define M3_STEP(PC0, PC1, PN0, PN1, t, LDK) do { const int buf_ = (t) & 1; \
        if (ABL != 4) { if (LDK) M3_LOADK((t) + 2); M3_LOADV((t) + 1); } \
        const LAS unsigned char* kb_ = lds + OFF_K + (buf_ ^ 1) * KB + r32 * PK + hi * 16; \
        const unsigned vb_ = (unsigned)(uintptr_t)(lds + OFF_V + buf_ * VB) + (unsigned)((4 * hi + ((lane & 15) >> 2)) * PV + ((((lane >> 4) & 1) * 16 + (lane & 3) * 4) * 2)); \
        bf16x8 kf0_ = M3_KF(0, kb_), kf1_ = M3_KF(1, kb_), kf2_ = M3_KF(2, kb_), kf3_ = M3_KF(3, kb_); \
        float sacc_ = 0.f; u32x4 pw_[4]; SBAR_; \
        if (ABL != 3) { PN0 = __builtin_amdgcn_mfma_f32_32x32x16_bf16(kf0_, qf[0], negm, 0, 0, 0); } else { PN0 = negm; PN0[0] += (float)kf0_[0] + (float)qf[0][0]; } kf0_ = M3_KF(4, kb_); M3_EXPK(PC0, 0, 0, 0); M3_EXPK(PC0, 2, 0, 1); asm volatile("" : "+v"(pw_[0])); SBAR_; \
        if (ABL != 3) { PN1 = __builtin_amdgcn_mfma_f32_32x32x16_bf16(kf1_, qf[0], negm, 0, 0, 0); } else { PN1 = negm; PN1[0] += (float)kf1_[0] + (float)qf[0][0]; } kf1_ = M3_KF(5, kb_); M3_EXPK(PC0, 4, 0, 2); asm volatile("" : "+v"(pw_[0])); SBAR_; \
        if (ABL != 3) { PN0 = __builtin_amdgcn_mfma_f32_32x32x16_bf16(kf2_, qf[1], PN0, 0, 0, 0); } else { PN0 = PN0; PN0[0] += (float)kf2_[0] + (float)qf[1][0]; } kf2_ = M3_KF(6, kb_); M3_EXPK(PC0, 6, 0, 3); asm volatile("" : "+v"(pw_[0])); SBAR_; \
        if (ABL != 3) { PN1 = __builtin_amdgcn_mfma_f32_32x32x16_bf16(kf3_, qf[1], PN1, 0, 0, 0); } else { PN1 = PN1; PN1[0] += (float)kf3_[0] + (float)qf[1][0]; } kf3_ = M3_KF(7, kb_); M3_EXPK(PC0, 8, 1, 0); M3_EXPK(PC0, 10, 1, 1); asm volatile("" : "+v"(pw_[1])); SBAR_; \
        if (ABL != 3) { PN0 = __builtin_amdgcn_mfma_f32_32x32x16_bf16(kf0_, qf[2], PN0, 0, 0, 0); } else { PN0 = PN0; PN0[0] += (float)kf0_[0] + (float)qf[2][0]; } kf0_ = M3_KF(8, kb_); M3_EXPK(PC0, 12, 1, 2); asm volatile("" : "+v"(pw_[1])); SBAR_; \
        if (ABL != 3) { PN1 = __builtin_amdgcn_mfma_f32_32x32x16_bf16(kf1_, qf[2], PN1, 0, 0, 0); } else { PN1 = PN1; PN1[0] += (float)kf1_[0] + (float)qf[2][0]; } kf1_ = M3_KF(9, kb_); M3_EXPK(PC0, 14, 1, 3); asm volatile("" : "+v"(pw_[1])); SBAR_; \
        if (ABL != 3) { PN0 = __builtin_amdgcn_mfma_f32_32x32x16_bf16(kf2_, qf[3], PN0, 0, 0, 0); } else { PN0 = PN0; PN0[0] += (float)kf2_[0] + (float)qf[3][0]; } kf2_ = M3_KF(10, kb_); M3_EXPK(PC1, 0, 2, 0); M3_EXPK(PC1, 2, 2, 1); asm volatile("" : "+v"(pw_[2])); SBAR_; \
        if (ABL != 3) { PN1 = __builtin_amdgcn_mfma_f32_32x32x16_bf16(kf3_, qf[3], PN1, 0, 0, 0); } else { PN1 = PN1; PN1[0] += (float)kf3_[0] + (float)qf[3][0]; } kf3_ = M3_KF(11, kb_); M3_EXPK(PC1, 4, 2, 2); asm volatile("" : "+v"(pw_[2])); SBAR_; \
        if (ABL != 3) { PN0 = __builtin_amdgcn_mfma_f32_32x32x16_bf16(kf0_, qf[4], PN0, 0, 0, 0); } else { PN0 = PN0; PN0[0] += (float)kf0_[0] + (float)qf[4][0]; } M3_EXPK(PC1, 6, 2, 3); asm volatile("" : "+v"(pw_[2])); SBAR_; \
        if (ABL != 3) { PN1 = __builtin_amdgcn_mfma_f32_32x32x16_bf16(kf1_, qf[4], PN1, 0, 0, 0); } else { PN1 = PN1; PN1[0] += (float)kf1_[0] + (float)qf[4][0]; } M3_EXPK(PC1, 8, 3, 0); M3_EXPK(PC1, 10, 3, 1); asm volatile("" : "+v"(pw_[3])); SBAR_; \
        if (ABL != 3) { PN0 = __builtin_amdgcn_mfma_f32_32x32x16_bf16(kf2_, qf[5], PN0, 0, 0, 0); } else { PN0 = PN0; PN0[0] += (float)kf2_[0] + (float)qf[5][0]; } M3_EXPK(PC1, 12, 3, 2); asm volatile("" : "+v"(pw_[3])); SBAR_; \
        if (ABL != 3) { PN1 = __builtin_amdgcn_mfma_f32_32x32x16_bf16(kf3_, qf[5], PN1, 0, 0, 0); } else { PN1 = PN1; PN1[0] += (float)kf3_[0] + (float)qf[5][0]; } M3_EXPK(PC1, 14, 3, 3); asm volatile("" : "+v"(pw_[3])); SBAR_; \
        bf16x8 vf0_, vf1_; M3_VF(0, vb_, vf0_); M3_VF(1, vb_, vf1_); \
        float ma_ = M3_MX3(PN0[0], PN0[1], PN1[0]), mb_ = M3_MX3(PN0[2], PN0[3], PN1[1]); SBAR_; \
        if (ABL != 2) { o[0] = __builtin_amdgcn_mfma_f32_32x32x16_bf16(__builtin_bit_cast(bf16x8, pw_[0]), vf0_, o[0], 0, 0, 0); } else { o[0][0] += __builtin_bit_cast(float, pw_[0][0]) + (float)vf0_[0]; } M3_VF(2, vb_, vf0_); sacc_ += (PC0[0] + PC0[1]) + (PC0[2] + PC0[3]); ma_ = M3_MX3(ma_, PN1[2], PN1[3]); ma_ = M3_MX3(ma_, PN0[4], PN0[5]); asm volatile("" : "+v"(ma_), "+v"(mb_), "+v"(sacc_)); SBAR_; \
        if (ABL != 2) { o[0] = __builtin_amdgcn_mfma_f32_32x32x16_bf16(__builtin_bit_cast(bf16x8, pw_[1]), vf1_, o[0], 0, 0, 0); } else { o[0][0] += __builtin_bit_cast(float, pw_[1][0]) + (float)vf1_[0]; } M3_VF(3, vb_, vf1_); sacc_ += (PC0[4] + PC0[5]) + (PC0[6] + PC0[7]); mb_ = M3_MX3(mb_, PN0[6], PN0[7]); ma_ = M3_MX3(ma_, PN1[4], PN1[5]); asm volatile("" : "+v"(ma_), "+v"(mb_), "+v"(sacc_)); SBAR_; \
        if (ABL != 2) { o[0] = __builtin_amdgcn_mfma_f32_32x32x16_bf16(__builtin_bit_cast(bf16x8, pw_[2]), vf0_, o[0], 0, 0, 0); } else { o[0][0] += __builtin_bit_cast(float, pw_[2][0]) + (float)vf0_[0]; } M3_VF(4, vb_, vf0_); sacc_ += (PC0[8] + PC0[9]) + (PC0[10] + PC0[11]); mb_ = M3_MX3(mb_, PN1[6], PN1[7]); ma_ = M3_MX3(ma_, PN0[8], PN0[9]); asm volatile("" : "+v"(ma_), "+v"(mb_), "+v"(sacc_)); SBAR_; \
        if (ABL != 2) { o[0] = __builtin_amdgcn_mfma_f32_32x32x16_bf16(__builtin_bit_cast(bf16x8, pw_[3]), vf1_, o[0], 0, 0, 0); } else { o[0][0] += __builtin_bit_cast(float, pw_[3][0]) + (float)vf1_[0]; } M3_VF(5, vb_, vf1_); sacc_ += (PC0[12] + PC0[13]) + (PC0[14] + PC0[15]); mb_ = M3_MX3(mb_, PN0[10], PN0[11]); ma_ = M3_MX3(ma_, PN1[8], PN1[9]); asm volatile("" : "+v"(ma_), "+v"(mb_), "+v"(sacc_)); SBAR_; \
        if (ABL != 2) { o[1] = __builtin_amdgcn_mfma_f32_32x32x16_bf16(__builtin_bit_cast(bf16x8, pw_[0]), vf0_, o[1], 0, 0, 0); } else { o[1][0] += __builtin_bit_cast(float, pw_[0][0]) + (float)vf0_[0]; } M3_VF(6, vb_, vf0_); sacc_ += (PC1[0] + PC1[1]) + (PC1[2] + PC1[3]); mb_ = M3_MX3(mb_, PN1[10], PN1[11]); ma_ = M3_MX3(ma_, PN0[12], PN0[13]); asm volatile("" : "+v"(ma_), "+v"(mb_), "+v"(sacc_)); SBAR_; \
        if (ABL != 2) { o[1] = __builtin_amdgcn_mfma_f32_32x32x16_bf16(__builtin_bit_cast(bf16x8, pw_[1]), vf1_, o[1], 0, 0, 0); } else { o[1][0] += __builtin_bit_cast(float, pw_[1][0]) + (float)vf1_[0]; } M3_VF(7, vb_, vf1_); sacc_ += (PC1[4] + PC1[5]) + (PC1[6] + PC1[7]); mb_ = M3_MX3(mb_, PN0[14], PN0[15]); asm volatile("" : "+v"(ma_), "+v"(mb_), "+v"(sacc_)); SBAR_; \
        if (ABL != 2) { o[1] = __builtin_amdgcn_mfma_f32_32x32x16_bf16(__builtin_bit_cast(bf16x8, pw_[2]), vf0_, o[1], 0, 0, 0); } else { o[1][0] += __builtin_bit_cast(float, pw_[2][0]) + (float)vf0_[0]; } sacc_ += (PC1[8] + PC1[9]) + (PC1[10] + PC1[11]); ma_ = M3_MX3(ma_, PN1[12], PN1[13]); asm volatile("" : "+v"(ma_), "+v"(mb_), "+v"(sacc_)); SBAR_; \
        if (ABL != 2) { o[1] = __builtin_amdgcn_mfma_f32_32x32x16_bf16(__builtin_bit_cast(bf16x8, pw_[3]), vf1_, o[1], 0, 0, 0); } else { o[1][0] += __builtin_bit_cast(float, pw_[3][0]) + (float)vf1_[0]; } sacc_ += (PC1[12] + PC1[13]) + (PC1[14] + PC1[15]); mb_ = M3_MX3(mb_, PN1[14], PN1[15]); asm volatile("" : "+v"(ma_), "+v"(mb_), "+v"(sacc_)); SBAR_; \
        lsum += sacc_; \
        float rm_ = fmaxf(ma_, mb_); rm_ = fmaxf(rm_, __shfl_xor(rm_, 32)); \
        if (__any(rm_ > THR)) { const float dl_ = fmaxf(rm_, 0.f); const float f_ = fast_exp2(-dl_); lsum *= f_; \
            _Pragma("unroll") for (int r = 0; r < 16; ++r) { PN0[r] -= dl_; PN1[r] -= dl_; negm[r] -= dl_; } \
            if (hi == 0) scr[r32] = f_; \
            _Pragma("unroll") for (int r = 0; r < 16; ++r) { const float fr_ = scr[crow(r, hi)]; _Pragma("unroll") for (int d0 = 0; d0 < ND0; ++d0) o[d0][r] *= fr_; } } \
        if (ABL != 4) { if (LDK) M3_STOREK(buf_); M3_STOREV(buf_ ^ 1); } \
        if (ABL != 5) __syncthreads(); } while (0)
#define M3_TAIL(PC0, PC1, t) do { const int buf_ = (t) & 1; \
        float sacc_ = 0.f; u32x4 pw_[4]; \
        _Pragma("unroll") for (int q = 0; q < 8; ++q) { M3_EXPAIR(PC0, 2 * q, q >> 2, q & 3); } \
        _Pragma("unroll") for (int q = 0; q < 8; ++q) { M3_EXPAIR(PC1, 2 * q, 2 + (q >> 2), q & 3); } \
        lsum += sacc_; \
        const unsigned vb_ = (unsigned)(uintptr_t)(lds + OFF_V + buf_ * VB) + (unsigned)((4 * hi + ((lane & 15) >> 2)) * PV + ((((lane >> 4) & 1) * 16 + (lane & 3) * 4) * 2)); \
        _Pragma("unroll") for (int i = 0; i < 8; ++i) { bf16x8 vf_; M3_VF(i, vb_, vf_); o[i >> 2] = __builtin_amdgcn_mfma_f32_32x32x16_bf16(__builtin_bit_cast(bf16x8, pw_[i & 3]), vf_, o[i >> 2], 0, 0, 0); } \
        __syncthreads(); } while (0)
    for (int t = 0; t < NT - 2; t += 2) { M3_STEP(pA0, pA1, pB0, pB1, t, 1); M3_STEP(pB0, pB1, pA0, pA1, t + 1, 1); }
    M3_STEP(pA0, pA1, pB0, pB1, NT - 2, 0);
    M3_TAIL(pB0, pB1, NT - 1);
    lsum += __shfl_xor(lsum, 32);
    if (hi == 0) scr[r32] = fast_rcp(lsum);
    LAS bf16_t* ost = (LAS bf16_t*)(lds + OFF_OST) + wid * 32 * DV;
#pragma unroll
    for (int r = 0; r < 16; ++r) { const int q = crow(r, hi); const float ri = scr[q];
#pragma unroll
        for (int d0 = 0; d0 < ND0; ++d0) { const float val = o[d0][r] * ri; ost[q * DV + d0 * 32 + r32] = (bf16_t)(cvt_pk_bf16(val, val) & 0xffffu); } }
    asm volatile("s_waitcnt lgkmcnt(0)" ::: "memory");
    { bf16_t* og = A.o + (size_t)wave_tok0 * LDO + h * DV;
#pragma unroll
      for (int i = 0; i < DV / 16; ++i) { const int id = i * 64 + lane; const int row = id / VCH, ch = id % VCH;
          const u32x4 v = *(const LAS u32x4*)(ost + row * DV + ch * 8); st_g<6>((u32x4*)(og + (size_t)row * LDO + ch * 8), v); } }
    __syncthreads();
#undef M3_LOADK
#undef M3_LOADV
#undef M3_STOREK
#undef M3_STOREV
#undef M3_ROWMAX
#undef M3_KF
#undef M3_EXPAIR
#undef M3_EXPK
#undef M3_VF
#undef M3_STEP
#undef M3_TAIL
#undef M3_MX3
}
template <int ABL>
__device__ __forceinline__ void attn_unit_mla4(LAS unsigned char* lds, const AttnArgs& A, const int b, const int h, const int ub) {
    constexpr int DQK = 96, DV = 64;
    constexpr int PK = DQK * 2 + 16, PV = DV * 2 + 64, KB = 64 * PK, VB = 64 * PV;
    constexpr int OFF_K = 0, OFF_V = 2 * KB, OFF_SCR = OFF_V + 3 * VB, OFF_OST = OFF_SCR + 8 * 256, OFF_END = OFF_OST + 8 * 32 * DV * 2;
    static_assert(OFF_END <= LDS_BYTES - 64, "attention LDS");
    constexpr int KCH = DQK / 8, VCH = DV / 8, NKC = 64 * KCH, KPT = 2;
    constexpr int LDQ = 768, LDO = 512, NDS = DQK / 16, ND0 = DV / 32, NT = 64;
#ifndef ATT_THR
#define ATT_THR 8.0f
#endif
    constexpr float THR = ATT_THR;
    int tid_ = threadIdx.x; asm volatile("" : "+v"(tid_));
    const int tid = tid_, lane = tid & 63, r32 = lane & 31, hi = lane >> 5; const int wid = __builtin_amdgcn_readfirstlane(tid >> 6);
    const int wave_tok0 = b * S_ + ub * 256 + wid * 32;
    bf16x8 qf[NDS];
    { const bf16_t* qp = A.q + (size_t)(wave_tok0 + r32) * LDQ + h * DQK + hi * 8;
#pragma unroll
      for (int ds = 0; ds < NDS; ++ds) qf[ds] = ld_g<17>((const bf16x8*)(qp + ds * 16)); }
    const bf16_t* ksrc[KPT]; int kstr[KPT]; unsigned kdst[KPT]; bool kval[KPT];
    const bf16_t* vsrc; unsigned vdst;
    constexpr int KSTRIDE = 64 * 1024;
#pragma unroll
    for (int j = 0; j < KPT; ++j) { const int ci = tid + 512 * j; kval[j] = ci < NKC; const int cic = kval[j] ? ci : 0; const int row = cic / KCH, cc = cic % KCH;
        kdst[j] = (unsigned)(OFF_K + row * PK + cc * 16); kstr[j] = KSTRIDE; const size_t kt = (size_t)b * S_ + row;
        if (cc < 8) ksrc[j] = A.k0 + kt * 1024 + h * 64 + cc * 8; else { ksrc[j] = A.k1 + kt * 32 + (cc - 8) * 8; kstr[j] = 64 * 32; } }
    { const int row = tid / VCH, cc = tid % VCH; vdst = (unsigned)(OFF_V + row * PV + cc * 16); vsrc = A.v + ((size_t)b * S_ + row) * 1024 + h * 64 + cc * 8; }
    u32x4 kst[KPT], vst;
#define M3_LOADK(tile) do { _Pragma("unroll") for (int j = 0; j < KPT; ++j) if (kval[j]) kst[j] = *(const u32x4*)(ksrc[j] + (size_t)(tile) * kstr[j]); } while (0)
#define M3_LOADV(tile) do { vst = *(const u32x4*)(vsrc + (size_t)(tile) * KSTRIDE); } while (0)
#define M3_STOREK(buf) do { _Pragma("unroll") for (int j = 0; j < KPT; ++j) if (kval[j]) *(LAS u32x4*)(lds + kdst[j] + (buf) * KB) = kst[j]; } while (0)
#define M3_STOREV(boff) do { *(LAS u32x4*)(lds + vdst + (boff)) = vst; } while (0)
    LAS float* scr = (LAS float*)(lds + OFF_SCR) + wid * 64;
#define M3_ROWMAX(P0, P1, rm) do { float a_ = max3f(P0[0], P0[1], P1[0]), b_ = max3f(P0[2], P0[3], P1[1]); a_ = max3f(a_, P1[2], P1[3]); \
        _Pragma("unroll") for (int r = 4; r < 16; r += 4) { a_ = max3f(a_, P0[r], P0[r + 1]); b_ = max3f(b_, P0[r + 2], P0[r + 3]); a_ = max3f(a_, P1[r], P1[r + 1]); b_ = max3f(b_, P1[r + 2], P1[r + 3]); } \
        rm = fmaxf(a_, b_); rm = fmaxf(rm, __shfl_xor(rm, 32)); } while (0)
    f32x16 o[ND0], negm;
#pragma unroll
    for (int r = 0; r < 16; ++r) negm[r] = 0.f;
#pragma unroll
    for (int d0 = 0; d0 < ND0; ++d0)
#pragma unroll
        for (int r = 0; r < 16; ++r) o[d0][r] = 0.f;
    float lsum = 0.f;
    f32x16 pA0, pA1, pB0, pB1;
    { u32x4 k1st[KPT];
      M3_LOADK(0); M3_LOADV(0);
#pragma unroll
      for (int j = 0; j < KPT; ++j) if (kval[j]) k1st[j] = *(const u32x4*)(ksrc[j] + (size_t)kstr[j]);
      M3_STOREK(0); M3_STOREV(0);
#pragma unroll
      for (int j = 0; j < KPT; ++j) if (kval[j]) *(LAS u32x4*)(lds + kdst[j] + KB) = k1st[j]; }
    __syncthreads();
    { const LAS unsigned char* kb_ = lds + OFF_K + r32 * PK + hi * 16; pA0 = negm; pA1 = negm;
#pragma unroll
      for (int ds = 0; ds < NDS; ++ds) { const bf16x8 a0_ = *(const LAS bf16x8*)(kb_ + ds * 32), a1_ = *(const LAS bf16x8*)(kb_ + 32 * PK + ds * 32);
          pA0 = __builtin_amdgcn_mfma_f32_32x32x16_bf16(a0_, qf[ds], pA0, 0, 0, 0); pA1 = __builtin_amdgcn_mfma_f32_32x32x16_bf16(a1_, qf[ds], pA1, 0, 0, 0); } }
    { float rm; M3_ROWMAX(pA0, pA1, rm);
#pragma unroll
      for (int r = 0; r < 16; ++r) { pA0[r] -= rm; pA1[r] -= rm; negm[r] = -rm; } }
    __syncthreads();
    bf16x8 kf0_, kf1_, kf2_, kf3_;
    { const LAS unsigned char* kb1_ = lds + OFF_K + KB + r32 * PK + hi * 16; kf0_ = *(const LAS bf16x8*)(kb1_); kf1_ = *(const LAS bf16x8*)(kb1_ + 32 * PK); kf2_ = *(const LAS bf16x8*)(kb1_ + 32); kf3_ = *(const LAS bf16x8*)(kb1_ + 32 + 32 * PK); }
    int vc_ = 0, vn_ = VB, vf3_ = 2 * VB;
#define M3_KF(i, kb_) (*(const LAS bf16x8*)((kb_) + ((i) >> 1) * 32 + ((i) & 1) * 32 * PK))
#define M3_EXPAIR(P, r, S, W) do { if (ABL != 1) { P[r] = fast_exp2(P[r]); P[(r) + 1] = fast_exp2(P[(r) + 1]); } sacc_ += P[r] + P[(r) + 1]; pw_[S][W] = cvt_pk_bf16(P[r], P[(r) + 1]); } while (0)
#define M3_EXPK(P, r, S, W) do { if (ABL != 1) { P[r] = fast_exp2(P[r]); P[(r) + 1] = fast_exp2(P[(r) + 1]); } pw_[S][W] = cvt_pk_bf16(P[r], P[(r) + 1]); } while (0)
#define M3_VF(i, vb_, dst) do { const s16x4 lo_ = vtr((vb_) + (unsigned)(16 * ((i) & 3) * PV + ((i) >> 2) * 64)), hh_ = vtr((vb_) + (unsigned)(16 * ((i) & 3) * PV + 8 * PV + ((i) >> 2) * 64)); \
        dst = (bf16x8){lo_[0], lo_[1], lo_[2], lo_[3], hh_[0], hh_[1], hh_[2], hh_[3]}; } while (0)

#define M3_MX3(a, b, c) __builtin_fmaxf(__builtin_fmaxf((a), (b)), (c))
#define M3_STEP(PC0, PC1, PN0, PN1, t, LDK) do { const int buf_ = (t) & 1; \
        if (ABL != 4) { if (LDK) M3_LOADK((t) + 2); M3_LOADV((t) + 1); } \
        const LAS unsigned char* kb_ = lds + OFF_K + (buf_ ^ 1) * KB + r32 * PK + hi * 16; \
        const unsigned vb_ = (unsigned)(uintptr_t)(lds + OFF_V + vc_) + (unsigned)((4 * hi + ((lane & 15) >> 2)) * PV + ((((lane >> 4) & 1) * 16 + (lane & 3) * 4) * 2)); \
        float sacc_ = 0.f; u32x4 pw_[4]; SBAR_; \
        if (ABL != 3) { PN0 = __builtin_amdgcn_mfma_f32_32x32x16_bf16(kf0_, qf[0], negm, 0, 0, 0); } else { PN0 = negm; PN0[0] += (float)kf0_[0] + (float)qf[0][0]; } kf0_ = M3_KF(4, kb_); M3_EXPK(PC0, 0, 0, 0); M3_EXPK(PC0, 2, 0, 1); asm volatile("" : "+v"(pw_[0])); SBAR_; \
        if (ABL != 3) { PN1 = __builtin_amdgcn_mfma_f32_32x32x16_bf16(kf1_, qf[0], negm, 0, 0, 0); } else { PN1 = negm; PN1[0] += (float)kf1_[0] + (float)qf[0][0]; } kf1_ = M3_KF(5, kb_); M3_EXPK(PC0, 4, 0, 2); asm volatile("" : "+v"(pw_[0])); SBAR_; \
        if (ABL != 3) { PN0 = __builtin_amdgcn_mfma_f32_32x32x16_bf16(kf2_, qf[1], PN0, 0, 0, 0); } else { PN0 = PN0; PN0[0] += (float)kf2_[0] + (float)qf[1][0]; } kf2_ = M3_KF(6, kb_); M3_EXPK(PC0, 6, 0, 3); asm volatile("" : "+v"(pw_[0])); SBAR_; \
        if (ABL != 3) { PN1 = __builtin_amdgcn_mfma_f32_32x32x16_bf16(kf3_, qf[1], PN1, 0, 0, 0); } else { PN1 = PN1; PN1[0] += (float)kf3_[0] + (float)qf[1][0]; } kf3_ = M3_KF(7, kb_); M3_EXPK(PC0, 8, 1, 0); M3_EXPK(PC0, 10, 1, 1); asm volatile("" : "+v"(pw_[1])); SBAR_; \
        if (ABL != 3) { PN0 = __builtin_amdgcn_mfma_f32_32x32x16_bf16(kf0_, qf[2], PN0, 0, 0, 0); } else { PN0 = PN0; PN0[0] += (float)kf0_[0] + (float)qf[2][0]; } kf0_ = M3_KF(8, kb_); M3_EXPK(PC0, 12, 1, 2); asm volatile("" : "+v"(pw_[1])); SBAR_; \
        if (ABL != 3) { PN1 = __builtin_amdgcn_mfma_f32_32x32x16_bf16(kf1_, qf[2], PN1, 0, 0, 0); } else { PN1 = PN1; PN1[0] += (float)kf1_[0] + (float)qf[2][0]; } kf1_ = M3_KF(9, kb_); M3_EXPK(PC0, 14, 1, 3); asm volatile("" : "+v"(pw_[1])); SBAR_; \
        if (ABL != 3) { PN0 = __builtin_amdgcn_mfma_f32_32x32x16_bf16(kf2_, qf[3], PN0, 0, 0, 0); } else { PN0 = PN0; PN0[0] += (float)kf2_[0] + (float)qf[3][0]; } kf2_ = M3_KF(10, kb_); M3_EXPK(PC1, 0, 2, 0); M3_EXPK(PC1, 2, 2, 1); asm volatile("" : "+v"(pw_[2])); SBAR_; \
        if (ABL != 3) { PN1 = __builtin_amdgcn_mfma_f32_32x32x16_bf16(kf3_, qf[3], PN1, 0, 0, 0); } else { PN1 = PN1; PN1[0] += (float)kf3_[0] + (float)qf[3][0]; } kf3_ = M3_KF(11, kb_); M3_EXPK(PC1, 4, 2, 2); asm volatile("" : "+v"(pw_[2])); SBAR_; \
        if (ABL != 3) { PN0 = __builtin_amdgcn_mfma_f32_32x32x16_bf16(kf0_, qf[4], PN0, 0, 0, 0); } else { PN0 = PN0; PN0[0] += (float)kf0_[0] + (float)qf[4][0]; } M3_EXPK(PC1, 6, 2, 3); asm volatile("" : "+v"(pw_[2])); SBAR_; \
        if (ABL != 3) { PN1 = __builtin_amdgcn_mfma_f32_32x32x16_bf16(kf1_, qf[4], PN1, 0, 0, 0); } else { PN1 = PN1; PN1[0] += (float)kf1_[0] + (float)qf[4][0]; } M3_EXPK(PC1, 8, 3, 0); M3_EXPK(PC1, 10, 3, 1); asm volatile("" : "+v"(pw_[3])); SBAR_; \
        if (ABL != 3) { PN0 = __builtin_amdgcn_mfma_f32_32x32x16_bf16(kf2_, qf[5], PN0, 0, 0, 0); } else { PN0 = PN0; PN0[0] += (float)kf2_[0] + (float)qf[5][0]; } M3_EXPK(PC1, 12, 3, 2); asm volatile("" : "+v"(pw_[3])); SBAR_; \
        if (ABL != 3) { PN1 = __builtin_amdgcn_mfma_f32_32x32x16_bf16(kf3_, qf[5], PN1, 0, 0, 0); } else { PN1 = PN1; PN1[0] += (float)kf3_[0] + (float)qf[5][0]; } M3_EXPK(PC1, 14, 3, 3); asm volatile("" : "+v"(pw_[3])); SBAR_; \
        bf16x8 vf0_, vf1_; M3_VF(0, vb_, vf0_); M3_VF(1, vb_, vf1_); \
        float ma_ = M3_MX3(PN0[0], PN0[1], PN1[0]), mb_ = M3_MX3(PN0[2], PN0[3], PN1[1]); SBAR_; \
        if (ABL != 2) { o[0] = __builtin_amdgcn_mfma_f32_32x32x16_bf16(__builtin_bit_cast(bf16x8, pw_[0]), vf0_, o[0], 0, 0, 0); } else { o[0][0] += __builtin_bit_cast(float, pw_[0][0]) + (float)vf0_[0]; } M3_VF(2, vb_, vf0_); sacc_ += (PC0[0] + PC0[1]) + (PC0[2] + PC0[3]); ma_ = M3_MX3(ma_, PN1[2], PN1[3]); ma_ = M3_MX3(ma_, PN0[4], PN0[5]); asm volatile("" : "+v"(ma_), "+v"(mb_), "+v"(sacc_)); SBAR_; \
        if (ABL != 2) { o[0] = __builtin_amdgcn_mfma_f32_32x32x16_bf16(__builtin_bit_cast(bf16x8, pw_[1]), vf1_, o[0], 0, 0, 0); } else { o[0][0] += __builtin_bit_cast(float, pw_[1][0]) + (float)vf1_[0]; } M3_VF(3, vb_, vf1_); sacc_ += (PC0[4] + PC0[5]) + (PC0[6] + PC0[7]); mb_ = M3_MX3(mb_, PN0[6], PN0[7]); ma_ = M3_MX3(ma_, PN1[4], PN1[5]); asm volatile("" : "+v"(ma_), "+v"(mb_), "+v"(sacc_)); SBAR_; \
        if (ABL != 2) { o[0] = __builtin_amdgcn_mfma_f32_32x32x16_bf16(__builtin_bit_cast(bf16x8, pw_[2]), vf0_, o[0], 0, 0, 0); } else { o[0][0] += __builtin_bit_cast(float, pw_[2][0]) + (float)vf0_[0]; } M3_VF(4, vb_, vf0_); sacc_ += (PC0[8] + PC0[9]) + (PC0[10] + PC0[11]); mb_ = M3_MX3(mb_, PN1[6], PN1[7]); ma_ = M3_MX3(ma_, PN0[8], PN0[9]); asm volatile("" : "+v"(ma_), "+v"(mb_), "+v"(sacc_)); SBAR_; \
        if (ABL != 2) { o[0] = __builtin_amdgcn_mfma_f32_32x32x16_bf16(__builtin_bit_cast(bf16x8, pw_[3]), vf1_, o[0], 0, 0, 0); } else { o[0][0] += __builtin_bit_cast(float, pw_[3][0]) + (float)vf1_[0]; } M3_VF(5, vb_, vf1_); sacc_ += (PC0[12] + PC0[13]) + (PC0[14] + PC0[15]); mb_ = M3_MX3(mb_, PN0[10], PN0[11]); ma_ = M3_MX3(ma_, PN1[8], PN1[9]); asm volatile("" : "+v"(ma_), "+v"(mb_), "+v"(sacc_)); SBAR_; \
        if (ABL != 4) { if (LDK) M3_STOREK(buf_); M3_STOREV(vn_); } \
        if (ABL != 5) { asm volatile("s_waitcnt lgkmcnt(0)\n\ts_barrier" ::: "memory"); } SBAR_; \
        if (ABL != 2) { o[1] = __builtin_amdgcn_mfma_f32_32x32x16_bf16(__builtin_bit_cast(bf16x8, pw_[0]), vf0_, o[1], 0, 0, 0); } else { o[1][0] += __builtin_bit_cast(float, pw_[0][0]) + (float)vf0_[0]; } M3_VF(6, vb_, vf0_); sacc_ += (PC1[0] + PC1[1]) + (PC1[2] + PC1[3]); mb_ = M3_MX3(mb_, PN1[10], PN1[11]); ma_ = M3_MX3(ma_, PN0[12], PN0[13]); asm volatile("" : "+v"(ma_), "+v"(mb_), "+v"(sacc_)); SBAR_; \
        if (ABL != 2) { o[1] = __builtin_amdgcn_mfma_f32_32x32x16_bf16(__builtin_bit_cast(bf16x8, pw_[1]), vf1_, o[1], 0, 0, 0); } else { o[1][0] += __builtin_bit_cast(float, pw_[1][0]) + (float)vf1_[0]; } M3_VF(7, vb_, vf1_); sacc_ += (PC1[4] + PC1[5]) + (PC1[6] + PC1[7]); mb_ = M3_MX3(mb_, PN0[14], PN0[15]); asm volatile("" : "+v"(ma_), "+v"(mb_), "+v"(sacc_)); SBAR_; \
        if (ABL != 2) { o[1] = __builtin_amdgcn_mfma_f32_32x32x16_bf16(__builtin_bit_cast(bf16x8, pw_[2]), vf0_, o[1], 0, 0, 0); } else { o[1][0] += __builtin_bit_cast(float, pw_[2][0]) + (float)vf0_[0]; } sacc_ += (PC1[8] + PC1[9]) + (PC1[10] + PC1[11]); ma_ = M3_MX3(ma_, PN1[12], PN1[13]); asm volatile("" : "+v"(ma_), "+v"(mb_), "+v"(sacc_)); SBAR_; \
        if (ABL != 2) { o[1] = __builtin_amdgcn_mfma_f32_32x32x16_bf16(__builtin_bit_cast(bf16x8, pw_[3]), vf1_, o[1], 0, 0, 0); } else { o[1][0] += __builtin_bit_cast(float, pw_[3][0]) + (float)vf1_[0]; } sacc_ += (PC1[12] + PC1[13]) + (PC1[14] + PC1[15]); mb_ = M3_MX3(mb_, PN1[14], PN1[15]); asm volatile("" : "+v"(ma_), "+v"(mb_), "+v"(sacc_)); SBAR_; \
        lsum += sacc_; \
        { const LAS unsigned char* kbn_ = lds + OFF_K + buf_ * KB + r32 * PK + hi * 16; kf0_ = M3_KF(0, kbn_); kf1_ = M3_KF(1, kbn_); kf2_ = M3_KF(2, kbn_); kf3_ = M3_KF(3, kbn_); } \
        { const int v_ = vc_; vc_ = vn_; vn_ = vf3_; vf3_ = v_; } \
        float rm_ = fmaxf(ma_, mb_); rm_ = fmaxf(rm_, __shfl_xor(rm_, 32)); \
        if (__any(rm_ > THR)) { const float dl_ = fmaxf(rm_, 0.f); const float f_ = fast_exp2(-dl_); lsum *= f_; \
            _Pragma("unroll") for (int r = 0; r < 16; ++r) { PN0[r] -= dl_; PN1[r] -= dl_; negm[r] -= dl_; } \
            if (hi == 0) scr[r32] = f_; \
            _Pragma("unroll") for (int r = 0; r < 16; ++r) { const float fr_ = scr[crow(r, hi)]; _Pragma("unroll") for (int d0 = 0; d0 < ND0; ++d0) o[d0][r] *= fr_; } } \
        } while (0)
#define M3_TAIL(PC0, PC1, t) do { const int buf_ = (t) & 1; \
        float sacc_ = 0.f; u32x4 pw_[4]; \
        _Pragma("unroll") for (int q = 0; q < 8; ++q) { M3_EXPAIR(PC0, 2 * q, q >> 2, q & 3); } \
        _Pragma("unroll") for (int q = 0; q < 8; ++q) { M3_EXPAIR(PC1, 2 * q, 2 + (q >> 2), q & 3); } \
        lsum += sacc_; \
        const unsigned vb_ = (unsigned)(uintptr_t)(lds + OFF_V + vc_) + (unsigned)((4 * hi + ((lane & 15) >> 2)) * PV + ((((lane >> 4) & 1) * 16 + (lane & 3) * 4) * 2)); \
        _Pragma("unroll") for (int i = 0; i < 8; ++i) { bf16x8 vf_; M3_VF(i, vb_, vf_); o[i >> 2] = __builtin_amdgcn_mfma_f32_32x32x16_bf16(__builtin_bit_cast(bf16x8, pw_[i & 3]), vf_, o[i >> 2], 0, 0, 0); } \
        __syncthreads(); } while (0)
    for (int t = 0; t < NT - 2; t += 2) { M3_STEP(pA0, pA1, pB0, pB1, t, 1); M3_STEP(pB0, pB1, pA0, pA1, t + 1, 1); }
    M3_STEP(pA0, pA1, pB0, pB1, NT - 2, 0);
    M3_TAIL(pB0, pB1, NT - 1);
    lsum += __shfl_xor(lsum, 32);
    if (hi == 0) scr[r32] = fast_rcp(lsum);
    LAS bf16_t* ost = (LAS bf16_t*)(lds + OFF_OST) + wid * 32 * DV;
#pragma unroll
    for (int r = 0; r < 16; ++r) { const int q = crow(r, hi); const float ri = scr[q];
#pragma unroll
        for (int d0 = 0; d0 < ND0; ++d0) { const float val = o[d0][r] * ri; ost[q * DV + d0 * 32 + r32] = (bf16_t)(cvt_pk_bf16(val, val) & 0xffffu); } }
    asm volatile("s_waitcnt lgkmcnt(0)" ::: "memory");
    { bf16_t* og = A.o + (size_t)wave_tok0 * LDO + h * DV;
#pragma unroll
      for (int i = 0; i < DV / 16; ++i) { const int id = i * 64 + lane; const int row = id / VCH, ch = id % VCH;
          const u32x4 v = *(const LAS u32x4*)(ost + row * DV + ch * 8); st_g<6>((u32x4*)(og + (size_t)row * LDO + ch * 8), v); } }
    __syncthreads();
#undef M3_LOADK
#undef M3_LOADV
#undef M3_STOREK
#undef M3_STOREV
#undef M3_ROWMAX
#undef M3_KF
#undef M3_EXPAIR
#undef M3_EXPK
#undef M3_VF
#undef M3_STEP
#undef M3_TAIL
#undef M3_MX3
}
#undef SBAR_
}

namespace att {
__device__ __forceinline__ void attn_unit_mla16(LAS unsigned char* lds, const AttnArgs& A, const int b, const int h, const int ub) {
    constexpr int DQK = 96, DV = 64, KROW = 256, PV = 160, KB = 64 * KROW, VB = 64 * PV;
    constexpr int OFF_K = 0, OFF_V = 2 * KB, OFF_OST = OFF_V + 2 * VB, OFF_END = OFF_OST + 8 * 32 * DV * 2;
    static_assert(OFF_END <= LDS_BYTES - 64, "attention LDS");
    constexpr int KCH = 12, VCH = 8, NKC = 64 * KCH, KPT = 2, LDQ = 768, LDO = 512, NT = 64;
    constexpr float THR = 8.0f;
    int tid_ = threadIdx.x; asm volatile("" : "+v"(tid_));
    const int tid = tid_, lane = tid & 63, lj = lane & 15, fq = lane >> 4; const int wid = __builtin_amdgcn_readfirstlane(tid >> 6);
    const int wave_tok0 = b * S_ + ub * 256 + wid * 32;
    bf16x8 qf[2][3];
#pragma unroll
    for (int g = 0; g < 2; ++g) { const bf16_t* qp = A.q + (size_t)(wave_tok0 + 16 * g + lj) * LDQ + h * DQK + fq * 8;
#pragma unroll
        for (int ds = 0; ds < 3; ++ds) qf[g][ds] = *(const bf16x8*)(qp + ds * 32); }
    const bf16_t* ksrc[KPT]; int kstr[KPT]; unsigned kdst[KPT]; bool kval[KPT];
    const bf16_t* vsrc; unsigned vdst;
    constexpr int KSTRIDE = 64 * 1024;
#pragma unroll
    for (int j = 0; j < KPT; ++j) { const int ci = tid + 512 * j; kval[j] = ci < NKC; const int cic = kval[j] ? ci : 0; const int row = cic / KCH, cc = cic % KCH;
        kdst[j] = (unsigned)(OFF_K + row * KROW + ((cc ^ (row & 15)) << 4)); kstr[j] = KSTRIDE; const size_t kt = (size_t)b * S_ + row;
        if (cc < 8) ksrc[j] = A.k0 + kt * 1024 + h * 64 + cc * 8; else { ksrc[j] = A.k1 + kt * 32 + (cc - 8) * 8; kstr[j] = 64 * 32; } }
    { const int row = tid / VCH, cc = tid % VCH; vdst = (unsigned)(OFF_V + row * PV + cc * 16); vsrc = A.v + ((size_t)b * S_ + row) * 1024 + h * 64 + cc * 8; }
    u32x4 kst[KPT], vst;
#define M16_LOADK(tile) do { _Pragma("unroll") for (int j = 0; j < KPT; ++j) if (kval[j]) kst[j] = *(const u32x4*)(ksrc[j] + (size_t)(tile) * kstr[j]); } while (0)
#define M16_LOADV(tile) do { vst = *(const u32x4*)(vsrc + (size_t)(tile) * KSTRIDE); } while (0)
#define M16_STOREK(buf) do { _Pragma("unroll") for (int j = 0; j < KPT; ++j) if (kval[j]) *(LAS u32x4*)(lds + kdst[j] + (buf) * KB) = kst[j]; } while (0)
#define M16_STOREV(buf) do { *(LAS u32x4*)(lds + vdst + (buf) * VB) = vst; } while (0)
#define M16_QK(SN, buf) do { const LAS unsigned char* kb_ = lds + OFF_K + (buf) * KB + lj * KROW; \
        _Pragma("unroll") for (int kt = 0; kt < 4; ++kt) _Pragma("unroll") for (int ds = 0; ds < 3; ++ds) { const bf16x8 a_ = *(const LAS bf16x8*)(kb_ + kt * 16 * KROW + (((4 * ds + fq) ^ lj) << 4)); \
            _Pragma("unroll") for (int g = 0; g < 2; ++g) SN[kt][g] = __builtin_amdgcn_mfma_f32_16x16x32_bf16(a_, qf[g][ds], ds == 0 ? negm[g] : SN[kt][g], 0, 0, 0); } } while (0)
#define M16_ROWMAX(SX, g, rm) do { float a_ = max3f(SX[0][g][0], SX[0][g][1], SX[0][g][2]), b_ = max3f(SX[0][g][3], SX[1][g][0], SX[1][g][1]); \
        a_ = max3f(a_, SX[1][g][2], SX[1][g][3]); b_ = max3f(b_, SX[2][g][0], SX[2][g][1]); a_ = max3f(a_, SX[2][g][2], SX[2][g][3]); b_ = max3f(b_, SX[3][g][0], SX[3][g][1]); a_ = max3f(a_, SX[3][g][2], SX[3][g][3]); \
        rm = fmaxf(a_, b_); rm = fmaxf(rm, __shfl_xor(rm, 16)); rm = fmaxf(rm, __shfl_xor(rm, 32)); } while (0)
    f32x4 o[2][4], negm[2]; float lsum[2] = {0.f, 0.f};
#pragma unroll
    for (int g = 0; g < 2; ++g) { negm[g] = (f32x4){0.f, 0.f, 0.f, 0.f};
#pragma unroll
        for (int dt = 0; dt < 4; ++dt) o[g][dt] = (f32x4){0.f, 0.f, 0.f, 0.f}; }
    f32x4 sA[4][2], sB[4][2];
    { u32x4 k1st[KPT];
      M16_LOADK(0); M16_LOADV(0);
#pragma unroll
      for (int j = 0; j < KPT; ++j) if (kval[j]) k1st[j] = *(const u32x4*)(ksrc[j] + (size_t)kstr[j]);
      M16_STOREK(0); M16_STOREV(0);
#pragma unroll
      for (int j = 0; j < KPT; ++j) if (kval[j]) *(LAS u32x4*)(lds + kdst[j] + KB) = k1st[j]; }
    __syncthreads();
    M16_QK(sA, 0);
#pragma unroll
    for (int g = 0; g < 2; ++g) { float rm; M16_ROWMAX(sA, g, rm);
#pragma unroll
        for (int kt = 0; kt < 4; ++kt) sA[kt][g] = sA[kt][g] - rm;
        negm[g] = (f32x4){-rm, -rm, -rm, -rm}; }
    __syncthreads();
    const int q_ = lj >> 2, p_ = lj & 3;
#define M16_STEP(SC, SN, t) do { const int buf_ = (t) & 1; \
        if ((t) + 2 < NT) M16_LOADK((t) + 2); if ((t) + 1 < NT) M16_LOADV((t) + 1); \
        if ((t) + 1 < NT) M16_QK(SN, buf_ ^ 1); \
        bf16x8 pa_[2][2]; \
        _Pragma("unroll") for (int g = 0; g < 2; ++g) { float ps_ = 0.f; \
            _Pragma("unroll") for (int kt = 0; kt < 4; ++kt) _Pragma("unroll") for (int e = 0; e < 4; ++e) { SC[kt][g][e] = fast_exp2(SC[kt][g][e]); ps_ += SC[kt][g][e]; } \
            lsum[g] += ps_; \
            _Pragma("unroll") for (int s = 0; s < 2; ++s) { u32x4 w_; w_.x = cvt_pk_bf16(SC[2 * s][g][0], SC[2 * s][g][1]); w_.y = cvt_pk_bf16(SC[2 * s][g][2], SC[2 * s][g][3]); \
                w_.z = cvt_pk_bf16(SC[2 * s + 1][g][0], SC[2 * s + 1][g][1]); w_.w = cvt_pk_bf16(SC[2 * s + 1][g][2], SC[2 * s + 1][g][3]); pa_[g][s] = __builtin_bit_cast(bf16x8, w_); } } \
        { const unsigned vb_ = (unsigned)(uintptr_t)(lds + OFF_V + buf_ * VB) + (unsigned)((4 * fq + q_) * PV + p_ * 8); \
          _Pragma("unroll") for (int s = 0; s < 2; ++s) _Pragma("unroll") for (int dt = 0; dt < 4; ++dt) { \
              const s16x4 lo_ = vtr(vb_ + (unsigned)(32 * s * PV + dt * 32)), hh_ = vtr(vb_ + (unsigned)((32 * s + 16) * PV + dt * 32)); \
              const bf16x8 vf_ = (bf16x8){lo_[0], lo_[1], lo_[2], lo_[3], hh_[0], hh_[1], hh_[2], hh_[3]}; \
              _Pragma("unroll") for (int g = 0; g < 2; ++g) o[g][dt] = __builtin_amdgcn_mfma_f32_16x16x32_bf16(pa_[g][s], vf_, o[g][dt], 0, 0, 0); } } \
        float rm0_ = 0.f, rm1_ = 0.f; \
        if ((t) + 1 < NT) { M16_ROWMAX(SN, 0, rm0_); M16_ROWMAX(SN, 1, rm1_); } \
        if (__any(fmaxf(rm0_, rm1_) > THR)) { \
            _Pragma("unroll") for (int g = 0; g < 2; ++g) { const float dl_ = fmaxf(g ? rm1_ : rm0_, 0.f); const float f_ = fast_exp2(-dl_); lsum[g] *= f_; \
                _Pragma("unroll") for (int kt = 0; kt < 4; ++kt) SN[kt][g] = SN[kt][g] - dl_; negm[g] = negm[g] - dl_; \
                _Pragma("unroll") for (int e = 0; e < 4; ++e) { const float fe_ = __shfl(f_, 4 * fq + e); _Pragma("unroll") for (int dt = 0; dt < 4; ++dt) o[g][dt][e] *= fe_; } } } \
        if ((t) + 2 < NT) M16_STOREK(buf_); if ((t) + 1 < NT) M16_STOREV(buf_ ^ 1); \
        __syncthreads(); } while (0)
    for (int t = 0; t < NT; t += 2) { M16_STEP(sA, sB, t); M16_STEP(sB, sA, t + 1); }
    LAS bf16_t* ost = (LAS bf16_t*)(lds + OFF_OST) + wid * 32 * DV;
#pragma unroll
    for (int g = 0; g < 2; ++g) { float l_ = lsum[g]; l_ += __shfl_xor(l_, 16); l_ += __shfl_xor(l_, 32); const float linv = fast_rcp(l_);
#pragma unroll
        for (int e = 0; e < 4; ++e) { const float li = __shfl(linv, 4 * fq + e);
#pragma unroll
            for (int dt = 0; dt < 4; ++dt) { const float val = o[g][dt][e] * li; ost[(16 * g + 4 * fq + e) * DV + 16 * dt + lj] = (bf16_t)(cvt_pk_bf16(val, val) & 0xffffu); } } }
    asm volatile("s_waitcnt lgkmcnt(0)" ::: "memory");
    { bf16_t* og = A.o + (size_t)wave_tok0 * LDO + h * DV;
#pragma unroll
      for (int i = 0; i < DV / 16; ++i) { const int id = i * 64 + lane; const int row = id / VCH, ch = id % VCH;
          const u32x4 v = *(const LAS u32x4*)(ost + row * DV + ch * 8); *(u32x4*)(og + (size_t)row * LDO + ch * 8) = v; } }
    __syncthreads();
#undef M16_LOADK
#undef M16_LOADV
#undef M16_STOREK
#undef M16_STOREV
#undef M16_QK
#undef M16_ROWMAX
#undef M16_STEP
}
}

namespace na2 {
typedef short v4i16_t __attribute__((ext_vector_type(4)));
constexpr int NS = 6, DPF = 5, TILE = 16384;
constexpr int OFF_RING = 0, OFF_OST = NS * TILE, OFF_TAB = OFF_OST + 8 * 2048, TAB_FLOATS = 8 * 465;
static_assert(OFF_TAB + TAB_FLOATS * 4 <= LDS_BYTES - 64, "na2 LDS");
__device__ __forceinline__ void glds16(const void* gsrc, unsigned lds_dst) { unsigned keep;
    asm volatile("s_mov_b32 %0, m0\n\ts_mov_b32 m0, %2\n\ts_nop 0\n\tglobal_load_lds_dwordx4 %1, off\n\ts_mov_b32 m0, %0" : "=&s"(keep) : "v"(gsrc), "s"(lds_dst) : "memory"); }
__device__ __forceinline__ s16x4 vtr(unsigned addr) { return __builtin_bit_cast(s16x4, __builtin_amdgcn_ds_read_tr16_b64_v4i16((LAS v4i16_t*)(uintptr_t)addr)); }
__device__ __forceinline__ int clampi(int v, int lo, int hi) { return v < lo ? lo : (v > hi ? hi : v); }
#define NA_WAITBAR(N) asm volatile("s_waitcnt vmcnt(" #N ") lgkmcnt(0)\n\ts_barrier" ::: "memory")

__device__ __forceinline__ void na_phase(LAS unsigned char* lds, const bf16_t* qn, const bf16_t* kn, const bf16_t* vn, bf16_t* on, const float* rpb, const int vcu, const int G) {
    int tid_ = threadIdx.x; asm volatile("" : "+v"(tid_));
    const int tid = tid_, lane = tid & 63, lj = lane & 15, fq = lane >> 4; const int wid = __builtin_amdgcn_readfirstlane(tid >> 6);
    const int hl = wid >> 2, g = wid & 3; const int csg = (g == 0) ? 0 : (g == 1 ? 8 : (g == 2 ? 24 : 32));
    LAS float* tab = (LAS float*)(lds + OFF_TAB);
    { float tv[8];
#pragma unroll
      for (int k = 0; k < 8; ++k) { const int i = tid + NTHREADS * k; tv[k] = (i < TAB_FLOATS) ? rpb[i] : 0.f; }
#pragma unroll
      for (int k = 0; k < 8; ++k) { const int i = tid + NTHREADS * k; if (i < TAB_FLOATS) tab[i] = tv[k] * LOG2E; } }
    const unsigned lds0 = (unsigned)(uintptr_t)lds;
    if (vcu >= 2048) { __syncthreads(); return; }
    const int nunits = (2048 - vcu + G - 1) / G; const int total = nunits * 17;
    unsigned offK[2], offV[2], dstw[2];
#pragma unroll
    for (int p = 0; p < 2; ++p) { const int ii = wid * 2 + p, row = 4 * ii + (lane >> 4), cp = lane & 15;
        offK[p] = (unsigned)(row * 1024 + ((cp ^ (row & 15)) << 4)); offV[p] = (unsigned)(row * 1024 + ((cp ^ ((row & 7) << 1)) << 4)); dstw[p] = lds0 + OFF_RING + ii * 1024; }
#define NA_ISSUE(tau, slot) do { const int n_ = (tau) / 17, i_ = (tau) - 17 * n_; const int U_ = vcu + n_ * G; const int b_ = U_ >> 8, hp_ = (U_ >> 6) & 3, r_ = U_ & 63; \
        const int kr_ = (i_ == 0) ? r_ : clampi(r_ - 4, 0, 56) + ((i_ - 1) & 7); const bf16_t* src_ = (i_ == 0) ? qn : (i_ < 9 ? kn : vn); \
        const char* base_ = (const char*)(src_ + ((size_t)(b_ * S_ + kr_ * 64) * 512 + hp_ * 128)); \
        _Pragma("unroll") for (int p = 0; p < 2; ++p) glds16(base_ + (i_ < 9 ? offK[p] : offV[p]), (unsigned)__builtin_amdgcn_readfirstlane(dstw[p] + (slot) * TILE)); } while (0)
    int islot = 0;
#pragma unroll
    for (int d = 0; d < DPF; ++d) { if (d < total) { NA_ISSUE(d, islot); islot = (islot + 1 == NS) ? 0 : islot + 1; } }
    int cslot = 0;
    for (int n = 0; n < nunits; ++n) {
        const int U = vcu + n * G; const int b = U >> 8, hp = (U >> 6) & 3, r = U & 63; const int rs = clampi(r - 4, 0, 56); const int head = hp * 2 + hl;
        const int tok0 = b * S_ + r * 64 + 16 * g;
        bf16x8 qf[2];
        f32x4 s[8][2]; bf16x8 pa[8]; f32x4 o[4]; float lsum = 0.f;
#pragma unroll
        for (int dt = 0; dt < 4; ++dt) o[dt] = (f32x4){0.f, 0.f, 0.f, 0.f};
#pragma clang loop unroll(full)
        for (int i0 = 0; i0 < 17; ++i0) {
            const int tau = n * 17 + i0; const int i = i0 - 1;
            if (tau + DPF <= total) NA_WAITBAR(8); else NA_WAITBAR(0);
            if (tau + DPF < total) { NA_ISSUE(tau + DPF, islot); islot = (islot + 1 == NS) ? 0 : islot + 1; }
            const unsigned sbase = lds0 + OFF_RING + cslot * TILE; cslot = (cslot + 1 == NS) ? 0 : cslot + 1;
            if (i0 == 0) {
                const int kc = 16 * g + lj;
#pragma unroll
                for (int ds = 0; ds < 2; ++ds) { const int c = hl * 8 + ds * 4 + fq; qf[ds] = *(const LAS bf16x8*)(uintptr_t)(sbase + kc * 256 + ((c ^ (kc & 15)) << 4)); }
            } else if (i < 8) {
#pragma unroll
                for (int ct = 0; ct < 2; ++ct) { s[i][ct] = (f32x4){0.f, 0.f, 0.f, 0.f}; const int kc = csg + 16 * ct + lj;
#pragma unroll
                    for (int ds = 0; ds < 2; ++ds) { const int c = hl * 8 + ds * 4 + fq; const bf16x8 a = *(const LAS bf16x8*)(uintptr_t)(sbase + kc * 256 + ((c ^ (kc & 15)) << 4));
                        s[i][ct] = __builtin_amdgcn_mfma_f32_16x16x32_bf16(a, qf[ds], s[i][ct], 0, 0, 0); } }
                if (i == 7) {
                    const int c = 16 * g + lj, cs = clampi(c - 8, 0, 48); float m = -1e30f;
#pragma unroll
                    for (int t = 0; t < 8; ++t) { const LAS float* trow = tab + head * 465 + (rs + t - r + 7) * 31;
#pragma unroll
                        for (int ct = 0; ct < 2; ++ct)
#pragma unroll
                            for (int e = 0; e < 4; ++e) { const int kc = csg + 16 * ct + 4 * fq + e; const bool v = (unsigned)(kc - cs) < 16u; const float bias = trow[v ? (kc - c + 15) : 0];
                                const float x = v ? s[t][ct][e] + bias : -1e30f; s[t][ct][e] = x; m = fmaxf(m, x); } }
                    m = fmaxf(m, __shfl_xor(m, 16)); m = fmaxf(m, __shfl_xor(m, 32));
#pragma unroll
                    for (int t = 0; t < 8; ++t) {
#pragma unroll
                        for (int ct = 0; ct < 2; ++ct)
#pragma unroll
                            for (int e = 0; e < 4; ++e) { const float p = fast_exp2(s[t][ct][e] - m); s[t][ct][e] = p; lsum += p; }
                        u32x4 w; w.x = cvt_pk_bf16(s[t][0][0], s[t][0][1]); w.y = cvt_pk_bf16(s[t][0][2], s[t][0][3]); w.z = cvt_pk_bf16(s[t][1][0], s[t][1][1]); w.w = cvt_pk_bf16(s[t][1][2], s[t][1][3]);
                        pa[t] = __builtin_bit_cast(bf16x8, w); }
                    lsum += __shfl_xor(lsum, 16); lsum += __shfl_xor(lsum, 32);
                }
            } else {
                const int t = i - 8; const int q = lj >> 2, p = lj & 3;
#pragma unroll
                for (int dt = 0; dt < 4; ++dt) { const int c = hl * 8 + 2 * dt + (p >> 1); s16x4 tr[2];
#pragma unroll
                    for (int ct = 0; ct < 2; ++ct) { const int kc = csg + 16 * ct + 4 * fq + q; tr[ct] = vtr(sbase + kc * 256 + ((c ^ ((kc & 7) << 1)) << 4) + (p & 1) * 8); }
                    const bf16x8 vf = (bf16x8){tr[0][0], tr[0][1], tr[0][2], tr[0][3], tr[1][0], tr[1][1], tr[1][2], tr[1][3]};
                    o[dt] = __builtin_amdgcn_mfma_f32_16x16x32_bf16(pa[t], vf, o[dt], 0, 0, 0); }
                if (i == 15) {
                    const float linv = fast_rcp(lsum); float li[4];
#pragma unroll
                    for (int e = 0; e < 4; ++e) li[e] = __shfl(linv, 4 * fq + e);
                    LAS bf16_t* ost = (LAS bf16_t*)(lds + OFF_OST) + wid * 1024;
#pragma unroll
                    for (int dt = 0; dt < 4; ++dt)
#pragma unroll
                        for (int e = 0; e < 4; ++e) { const float val = o[dt][e] * li[e]; ost[(4 * fq + e) * 64 + 16 * dt + lj] = (bf16_t)(cvt_pk_bf16(val, val) & 0xffffu); }
                    asm volatile("s_waitcnt lgkmcnt(0)" ::: "memory");
                    bf16_t* og = on + (size_t)tok0 * 512 + head * 64;
#pragma unroll
                    for (int k = 0; k < 2; ++k) { const int id = lane + 64 * k, row = id >> 3, ch = id & 7; const u32x4 v = *(const LAS u32x4*)(ost + row * 64 + ch * 8); st_g<6>((u32x4*)(og + (size_t)row * 512 + ch * 8), v); }
                }
            }
        }
    }
    asm volatile("s_waitcnt vmcnt(0) lgkmcnt(0)" ::: "memory");
    __syncthreads();
#undef NA_ISSUE
}
#undef NA_WAITBAR
}

namespace na3 {
typedef short v4i16_t __attribute__((ext_vector_type(4)));
constexpr int NS = 6, DPF = 5, TILE = 16384;
constexpr int OFF_RING = 0, OFF_OST = NS * TILE, OFF_TAB = OFF_OST + 8 * 2048, TAB_FLOATS = 8 * 465;
static_assert(OFF_TAB + TAB_FLOATS * 4 <= LDS_BYTES - 64, "na3 LDS");
__device__ __forceinline__ void glds16(const void* gsrc, unsigned lds_dst) { unsigned keep;
    asm volatile("s_mov_b32 %0, m0\n\ts_mov_b32 m0, %2\n\ts_nop 0\n\tglobal_load_lds_dwordx4 %1, off\n\ts_mov_b32 m0, %0" : "=&s"(keep) : "v"(gsrc), "s"(lds_dst) : "memory"); }
__device__ __forceinline__ s16x4 vtr(unsigned addr) { return __builtin_bit_cast(s16x4, __builtin_amdgcn_ds_read_tr16_b64_v4i16((LAS v4i16_t*)(uintptr_t)addr)); }
__device__ __forceinline__ int clampi(int v, int lo, int hi) { return v < lo ? lo : (v > hi ? hi : v); }
#define NA_WAITBAR(N) asm volatile("s_waitcnt vmcnt(" #N ") lgkmcnt(0)\n\ts_barrier" ::: "memory")

__device__ __forceinline__ void na_phase(LAS unsigned char* lds, const bf16_t* qn, const bf16_t* kn, const bf16_t* vn, bf16_t* on, const float* rpb, const int vcu, const int G, const int bal) {
    int tid_ = threadIdx.x; asm volatile("" : "+v"(tid_));
    const int tid = tid_, lane = tid & 63, lj = lane & 15, fq = lane >> 4; const int wid = __builtin_amdgcn_readfirstlane(tid >> 6);
    const int hl = wid >> 2, g = wid & 3; const int csg = (g == 0) ? 0 : (g == 1 ? 8 : (g == 2 ? 24 : 32));
    LAS float* tab = (LAS float*)(lds + OFF_TAB);
    { float tv[8];
#pragma unroll
      for (int k = 0; k < 8; ++k) { const int i = tid + NTHREADS * k; tv[k] = (i < TAB_FLOATS) ? rpb[i] : 0.f; }
#pragma unroll
      for (int k = 0; k < 8; ++k) { const int i = tid + NTHREADS * k; if (i < TAB_FLOATS) tab[i] = tv[k] * LOG2E; } }
    const unsigned lds0 = (unsigned)(uintptr_t)lds;
    if (bal < 0 && vcu >= 1024) { __syncthreads(); return; }
    const int nunits = (bal < 0) ? (1024 - vcu + G - 1) / G : (bal == 128 ? 3 : 5); const int total = nunits * 20;
#define NA_UNIT(n) ((bal < 0 || (n) < 3) ? (vcu + (n) * G) : (768 + 2 * bal + ((n) - 3)))
    unsigned offK[2], offV[2], dstw[2];
#pragma unroll
    for (int p = 0; p < 2; ++p) { const int ii = wid * 2 + p, row = 4 * ii + (lane >> 4), cp = lane & 15;
        offK[p] = (unsigned)(row * 1024 + ((cp ^ (row & 15)) << 4)); offV[p] = (unsigned)(row * 1024 + ((cp ^ ((row & 7) << 1)) << 4)); dstw[p] = lds0 + OFF_RING + ii * 1024; }
#define NA_ISSUE(tau, slot) do { const int n_ = (tau) / 20, i_ = (tau) - 20 * n_; const int U_ = NA_UNIT(n_); const int b_ = U_ >> 7, hp_ = (U_ >> 5) & 3, r_ = (U_ & 31) * 2; \
        const int kr_ = (i_ < 2) ? (r_ + i_) : clampi(clampi(r_ - 4, 0, 56) + ((i_ < 11) ? (i_ - 2) : (i_ - 11)), 0, 63); const bf16_t* src_ = (i_ < 2) ? qn : (i_ < 11 ? kn : vn); \
        const char* base_ = (const char*)(src_ + ((size_t)(b_ * S_ + kr_ * 64) * 512 + hp_ * 128)); \
        _Pragma("unroll") for (int p = 0; p < 2; ++p) glds16(base_ + (i_ < 11 ? offK[p] : offV[p]), (unsigned)__builtin_amdgcn_readfirstlane(dstw[p] + (slot) * TILE)); } while (0)
    int islot = 0;
#pragma unroll
    for (int d = 0; d < DPF; ++d) { if (d < total) { NA_ISSUE(d, islot); islot = (islot + 1 == NS) ? 0 : islot + 1; } }
    int cslot = 0;
    for (int n = 0; n < nunits; ++n) {
        const int U = NA_UNIT(n); const int b = U >> 7, hp = (U >> 5) & 3, r = (U & 31) * 2; const int rs = clampi(r - 4, 0, 56); const int dsh = clampi(r - 3, 0, 56) - rs;
        const int head = hp * 2 + hl;
        const int tok0 = b * S_ + r * 64 + 16 * g;
        bf16x8 qf[2][2];
        f32x4 s[2][9][2]; bf16x8 pa[2][9]; f32x4 o[2][4]; float lsum[2] = {0.f, 0.f};
#pragma unroll
        for (int j = 0; j < 2; ++j)
#pragma unroll
            for (int dt = 0; dt < 4; ++dt) o[j][dt] = (f32x4){0.f, 0.f, 0.f, 0.f};
#pragma clang loop unroll(full)
        for (int i0 = 0; i0 < 20; ++i0) {
            const int tau = n * 20 + i0;
            if (tau + DPF <= total) NA_WAITBAR(8); else NA_WAITBAR(0);
            if (tau + DPF < total) { NA_ISSUE(tau + DPF, islot); islot = (islot + 1 == NS) ? 0 : islot + 1; }
            const unsigned sbase = lds0 + OFF_RING + cslot * TILE; cslot = (cslot + 1 == NS) ? 0 : cslot + 1;
            if (i0 < 2) {
                const int kc = 16 * g + lj;
#pragma unroll
                for (int ds = 0; ds < 2; ++ds) { const int c = hl * 8 + ds * 4 + fq; qf[i0][ds] = *(const LAS bf16x8*)(uintptr_t)(sbase + kc * 256 + ((c ^ (kc & 15)) << 4)); }
            } else if (i0 < 11) {
                const int t = i0 - 2;
#pragma unroll
                for (int ct = 0; ct < 2; ++ct) { const int kc = csg + 16 * ct + lj; s[0][t][ct] = (f32x4){0.f, 0.f, 0.f, 0.f}; s[1][t][ct] = (f32x4){0.f, 0.f, 0.f, 0.f};
#pragma unroll
                    for (int ds = 0; ds < 2; ++ds) { const int c = hl * 8 + ds * 4 + fq; const bf16x8 a = *(const LAS bf16x8*)(uintptr_t)(sbase + kc * 256 + ((c ^ (kc & 15)) << 4));
                        s[0][t][ct] = __builtin_amdgcn_mfma_f32_16x16x32_bf16(a, qf[0][ds], s[0][t][ct], 0, 0, 0); s[1][t][ct] = __builtin_amdgcn_mfma_f32_16x16x32_bf16(a, qf[1][ds], s[1][t][ct], 0, 0, 0); } }
                if (i0 == 10) {
                    const int c = 16 * g + lj, cs = clampi(c - 8, 0, 48);
#pragma unroll
                    for (int j = 0; j < 2; ++j) { float m = -1e30f; const int dj = j ? dsh : 0;
#pragma unroll
                        for (int t2 = 0; t2 < 9; ++t2) { const bool tv = (unsigned)(t2 - dj) < 8u; const int drr = tv ? (rs + t2 - (r + j) + 7) : 0; const LAS float* trow = tab + head * 465 + drr * 31;
#pragma unroll
                            for (int ct = 0; ct < 2; ++ct)
#pragma unroll
                                for (int e = 0; e < 4; ++e) { const int kc = csg + 16 * ct + 4 * fq + e; const bool v = tv && ((unsigned)(kc - cs) < 16u); const float bias = trow[v ? (kc - c + 15) : 0];
                                    const float x = v ? s[j][t2][ct][e] + bias : -1e30f; s[j][t2][ct][e] = x; m = fmaxf(m, x); } }
                        m = fmaxf(m, __shfl_xor(m, 16)); m = fmaxf(m, __shfl_xor(m, 32));
                        float ls = 0.f;
#pragma unroll
                        for (int t2 = 0; t2 < 9; ++t2) {
#pragma unroll
                            for (int ct = 0; ct < 2; ++ct)
#pragma unroll
                                for (int e = 0; e < 4; ++e) { const float p = fast_exp2(s[j][t2][ct][e] - m); s[j][t2][ct][e] = p; ls += p; }
                            u32x4 w; w.x = cvt_pk_bf16(s[j][t2][0][0], s[j][t2][0][1]); w.y = cvt_pk_bf16(s[j][t2][0][2], s[j][t2][0][3]); w.z = cvt_pk_bf16(s[j][t2][1][0], s[j][t2][1][1]); w.w = cvt_pk_bf16(s[j][t2][1][2], s[j][t2][1][3]);
                            pa[j][t2] = __builtin_bit_cast(bf16x8, w); }
                        ls += __shfl_xor(ls, 16); ls += __shfl_xor(ls, 32); lsum[j] = ls; }
                }
            } else {
                const int t = i0 - 11; const int q = lj >> 2, p = lj & 3;
#pragma unroll
                for (int dt = 0; dt < 4; ++dt) { const int c = hl * 8 + 2 * dt + (p >> 1); s16x4 tr[2];
#pragma unroll
                    for (int ct = 0; ct < 2; ++ct) { const int kc = csg + 16 * ct + 4 * fq + q; tr[ct] = vtr(sbase + kc * 256 + ((c ^ ((kc & 7) << 1)) << 4) + (p & 1) * 8); }
                    const bf16x8 vf = (bf16x8){tr[0][0], tr[0][1], tr[0][2], tr[0][3], tr[1][0], tr[1][1], tr[1][2], tr[1][3]};
                    o[0][dt] = __builtin_amdgcn_mfma_f32_16x16x32_bf16(pa[0][t], vf, o[0][dt], 0, 0, 0); o[1][dt] = __builtin_amdgcn_mfma_f32_16x16x32_bf16(pa[1][t], vf, o[1][dt], 0, 0, 0); }
                if (i0 == 19) {
                    LAS bf16_t* ost = (LAS bf16_t*)(lds + OFF_OST) + wid * 1024;
#pragma unroll
                    for (int j = 0; j < 2; ++j) { const float linv = fast_rcp(lsum[j]); float li[4];
#pragma unroll
                        for (int e = 0; e < 4; ++e) li[e] = __shfl(linv, 4 * fq + e);
#pragma unroll
                        for (int dt = 0; dt < 4; ++dt)
#pragma unroll
                            for (int e = 0; e < 4; ++e) { const float val = o[j][dt][e] * li[e]; ost[(4 * fq + e) * 64 + 16 * dt + lj] = (bf16_t)(cvt_pk_bf16(val, val) & 0xffffu); }
                        asm volatile("s_waitcnt lgkmcnt(0)" ::: "memory");
                        bf16_t* og = on + (size_t)(tok0 + j * 64) * 512 + head * 64;
#pragma unroll
                        for (int k = 0; k < 2; ++k) { const int id = lane + 64 * k, row = id >> 3, ch = id & 7; const u32x4 v = *(const LAS u32x4*)(ost + row * 64 + ch * 8); st_g<6>((u32x4*)(og + (size_t)row * 512 + ch * 8), v); }
                        asm volatile("s_waitcnt lgkmcnt(0)" ::: "memory"); }
                }
            }
        }
    }
    asm volatile("s_waitcnt vmcnt(0) lgkmcnt(0)" ::: "memory");
    __syncthreads();
#undef NA_ISSUE
#undef NA_UNIT
}
#undef NA_WAITBAR
}

struct HalfMap { int drow; float cs; bool rp; bool valid; };
template <int NTB>
__device__ __forceinline__ void p0_item64(const float* W, int ldw, int k0, int n0, bf16_t* WT, int ldwt, const HalfMap h0, const HalfMap h1, int dk0, const float* g, LAS float* scr, int lane) {
    const int n4 = (lane & 15) * 4, kq = lane >> 4; const bool hv = (n4 < 32) ? h0.valid : h1.valid; const float cs = (n4 < 32) ? h0.cs : h1.cs;
    f32x4 v[16];
#pragma unroll
    for (int j = 0; j < 16; ++j) { v[j] = (f32x4){0.f, 0.f, 0.f, 0.f}; if (hv) v[j] = ld_g<12>((const f32x4*)(W + (size_t)(k0 + 4 * j + kq) * ldw + n0 + n4)); }
#pragma unroll
    for (int j = 0; j < 16; ++j) { const int k = 4 * j + kq; float sc = cs; if (g) sc *= g[k0 + k];
#pragma unroll
        for (int e = 0; e < 4; ++e) scr[(n4 + e) * 65 + k] = v[j][e] * sc; }
    asm volatile("s_waitcnt lgkmcnt(0)" ::: "memory");
    const int c = lane & 7;
#pragma unroll
    for (int j = 0; j < 8; ++j) { const int nn = 8 * j + (lane >> 3); const LAS float* s = scr + nn * 65 + 8 * c;
        u32x4 o; o.x = cvt_pk_bf16(s[0], s[1]); o.y = cvt_pk_bf16(s[2], s[3]); o.z = cvt_pk_bf16(s[4], s[5]); o.w = cvt_pk_bf16(s[6], s[7]);
        const bool hi_ = nn >= 32; const int w = nn & 31; const bool rp = hi_ ? h1.rp : h0.rp; const int nd = rp ? ((w & 16) + 2 * (w & 7) + ((w >> 3) & 1)) : w;
        const int drow = (hi_ ? h1.drow : h0.drow) + nd;
        if (hi_ ? h1.valid : h0.valid) st_g<NTB>((u32x4*)(WT + (size_t)drow * ldwt + dk0 + k0 + 8 * c), o); }
    asm volatile("s_waitcnt lgkmcnt(0)" ::: "memory");
}
template <int NTB>
__device__ __forceinline__ void p0_rows(const float* src, bf16_t* dst, float* rstd, int nrows, int gw, int NGW, int lane) {
    f32x4 nx[4];
    if (gw < nrows) { const f32x4* xr = (const f32x4*)(src + (size_t)gw * D_) + lane;
#pragma unroll
        for (int j = 0; j < 4; ++j) nx[j] = ld_g<12>(xr + 64 * j); }
    for (int m = gw; m < nrows; m += NGW) {
        f32x4 v[4]; float s = 0.f;
#pragma unroll
        for (int j = 0; j < 4; ++j) { v[j] = nx[j]; s += (v[j][0] * v[j][0] + v[j][1] * v[j][1]) + (v[j][2] * v[j][2] + v[j][3] * v[j][3]); }
        { const int nm = m + NGW; if (nm < nrows) { const f32x4* xr = (const f32x4*)(src + (size_t)nm * D_) + lane;
#pragma unroll
            for (int j = 0; j < 4; ++j) nx[j] = ld_g<12>(xr + 64 * j); } }
        s = wave_sum(s);
        u32x2* o8 = (u32x2*)(dst + (size_t)m * D_) + lane;
#pragma unroll
        for (int j = 0; j < 4; ++j) { u32x2 w; w.x = cvt_pk_bf16(v[j][0], v[j][1]); w.y = cvt_pk_bf16(v[j][2], v[j][3]); st_g<NTB>(o8 + 64 * j, w); }
        if (lane == 0) rstd[m] = rsqrtf(s * (1.0f / 1024.0f) + EPS_);
    }
}

#define PX(P) ((P).in[0])
#define PMEM(P) ((P).in[1])
#define PGMIX(P) ((P).in[2])
#define PWIN(P) ((P).in[3])
#define PRPB(P) ((P).in[4])
#define PQN(P) ((P).in[5])
#define PWUQ(P) ((P).in[6])
#define PKVN(P) ((P).in[7])
#define PWUKV(P) ((P).in[8])
#define PGMEM(P) ((P).in[9])
#define PWMEMKV(P) ((P).in[10])
#define PWOUT(P) ((P).in[14])
#define PGFFN(P) ((P).in[15])
#define PWROUTER(P) ((P).in[16])
#define PBROUTER(P) ((P).in[17])
#define PWGATE(P) ((P).in[18])
#define PWUP(P) ((P).in[19])
#define PWDOWN(P) ((P).in[20])
#define PGFINAL(P) ((P).in[21])
typedef Args Ptrs;

#ifndef EX_K1
#define EX_K1 3
#endif
#ifndef EX_K2
#define EX_K2 2
#endif
#ifndef EX_K3
#define EX_K3 4
#endif
#ifndef EX_K1A
#define EX_K1A 4
#endif
constexpr int EX_N1A = 768 * EX_K1A, EX_N1 = 768 * EX_K1, EX_N2 = 1024 * EX_K2, EX_N3 = 1024 * EX_K3, EX_DEFER = EX_N1A + EX_N1 + EX_N2 + EX_N3;
static_assert(EX_DEFER <= 3 * 16 * 256, "deferred expert items");
struct ExItem { const float* W; bf16_t* WT; const float* g; int k0, n0, d0; };
__device__ __forceinline__ ExItem ex_decode(const Ptrs& P, int r) {
    const int kind = r >> 12, rr = r & 4095; const int e = rr >> 8, q = rr & 255, kb = q >> 4, n0 = (q & 15) * 64; ExItem it; it.k0 = kb * 64; it.n0 = n0;
    if (kind == 2) { it.W = PWDOWN(P) + (size_t)e * 1048576; it.WT = (bf16_t*)(P.ws + WS_WD) + (size_t)e * 1048576; it.g = nullptr; it.d0 = n0; }
    else { it.W = (kind == 0 ? PWGATE(P) : PWUP(P)) + (size_t)e * 1048576; it.WT = (bf16_t*)(P.ws + WS_WGU) + (size_t)e * 2097152; it.g = PGFFN(P); it.d0 = (n0 >> 7) * 256 + (n0 & 127) + (kind == 1 ? 128 : 0); }
    return it;
}
__device__ __forceinline__ void ex_load(const ExItem& it, int lane, f32x4 (&v)[16]) {
    const int n4 = (lane & 15) * 4, kq = lane >> 4;
#pragma unroll
    for (int j = 0; j < 16; ++j) v[j] = ld_g<12>((const f32x4*)(it.W + (size_t)(it.k0 + 4 * j + kq) * 1024 + it.n0 + n4));
}
__device__ __forceinline__ void ex_finish(const ExItem& it, const f32x4 (&v)[16], LAS float* scr, int lane) {
    const int n4 = (lane & 15) * 4, kq = lane >> 4;
#pragma unroll
    for (int j = 0; j < 16; ++j) { const int k = 4 * j + kq; const float sc = it.g ? it.g[it.k0 + k] : 1.0f;
#pragma unroll
        for (int e = 0; e < 4; ++e) scr[(n4 + e) * 65 + k] = v[j][e] * sc; }
    asm volatile("s_waitcnt lgkmcnt(0)" ::: "memory");
    const int c = lane & 7;
#pragma unroll
    for (int j = 0; j < 8; ++j) { const int nn = 8 * j + (lane >> 3); const LAS float* s_ = scr + nn * 65 + 8 * c;
        u32x4 o; o.x = cvt_pk_bf16(s_[0], s_[1]); o.y = cvt_pk_bf16(s_[2], s_[3]); o.z = cvt_pk_bf16(s_[4], s_[5]); o.w = cvt_pk_bf16(s_[6], s_[7]);
        st_g<10>((u32x4*)(it.WT + (size_t)(it.d0 + nn) * 1024 + it.k0 + 8 * c), o); }
    asm volatile("s_waitcnt lgkmcnt(0)" ::: "memory");
}
template <bool PIPE = true>
__device__ __forceinline__ void p0_expert_range(const Ptrs& P, LAS unsigned char* lds, int first, int count, int widx, int nw, int wave, int lane) {
    asm volatile("" : "+v"(lane));
    LAS float* scr = (LAS float*)(lds + wave * 16640);
    if constexpr (!PIPE) { for (int it = first + widx; it < first + count; it += nw) { f32x4 v[16]; const ExItem ii = ex_decode(P, it); ex_load(ii, lane, v); ex_finish(ii, v, scr, lane); } return; }
    const int end = first + count; int it = __builtin_amdgcn_readfirstlane(first + widx); nw = __builtin_amdgcn_readfirstlane(nw);
    f32x4 va[16], vb[16]; ExItem ia, ib;
    if (it < end) { ia = ex_decode(P, it); ex_load(ia, lane, va); }
    while (it < end) {
        const int it2 = it + nw; const bool h2 = it2 < end;
        if (h2) { ib = ex_decode(P, it2); ex_load(ib, lane, vb); }
        ex_finish(ia, va, scr, lane);
        const int it3 = it2 + nw;
        if (it3 < end) { ia = ex_decode(P, it3); ex_load(ia, lane, va); }
        if (h2) ex_finish(ib, vb, scr, lane);
        it = it3;
    }
}
__device__ __forceinline__ void phase0(const Ptrs& P, LAS unsigned char* lds, int gw, int NGW, int wave, int lane) {
    LAS float* scr = (LAS float*)(lds + wave * 16640);
    bf16_t* win = (bf16_t*)(P.ws + WS_WIN); bf16_t* wuq = (bf16_t*)(P.ws + WS_WUQ); bf16_t* wukv = (bf16_t*)(P.ws + WS_WUKV); bf16_t* wmk = (bf16_t*)(P.ws + WS_WMK);
    bf16_t* wo = (bf16_t*)(P.ws + WS_WO); bf16_t* wout = (bf16_t*)(P.ws + WS_WOUT); bf16_t* wgu = (bf16_t*)(P.ws + WS_WGU); bf16_t* wd = (bf16_t*)(P.ws + WS_WD);
    constexpr int I_E = 16 * 16, I_IN = 16 * 91, I_UQ = 6 * 12, I_UKV = 4 * 16, I_MK = 16 * 16, I_O = 8 * 16, I_OUT = 16 * 16;
    constexpr int NITEMS = 3 * 16 * I_E + I_IN + I_UQ + I_UKV + I_MK + 3 * I_O + I_OUT;
    p0_expert_range<false>(P, lds, EX_DEFER, 3 * 16 * I_E - EX_DEFER, gw, NGW, wave, lane);
    for (int it = gw; it < NITEMS - 3 * 16 * I_E; it += NGW) {
        int r = it;
        if (r < I_IN) { const int kb = r / 91, n0 = (r % 91) * 64; HalfMap hm[2];
#pragma unroll
            for (int hh = 0; hh < 2; ++hh) { const int n = n0 + 32 * hh; hm[hh].valid = n < INC_; hm[hh].drow = n < 2208 ? n : n + 96; hm[hh].cs = n < 512 ? C_NA : ((n >= 2208 && n < 2720) ? C_MEM : 1.0f); hm[hh].rp = (n == 2176); }
            p0_item64<7>(PWIN(P), INC_, kb * 64, n0, win, 1024, hm[0], hm[1], 0, PGMIX(P), scr, lane); continue; } r -= I_IN;
        if (r < I_UQ) { const int kb = r / 12, nb = (r % 12) * 2, n0 = nb * 32;
            p0_item64<7>(PWUQ(P), 768, kb * 64, n0, wuq, 384, HalfMap{n0, C_MLA, (nb % 3) == 2, true}, HalfMap{n0 + 32, C_MLA, ((nb + 1) % 3) == 2, true}, 0, PQN(P), scr, lane); continue; } r -= I_UQ;
        if (r < I_UKV) { const int kb = r / 16, nb = (r % 16) * 2, n0 = nb * 32; const int hh = nb >> 2, part = nb & 3; const int dr = (part < 2) ? (hh * 64 + part * 32) : (512 + hh * 64 + (part - 2) * 32);
            p0_item64<7>(PWUKV(P), 1024, kb * 64, n0, wukv, 384, HalfMap{dr, 1.0f, false, true}, HalfMap{dr + 32, 1.0f, false, true}, 0, PKVN(P), scr, lane); continue; } r -= I_UKV;
        if (r < I_MK) { const int kb = r / 16, n0 = (r % 16) * 64; p0_item64<7>(PWMEMKV(P), 1024, kb * 64, n0, wmk, 1024, HalfMap{n0, 1.0f, false, true}, HalfMap{n0 + 32, 1.0f, false, true}, 0, PGMEM(P), scr, lane); continue; } r -= I_MK;
        if (r < 3 * I_O) { const int br = r / I_O, q = r % I_O, kb = q / 16, n0 = (q % 16) * 64; p0_item64<7>(P.in[11 + br], 1024, kb * 64, n0, wo, 1536, HalfMap{n0, 1.0f, false, true}, HalfMap{n0 + 32, 1.0f, false, true}, br * 512, nullptr, scr, lane); continue; } r -= 3 * I_O;
        { const int kb = r / 16, n0 = (r % 16) * 64; p0_item64<7>(PWOUT(P), 1024, kb * 64, n0, wout, 1024, HalfMap{n0, 1.0f, false, true}, HalfMap{n0 + 32, 1.0f, false, true}, 0, nullptr, scr, lane); }
    }
    for (int i = gw * 64 + lane; i < 12288; i += NGW * 64) ((u32x4*)(win + (size_t)2208 * 1024))[i] = (u32x4){0u, 0u, 0u, 0u};
    bf16_t* xb = XB_PTR(P); float* rstd_x = (float*)(P.ws + WS_RSTDX);
    p0_rows<11>(PX(P), xb, rstd_x, T_, gw, NGW, lane);
    bf16_t* memb = (bf16_t*)(P.ws + WS_MEMB); float* rstd_m = (float*)(P.ws + WS_RSTDM);
    p0_rows<11>(PMEM(P), memb, rstd_m, 2048, gw, NGW, lane);
    if (gw == NGW - 1) { float* rope = (float*)(P.ws + WS_ROPE);
        for (int i = lane; i < 512; i += 64) { const int pos = i >> 3, fi = i & 7; const float inv = exp2f(-(float)fi * 1.6609640474436813f); const float ang = (float)pos * inv;
            float rev = ang * 0.15915494309189535f; rev -= floorf(rev); rope[2 * i] = __builtin_amdgcn_cosf(rev); rope[2 * i + 1] = __builtin_amdgcn_sinf(rev); } }
}

__device__ __forceinline__ void phase6(const Ptrs& P, LAS unsigned char* lds, int gw, int NGW, int lane) {
    LAS float* wrT = (LAS float*)lds;
    { f32x4 wv[8]; float gv[8];
#pragma unroll
      for (int k = 0; k < 8; ++k) { const int q = threadIdx.x + NTHREADS * k; wv[k] = ((const f32x4*)PWROUTER(P))[q]; gv[k] = PGFFN(P)[q >> 2]; }
#pragma unroll
      for (int k = 0; k < 8; ++k) { const int q = threadIdx.x + NTHREADS * k; const int d = q >> 2, e0 = (q & 3) * 4;
#pragma unroll
          for (int c = 0; c < 4; ++c) wrT[(e0 + c) * 1024 + d] = wv[k][c] * gv[k]; } }
    __syncthreads();
    const bf16_t* dbuf = (const bf16_t*)(P.ws + WS_H); bf16_t* hb = (bf16_t*)(P.ws + WS_HB); float* rstd_h = (float*)(P.ws + WS_RSTDH); float* aff = (float*)(P.ws + WS_AFF);
    const int b5 = (lane >> 5) & 1, b4 = (lane >> 4) & 1, b3 = (lane >> 3) & 1, b2 = (lane >> 2) & 1; const int e_me = 8 * b5 + 4 * b4 + 2 * b3 + b2;
    const float bias = PBROUTER(P)[e_me];
#if MK_XB_HB
    const bf16_t* xsrc = XB_PTR(P);
    u32x2 xn[4], dn[4];
    if (gw < T_) { const u32x2* xr = (const u32x2*)(xsrc + (size_t)gw * D_) + lane; const u32x2* dr = (const u32x2*)(dbuf + (size_t)gw * D_) + lane;
#else
    f32x4 xn[4]; u32x2 dn[4];
    if (gw < T_) { const f32x4* xr = (const f32x4*)(PX(P) + (size_t)gw * D_) + lane; const u32x2* dr = (const u32x2*)(dbuf + (size_t)gw * D_) + lane;
#endif
#pragma unroll
        for (int j = 0; j < 4; ++j) { xn[j] = ld_g<13>(xr + 64 * j); dn[j] = ld_g<13>(dr + 64 * j); } }
    for (int row = gw; row < T_; row += NGW) {
        asm volatile("" ::: "memory");
        f32x4 v[4]; float ss = 0.f;
#pragma unroll
        for (int j = 0; j < 4; ++j) {
#if MK_XB_HB
            v[j][0] = bflo(xn[j].x); v[j][1] = bfhi(xn[j].x); v[j][2] = bflo(xn[j].y); v[j][3] = bfhi(xn[j].y);
#else
            v[j] = xn[j];
#endif
            const u32x2 w = dn[j]; v[j][0] += bflo(w.x); v[j][1] += bfhi(w.x); v[j][2] += bflo(w.y); v[j][3] += bfhi(w.y);
            ss += (v[j][0] * v[j][0] + v[j][1] * v[j][1]) + (v[j][2] * v[j][2] + v[j][3] * v[j][3]); }
        { const int nrow = row + NGW; if (nrow < T_) {
#if MK_XB_HB
            const u32x2* xr = (const u32x2*)(xsrc + (size_t)nrow * D_) + lane;
#else
            const f32x4* xr = (const f32x4*)(PX(P) + (size_t)nrow * D_) + lane;
#endif
            const u32x2* dr = (const u32x2*)(dbuf + (size_t)nrow * D_) + lane;
#pragma unroll
            for (int j = 0; j < 4; ++j) { xn[j] = ld_g<13>(xr + 64 * j); dn[j] = ld_g<13>(dr + 64 * j); } } }
        u32x2* o8 = (u32x2*)(hb + (size_t)row * D_) + lane;
#pragma unroll
        for (int j = 0; j < 4; ++j) { u32x2 w; w.x = cvt_pk_bf16(v[j][0], v[j][1]); w.y = cvt_pk_bf16(v[j][2], v[j][3]); st_g<8>(o8 + 64 * j, w); }
        float a[16];
#pragma unroll
        for (int e = 0; e < 16; ++e) { float s = 0.f;
#pragma unroll
            for (int j = 0; j < 4; ++j) { const f32x4 w = *(const LAS f32x4*)(wrT + e * 1024 + 4 * lane + 256 * j); s += (v[j][0] * w[0] + v[j][1] * w[1]) + (v[j][2] * w[2] + v[j][3] * w[3]); }
            asm volatile("" : "+v"(s) :: "memory"); a[e] = s; }
        ss = wave_sum(ss); const float rstd = rsqrtf(ss * (1.0f / 1024.0f) + EPS_);
        if (lane == 0) rstd_h[row] = rstd;
        float a8[8], a4[4], a2[2], a1;
#pragma unroll
        for (int k = 0; k < 8; ++k) { const float send = b5 ? a[k] : a[k + 8]; const float recv = __shfl_xor(send, 32); a8[k] = (b5 ? a[k + 8] : a[k]) + recv; }
#pragma unroll
        for (int k = 0; k < 4; ++k) { const float send = b4 ? a8[k] : a8[k + 4]; const float recv = __shfl_xor(send, 16); a4[k] = (b4 ? a8[k + 4] : a8[k]) + recv; }
#pragma unroll
        for (int k = 0; k < 2; ++k) { const float send = b3 ? a4[k] : a4[k + 2]; const float recv = __shfl_xor(send, 8); a2[k] = (b3 ? a4[k + 2] : a4[k]) + recv; }
        { const float send = b2 ? a2[0] : a2[1]; const float recv = __shfl_xor(send, 4); a1 = (b2 ? a2[1] : a2[0]) + recv; }
        a1 += __shfl_xor(a1, 2); a1 += __shfl_xor(a1, 1);
        const float logit = a1 * rstd + bias;
        float mx = logit; mx = fmaxf(mx, __shfl_xor(mx, 4)); mx = fmaxf(mx, __shfl_xor(mx, 8)); mx = fmaxf(mx, __shfl_xor(mx, 16)); mx = fmaxf(mx, __shfl_xor(mx, 32));
        const float pe = expf(logit - mx); float sm = pe; sm += __shfl_xor(sm, 4); sm += __shfl_xor(sm, 8); sm += __shfl_xor(sm, 16); sm += __shfl_xor(sm, 32);
        if ((lane & 3) == 0) aff[(size_t)row * 16 + e_me] = pe / sm;
    }
    __syncthreads();
}

__device__ __forceinline__ void phase7(const Ptrs& P, LAS unsigned char* lds, int G) {
    LAS unsigned* keys = (LAS unsigned*)lds;
    LAS unsigned* hist = keys + 4096;
    LAS unsigned* misc = hist + 256;
    LAS int* tokl = (LAS int*)(misc + 32);
    int tid_ = threadIdx.x; asm volatile("" : "+v"(tid_));
    const int tid = tid_, lane = tid & 63, wid = tid >> 6;
    const float* aff = (const float*)(P.ws + WS_AFF); int* idx = (int*)(P.ws + WS_IDX); float* gsel = (float*)(P.ws + WS_GSEL); int* sel = (int*)(P.ws + WS_SEL);
    const bf16_t* hb = (const bf16_t*)(P.ws + WS_HB); bf16_t* xs = (bf16_t*)(P.ws + WS_XS); const float* rstd_h = (const float*)(P.ws + WS_RSTDH); float* rstd_xs = (float*)(P.ws + WS_RSTDXS);
    for (int task = blockIdx.x; task < 128; task += G) {
        const int b = task >> 4, e = task & 15;
        { float kvv[8];
#pragma unroll
          for (int k = 0; k < 8; ++k) kvv[k] = aff[((size_t)b * S_ + tid + NTHREADS * k) * 16 + e];
#pragma unroll
          for (int k = 0; k < 8; ++k) keys[tid + NTHREADS * k] = __float_as_uint(kvv[k]); }
        if (tid == 0) { misc[0] = 0u; misc[1] = 512u; }
        __syncthreads();
        for (int shift = 24; shift >= 0; shift -= 8) {
            if (tid < 256) hist[tid] = 0u;
            __syncthreads();
            const unsigned prefix = misc[0];
#pragma unroll
            for (int j = 0; j < 8; ++j) { const unsigned k = keys[tid * 8 + j]; if (shift == 24 || (k >> (shift + 8)) == prefix) __hip_atomic_fetch_add(&hist[(k >> shift) & 255u], 1u, __ATOMIC_RELAXED, __HIP_MEMORY_SCOPE_WORKGROUP); }
            __syncthreads();
            if (wid == 0) {
                const unsigned kk = misc[1];
                const unsigned h0 = hist[4 * lane], h1 = hist[4 * lane + 1], h2 = hist[4 * lane + 2], h3 = hist[4 * lane + 3];
                const unsigned s = h0 + h1 + h2 + h3;
                unsigned incl = s;
#pragma unroll
                for (int o = 1; o < 64; o <<= 1) { const unsigned t = __shfl_down(incl, o); if (lane + o < 64) incl += t; }
                const unsigned excl = incl - s;
                if (excl < kk && kk <= incl) {
                    unsigned rem = kk - excl; unsigned bin;
                    if (rem <= h3) { bin = 3; } else { rem -= h3; if (rem <= h2) { bin = 2; } else { rem -= h2; if (rem <= h1) { bin = 1; } else { rem -= h1; bin = 0; } } }
                    misc[0] = (prefix << 8) | (unsigned)(4 * lane + bin); misc[1] = rem;
                }
            }
            __syncthreads();
        }
        const unsigned thr = misc[0], kk = misc[1];
        unsigned kv[8]; unsigned cg_ = 0, ce = 0;
#pragma unroll
        for (int j = 0; j < 8; ++j) { kv[j] = keys[tid * 8 + j]; cg_ += kv[j] > thr ? 1u : 0u; ce += kv[j] == thr ? 1u : 0u; }
        unsigned ig = cg_, ie = ce;
#pragma unroll
        for (int o = 1; o < 64; o <<= 1) { const unsigned tg = __shfl_up(ig, o), te = __shfl_up(ie, o); if (lane >= o) { ig += tg; ie += te; } }
        if (lane == 63) { misc[8 + wid] = ig; misc[16 + wid] = ie; }
        __syncthreads();
        unsigned bg = ig - cg_, be = ie - ce;
        for (int w = 0; w < wid; ++w) { bg += misc[8 + w]; be += misc[16 + w]; }
#pragma unroll
        for (int j = 0; j < 8; ++j) { const int t = tid * 8 + j; const bool isg = kv[j] > thr, ise = kv[j] == thr; const bool s_ = isg || (ise && be < kk);
            const unsigned slot = bg + (be < kk ? be : kk);
            if (s_) { idx[task * 512 + slot] = t; gsel[task * 512 + slot] = __uint_as_float(kv[j]); tokl[slot] = t; }
            sel[((size_t)b * S_ + t) * 16 + e] = s_ ? (int)slot : -1;
            bg += isg ? 1u : 0u; be += ise ? 1u : 0u; }
        __syncthreads();
        { const int t = tokl[tid]; rstd_xs[(size_t)task * 512 + tid] = rstd_h[(size_t)b * S_ + t]; }
        __syncthreads();
    }
}

__device__ __forceinline__ void phase10(const Ptrs& P, int gw, int NGW, int lane) {
    const bf16_t* hbb = (const bf16_t*)(P.ws + WS_HB); const bf16_t* ybuf = (const bf16_t*)(P.ws + WS_XS); const int* sel = (const int*)(P.ws + WS_SEL);
    f32x4 gf[4];
#pragma unroll
    for (int j = 0; j < 4; ++j) gf[j] = ((const f32x4*)PGFINAL(P))[lane + 64 * j];
    u32x2 hw[4]; int sv = -1;
    if (gw < T_) { const u32x2* hr = (const u32x2*)(hbb + (size_t)gw * D_) + lane;
#pragma unroll
        for (int j = 0; j < 4; ++j) hw[j] = ld_g<14>(hr + 64 * j);
        sv = sel[(size_t)gw * 16 + (lane & 15)]; }
    for (int row = gw; row < T_; row += NGW) {
        f32x4 v[4];
#pragma unroll
        for (int j = 0; j < 4; ++j) { v[j][0] = bflo(hw[j].x); v[j][1] = bfhi(hw[j].x); v[j][2] = bflo(hw[j].y); v[j][3] = bfhi(hw[j].y); }
        const int svc = sv; const int b = row >> 12;
        unsigned mask = (unsigned)(__ballot(svc >= 0) & 0xffffull);
        const int nrow = row + NGW;
        if (nrow < T_) { const u32x2* hr = (const u32x2*)(hbb + (size_t)nrow * D_) + lane;
#pragma unroll
            for (int j = 0; j < 4; ++j) hw[j] = ld_g<14>(hr + 64 * j);
            sv = sel[(size_t)nrow * 16 + (lane & 15)]; }
        while (mask) {
            const int e0 = __builtin_ctz(mask); mask &= mask - 1u; const bool two = mask != 0u; const int e1 = two ? __builtin_ctz(mask) : e0; if (two) mask &= mask - 1u;
            const int s0 = __builtin_amdgcn_readlane(svc, e0), s1 = __builtin_amdgcn_readlane(svc, e1);
            const u32x2* y0 = (const u32x2*)(ybuf + ((size_t)(b * 16 + e0) * 512 + s0) * D_) + lane; const u32x2* y1 = (const u32x2*)(ybuf + ((size_t)(b * 16 + e1) * 512 + s1) * D_) + lane;
            u32x2 w0[4], w1[4];
#pragma unroll
            for (int j = 0; j < 4; ++j) { w0[j] = ld_g<14>(y0 + 64 * j); w1[j] = ld_g<14>(y1 + 64 * j); }
            const float f1 = two ? 1.0f : 0.0f;
#pragma unroll
            for (int j = 0; j < 4; ++j) { v[j][0] += bflo(w0[j].x) + f1 * bflo(w1[j].x); v[j][1] += bfhi(w0[j].x) + f1 * bfhi(w1[j].x); v[j][2] += bflo(w0[j].y) + f1 * bflo(w1[j].y); v[j][3] += bfhi(w0[j].y) + f1 * bfhi(w1[j].y); }
        }
        float ss = 0.f;
#pragma unroll
        for (int j = 0; j < 4; ++j) ss += (v[j][0] * v[j][0] + v[j][1] * v[j][1]) + (v[j][2] * v[j][2] + v[j][3] * v[j][3]);
        ss = wave_sum(ss); const float rs = rsqrtf(ss * (1.0f / 1024.0f) + EPS_);
        f32x4* orow = (f32x4*)(P.out + (size_t)row * D_) + lane;
#pragma unroll
        for (int j = 0; j < 4; ++j) st_g<9>(orow + 64 * j, v[j] * rs * gf[j]);
    }
}

#ifndef MK_LAUNCHES
#define MK_LAUNCHES 1
#endif
constexpr int NPHASES = 11;

__global__ void __launch_bounds__(NTHREADS, 2) mk_fwd(Args args) {
    extern __shared__ __attribute__((aligned(16))) unsigned char lds_raw[];
    LAS unsigned char* lds = (LAS unsigned char*)lds_raw;
    cg::grid_group grid = cg::this_grid();
    const int tid = threadIdx.x, lane = tid & 63; const int wave = __builtin_amdgcn_readfirstlane(tid >> 6);
    const int G = gridDim.x; int bx = blockIdx.x; int vcu = (G % 8 == 0) ? (bx % 8) * (G / 8) + bx / 8 : bx;
    int gw = vcu * 8 + wave; const int NGW = G * 8;
    const Args& P = args;
    unsigned char* ws = args.ws; unsigned char* dob = (unsigned char*)args.out;
    const int lo = args.ph_lo, hi = args.ph_hi;
    volatile LAS unsigned* xst = (volatile LAS unsigned*)(lds + LDS_BYTES - 16);
    if (tid < 12) ((volatile LAS unsigned*)(lds + LDS_BYTES - 48))[tid] = 0u;
    __syncthreads();
    XcdBarrier xbar; xbar.bar = (unsigned*)(args.ws + WS_CTL); xbar.x = 0; xbar.st = xst;
    if (args.coop) xbar = xcd_barrier_post((unsigned*)(args.ws + WS_CTL), xst);
#ifndef MK_ONLY
#define MK_ONLY -1
#endif
#define IN(k) ((MK_ONLY < 0 || MK_ONLY == (k)) && lo <= (k) && (k) < hi)
#ifndef MK_REPEAT
#define MK_REPEAT -1
#endif
#define REPS(k) ((MK_REPEAT == (k)) ? 2 : 1)
#ifndef MLA_CALL
#define MLA_CALL att::attn_unit_mla3<0>(lds, A, bh >> 3, bh & 7, U & 15)
#endif
#ifndef ATT_MEM_CALL
#define ATT_MEM_CALL att::attn_unit<128, 128, 1, false>(lds, A, bh >> 2, bh & 3, U & 15)
#endif
#ifndef NA_NS
#define NA_NS na3
#endif
#ifndef MK_NA_V1
#define MK_NA_V1 0
#endif
#ifndef MK_CG_SEAMS
#define MK_CG_SEAMS 0
#endif
#define SEAM(k) do { if (IN(k) && IN((k) + 1)) { if ((k) < MK_CG_SEAMS) grid.sync(); else xcd_barrier(xbar); } } while (0)

    if (args.pad == 0x5eed) grid.sync();
    if (IN(0)) for (int rep = 0; rep < REPS(0); ++rep) { if (rep) xcd_barrier(xbar); phase0(P, lds, gw, NGW, wave, lane); }
    SEAM(0);
#ifndef MK_XCC_ORDER
#define MK_XCC_ORDER 0
#endif
    if (MK_XCC_ORDER && args.coop && lo == 0 && hi > 1 && (G % 8) == 0) {
        if (tid == 0) { unsigned* bar = (unsigned*)(args.ws + WS_CTL); bool ok = true;
#pragma unroll
            for (unsigned j = 0; j < 16; ++j) { const unsigned c = xb_ld(&bar[XB_XCNT(j)]); ok = ok && (c == (j < 8 ? (unsigned)(G / 8) : 0u)); }
            ((volatile LAS unsigned*)(lds + LDS_BYTES - 32))[0] = ok ? 1u : 0u; }
        __syncthreads();
        if (((volatile LAS unsigned*)(lds + LDS_BYTES - 32))[0]) { bx = (int)(xst[2] * 8u + xst[3]); vcu = (bx % 8) * (G / 8) + bx / 8; gw = vcu * 8 + wave; }
        __syncthreads();
    }
    if (IN(1)) for (int rep = 0; rep < REPS(1); ++rep) { if (rep) xcd_barrier(xbar);
        SchedP1 S{bx, G, (const char*)XB_PTR(P), (const char*)(ws + WS_WIN), (const char*)(ws + WS_MEMB), (const char*)(ws + WS_WMK)};
        EpiP1 E{(const float*)(ws + WS_RSTDX), (const float*)(ws + WS_RSTDM), (bf16_t*)(ws + WS_NA), (bf16_t*)(ws + WS_ZC), (bf16_t*)(ws + WS_ZQM), (bf16_t*)(ws + WS_ZG), (bf16_t*)(ws + WS_KVMEM),
                (bf16_t*)(dob + DO_KPE), (float*)(ws + WS_SSQQ), (float*)(ws + WS_SSQKV), (const float*)(ws + WS_ROPE),
                __builtin_amdgcn_make_buffer_rsrc((void*)ws, (short)0, (int)WS_END, 0x00020000), (const char*)ws};
#ifndef MK_P1_SKEW
#define MK_P1_SKEW 1300
#endif
        if (EX_N1A > 0 && G == 256) { if (bx >= 160) p0_expert_range(P, lds, 0, EX_N1A, (bx - 160) * 8 + wave, 768, wave, lane); __syncthreads(); }
        else if (MK_P1_SKEW > 0 && G == 256) {
            const unsigned long long dly = (bx >= 160) ? (unsigned long long)MK_P1_SKEW : 0ull;
            const unsigned long long t0 = __builtin_amdgcn_s_memrealtime();
            while (__builtin_amdgcn_s_memrealtime() - t0 < dly) __builtin_amdgcn_s_sleep(32);
        }
        pg8::gemm_phase<EpiP1, SchedP1, false>(lds, 1024, 1024, S, E);
        if (EX_DEFER > 0) { if (G == 256) { if (bx >= 160) p0_expert_range(P, lds, EX_N1A, EX_N1, (bx - 160) * 8 + wave, 768, wave, lane); }
                            else p0_expert_range(P, lds, 0, EX_DEFER, gw, NGW, wave, lane); }
    }
    SEAM(1);
    if (IN(2)) for (int rep = 0; rep < REPS(2); ++rep) { if (rep) xcd_barrier(xbar);
        SchedP2 S{bx, G, (const char*)(ws + WS_ZC), (const char*)(ws + WS_WUQ), (const char*)(ws + WS_WUKV)};
        EpiP2 E{(const float*)(ws + WS_SSQQ), (const float*)(ws + WS_SSQKV), (bf16_t*)(dob + DO_QMLA), (bf16_t*)(dob + DO_KVBUF), (const float*)(ws + WS_ROPE)};
        pg8::gemm_phase<EpiP2, SchedP2, false>(lds, 768, 384, S, E);
        if (EX_N2 > 0 && G == 256 && bx >= 128) p0_expert_range(P, lds, EX_N1A + EX_N1, EX_N2, (bx - 128) * 8 + wave, 1024, wave, lane);
    }
    SEAM(2);
    if (IN(3)) {
#ifdef MK_ABL
        { att::AttnArgs A{(const bf16_t*)(dob + DO_QMLA), (const bf16_t*)(dob + DO_KVBUF), (const bf16_t*)(dob + DO_KPE), (const bf16_t*)(dob + DO_KVBUF) + 512, (bf16_t*)(ws + WS_ZC), nullptr};
          for (int U = vcu; U < 1024; U += G) { const int bh = U >> 4; att::attn_unit_mla3<MK_ABL>(lds, A, bh >> 3, bh & 7, U & 15); } xcd_barrier(xbar); }
#endif
        { att::AttnArgs A{(const bf16_t*)(dob + DO_QMLA), (const bf16_t*)(dob + DO_KVBUF), (const bf16_t*)(dob + DO_KPE), (const bf16_t*)(dob + DO_KVBUF) + 512, (bf16_t*)(ws + WS_ZC), nullptr};
          for (int rep = 0; rep < REPS(30); ++rep) { if (rep) xcd_barrier(xbar);
          for (int U = vcu; U < 1024; U += G) { const int bh = U >> 4; MLA_CALL; } } }
        NA_NS::na_phase(lds, (const bf16_t*)(ws + WS_NA), (const bf16_t*)(ws + WS_NA) + (size_t)T_ * 512, (const bf16_t*)(ws + WS_NA) + (size_t)2 * T_ * 512, (bf16_t*)(ws + WS_NA), args.in[4], vcu, G, -1);
        { att::AttnArgs A{(const bf16_t*)(ws + WS_ZQM), (const bf16_t*)(ws + WS_KVMEM), nullptr, (const bf16_t*)(ws + WS_KVMEM) + 512, (bf16_t*)(ws + WS_ZQM), nullptr};
          for (int U = vcu; U < 512; U += G) { const int bh = U >> 4; ATT_MEM_CALL; } }
    }
    SEAM(3);
    if (IN(4)) for (int rep = 0; rep < REPS(4); ++rep) { if (rep) xcd_barrier(xbar);
        SchedP4 S{bx, G, (const char*)(ws + WS_NA), (const char*)(ws + WS_ZC), (const char*)(ws + WS_ZQM), (const char*)(ws + WS_WO)};
#ifndef MK_P4_NOHOOK
#define MK_P4_NOHOOK 0
#endif
        EpiP4 E{(const bf16_t*)(ws + WS_ZG), (bf16_t*)(dob + DO_MERGED), (MK_P4_NOHOOK && REPS(4) == 2 && rep == 0) ? 1 : 0};
#ifndef MK_P4_SKEW
#define MK_P4_SKEW 0
#endif
        if (MK_P4_SKEW > 0) {
            const unsigned long long dly = (bx & 8) ? (unsigned long long)MK_P4_SKEW : 0ull;
            const unsigned long long t0 = __builtin_amdgcn_s_memrealtime();
            while (__builtin_amdgcn_s_memrealtime() - t0 < dly) __builtin_amdgcn_s_sleep(32);
        }
        pg8::gemm_phase<EpiP4, SchedP4, true>(lds, 512, 1536, S, E);
    }
    SEAM(4);
    if (IN(5)) for (int rep = 0; rep < REPS(5); ++rep) { if (rep) xcd_barrier(xbar);
        SchedP5 S{bx, G, (const char*)(dob + DO_MERGED), (const char*)(ws + WS_WOUT)};
        EpiP5 E{(bf16_t*)(ws + WS_H)};
        pg8::gemm_phase<EpiP5, SchedP5, false>(lds, 1024, 1024, S, E);
    }
    SEAM(5);
    if (IN(6)) for (int rep = 0; rep < REPS(6); ++rep) { if (rep) xcd_barrier(xbar); phase6(P, lds, gw, NGW, lane); }
    SEAM(6);
    if (IN(7)) for (int rep = 0; rep < REPS(7); ++rep) { if (rep) xcd_barrier(xbar); phase7(P, lds, G);
        if (EX_N3 > 0 && G == 256 && (int)blockIdx.x >= 128) p0_expert_range(P, lds, EX_N1A + EX_N1 + EX_N2, EX_N3, ((int)blockIdx.x - 128) * 8 + wave, 1024, wave, lane); }
    SEAM(7);
    if (IN(8)) for (int rep = 0; rep < REPS(8); ++rep) { if (rep) xcd_barrier(xbar);
        SchedP8 S{bx, G, (const char*)(ws + WS_HB), (const char*)(ws + WS_WGU)};
        EpiP8 E{(const float*)(ws + WS_RSTDXS), (bf16_t*)(dob + DO_ACT)};
        LAS int* gtab = (LAS int*)(lds + pg8::STAGE_BYTES);
        { const int* idxg = (const int*)(ws + WS_IDX); pg8::Unit u_; int rowv[8], tokv[8];
#pragma unroll
          for (int i = 0; i < 8; ++i) { rowv[i] = S.next(i, u_) ? u_.pm * 256 + (tid & 255) : -1; }
#pragma unroll
          for (int i = 0; i < 8; ++i) tokv[i] = (rowv[i] >= 0) ? idxg[rowv[i]] : 0;
#pragma unroll
          for (int i = 0; i < 8; ++i) if (rowv[i] >= 0 && tid < 256) gtab[i * 256 + tid] = tokv[i] + (rowv[i] >> 13) * S_;
          __syncthreads(); }
        pg8::gemm_phase<EpiP8, SchedP8, false, true>(lds, 1024, 1024, S, E, gtab);
    }
    SEAM(8);
    if (IN(9)) for (int rep = 0; rep < REPS(9); ++rep) { if (rep) xcd_barrier(xbar);
        SchedP9 S{bx, G, (const char*)(dob + DO_ACT), (const char*)(ws + WS_WD)};
        EpiP9 E{(const float*)(ws + WS_GSEL), (bf16_t*)(ws + WS_XS)};
        pg8::gemm_phase<EpiP9, SchedP9, false>(lds, 1024, 1024, S, E);
    }
    SEAM(9);
    if (IN(10)) for (int rep = 0; rep < REPS(10); ++rep) { if (rep) xcd_barrier(xbar); phase10(P, gw, NGW, lane); }
#undef IN
#undef SEAM
}

extern "C" void kernel_launch(void* const* d_in, const int* in_sizes, int n_in, void* d_out, int out_size, void* d_ws, size_t ws_size, hipStream_t stream) {
    static int grid = 0;
    if (grid == 0) {
        if (n_in != 22 || out_size != T_ * D_ || ws_size < WS_END) { fprintf(stderr, "kernel_launch: unexpected shapes (n_in %d out %d ws %zu)\n", n_in, out_size, ws_size); grid = -1; return; }
        int dev = 0, cus = 0, per_cu = 0;
        hipGetDevice(&dev); hipDeviceGetAttribute(&cus, hipDeviceAttributeMultiprocessorCount, dev);
        if (hipFuncSetAttribute((const void*)mk_fwd, hipFuncAttributeMaxDynamicSharedMemorySize, LDS_BYTES) != hipSuccess) { fprintf(stderr, "kernel_launch: hipFuncSetAttribute failed\n"); grid = -1; return; }
        hipOccupancyMaxActiveBlocksPerMultiprocessor(&per_cu, (const void*)mk_fwd, NTHREADS, LDS_BYTES);
        (void)hipGetLastError();
        if (per_cu < 1) { fprintf(stderr, "kernel_launch: occupancy query says %d blocks per CU\n", per_cu); per_cu = 1; }
        grid = cus * 1;
        fprintf(stderr, "kernel_launch: cus %d per_cu %d grid %d ws %zu\n", cus, per_cu, grid, ws_size);
    }
    if (grid < 0) return;
    if (hipMemsetAsync((char*)d_ws + WS_CTL, 0, CTL_BYTES, stream) != hipSuccess) { fprintf(stderr, "kernel_launch: memset failed\n"); return; }
    Args a{};
    for (int i = 0; i < 22; ++i) a.in[i] = (const float*)d_in[i];
    a.out = (float*)d_out; a.ws = (unsigned char*)d_ws;
#if MK_LAUNCHES == 1
    a.ph_lo = 0; a.ph_hi = NPHASES; a.coop = 1;
    void* kargs[] = {&a};
    hipError_t e = hipLaunchCooperativeKernel((const void*)mk_fwd, dim3(grid), dim3(NTHREADS), kargs, LDS_BYTES, stream);
    if (e != hipSuccess) fprintf(stderr, "kernel_launch: cooperative launch failed: %s (grid %d)\n", hipGetErrorString(e), grid);
#else
    for (int p = 0; p < NPHASES; ++p) { a.ph_lo = p; a.ph_hi = p + 1; a.coop = 0; hipLaunchKernelGGL(mk_fwd, dim3(grid), dim3(NTHREADS), LDS_BYTES, stream, a); }
#endif
}
```

```cpp
#include <hip/hip_runtime.h>
#include <hip/hip_cooperative_groups.h>
#include <cstdio>
#include <cstdint>
namespace cg = cooperative_groups;

#define LAS __attribute__((address_space(3)))
typedef unsigned short bf16_t;
typedef short bf16x8 __attribute__((ext_vector_type(8)));
typedef short s16x4 __attribute__((ext_vector_type(4)));
typedef float f32x2 __attribute__((ext_vector_type(2)));
typedef float f32x4 __attribute__((ext_vector_type(4)));
typedef float f32x16 __attribute__((ext_vector_type(16)));
typedef unsigned u32x2 __attribute__((ext_vector_type(2)));
typedef unsigned u32x4 __attribute__((ext_vector_type(4)));

constexpr int T_ = 32768, S_ = 4096, D_ = 1024, NB_ = 8, INC_ = 5792, NZ_ = 5888;
constexpr float EPS_ = 1e-6f;
constexpr float LOG2E = 1.4426950408889634f;
constexpr float C_NA = 0.125f * LOG2E, C_MLA = 0.10206207261596577f * LOG2E, C_MEM = 0.08838834764831845f * LOG2E;

constexpr size_t MiB = (size_t)1 << 20;
constexpr size_t WS_WIN = 0;
constexpr size_t WS_WUQ = 12 * MiB;
constexpr size_t WS_WUKV = 13 * MiB;
constexpr size_t WS_WMK = 14 * MiB;
constexpr size_t WS_WO = 16 * MiB;
constexpr size_t WS_WOUT = 19 * MiB;
constexpr size_t WS_WGU = 21 * MiB;
constexpr size_t WS_WD = 85 * MiB;
constexpr size_t WS_RSTDX = 117 * MiB;
constexpr size_t WS_RSTDM = WS_RSTDX + 128 * 1024;
constexpr size_t WS_RSTDH = WS_RSTDM + 128 * 1024;
constexpr size_t WS_ROPE = WS_RSTDH + 128 * 1024;
constexpr size_t WS_RSTDXS = WS_ROPE + 128 * 1024;
constexpr size_t WS_GSEL = WS_RSTDXS + 256 * 1024;
constexpr size_t WS_IDX = WS_GSEL + 256 * 1024;
constexpr size_t WS_SSQQ = 119 * MiB;
constexpr size_t WS_SSQKV = 121 * MiB;
constexpr size_t WS_AFF = 122 * MiB;
constexpr size_t WS_SEL = 124 * MiB;
constexpr size_t WS_MEMB = 126 * MiB;
constexpr size_t WS_KVMEM = 130 * MiB;
constexpr size_t WS_ZG = 134 * MiB;
constexpr size_t WS_H = 134 * MiB;
constexpr size_t WS_HB = 262 * MiB;
constexpr size_t WS_NA = 326 * MiB;
constexpr size_t WS_XS = 326 * MiB;
constexpr size_t WS_ZC = 422 * MiB;
constexpr size_t WS_ZQM = 470 * MiB;
constexpr size_t WS_CTL = 502 * MiB;
constexpr size_t CTL_BYTES = 16384;
constexpr size_t WS_END = 503 * MiB;
constexpr size_t DO_XB = 0, DO_QMLA = 0, DO_KVBUF = 48 * MiB, DO_KPE = 112 * MiB, DO_MERGED = 0, DO_ACT = 0;

constexpr int LDS_BYTES = 147456;
constexpr int NTHREADS = 512;

typedef __bf16 bf16x2_t __attribute__((ext_vector_type(2)));
__device__ __forceinline__ unsigned cvt_pk_bf16(float lo, float hi) { const f32x2 v = {lo, hi}; const bf16x2_t b = __builtin_convertvector(v, bf16x2_t); return __builtin_bit_cast(unsigned, b); }
__device__ __forceinline__ float bf2f(unsigned short b) { return __uint_as_float(((unsigned)b) << 16); }
__device__ __forceinline__ float bflo(unsigned w) { return __uint_as_float(w << 16); }
__device__ __forceinline__ float bfhi(unsigned w) { return __uint_as_float(w & 0xffff0000u); }
__device__ __forceinline__ float wave_sum(float v) {
#pragma unroll
    for (int o = 1; o < 64; o <<= 1) v += __shfl_xor(v, o);
    return v;
}
__device__ __forceinline__ float fast_exp2(float x) { return __builtin_amdgcn_exp2f(x); }
__device__ __forceinline__ float fast_rcp(float x) { return __builtin_amdgcn_rcpf(x); }
__device__ __forceinline__ int crow(int r, int hi) { return (r & 3) + 8 * (r >> 2) + 4 * hi; }


#define XB_TMO      128
#define XB_XCNT(j)  (256  + 64 * (j))
#define XB_XSUB(j)  (1280 + 64 * (j))
#define XB_XGEN(j)  (2304 + 64 * (j))
#define XB_TOP      3328
#define XB_TOPGEN   3392
#define XCD_BAR_WORDS 3456
#define XB_SPIN_CAP (1u << 18)
__device__ __forceinline__ unsigned xb_ld(unsigned* p)              { return __hip_atomic_load(p, __ATOMIC_RELAXED, __HIP_MEMORY_SCOPE_AGENT); }
__device__ __forceinline__ unsigned xb_add(unsigned* p, unsigned v) { return __hip_atomic_fetch_add(p, v, __ATOMIC_RELAXED, __HIP_MEMORY_SCOPE_AGENT); }
__device__ __forceinline__ unsigned xb_xcc_id() { return (unsigned)__builtin_amdgcn_s_getreg((3 << 11) | 20) & 0xFu; }
#define XB_SPIN(cond, bar) do { unsigned _sp = 0; while (cond) { __builtin_amdgcn_s_sleep(1); \
    if ((++_sp & 255u) == 0u) { if (xb_ld(&(bar)[XB_TMO])) break; if (_sp > XB_SPIN_CAP) { atomicAdd(&(bar)[XB_TMO], 1u); break; } } } } while (0)
struct XcdBarrier { unsigned* bar; unsigned x; volatile LAS unsigned* st; };
__device__ __forceinline__ XcdBarrier xcd_barrier_post(unsigned* bar, volatile LAS unsigned* st) {
    XcdBarrier b; b.bar = bar; b.x = xb_xcc_id(); b.st = st;
    if (threadIdx.x == 0) { const unsigned rank = xb_add(&bar[XB_XCNT(b.x)], 1u); st[2] = rank; st[3] = b.x; }
    return b;
}
__device__ __forceinline__ void xcd_barrier_complete(unsigned* bar, unsigned x, unsigned& nloc, unsigned& nx) {
    const unsigned G = gridDim.x * gridDim.y * gridDim.z;
    unsigned sum, cnt, mine, sp = 0u;
    for (;;) {
        sum = 0u; cnt = 0u; mine = 0u;
#pragma unroll
        for (unsigned j = 0; j < 16; ++j) { const unsigned c = xb_ld(&bar[XB_XCNT(j)]); sum += c; cnt += (c > 0u) ? 1u : 0u; mine = (j == x) ? c : mine; }
        if (sum == G) break;
        __builtin_amdgcn_s_sleep(1);
        if ((++sp & 255u) == 0u) { if (xb_ld(&bar[XB_TMO])) break; if (sp > XB_SPIN_CAP) { atomicAdd(&bar[XB_TMO], 1u); break; } }
    }
    nloc = mine > 0u ? mine : 1u; nx = cnt > 0u ? cnt : 1u;
}
__device__ __forceinline__ void xcd_barrier(const XcdBarrier& b) {
    asm volatile("s_waitcnt vmcnt(0)" ::: "memory");
    __syncthreads();
    if (threadIdx.x == 0) {
        unsigned* bar = b.bar;
        __builtin_amdgcn_s_waitcnt(0);
        unsigned nloc = b.st[0], nx = b.st[1];
        if (nloc == 0u) { xcd_barrier_complete(bar, b.x, nloc, nx); b.st[0] = nloc; b.st[1] = nx; }
        const unsigned old = xb_add(&bar[XB_XSUB(b.x)], 1u);
        const unsigned gen = old / nloc;
        if (old + 1u == (gen + 1u) * nloc) {
            __builtin_amdgcn_fence(__ATOMIC_RELEASE, "agent");
            asm volatile("s_waitcnt vmcnt(0)" ::: "memory");
            const unsigned og = xb_add(&bar[XB_TOP], 1u);
            const unsigned tg = og / nx;
            if (og + 1u == (tg + 1u) * nx) xb_add(&bar[XB_TOPGEN], 1u);
            else XB_SPIN(xb_ld(&bar[XB_TOPGEN]) == tg, bar);
            __builtin_amdgcn_fence(__ATOMIC_ACQUIRE, "agent");
            xb_add(&bar[XB_XGEN(b.x)], 1u);
            asm volatile("s_waitcnt vmcnt(0)" ::: "memory");
        } else {
            XB_SPIN(xb_ld(&bar[XB_XGEN(b.x)]) == gen, bar);
            __builtin_amdgcn_fence(__ATOMIC_ACQUIRE, "agent");
            asm volatile("s_waitcnt vmcnt(0)" ::: "memory");
        }
    }
    __syncthreads();
}

struct Args { const float* in[22]; float* out; unsigned char* ws; int ph_lo, ph_hi, coop, pad; };

#ifndef MK_NT
#define MK_NT 0x3001
#endif
template <int BIT, class V> __device__ __forceinline__ void st_g(V* p, const V v) { if constexpr ((MK_NT >> BIT) & 1) __builtin_nontemporal_store(v, p); else *p = v; }
template <int BIT, class V> __device__ __forceinline__ V ld_g(const V* p) { if constexpr ((MK_NT >> BIT) & 1) return __builtin_nontemporal_load(p); else return *p; }
#ifndef MK_XB_HB
#define MK_XB_HB 0
#endif
#if MK_XB_HB
#define XB_PTR(P) ((bf16_t*)((P).ws + WS_HB))
#else
#define XB_PTR(P) ((bf16_t*)(((unsigned char*)(P).out) + DO_XB))
#endif

namespace pg8 {
#ifndef PG8_WGM
#define PG8_WGM 8
#endif
constexpr int BM = 256, BK = 64, HALF = 128, HTB = HALF * BK * 2, STAGE_BYTES = 8 * HTB, NXCD = 8, WGM = PG8_WGM;
__device__ __forceinline__ int lds_byte(int r, int c) { const int st = (r >> 4) * 2 + (c >> 5), rr = r & 15, cc = c & 31, ob = rr * 64 + cc * 2; return st * 1024 + (ob ^ (((ob >> 9) & 1) << 5)); }
__device__ __forceinline__ void stage_rc(int b, int& R, int& C) { const int st = b / 1024, sb = b % 1024, swz = sb ^ (((sb >> 9) & 1) << 5); R = (st >> 1) * 16 + swz / 64; C = (st & 1) * 32 + (swz % 64) / 2; }
__device__ __forceinline__ int perm32(int rho) { const int n = rho >> 4, i = rho & 15; return 8 * (i >> 2) + 4 * n + (i & 3); }

struct Unit { int pm, pn, kind, nt, aux; const char* A; const char* A1; const char* A2; const char* B; };

__device__ __forceinline__ void tile_order(int L, int nM, int nN, int& pm, int& pn) {
    const int nwg = nM * nN; int wgid = L;
    { const int q = nwg / NXCD, r = nwg % NXCD, xcd = wgid % NXCD, off = wgid / NXCD; wgid = (xcd < r ? xcd * (q + 1) : r * (q + 1) + (xcd - r) * q) + off; }
    const int nig = WGM * nN, gid = wgid / nig, fm = gid * WGM, gsz = (nM - fm) < WGM ? (nM - fm) : WGM;
    pm = fm + ((wgid % nig) % gsz); pn = (wgid % nig) / gsz;
}

template <class Epi, class Sched, bool SEG3, bool GATHER = false>
__device__ __forceinline__ void gemm_phase(LAS unsigned char* lds, const int lda, const int ldb, const Sched& S, const Epi& E, const LAS int* gtab = nullptr) {
    int tid_ = threadIdx.x; asm volatile("" : "+v"(tid_));
    const int tid = tid_, wid = __builtin_amdgcn_readfirstlane(tid >> 6), lane = tid & 63, wr = wid >> 2, wc = wid & 3, fr = lane & 15, fq = lane >> 4;
    unsigned voffA[2], voffB[2]; int gR[2]; unsigned gC[2];
#pragma unroll
    for (int i = 0; i < 2; ++i) { int R, C; stage_rc(tid * 16 + i * 8192, R, C); gR[i] = R; gC[i] = (unsigned)C * 2u; const int Rb = Epi::PERM ? ((R & ~31) + perm32(R & 31)) : R;
        voffA[i] = (unsigned)(R * lda + C) * 2u; voffB[i] = (unsigned)(Rb * ldb + C) * 2u; }
    const size_t kstep = (size_t)(BK * 2);
    const size_t hstepA = (size_t)HALF * lda * 2, hstepB = (size_t)HALF * ldb * 2;
    const unsigned ldsw = (unsigned)wid * 1024u;
    const int aoff = lds_byte(wr * 64 + fr, fq * 8), boff = lds_byte(wc * 32 + fr, fq * 8);
#define PG8_SA(b, h) (((b) * 2 + (h)) * HTB)
#define PG8_SB(b, h) ((4 + (b) * 2 + (h)) * HTB)
#define PG8_STAGE(bufoff, gbase, voff) do { _Pragma("unroll") for (int _i = 0; _i < 2; ++_i) \
        __builtin_amdgcn_global_load_lds((const unsigned*)((const char*)(gbase) + (voff)[_i]), (LAS unsigned*)(lds + (bufoff) + ldsw + _i * 8192), 16, 0, 0); } while (0)
#define PG8_GLOAD(dst, ord) do { _Pragma("unroll") for (int _h = 0; _h < 2; ++_h) _Pragma("unroll") for (int _i = 0; _i < 2; ++_i) dst[_h][_i] = (unsigned)gtab[(ord) * 256 + _h * 128 + gR[_i]] * (unsigned)(lda * 2) + gC[_i]; } while (0)
#define PG8_STAGE_A(bufoff, kptr, h, VS) do { if constexpr (GATHER) { PG8_STAGE(bufoff, kptr, VS[h]); } else { PG8_STAGE(bufoff, (kptr) + (h) * hstepA, voffA); } } while (0)
#define PG8_LDA(dst, b, h) do { _Pragma("unroll") for (int m = 0; m < 4; ++m) _Pragma("unroll") for (int k = 0; k < 2; ++k) dst[m][k] = *(const LAS bf16x8*)(lds + PG8_SA(b, h) + aoff + m * 2048 + k * 1024); } while (0)
#define PG8_LDB(dst, b, h) do { _Pragma("unroll") for (int n = 0; n < 2; ++n) _Pragma("unroll") for (int k = 0; k < 2; ++k) dst[n][k] = *(const LAS bf16x8*)(lds + PG8_SB(b, h) + boff + n * 2048 + k * 1024); } while (0)
#define PG8_MMA(ai, bj, At, Bt) do { __builtin_amdgcn_s_setprio(1); _Pragma("unroll") for (int m = 0; m < 4; ++m) _Pragma("unroll") for (int n = 0; n < 2; ++n) _Pragma("unroll") for (int k = 0; k < 2; ++k) \
        acc[ai][bj][m][n] = __builtin_amdgcn_mfma_f32_16x16x32_bf16(Bt[n][k], At[m][k], acc[ai][bj][m][n], 0, 0, 0); __builtin_amdgcn_s_setprio(0); } while (0)
#define PG8_WAIT_V(n) asm volatile("s_waitcnt vmcnt(" #n ")" ::: "memory")
#define PG8_WAIT_L(n) asm volatile("s_waitcnt lgkmcnt(" #n ")" ::: "memory")
#define PG8_BAR __builtin_amdgcn_s_barrier()
#define PG8_SCHED __builtin_amdgcn_sched_barrier(0)
#define PG8_TA(u, kt) (SEG3 ? (((kt) < 8 ? (u).A : ((kt) < 16 ? (u).A1 : (u).A2)) + (size_t)((kt) & 7) * kstep) : ((u).A + (size_t)(kt) * kstep))
#define PG8_TB(u, kt) ((u).B + (size_t)(kt) * kstep)
    Unit cur, nxt; int ui = 0;
    if (!S.next(0, cur)) return;
    f32x4 acc[2][2][4][2];
#pragma unroll
    for (int a = 0; a < 2; ++a)
#pragma unroll
        for (int b = 0; b < 2; ++b)
#pragma unroll
            for (int m = 0; m < 4; ++m)
#pragma unroll
                for (int n = 0; n < 2; ++n) acc[a][b][m][n] = (f32x4){0.f, 0.f, 0.f, 0.f};
    bf16x8 At[4][2], B0[2][2], B1[2][2];
    unsigned vC[2][2], vN[2][2];
#pragma unroll
    for (int _h = 0; _h < 2; ++_h)
#pragma unroll
        for (int _i = 0; _i < 2; ++_i) { vC[_h][_i] = 0u; vN[_h][_i] = 0u; }
    if constexpr (GATHER) { PG8_GLOAD(vC, cur.aux); }
    {
        const char* cA = PG8_TA(cur, 0); const char* cB = PG8_TB(cur, 0);
        PG8_STAGE(PG8_SB(0, 0), cB, voffB); PG8_STAGE(PG8_SB(0, 1), cB + hstepB, voffB); PG8_STAGE_A(PG8_SA(0, 0), cA, 0, vC); PG8_STAGE_A(PG8_SA(0, 1), cA, 1, vC);
        if (wr == 1) PG8_BAR;
        PG8_WAIT_V(2); PG8_BAR;
        const char* cA1 = PG8_TA(cur, 1); const char* cB1 = PG8_TB(cur, 1);
        PG8_STAGE(PG8_SB(1, 0), cB1, voffB); PG8_STAGE_A(PG8_SA(1, 0), cA1, 0, vC); PG8_STAGE(PG8_SB(1, 1), cB1 + hstepB, voffB);
        PG8_WAIT_V(6); PG8_BAR;
    }
    for (;;) {
        const bool has_next = S.next(ui + 1, nxt);
        if constexpr (GATHER) { if (has_next) PG8_GLOAD(vN, nxt.aux); }
        const int nt = cur.nt;
        for (int t = 0; t < nt; t += 2) {
            const bool last = (t == nt - 2);
            const char* a1 = PG8_TA(cur, t + 1);
            const char* a2; const char* b2;
            if (last) { if (has_next) { a2 = PG8_TA(nxt, 0); b2 = PG8_TB(nxt, 0); } else { a2 = PG8_TA(cur, 0); b2 = PG8_TB(cur, 0); } }
            else { a2 = PG8_TA(cur, t + 2); b2 = PG8_TB(cur, t + 2); }
            const char* a3 = a2 + kstep; const char* b3 = b2 + kstep;
            unsigned vS[2][2];
#pragma unroll
            for (int _h = 0; _h < 2; ++_h)
#pragma unroll
                for (int _i = 0; _i < 2; ++_i) vS[_h][_i] = (last && has_next) ? vN[_h][_i] : vC[_h][_i];
            if constexpr (Epi::HAS_MID) { if (t > 0 && (t & 7) == 0) E.mid(acc, cur, t >> 3, wr, wc, fr, fq); }
            PG8_LDB(B0, 0, 0); PG8_LDB(B1, 0, 1); PG8_SCHED; PG8_LDA(At, 0, 0); PG8_STAGE_A(PG8_SA(1, 1), a1, 1, vC);
            PG8_WAIT_V(8); PG8_WAIT_L(0); PG8_BAR; PG8_MMA(0, 0, At, B0); PG8_MMA(0, 1, At, B1); PG8_BAR; PG8_SCHED;
            PG8_LDA(At, 0, 1); PG8_STAGE(PG8_SB(0, 0), b2, voffB); PG8_STAGE(PG8_SB(0, 1), b2 + hstepB, voffB); PG8_STAGE_A(PG8_SA(0, 0), a2, 0, vS);
            PG8_WAIT_V(8); PG8_WAIT_L(0); PG8_BAR; PG8_MMA(1, 0, At, B0); PG8_MMA(1, 1, At, B1); PG8_BAR; PG8_SCHED;
            PG8_LDB(B0, 1, 0); PG8_LDB(B1, 1, 1); PG8_SCHED; PG8_LDA(At, 1, 0); PG8_STAGE_A(PG8_SA(0, 1), a2, 1, vS);
            PG8_WAIT_V(8); PG8_WAIT_L(0); PG8_BAR; PG8_MMA(0, 0, At, B0); PG8_MMA(0, 1, At, B1); PG8_BAR; PG8_SCHED;
            PG8_LDA(At, 1, 1); PG8_STAGE(PG8_SB(1, 0), b3, voffB); PG8_STAGE(PG8_SB(1, 1), b3 + hstepB, voffB); PG8_STAGE_A(PG8_SA(1, 0), a3, 0, vS);
            PG8_WAIT_V(8); PG8_WAIT_L(0); PG8_BAR; PG8_MMA(1, 0, At, B0); PG8_MMA(1, 1, At, B1); PG8_BAR; PG8_SCHED;
        }
        if (wr == 0) PG8_BAR;
        E(acc, cur, wr, wc, fr, fq);
        if (!has_next) break;
        if constexpr (Epi::HAS_GATE) E.gate(ui + 1);
#pragma unroll
        for (int a = 0; a < 2; ++a)
#pragma unroll
            for (int b = 0; b < 2; ++b)
#pragma unroll
                for (int m = 0; m < 4; ++m)
#pragma unroll
                    for (int n = 0; n < 2; ++n) acc[a][b][m][n] = (f32x4){0.f, 0.f, 0.f, 0.f};
        cur = nxt; ++ui;
#pragma unroll
        for (int _h = 0; _h < 2; ++_h)
#pragma unroll
            for (int _i = 0; _i < 2; ++_i) vC[_h][_i] = vN[_h][_i];
        if (wr == 1) PG8_BAR;
    }
    PG8_WAIT_V(0);
    PG8_BAR;
#undef PG8_SA
#undef PG8_SB
#undef PG8_STAGE
#undef PG8_STAGE_A
#undef PG8_GLOAD
#undef PG8_LDA
#undef PG8_LDB
#undef PG8_MMA
#undef PG8_WAIT_V
#undef PG8_WAIT_L
#undef PG8_BAR
#undef PG8_SCHED
#undef PG8_TA
#undef PG8_TB
}
}

__device__ __forceinline__ u32x4 pack8(const f32x4 v0, const f32x4 v1) { u32x4 w; w.x = cvt_pk_bf16(v0[0], v0[1]); w.y = cvt_pk_bf16(v0[2], v0[3]); w.z = cvt_pk_bf16(v1[0], v1[1]); w.w = cvt_pk_bf16(v1[2], v1[3]); return w; }
__device__ __forceinline__ void rope8(f32x4& v0, f32x4& v1, int row, int fq, const float* rope) {
    const int t = row & (S_ - 1); const int pos = (fq >> 1) ? (t & 63) : (t >> 6);
    const f32x4* cs = (const f32x4*)(rope + (pos * 8 + 4 * (fq & 1)) * 2);
    const f32x4 c01 = cs[0], c23 = cs[1];
    float a, b;
    a = v0[0]; b = v0[1]; v0[0] = a * c01[0] - b * c01[1]; v0[1] = a * c01[1] + b * c01[0];
    a = v0[2]; b = v0[3]; v0[2] = a * c01[2] - b * c01[3]; v0[3] = a * c01[3] + b * c01[2];
    a = v1[0]; b = v1[1]; v1[0] = a * c23[0] - b * c23[1]; v1[1] = a * c23[1] + b * c23[0];
    a = v1[2]; b = v1[3]; v1[2] = a * c23[2] - b * c23[3]; v1[3] = a * c23[3] + b * c23[2];
}

#ifndef MK_GATE_U8
#define MK_GATE_U8 0
#endif
__device__ __forceinline__ unsigned gate_q(float x) { x = fminf(fmaxf(x, -30.f), 30.f); const float sg = fast_rcp(1.0f + fast_exp2(-LOG2E * x)); return (unsigned)fminf(fmaxf(__builtin_rintf(sg * 255.0f), 1.0f), 255.0f); }
__device__ __forceinline__ u32x2 gate_pack8(const f32x4 v0, const f32x4 v1) { u32x2 w;
    w.x = gate_q(v0[0]) | (gate_q(v0[1]) << 8) | (gate_q(v0[2]) << 16) | (gate_q(v0[3]) << 24); w.y = gate_q(v1[0]) | (gate_q(v1[1]) << 8) | (gate_q(v1[2]) << 16) | (gate_q(v1[3]) << 24); return w; }
__device__ __forceinline__ float ub(unsigned w, int k) { return (float)((w >> (8 * k)) & 0xffu); }
__device__ __forceinline__ float sig_den(float x) { x = fminf(fmaxf(x, -30.f), 30.f); return 1.0f + fast_exp2(-LOG2E * x); }
#ifndef MK_SC1_P1
#define MK_SC1_P1 0
#endif
struct EpiP1 {
    static constexpr bool PERM = true, HAS_MID = false, HAS_GATE = true;
    const float* rstd_x; const float* rstd_m; bf16_t* na; bf16_t* zc; bf16_t* zqm; bf16_t* zg; bf16_t* kvmem; bf16_t* kpe; float* ssq_q; float* ssq_kv; const float* rope;
    unsigned* xflag; unsigned xneed;
    __device__ __forceinline__ void gate(int ui) const {
        if (xneed != 0u && ui == 4) {
            if (threadIdx.x == 0) { unsigned sp = 0u; while (__hip_atomic_load(xflag, __ATOMIC_RELAXED, __HIP_MEMORY_SCOPE_AGENT) < xneed) { __builtin_amdgcn_s_sleep(2); if (++sp > (1u << 22)) break; }
                __builtin_amdgcn_fence(__ATOMIC_ACQUIRE, "agent"); }
            __syncthreads();
        }
    }
    __amdgpu_buffer_rsrc_t wsr; const char* wsb;
    __device__ __forceinline__ void operator()(const f32x4 (&acc)[2][2][4][2], const pg8::Unit& u, int wr, int wc, int fr, int fq) const {
        const int row0 = u.pm * 256 + wr * 64 + fr; const int pn = u.pn;
        bf16_t* base; int ld, colt; const float* rsp;
        if (u.kind == 0) { rsp = rstd_x;
            if (pn < 6) { base = na + (size_t)(pn >> 1) * T_ * 512; ld = 512; colt = (pn & 1) * 256; }
            else if (pn < 9) { base = zc; ld = 768; colt = (pn - 6) * 256; }
            else if (pn < 11) { base = zqm; ld = 512; colt = (pn - 9) * 256; }
            else { base = zg; ld = 3072; colt = (pn - 11) * 256; } }
        else { rsp = rstd_m; base = kvmem; ld = 1024; colt = pn * 256; }
        const int col0 = colt + wc * 32 + 8 * fq;
        const bool stats = (u.kind == 0) && (pn >= 6) && (pn < 9); const bool isgate = (u.kind == 0) && (pn >= 11);
#pragma unroll
        for (int ai = 0; ai < 2; ++ai)
#pragma unroll
            for (int m = 0; m < 4; ++m) { const int row = row0 + ai * 128 + m * 16; const float rs = rsp[row]; bf16_t* rowp = base + (size_t)row * ld + col0;
#pragma unroll
                for (int bj = 0; bj < 2; ++bj) { f32x4 v0 = acc[ai][bj][m][0] * rs, v1 = acc[ai][bj][m][1] * rs;
#if !MK_GATE_U8
                    if (isgate) {
#pragma unroll
                        for (int e = 0; e < 4; ++e) { v0[e] = sig_den(v0[e]); v1[e] = sig_den(v1[e]); } }
#endif
#if MK_SC1_P1
                    __builtin_amdgcn_raw_buffer_store_b128(pack8(v0, v1), wsr, (int)((const char*)(rowp + bj * 128) - wsb), 0, 16);
#else
#if MK_GATE_U8
                    if (isgate) { st_g<0>((u32x2*)((unsigned char*)zg + (size_t)row * 3072 + col0 + bj * 128), gate_pack8(v0, v1)); continue; }
#endif
                    if (((MK_NT >> 16) & 1) && stats) *(u32x4*)(rowp + bj * 128) = pack8(v0, v1);
                    else st_g<0>((u32x4*)(rowp + bj * 128), pack8(v0, v1));
#endif
                    if (stats) { const int idx = (pn - 6) * 2 + bj;
                        if (idx < 5) { float s = (v0[0] * v0[0] + v0[1] * v0[1]) + (v0[2] * v0[2] + v0[3] * v0[3]) + (v1[0] * v1[0] + v1[1] * v1[1]) + (v1[2] * v1[2] + v1[3] * v1[3]);
                            s += __shfl_xor(s, 16); s += __shfl_xor(s, 32);
                            if (fq == 0) { if (idx < 3) ssq_q[(size_t)row * 12 + idx * 4 + wc] = s; else ssq_kv[(size_t)row * 8 + (idx - 3) * 4 + wc] = s; } }
                        else if (wc == 0) { rope8(v0, v1, row, fq, rope); *(u32x4*)(kpe + (size_t)row * 32 + 8 * fq) = pack8(v0, v1); } } } }
    }
};
struct SchedP1 {
    int c, G; const char* xb; const char* win; const char* memb; const char* wmk;
    __device__ __forceinline__ bool next(int i, pg8::Unit& u) const {
        const int L = i * G + c; int pm, pn;
        if (L < 2944) { pg8::tile_order(L, 128, 23, pm, pn); u.pm = pm; u.pn = pn; u.kind = 0; u.nt = 16; u.aux = 0; u.A = xb + (size_t)pm * 256 * 2048; u.B = win + (size_t)pn * 256 * 2048; u.A1 = u.A; u.A2 = u.A; return true; }
        if (L < 2976) { pg8::tile_order(L - 2944, 8, 4, pm, pn); u.pm = pm; u.pn = pn; u.kind = 1; u.nt = 16; u.aux = 0; u.A = memb + (size_t)pm * 256 * 2048; u.B = wmk + (size_t)pn * 256 * 2048; u.A1 = u.A; u.A2 = u.A; return true; }
        return false;
    }
};

struct EpiP2 {
    static constexpr bool PERM = true, HAS_MID = false, HAS_GATE = false;
    const float* ssq_q; const float* ssq_kv; bf16_t* qmla; bf16_t* kvbuf; const float* rope;
    __device__ __forceinline__ void operator()(const f32x4 (&acc)[2][2][4][2], const pg8::Unit& u, int wr, int wc, int fr, int fq) const {
        const int row0 = u.pm * 256 + wr * 64 + fr; const int pn = u.pn;
        float rs[2][4];
        if (u.kind == 0) {
#pragma unroll
            for (int ai = 0; ai < 2; ++ai)
#pragma unroll
                for (int m = 0; m < 4; ++m) { const f32x4* p = (const f32x4*)(ssq_q + (size_t)(row0 + ai * 128 + m * 16) * 12); const f32x4 a = p[0], b = p[1], c = p[2];
                    const float s = ((a[0] + a[1]) + (a[2] + a[3])) + ((b[0] + b[1]) + (b[2] + b[3])) + ((c[0] + c[1]) + (c[2] + c[3])); rs[ai][m] = rsqrtf(s * (1.0f / 384.0f) + EPS_); }
        } else {
#pragma unroll
            for (int ai = 0; ai < 2; ++ai)
#pragma unroll
                for (int m = 0; m < 4; ++m) { const f32x4* p = (const f32x4*)(ssq_kv + (size_t)(row0 + ai * 128 + m * 16) * 8); const f32x4 a = p[0], b = p[1];
                    const float s = ((a[0] + a[1]) + (a[2] + a[3])) + ((b[0] + b[1]) + (b[2] + b[3])); rs[ai][m] = rsqrtf(s * (1.0f / 256.0f) + EPS_); }
        }
        bf16_t* base = u.kind == 0 ? qmla : kvbuf; const int ld = u.kind == 0 ? 768 : 1024;
        const int col0 = pn * 256 + wc * 32 + 8 * fq;
#pragma unroll
        for (int bj = 0; bj < 2; ++bj) { const bool isrope = (u.kind == 0) && (((8 * pn + 4 * bj + wc) % 3) == 2);
#pragma unroll
            for (int ai = 0; ai < 2; ++ai)
#pragma unroll
                for (int m = 0; m < 4; ++m) { const int row = row0 + ai * 128 + m * 16; f32x4 v0 = acc[ai][bj][m][0] * rs[ai][m], v1 = acc[ai][bj][m][1] * rs[ai][m];
                    if (isrope) rope8(v0, v1, row, fq, rope);
                    st_g<1>((u32x4*)(base + (size_t)row * ld + col0 + bj * 128), pack8(v0, v1)); } }
    }
};
struct SchedP2 {
    int c, G; const char* zc; const char* wuq; const char* wukv;
    __device__ __forceinline__ bool next(int i, pg8::Unit& u) const {
        const int L = i * G + c; int pm, pn;
        if (L < 384) { pg8::tile_order(L, 128, 3, pm, pn); u.pm = pm; u.pn = pn; u.kind = 0; u.nt = 6; u.aux = 0; u.A = zc + (size_t)pm * 256 * 1536; u.B = wuq + (size_t)pn * 256 * 768; u.A1 = u.A; u.A2 = u.A; return true; }
        if (L < 896) { pg8::tile_order(L - 384, 128, 4, pm, pn); u.pm = pm; u.pn = pn; u.kind = 1; u.nt = 4; u.aux = 0; u.A = zc + (size_t)pm * 256 * 1536 + 768; u.B = wukv + (size_t)pn * 256 * 768; u.A1 = u.A; u.A2 = u.A; return true; }
        return false;
    }
};

struct EpiP4 {
    static constexpr bool PERM = true, HAS_MID = true, HAS_GATE = false;
    const bf16_t* zg; bf16_t* merged; int nohook;
#if MK_GATE_U8
    __device__ __forceinline__ void mid(f32x4 (&acc)[2][2][4][2], const pg8::Unit& u, int seg, int wr, int wc, int fr, int fq) const {
        if (nohook) return;
        const int row0 = u.pm * 256 + wr * 64 + fr; const int col0 = u.pn * 256 + wc * 32 + 8 * fq; const unsigned char* z8 = (const unsigned char*)zg;
        u32x2 ga[2][4][2], gb[2][4][2];
#pragma unroll
        for (int ai = 0; ai < 2; ++ai)
#pragma unroll
            for (int m = 0; m < 4; ++m) { const unsigned char* gp = z8 + (size_t)(row0 + ai * 128 + m * 16) * 3072 + col0 + (seg - 1) * 1024;
#pragma unroll
                for (int bj = 0; bj < 2; ++bj) { ga[ai][m][bj] = ld_g<15>((const u32x2*)(gp + bj * 128)); gb[ai][m][bj] = ld_g<15>((const u32x2*)(gp + 1024 + bj * 128)); } }
#pragma unroll
        for (int ai = 0; ai < 2; ++ai)
#pragma unroll
            for (int m = 0; m < 4; ++m)
#pragma unroll
                for (int bj = 0; bj < 2; ++bj)
#pragma unroll
                    for (int n = 0; n < 2; ++n) { const unsigned wa = ga[ai][m][bj][n], wb = gb[ai][m][bj][n];
#pragma unroll
                        for (int k = 0; k < 4; ++k) acc[ai][bj][m][n][k] *= ub(wa, k) * fast_rcp(ub(wb, k)); }
    }
    __device__ __forceinline__ void operator()(const f32x4 (&acc)[2][2][4][2], const pg8::Unit& u, int wr, int wc, int fr, int fq) const {
        const int row0 = u.pm * 256 + wr * 64 + fr; const int col0 = u.pn * 256 + wc * 32 + 8 * fq; const unsigned char* z8 = (const unsigned char*)zg;
#pragma unroll
        for (int ai = 0; ai < 2; ++ai) {
            u32x2 gg[4][2];
#pragma unroll
            for (int m = 0; m < 4; ++m) { const unsigned char* gp = z8 + (size_t)(row0 + ai * 128 + m * 16) * 3072 + col0 + 2048;
#pragma unroll
                for (int bj = 0; bj < 2; ++bj) gg[m][bj] = ld_g<15>((const u32x2*)(gp + bj * 128)); }
#pragma unroll
            for (int m = 0; m < 4; ++m) { const int row = row0 + ai * 128 + m * 16;
#pragma unroll
                for (int bj = 0; bj < 2; ++bj) { const u32x2 g = gg[m][bj]; f32x4 v0 = acc[ai][bj][m][0], v1 = acc[ai][bj][m][1];
#pragma unroll
                    for (int k = 0; k < 4; ++k) { v0[k] *= ub(g[0], k) * (1.0f / 255.0f); v1[k] *= ub(g[1], k) * (1.0f / 255.0f); }
                    st_g<2>((u32x4*)(merged + (size_t)row * 1024 + col0 + bj * 128), pack8(v0, v1)); } }
        }
    }
#else
    __device__ __forceinline__ void mid(f32x4 (&acc)[2][2][4][2], const pg8::Unit& u, int seg, int wr, int wc, int fr, int fq) const {
        if (nohook) return;
        const int row0 = u.pm * 256 + wr * 64 + fr; const int col0 = u.pn * 256 + wc * 32 + 8 * fq;
#pragma unroll
        for (int ai = 0; ai < 2; ++ai) {
            u32x4 ga[4][2], gb[4][2];
#pragma unroll
            for (int m = 0; m < 4; ++m) { const bf16_t* gp = zg + (size_t)(row0 + ai * 128 + m * 16) * 3072 + col0 + (seg - 1) * 1024;
#pragma unroll
                for (int bj = 0; bj < 2; ++bj) { ga[m][bj] = ld_g<15>((const u32x4*)(gp + bj * 128)); gb[m][bj] = ld_g<15>((const u32x4*)(gp + 1024 + bj * 128)); } }
#pragma unroll
            for (int m = 0; m < 4; ++m)
#pragma unroll
                for (int bj = 0; bj < 2; ++bj)
#pragma unroll
                    for (int e = 0; e < 4; ++e) { const unsigned wa = ga[m][bj][e], wb = gb[m][bj][e];
                        const float r0 = bflo(wb) * fast_rcp(bflo(wa)), r1 = bfhi(wb) * fast_rcp(bfhi(wa));
                        acc[ai][bj][m][e >> 1][(e & 1) * 2] *= r0; acc[ai][bj][m][e >> 1][(e & 1) * 2 + 1] *= r1; }
        }
    }
    __device__ __forceinline__ void operator()(const f32x4 (&acc)[2][2][4][2], const pg8::Unit& u, int wr, int wc, int fr, int fq) const {
        const int row0 = u.pm * 256 + wr * 64 + fr; const int col0 = u.pn * 256 + wc * 32 + 8 * fq;
#pragma unroll
        for (int ai = 0; ai < 2; ++ai) {
            u32x4 gg[4][2];
#pragma unroll
            for (int m = 0; m < 4; ++m) { const bf16_t* gp = zg + (size_t)(row0 + ai * 128 + m * 16) * 3072 + col0 + 2048;
#pragma unroll
                for (int bj = 0; bj < 2; ++bj) gg[m][bj] = ld_g<15>((const u32x4*)(gp + bj * 128)); }
#pragma unroll
            for (int m = 0; m < 4; ++m) { const int row = row0 + ai * 128 + m * 16;
#pragma unroll
                for (int bj = 0; bj < 2; ++bj) { const u32x4 g = gg[m][bj]; f32x4 v0 = acc[ai][bj][m][0], v1 = acc[ai][bj][m][1];
                    v0[0] *= fast_rcp(bflo(g[0])); v0[1] *= fast_rcp(bfhi(g[0])); v0[2] *= fast_rcp(bflo(g[1])); v0[3] *= fast_rcp(bfhi(g[1]));
                    v1[0] *= fast_rcp(bflo(g[2])); v1[1] *= fast_rcp(bfhi(g[2])); v1[2] *= fast_rcp(bflo(g[3])); v1[3] *= fast_rcp(bfhi(g[3]));
                    st_g<2>((u32x4*)(merged + (size_t)row * 1024 + col0 + bj * 128), pack8(v0, v1)); } }
        }
    }
#endif
};
struct SchedP4 {
    int c, G; const char* yna; const char* ymla; const char* ymem; const char* wo;
    __device__ __forceinline__ bool next(int i, pg8::Unit& u) const {
        const int L = i * G + c; int pm, pn; if (L >= 512) return false;
        pg8::tile_order(L, 128, 4, pm, pn); u.pm = pm; u.pn = pn; u.kind = 0; u.nt = 24; u.aux = 0;
        u.A = yna + (size_t)pm * 256 * 1024; u.A1 = ymla + (size_t)pm * 256 * 1024; u.A2 = ymem + (size_t)pm * 256 * 1024; u.B = wo + (size_t)pn * 256 * 3072; return true;
    }
};

struct EpiP5 {
    static constexpr bool PERM = true, HAS_MID = false, HAS_GATE = false;
    bf16_t* delta;
    __device__ __forceinline__ void operator()(const f32x4 (&acc)[2][2][4][2], const pg8::Unit& u, int wr, int wc, int fr, int fq) const {
        const int row0 = u.pm * 256 + wr * 64 + fr; const int col0 = u.pn * 256 + wc * 32 + 8 * fq;
#pragma unroll
        for (int ai = 0; ai < 2; ++ai)
#pragma unroll
            for (int m = 0; m < 4; ++m) { bf16_t* rowp = delta + (size_t)(row0 + ai * 128 + m * 16) * 1024 + col0;
#pragma unroll
                for (int bj = 0; bj < 2; ++bj) st_g<3>((u32x4*)(rowp + bj * 128), pack8(acc[ai][bj][m][0], acc[ai][bj][m][1])); }
    }
};
struct SchedP5 {
    int c, G; const char* merged; const char* wout;
    __device__ __forceinline__ bool next(int i, pg8::Unit& u) const {
        const int L = i * G + c; int pm, pn; if (L >= 512) return false;
        pg8::tile_order(L, 128, 4, pm, pn); u.pm = pm; u.pn = pn; u.kind = 0; u.nt = 16; u.aux = 0;
        u.A = merged + (size_t)pm * 256 * 2048; u.A1 = u.A; u.A2 = u.A; u.B = wout + (size_t)pn * 256 * 2048; return true;
    }
};

struct EpiP8 {
    static constexpr bool PERM = true, HAS_MID = false, HAS_GATE = false;
    const float* rstd_xs; bf16_t* act;
    __device__ __forceinline__ void operator()(const f32x4 (&acc)[2][2][4][2], const pg8::Unit& u, int wr, int wc, int fr, int fq) const {
        const int row0 = u.pm * 256 + wr * 64 + fr; const int col0 = u.pn * 128 + wc * 32 + 8 * fq;
#pragma unroll
        for (int ai = 0; ai < 2; ++ai)
#pragma unroll
            for (int m = 0; m < 4; ++m) { const int row = row0 + ai * 128 + m * 16; const float rs = rstd_xs[row]; f32x4 o[2];
#pragma unroll
                for (int n = 0; n < 2; ++n)
#pragma unroll
                    for (int e = 0; e < 4; ++e) { const float hg = acc[ai][0][m][n][e] * rs, hu = acc[ai][1][m][n][e] * rs; o[n][e] = hg * fast_rcp(1.0f + fast_exp2(-LOG2E * hg)) * hu; }
                st_g<4>((u32x4*)(act + (size_t)row * 1024 + col0), pack8(o[0], o[1])); }
    }
};
struct SchedP8 {
    int c, G; const char* xs; const char* wgu;
    __device__ __forceinline__ bool next(int i, pg8::Unit& u) const {
        const int L = i * G + c; int pm, pn; if (L >= 2048) return false;
        const int e = L >> 7; pg8::tile_order(L & 127, 16, 8, pm, pn); const int b = pm >> 1, half = pm & 1; const int grow0 = (b * 16 + e) * 512 + half * 256;
        u.pm = grow0 >> 8; u.pn = pn; u.kind = 0; u.nt = 16; u.aux = i; u.A = xs; u.A1 = u.A; u.A2 = u.A; u.B = wgu + (size_t)(e * 2048 + pn * 256) * 2048; return true;
    }
};
struct EpiP9 {
    static constexpr bool PERM = true, HAS_MID = false, HAS_GATE = false;
    const float* gsel; bf16_t* ybuf;
    __device__ __forceinline__ void operator()(const f32x4 (&acc)[2][2][4][2], const pg8::Unit& u, int wr, int wc, int fr, int fq) const {
        const int row0 = u.pm * 256 + wr * 64 + fr; const int col0 = u.pn * 256 + wc * 32 + 8 * fq;
#pragma unroll
        for (int ai = 0; ai < 2; ++ai)
#pragma unroll
            for (int m = 0; m < 4; ++m) { const int row = row0 + ai * 128 + m * 16; const float gs = gsel[row];
#pragma unroll
                for (int bj = 0; bj < 2; ++bj) st_g<5>((u32x4*)(ybuf + (size_t)row * 1024 + col0 + bj * 128), pack8(acc[ai][bj][m][0] * gs, acc[ai][bj][m][1] * gs)); }
    }
};
struct SchedP9 {
    int c, G; const char* act; const char* wd;
    __device__ __forceinline__ bool next(int i, pg8::Unit& u) const {
        const int L = i * G + c; int pm, pn; if (L >= 1024) return false;
        const int e = L >> 6; pg8::tile_order(L & 63, 16, 4, pm, pn); const int b = pm >> 1, half = pm & 1; const int grow0 = (b * 16 + e) * 512 + half * 256;
        u.pm = grow0 >> 8; u.pn = pn; u.kind = 0; u.nt = 16; u.aux = e; u.A = act + (size_t)grow0 * 2048; u.A1 = u.A; u.A2 = u.A; u.B = wd + (size_t)(e * 1024 + pn * 256) * 2048; return true;
    }
};

struct EpiMoE {
    static constexpr bool PERM = true, HAS_MID = false, HAS_GATE = false;
    EpiP8 e8; EpiP9 e9;
    __device__ __forceinline__ void operator()(const f32x4 (&acc)[2][2][4][2], const pg8::Unit& u, int wr, int wc, int fr, int fq) const { if (u.kind == 0) e8(acc, u, wr, wc, fr, fq); else e9(acc, u, wr, wc, fr, fq); }
};
struct SchedMoE {
    int e, grow0; const char* hb; const char* act; const char* wgu; const char* wd;
    __device__ __forceinline__ bool next(int i, pg8::Unit& u) const {
        if (i >= 12) return false;
        u.pm = grow0 >> 8; u.nt = 16;
        if (i < 8) { u.pn = i; u.kind = 0; u.aux = 0; u.A = hb; u.B = wgu + (size_t)(e * 2048 + i * 256) * 2048; }
        else { u.pn = i - 8; u.kind = 1; u.aux = 1; u.A = act; u.B = wd + (size_t)(e * 1024 + (i - 8) * 256) * 2048; }
        u.A1 = u.A; u.A2 = u.A; return true;
    }
};

namespace att {
typedef short v4i16_t __attribute__((ext_vector_type(4)));
struct AttnArgs { const bf16_t* q; const bf16_t* k0; const bf16_t* k1; const bf16_t* v; bf16_t* o; const float* rpb; };
__device__ __forceinline__ s16x4 vtr(unsigned addr) { return __builtin_bit_cast(s16x4, __builtin_amdgcn_ds_read_tr16_b64_v4i16((LAS v4i16_t*)(uintptr_t)addr)); }
__device__ __forceinline__ float max3f(float a, float b, float c) { return __builtin_fmaxf(__builtin_fmaxf(a, b), c); }

template <int DQK, int DV, int MODE, bool PIPE>
__device__ __forceinline__ void attn_unit(LAS unsigned char* lds, const AttnArgs& A, const int b, const int h, const int ub) {
    constexpr int PK = DQK * 2 + 16, PV = DV * 2 + 64, KB = 64 * PK, VB = 64 * PV;
    constexpr int OFF_K = 0, OFF_V = 2 * KB, OFF_SCR = OFF_V + 2 * VB, OFF_OST = OFF_SCR + 8 * 256, OFF_END = OFF_OST + 8 * 32 * DV * 2;
    static_assert(OFF_END <= LDS_BYTES - 64, "attention LDS");
    constexpr int KCH = DQK / 8, VCH = DV / 8, NKC = 64 * KCH, NVC = 64 * VCH, KPT = (NKC + 511) / 512, VPT = (NVC + 511) / 512;
    constexpr int LDQ = (MODE == 0) ? 768 : 512, LDO = 512;
    constexpr int NDS = DQK / 16, ND0 = DV / 32;
    constexpr int NT = (MODE == 0) ? 64 : 4;
#ifndef ATT_THR
#define ATT_THR 8.0f
#endif
    constexpr float THR = ATT_THR;
    int tid_ = threadIdx.x; asm volatile("" : "+v"(tid_));
    const int tid = tid_, lane = tid & 63, r32 = lane & 31, hi = lane >> 5; const int wid = __builtin_amdgcn_readfirstlane(tid >> 6);
    const int wave_tok0 = b * S_ + ub * 256 + wid * 32;
    bf16x8 qf[NDS];
    { const bf16_t* qp = A.q + (size_t)(wave_tok0 + r32) * LDQ + h * DQK + hi * 8;
#pragma unroll
      for (int ds = 0; ds < NDS; ++ds) qf[ds] = *(const bf16x8*)(qp + ds * 16); }
    const bf16_t* ksrc[KPT]; int kstr[KPT]; unsigned kdst[KPT]; bool kval[KPT];
    const bf16_t* vsrc[VPT]; unsigned vdst[VPT];
    constexpr int KSTRIDE = 64 * 1024;
#pragma unroll
    for (int j = 0; j < KPT; ++j) { const int ci = tid + 512 * j; kval[j] = ci < NKC; const int cic = kval[j] ? ci : 0; const int row = cic / KCH, cc = cic % KCH;
        kdst[j] = (unsigned)(OFF_K + row * PK + cc * 16); kstr[j] = KSTRIDE;
        if (MODE == 0) { const size_t kt = (size_t)b * S_ + row; if (cc < 8) ksrc[j] = A.k0 + kt * 1024 + h * 64 + cc * 8; else { ksrc[j] = A.k1 + kt * 32 + (cc - 8) * 8; kstr[j] = 64 * 32; } }
        else { const size_t kr = (size_t)b * 256 + row; ksrc[j] = A.k0 + kr * 1024 + h * 128 + cc * 8; } }
#pragma unroll
    for (int j = 0; j < VPT; ++j) { const int ci = tid + 512 * j; const int row = ci / VCH, cc = ci % VCH;
        vdst[j] = (unsigned)(OFF_V + row * PV + cc * 16);
        if (MODE == 0) { const size_t kt = (size_t)b * S_ + row; vsrc[j] = A.v + kt * 1024 + h * 64 + cc * 8; }
        else { const size_t kr = (size_t)b * 256 + row; vsrc[j] = A.v + kr * 1024 + h * 128 + cc * 8; } }
    u32x4 kst[KPT], vst[VPT];
#define ATT_LOADK(tile) do { _Pragma("unroll") for (int j = 0; j < KPT; ++j) if (kval[j]) kst[j] = *(const u32x4*)(ksrc[j] + (size_t)(tile) * kstr[j]); } while (0)
#define ATT_LOADV(tile) do { _Pragma("unroll") for (int j = 0; j < VPT; ++j) vst[j] = *(const u32x4*)(vsrc[j] + (size_t)(tile) * KSTRIDE); } while (0)
#define ATT_STOREK(buf) do { _Pragma("unroll") for (int j = 0; j < KPT; ++j) if (kval[j]) *(LAS u32x4*)(lds + kdst[j] + (buf) * KB) = kst[j]; } while (0)
#define ATT_STOREV(buf) do { _Pragma("unroll") for (int j = 0; j < VPT; ++j) *(LAS u32x4*)(lds + vdst[j] + (buf) * VB) = vst[j]; } while (0)
    LAS float* scr = (LAS float*)(lds + OFF_SCR) + wid * 64;
#define ATT_QK(P0, P1, buf) do { const LAS unsigned char* kb_ = lds + OFF_K + (buf) * KB + r32 * PK + hi * 16; P0 = negm; P1 = negm; __builtin_amdgcn_s_setprio(1); \
        _Pragma("unroll") for (int ds = 0; ds < NDS; ++ds) { const bf16x8 a0_ = *(const LAS bf16x8*)(kb_ + ds * 32), a1_ = *(const LAS bf16x8*)(kb_ + 32 * PK + ds * 32); \
            P0 = __builtin_amdgcn_mfma_f32_32x32x16_bf16(a0_, qf[ds], P0, 0, 0, 0); P1 = __builtin_amdgcn_mfma_f32_32x32x16_bf16(a1_, qf[ds], P1, 0, 0, 0); } __builtin_amdgcn_s_setprio(0); } while (0)
#define ATT_ROWMAX(P0, P1, rm) do { float a_ = max3f(P0[0], P0[1], P1[0]), b_ = max3f(P0[2], P0[3], P1[1]); a_ = max3f(a_, P1[2], P1[3]); \
        _Pragma("unroll") for (int r = 4; r < 16; r += 4) { a_ = max3f(a_, P0[r], P0[r + 1]); b_ = max3f(b_, P0[r + 2], P0[r + 3]); a_ = max3f(a_, P1[r], P1[r + 1]); b_ = max3f(b_, P1[r + 2], P1[r + 3]); } \
        rm = fmaxf(a_, b_); rm = fmaxf(rm, __shfl_xor(rm, 32)); } while (0)
    f32x16 o[ND0], negm;
#pragma unroll
    for (int r = 0; r < 16; ++r) negm[r] = 0.f;
#pragma unroll
    for (int d0 = 0; d0 < ND0; ++d0)
#pragma unroll
        for (int r = 0; r < 16; ++r) o[d0][r] = 0.f;
    float lsum = 0.f;
    f32x16 pA0, pA1, pB0, pB1;
    { u32x4 k1st[KPT];
      ATT_LOADK(0); ATT_LOADV(0);
#pragma unroll
      for (int j = 0; j < KPT; ++j) if (kval[j]) k1st[j] = *(const u32x4*)(ksrc[j] + (size_t)kstr[j]);
      ATT_STOREK(0); ATT_STOREV(0);
#pragma unroll
      for (int j = 0; j < KPT; ++j) if (kval[j]) *(LAS u32x4*)(lds + kdst[j] + KB) = k1st[j]; }
    __syncthreads();
    ATT_QK(pA0, pA1, 0);
    { float rm; ATT_ROWMAX(pA0, pA1, rm);
#pragma unroll
      for (int r = 0; r < 16; ++r) { pA0[r] -= rm; pA1[r] -= rm; negm[r] = -rm; } }
    __syncthreads();
#ifndef ATT_SGB
#define ATT_SGB 1
#endif
#define ATT_STEP(PC0, PC1, PN0, PN1, t) do { const int buf_ = (t) & 1; \
        if ((t) + 2 < NT) ATT_LOADK((t) + 2); if ((t) + 1 < NT) ATT_LOADV((t) + 1); \
        if constexpr (!PIPE) { if ((t) > 0) { ATT_QK(PC0, PC1, buf_); float rm0_; ATT_ROWMAX(PC0, PC1, rm0_); \
            if (__any(rm0_ > THR)) { const float dl_ = fmaxf(rm0_, 0.f); const float f_ = fast_exp2(-dl_); lsum *= f_; \
                _Pragma("unroll") for (int r = 0; r < 16; ++r) { PC0[r] -= dl_; PC1[r] -= dl_; negm[r] -= dl_; } \
                if (hi == 0) scr[r32] = f_; \
                _Pragma("unroll") for (int r = 0; r < 16; ++r) { const float fr_ = scr[crow(r, hi)]; _Pragma("unroll") for (int d0 = 0; d0 < ND0; ++d0) o[d0][r] *= fr_; } } } } \
          \
        if constexpr (PIPE) { if ((t) + 1 < NT) ATT_QK(PN0, PN1, buf_ ^ 1); } \
        float ps_ = 0.f; \
        _Pragma("unroll") for (int r = 0; r < 16; ++r) { PC0[r] = fast_exp2(PC0[r]); PC1[r] = fast_exp2(PC1[r]); ps_ += PC0[r] + PC1[r]; } \
        lsum += ps_; \
        bf16x8 pa_[4]; \
        _Pragma("unroll") for (int s = 0; s < 2; ++s) { u32x4 w_; \
            w_.x = cvt_pk_bf16(PC0[8 * s + 0], PC0[8 * s + 1]); w_.y = cvt_pk_bf16(PC0[8 * s + 2], PC0[8 * s + 3]); w_.z = cvt_pk_bf16(PC0[8 * s + 4], PC0[8 * s + 5]); w_.w = cvt_pk_bf16(PC0[8 * s + 6], PC0[8 * s + 7]); pa_[s] = __builtin_bit_cast(bf16x8, w_); \
            w_.x = cvt_pk_bf16(PC1[8 * s + 0], PC1[8 * s + 1]); w_.y = cvt_pk_bf16(PC1[8 * s + 2], PC1[8 * s + 3]); w_.z = cvt_pk_bf16(PC1[8 * s + 4], PC1[8 * s + 5]); w_.w = cvt_pk_bf16(PC1[8 * s + 6], PC1[8 * s + 7]); pa_[2 + s] = __builtin_bit_cast(bf16x8, w_); } \
          \
        { const unsigned vb_ = (unsigned)(uintptr_t)(lds + OFF_V + buf_ * VB) + (unsigned)((4 * hi + ((lane & 15) >> 2)) * PV + ((((lane >> 4) & 1) * 16 + (lane & 3) * 4) * 2)); \
          __builtin_amdgcn_s_setprio(1); \
          _Pragma("unroll") for (int d0 = 0; d0 < ND0; ++d0) _Pragma("unroll") for (int s = 0; s < 4; ++s) { \
              const s16x4 lo_ = vtr(vb_ + (unsigned)(16 * s * PV + d0 * 64)), hh_ = vtr(vb_ + (unsigned)(16 * s * PV + 8 * PV + d0 * 64)); \
              const bf16x8 vf_ = (bf16x8){lo_[0], lo_[1], lo_[2], lo_[3], hh_[0], hh_[1], hh_[2], hh_[3]}; \
              o[d0] = __builtin_amdgcn_mfma_f32_32x32x16_bf16(pa_[s], vf_, o[d0], 0, 0, 0); } \
          __builtin_amdgcn_s_setprio(0); } \
        float rm_ = 0.f; \
        if constexpr (PIPE) { if ((t) + 1 < NT) ATT_ROWMAX(PN0, PN1, rm_); } \
        if (ATT_SGB && PIPE) { _Pragma("unroll") for (int g_ = 0; g_ < 12 + 4 * ND0; ++g_) { __builtin_amdgcn_sched_group_barrier(0x008, 1, 0); __builtin_amdgcn_sched_group_barrier(0x100, 2, 0); __builtin_amdgcn_sched_group_barrier(0x002, 6, 0); } } \
          \
        if constexpr (PIPE) { if (__any(rm_ > THR)) { const float dl_ = fmaxf(rm_, 0.f); const float f_ = fast_exp2(-dl_); lsum *= f_; \
            _Pragma("unroll") for (int r = 0; r < 16; ++r) { PN0[r] -= dl_; PN1[r] -= dl_; negm[r] -= dl_; } \
            if (hi == 0) scr[r32] = f_; \
            _Pragma("unroll") for (int r = 0; r < 16; ++r) { const float fr_ = scr[crow(r, hi)]; _Pragma("unroll") for (int d0 = 0; d0 < ND0; ++d0) o[d0][r] *= fr_; } } } \
        if ((t) + 2 < NT) ATT_STOREK(buf_); if ((t) + 1 < NT) ATT_STOREV(buf_ ^ 1); \
        __syncthreads(); } while (0)
    if constexpr (PIPE) { for (int t = 0; t < NT; t += 2) { ATT_STEP(pA0, pA1, pB0, pB1, t); ATT_STEP(pB0, pB1, pA0, pA1, t + 1); } }
    else { for (int t = 0; t < NT; ++t) { ATT_STEP(pA0, pA1, pB0, pB1, t); } }
    lsum += __shfl_xor(lsum, 32);
    if (hi == 0) scr[r32] = fast_rcp(lsum);
    LAS bf16_t* ost = (LAS bf16_t*)(lds + OFF_OST) + wid * 32 * DV;
#pragma unroll
    for (int r = 0; r < 16; ++r) { const int q = crow(r, hi); const float ri = scr[q];
#pragma unroll
        for (int d0 = 0; d0 < ND0; ++d0) { const float val = o[d0][r] * ri; ost[q * DV + d0 * 32 + r32] = (bf16_t)(cvt_pk_bf16(val, val) & 0xffffu); } }
    asm volatile("s_waitcnt lgkmcnt(0)" ::: "memory");
    { bf16_t* og = A.o + (size_t)wave_tok0 * LDO + h * DV;
#pragma unroll
      for (int i = 0; i < DV / 16; ++i) { const int id = i * 64 + lane; const int row = id / VCH, ch = id % VCH;
          const u32x4 v = *(const LAS u32x4*)(ost + row * DV + ch * 8); st_g<6>((u32x4*)(og + (size_t)row * LDO + ch * 8), v); } }
    __syncthreads();
#undef ATT_LOADK
#undef ATT_LOADV
#undef ATT_STOREK
#undef ATT_STOREV
#undef ATT_QK
#undef ATT_ROWMAX
#undef ATT_STEP
}
}

namespace att {
#define SBAR_ __builtin_amdgcn_sched_barrier(0)
template <int ABL>
__device__ __forceinline__ void attn_unit_mla3(LAS unsigned char* lds, const AttnArgs& A, const int b, const int h, const int ub) {
    constexpr int DQK = 96, DV = 64;
    constexpr int PK = DQK * 2 + 16, PV = DV * 2 + 64, KB = 64 * PK, VB = 64 * PV;
    constexpr int OFF_K = 0, OFF_V = 2 * KB, OFF_SCR = OFF_V + 2 * VB, OFF_OST = OFF_SCR + 8 * 256, OFF_END = OFF_OST + 8 * 32 * DV * 2;
    static_assert(OFF_END <= LDS_BYTES - 64, "attention LDS");
    constexpr int KCH = DQK / 8, VCH = DV / 8, NKC = 64 * KCH, KPT = 2;
    constexpr int LDQ = 768, LDO = 512, NDS = DQK / 16, ND0 = DV / 32, NT = 64;
#ifndef ATT_THR
#define ATT_THR 8.0f
#endif
    constexpr float THR = ATT_THR;
    int tid_ = threadIdx.x; asm volatile("" : "+v"(tid_));
    const int tid = tid_, lane = tid & 63, r32 = lane & 31, hi = lane >> 5; const int wid = __builtin_amdgcn_readfirstlane(tid >> 6);
    const int wave_tok0 = b * S_ + ub * 256 + wid * 32;
    bf16x8 qf[NDS];
    { const bf16_t* qp = A.q + (size_t)(wave_tok0 + r32) * LDQ + h * DQK + hi * 8;
#pragma unroll
      for (int ds = 0; ds < NDS; ++ds) qf[ds] = ld_g<17>((const bf16x8*)(qp + ds * 16)); }
    const bf16_t* ksrc[KPT]; int kstr[KPT]; unsigned kdst[KPT]; bool kval[KPT];
    const bf16_t* vsrc; unsigned vdst;
    constexpr int KSTRIDE = 64 * 1024;
#pragma unroll
    for (int j = 0; j < KPT; ++j) { const int ci = tid + 512 * j; kval[j] = ci < NKC; const int cic = kval[j] ? ci : 0; const int row = cic / KCH, cc = cic % KCH;
        kdst[j] = (unsigned)(OFF_K + row * PK + cc * 16); kstr[j] = KSTRIDE; const size_t kt = (size_t)b * S_ + row;
        if (cc < 8) ksrc[j] = A.k0 + kt * 1024 + h * 64 + cc * 8; else { ksrc[j] = A.k1 + kt * 32 + (cc - 8) * 8; kstr[j] = 64 * 32; } }
    { const int row = tid / VCH, cc = tid % VCH; vdst = (unsigned)(OFF_V + row * PV + cc * 16); vsrc = A.v + ((size_t)b * S_ + row) * 1024 + h * 64 + cc * 8; }
    u32x4 kst[KPT], vst;
#define M3_LOADK(tile) do { _Pragma("unroll") for (int j = 0; j < KPT; ++j) if (kval[j]) kst[j] = *(const u32x4*)(ksrc[j] + (size_t)(tile) * kstr[j]); } while (0)
#define M3_LOADV(tile) do { vst = *(const u32x4*)(vsrc + (size_t)(tile) * KSTRIDE); } while (0)
#define M3_STOREK(buf) do { _Pragma("unroll") for (int j = 0; j < KPT; ++j) if (kval[j]) *(LAS u32x4*)(lds + kdst[j] + (buf) * KB) = kst[j]; } while (0)
#define M3_STOREV(buf) do { *(LAS u32x4*)(lds + vdst + (buf) * VB) = vst; } while (0)
    LAS float* scr = (LAS float*)(lds + OFF_SCR) + wid * 64;
#define M3_ROWMAX(P0, P1, rm) do { float a_ = max3f(P0[0], P0[1], P1[0]), b_ = max3f(P0[2], P0[3], P1[1]); a_ = max3f(a_, P1[2], P1[3]); \
        _Pragma("unroll") for (int r = 4; r < 16; r += 4) { a_ = max3f(a_, P0[r], P0[r + 1]); b_ = max3f(b_, P0[r + 2], P0[r + 3]); a_ = max3f(a_, P1[r], P1[r + 1]); b_ = max3f(b_, P1[r + 2], P1[r + 3]); } \
        rm = fmaxf(a_, b_); rm = fmaxf(rm, __shfl_xor(rm, 32)); } while (0)
    f32x16 o[ND0], negm;
#pragma unroll
    for (int r = 0; r < 16; ++r) negm[r] = 0.f;
#pragma unroll
    for (int d0 = 0; d0 < ND0; ++d0)
#pragma unroll
        for (int r = 0; r < 16; ++r) o[d0][r] = 0.f;
    float lsum = 0.f;
    f32x16 pA0, pA1, pB0, pB1;
    { u32x4 k1st[KPT];
      M3_LOADK(0); M3_LOADV(0);
#pragma unroll
      for (int j = 0; j < KPT; ++j) if (kval[j]) k1st[j] = *(const u32x4*)(ksrc[j] + (size_t)kstr[j]);
      M3_STOREK(0); M3_STOREV(0);
#pragma unroll
      for (int j = 0; j < KPT; ++j) if (kval[j]) *(LAS u32x4*)(lds + kdst[j] + KB) = k1st[j]; }
    __syncthreads();
    { const LAS unsigned char* kb_ = lds + OFF_K + r32 * PK + hi * 16; pA0 = negm; pA1 = negm;
#pragma unroll
      for (int ds = 0; ds < NDS; ++ds) { const bf16x8 a0_ = *(const LAS bf16x8*)(kb_ + ds * 32), a1_ = *(const LAS bf16x8*)(kb_ + 32 * PK + ds * 32);
          pA0 = __builtin_amdgcn_mfma_f32_32x32x16_bf16(a0_, qf[ds], pA0, 0, 0, 0); pA1 = __builtin_amdgcn_mfma_f32_32x32x16_bf16(a1_, qf[ds], pA1, 0, 0, 0); } }
    { float rm; M3_ROWMAX(pA0, pA1, rm);
#pragma unroll
      for (int r = 0; r < 16; ++r) { pA0[r] -= rm; pA1[r] -= rm; negm[r] = -rm; } }
    __syncthreads();
#define M3_KF(i, kb_) (*(const LAS bf16x8*)((kb_) + ((i) >> 1) * 32 + ((i) & 1) * 32 * PK))
#define M3_EXPAIR(P, r, S, W) do { if (ABL != 1) { P[r] = fast_exp2(P[r]); P[(r) + 1] = fast_exp2(P[(r) + 1]); } sacc_ += P[r] + P[(r) + 1]; pw_[S][W] = cvt_pk_bf16(P[r], P[(r) + 1]); } while (0)
#define M3_EXPK(P, r, S, W) do { if (ABL != 1) { P[r] = fast_exp2(P[r]); P[(r) + 1] = fast_exp2(P[(r) + 1]); } pw_[S][W] = cvt_pk_bf16(P[r], P[(r) + 1]); } while (0)
#define M3_VF(i, vb_, dst) do { const s16x4 lo_ = vtr((vb_) + (unsigned)(16 * ((i) & 3) * PV + ((i) >> 2) * 64)), hh_ = vtr((vb_) + (unsigned)(16 * ((i) & 3) * PV + 8 * PV + ((i) >> 2) * 64)); \
        dst = (bf16x8){lo_[0], lo_[1], lo_[2], lo_[3], hh_[0], hh_[1], hh_[2], hh_[3]}; } while (0)

#define M3_MX3(a, b, c) __builtin_fmaxf(__builtin_fmaxf((a), (b)), (c))
#define M3_STEP(PC0, PC1, PN0, PN1, t, LDK) do { const int buf_ = (t) & 1; \
        if (ABL != 4) { if (LDK) M3_LOADK((t) + 2); M3_LOADV((t) + 1); } \
        const LAS unsigned char* kb_ = lds + OFF_K + (buf_ ^ 1) * KB + r32 * PK + hi * 16; \
        const unsigned vb_ = (unsigned)(uintptr_t)(lds + OFF_V + buf_ * VB) + (unsigned)((4 * hi + ((lane & 15) >> 2)) * PV + ((((lane >> 4) & 1) * 16 + (lane & 3) * 4) * 2)); \
        bf16x8 kf0_ = M3_KF(0, kb_), kf1_ = M3_KF(1, kb_), kf2_ = M3_KF(2, kb_), kf3_ = M3_KF(3, kb_); \
        float sacc_ = 0.f; u32x4 pw_[4]; SBAR_; \
        if (ABL != 3) { PN0 = __builtin_amdgcn_mfma_f32_32x32x16_bf16(kf0_, qf[0], negm, 0, 0, 0); } else { PN0 = negm; PN0[0] += (float)kf0_[0] + (float)qf[0][0]; } kf0_ = M3_KF(4, kb_); M3_EXPK(PC0, 0, 0, 0); M3_EXPK(PC0, 2, 0, 1); asm volatile("" : "+v"(pw_[0])); SBAR_; \
        if (ABL != 3) { PN1 = __builtin_amdgcn_mfma_f32_32x32x16_bf16(kf1_, qf[0], negm, 0, 0, 0); } else { PN1 = negm; PN1[0] += (float)kf1_[0] + (float)qf[0][0]; } kf1_ = M3_KF(5, kb_); M3_EXPK(PC0, 4, 0, 2); asm volatile("" : "+v"(pw_[0])); SBAR_; \
        if (ABL != 3) { PN0 = __builtin_amdgcn_mfma_f32_32x32x16_bf16(kf2_, qf[1], PN0, 0, 0, 0); } else { PN0 = PN0; PN0[0] += (float)kf2_[0] + (float)qf[1][0]; } kf2_ = M3_KF(6, kb_); M3_EXPK(PC0, 6, 0, 3); asm volatile("" : "+v"(pw_[0])); SBAR_; \
        if (ABL != 3) { PN1 = __builtin_amdgcn_mfma_f32_32x32x16_bf16(kf3_, qf[1], PN1, 0, 0, 0); } else { PN1 = PN1; PN1[0] += (float)kf3_[0] + (float)qf[1][0]; } kf3_ = M3_KF(7, kb_); M3_EXPK(PC0, 8, 1, 0); M3_EXPK(PC0, 10, 1, 1); asm volatile("" : "+v"(pw_[1])); SBAR_; \
        if (ABL != 3) { PN0 = __builtin_amdgcn_mfma_f32_32x32x16_bf16(kf0_, qf[2], PN0, 0, 0, 0); } else { PN0 = PN0; PN0[0] += (float)kf0_[0] + (float)qf[2][0]; } kf0_ = M3_KF(8, kb_); M3_EXPK(PC0, 12, 1, 2); asm volatile("" : "+v"(pw_[1])); SBAR_; \
        if (ABL != 3) { PN1 = __builtin_amdgcn_mfma_f32_32x32x16_bf16(kf1_, qf[2], PN1, 0, 0, 0); } else { PN1 = PN1; PN1[0] += (float)kf1_[0] + (float)qf[2][0]; } kf1_ = M3_KF(9, kb_); M3_EXPK(PC0, 14, 1, 3); asm volatile("" : "+v"(pw_[1])); SBAR_; \
        if (ABL != 3) { PN0 = __builtin_amdgcn_mfma_f32_32x32x16_bf16(kf2_, qf[3], PN0, 0, 0, 0); } else { PN0 = PN0; PN0[0] += (float)kf2_[0] + (float)qf[3][0]; } kf2_ = M3_KF(10, kb_); M3_EXPK(PC1, 0, 2, 0); M3_EXPK(PC1, 2, 2, 1); asm volatile("" : "+v"(pw_[2])); SBAR_; \
        if (ABL != 3) { PN1 = __builtin_amdgcn_mfma_f32_32x32x16_bf16(kf3_, qf[3], PN1, 0, 0, 0); } else { PN1 = PN1; PN1[0] += (float)kf3_[0] + (float)qf[3][0]; } kf3_ = M3_KF(11, kb_); M3_EXPK(PC1, 4, 2, 2); asm volatile("" : "+v"(pw_[2])); SBAR_; \
        if (ABL != 3) { PN0 = __builtin_amdgcn_mfma_f32_32x32x16_bf16(kf0_, qf[4], PN0, 0, 0, 0); } else { PN0 = PN0; PN0[0] += (float)kf0_[0] + (float)qf[4][0]; } M3_EXPK(PC1, 6, 2, 3); asm volatile("" : "+v"(pw_[2])); SBAR_; \
        if (ABL != 3) { PN1 = __builtin_amdgcn_mfma_f32_32x32x16_bf16(kf1_, qf[4], PN1, 0, 0, 0); } else { PN1 = PN1; PN1[0] += (float)kf1_[0] + (float)qf[4][0]; } M3_EXPK(PC1, 8, 3, 0); M3_EXPK(PC1, 10, 3, 1); asm volatile("" : "+v"(pw_[3])); SBAR_; \
        if (ABL != 3) { PN0 = __builtin_amdgcn_mfma_f32_32x32x16_bf16(kf2_, qf[5], PN0, 0, 0, 0); } else { PN0 = PN0; PN0[0] += (float)kf2_[0] + (float)qf[5][0]; } M3_EXPK(PC1, 12, 3, 2); asm volatile("" : "+v"(pw_[3])); SBAR_; \
        if (ABL != 3) { PN1 = __builtin_amdgcn_mfma_f32_32x32x16_bf16(kf3_, qf[5], PN1, 0, 0, 0); } else { PN1 = PN1; PN1[0] += (float)kf3_[0] + (float)qf[5][0]; } M3_EXPK(PC1, 14, 3, 3); asm volatile("" : "+v"(pw_[3])); SBAR_; \
        bf16x8 vf0_, vf1_; M3_VF(0, vb_, vf0_); M3_VF(1, vb_, vf1_); \
        float ma_ = M3_MX3(PN0[0], PN0[1], PN1[0]), mb_ = M3_MX3(PN0[2], PN0[3], PN1[1]); SBAR_; \
        if (ABL != 2) { o[0] = __builtin_amdgcn_mfma_f32_32x32x16_bf16(__builtin_bit_cast(bf16x8, pw_[0]), vf0_, o[0], 0, 0, 0); } else { o[0][0] += __builtin_bit_cast(float, pw_[0][0]) + (float)vf0_[0]; } M3_VF(2, vb_, vf0_); sacc_ += (PC0[0] + PC0[1]) + (PC0[2] + PC0[3]); ma_ = M3_MX3(ma_, PN1[2], PN1[3]); ma_ = M3_MX3(ma_, PN0[4], PN0[5]); asm volatile("" : "+v"(ma_), "+v"(mb_), "+v"(sacc_)); SBAR_; \
        if (ABL != 2) { o[0] = __builtin_amdgcn_mfma_f32_32x32x16_bf16(__builtin_bit_cast(bf16x8, pw_[1]), vf1_, o[0], 0, 0, 0); } else { o[0][0] += __builtin_bit_cast(float, pw_[1][0]) + (float)vf1_[0]; } M3_VF(3, vb_, vf1_); sacc_ += (PC0[4] + PC0[5]) + (PC0[6] + PC0[7]); mb_ = M3_MX3(mb_, PN0[6], PN0[7]); ma_ = M3_MX3(ma_, PN1[4], PN1[5]); asm volatile("" : "+v"(ma_), "+v"(mb_), "+v"(sacc_)); SBAR_; \
        if (ABL != 2) { o[0] = __builtin_amdgcn_mfma_f32_32x32x16_bf16(__builtin_bit_cast(bf16x8, pw_[2]), vf0_, o[0], 0, 0, 0); } else { o[0][0] += __builtin_bit_cast(float, pw_[2][0]) + (float)vf0_[0]; } M3_VF(4, vb_, vf0_); sacc_ += (PC0[8] + PC0[9]) + (PC0[10] + PC0[11]); mb_ = M3_MX3(mb_, PN1[6], PN1[7]); ma_ = M3_MX3(ma_, PN0[8], PN0[9]); asm volatile("" : "+v"(ma_), "+v"(mb_), "+v"(sacc_)); SBAR_; \
        if (ABL != 2) { o[0] = __builtin_amdgcn_mfma_f32_32x32x16_bf16(__builtin_bit_cast(bf16x8, pw_[3]), vf1_, o[0], 0, 0, 0); } else { o[0][0] += __builtin_bit_cast(float, pw_[3][0]) + (float)vf1_[0]; } M3_VF(5, vb_, vf1_); sacc_ += (PC0[12] + PC0[13]) + (PC0[14] + PC0[15]); mb_ = M3_MX3(mb_, PN0[10], PN0[11]); ma_ = M3_MX3(ma_, PN1[8], PN1[9]); asm volatile("" : "+v"(ma_), "+v"(mb_), "+v"(sacc_)); SBAR_; \
        if (ABL != 2) { o[1] = __builtin_amdgcn_mfma_f32_32x32x16_bf16(__builtin_bit_cast(bf16x8, pw_[0]), vf0_, o[1], 0, 0, 0); } else { o[1][0] += __builtin_bit_cast(float, pw_[0][0]) + (float)vf0_[0]; } M3_VF(6, vb_, vf0_); sacc_ += (PC1[0] + PC1[1]) + (PC1[2] + PC1[3]); mb_ = M3_MX3(mb_, PN1[10], PN1[11]); ma_ = M3_MX3(ma_, PN0[12], PN0[13]); asm volatile("" : "+v"(ma_), "+v"(mb_), "+v"(sacc_)); SBAR_; \
        if (ABL != 2) { o[1] = __builtin_amdgcn_mfma_f32_32x32x16_bf16(__builtin_bit_cast(bf16x8, pw_[1]), vf1_, o[1], 0, 0, 0); } else { o[1][0] += __builtin_bit_cast(float, pw_[1][0]) + (float)vf1_[0]; } M3_VF(7, vb_, vf1_); sacc_ += (PC1[4] + PC1[5]) + (PC1[6] + PC1[7]); mb_ = M3_MX3(mb_, PN0[14], PN0[15]); asm volatile("" : "+v"(ma_), "+v"(mb_), "+v"(sacc_)); SBAR_; \
        if (ABL != 2) { o[1] = __builtin_amdgcn_mfma_f32_32x32x16_bf16(__builtin_bit_cast(bf16x8, pw_[2]), vf0_, o[1], 0, 0, 0); } else { o[1][0] += __builtin_bit_cast(float, pw_[2][0]) + (float)vf0_[0]; } sacc_ += (PC1[8] + PC1[9]) + (PC1[10] + PC1[11]); ma_ = M3_MX3(ma_, PN1[12], PN1[13]); asm volatile("" : "+v"(ma_), "+v"(mb_), "+v"(sacc_)); SBAR_; \
        if (ABL != 2) { o[1] = __builtin_amdgcn_mfma_f32_32x32x16_bf16(__builtin_bit_cast(bf16x8, pw_[3]), vf1_, o[1], 0, 0, 0); } else { o[1][0] += __builtin_bit_cast(float, pw_[3][0]) + (float)vf1_[0]; } sacc_ += (PC1[12] + PC1[13]) + (PC1[14] + PC1[15]); mb_ = M3_MX3(mb_, PN1[14], PN1[15]); asm volatile("" : "+v"(ma_), "+v"(mb_), "+v"(sacc_)); SBAR_; \
        lsum += sacc_; \
        float rm_ = fmaxf(ma_, mb_); rm_ = fmaxf(rm_, __shfl_xor(rm_, 32)); \
        if (__any(rm_ > THR)) { const float dl_ = fmaxf(rm_, 0.f); const float f_ = fast_exp2(-dl_); lsum *= f_; \
            _Pragma("unroll") for (int r = 0; r < 16; ++r) { PN0[r] -= dl_; PN1[r] -= dl_; negm[r] -= dl_; } \
            if (hi == 0) scr[r32] = f_; \
            _Pragma("unroll") for (int r = 0; r < 16; ++r) { const float fr_ = scr[crow(r, hi)]; _Pragma("unroll") for (int d0 = 0; d0 < ND0; ++d0) o[d0][r] *= fr_; } } \
        if (ABL != 4) { if (LDK) M3_STOREK(buf_); M3_STOREV(buf_ ^ 1); } \
        if (ABL != 5) __syncthreads(); } while (0)
#define M3_TAIL(PC0, PC1, t) do { const int buf_ = (t) & 1; \
        float sacc_ = 0.f; u32x4 pw_[4]; \
        _Pragma("unroll") for (int q = 0; q < 8; ++q) { M3_EXPAIR(PC0, 2 * q, q >> 2, q & 3); } \
        _Pragma("unroll") for (int q = 0; q < 8; ++q) { M3_EXPAIR(PC1, 2 * q, 2 + (q >> 2), q & 3); } \
        lsum += sacc_; \
        const unsigned vb_ = (unsigned)(uintptr_t)(lds + OFF_V + buf_ * VB) + (unsigned)((4 * hi + ((lane & 15) >> 2)) * PV + ((((lane >> 4) & 1) * 16 + (lane & 3) * 4) * 2)); \
        _Pragma("unroll") for (int i = 0; i < 8; ++i) { bf16x8 vf_; M3_VF(i, vb_, vf_); o[i >> 2] = __builtin_amdgcn_mfma_f32_32x32x16_bf16(__builtin_bit_cast(bf16x8, pw_[i & 3]), vf_, o[i >> 2], 0, 0, 0); } \
        __syncthreads(); } while (0)
    for (int t = 0; t < NT - 2; t += 2) { M3_STEP(pA0, pA1, pB0, pB1, t, 1); M3_STEP(pB0, pB1, pA0, pA1, t + 1, 1); }
    M3_STEP(pA0, pA1, pB0, pB1, NT - 2, 0);
    M3_TAIL(pB0, pB1, NT - 1);
    lsum += __shfl_xor(lsum, 32);
    if (hi == 0) scr[r32] = fast_rcp(lsum);
    LAS bf16_t* ost = (LAS bf16_t*)(lds + OFF_OST) + wid * 32 * DV;
#pragma unroll
    for (int r = 0; r < 16; ++r) { const int q = crow(r, hi); const float ri = scr[q];
#pragma unroll
        for (int d0 = 0; d0 < ND0; ++d0) { const float val = o[d0][r] * ri; ost[q * DV + d0 * 32 + r32] = (bf16_t)(cvt_pk_bf16(val, val) & 0xffffu); } }
    asm volatile("s_waitcnt lgkmcnt(0)" ::: "memory");
    { bf16_t* og = A.o + (size_t)wave_tok0 * LDO + h * DV;
#pragma unroll
      for (int i = 0; i < DV / 16; ++i) { const int id = i * 64 + lane; const int row = id / VCH, ch = id % VCH;
          const u32x4 v = *(const LAS u32x4*)(ost + row * DV + ch * 8); st_g<6>((u32x4*)(og + (size_t)row * LDO + ch * 8), v); } }
    __syncthreads();
#undef M3_LOADK
#undef M3_LOADV
#undef M3_STOREK
#undef M3_STOREV
#undef M3_ROWMAX
#undef M3_KF
#undef M3_EXPAIR
#undef M3_EXPK
#undef M3_VF
#undef M3_STEP
#undef M3_TAIL
#undef M3_MX3
}
template <int ABL>
__device__ __forceinline__ void attn_unit_mla4(LAS unsigned char* lds, const AttnArgs& A, const int b, const int h, const int ub) {
    constexpr int DQK = 96, DV = 64;
    constexpr int PK = DQK * 2 + 16, PV = DV * 2 + 64, KB = 64 * PK, VB = 64 * PV;
    constexpr int OFF_K = 0, OFF_V = 2 * KB, OFF_SCR = OFF_V + 3 * VB, OFF_OST = OFF_SCR + 8 * 256, OFF_END = OFF_OST + 8 * 32 * DV * 2;
    static_assert(OFF_END <= LDS_BYTES - 64, "attention LDS");
    constexpr int KCH = DQK / 8, VCH = DV / 8, NKC = 64 * KCH, KPT = 2;
    constexpr int LDQ = 768, LDO = 512, NDS = DQK / 16, ND0 = DV / 32, NT = 64;
#ifndef ATT_THR
#define ATT_THR 8.0f
#endif
    constexpr float THR = ATT_THR;
    int tid_ = threadIdx.x; asm volatile("" : "+v"(tid_));
    const int tid = tid_, lane = tid & 63, r32 = lane & 31, hi = lane >> 5; const int wid = __builtin_amdgcn_readfirstlane(tid >> 6);
    const int wave_tok0 = b * S_ + ub * 256 + wid * 32;
    bf16x8 qf[NDS];
    { const bf16_t* qp = A.q + (size_t)(wave_tok0 + r32) * LDQ + h * DQK + hi * 8;
#pragma unroll
      for (int ds = 0; ds < NDS; ++ds) qf[ds] = ld_g<17>((const bf16x8*)(qp + ds * 16)); }
    const bf16_t* ksrc[KPT]; int kstr[KPT]; unsigned kdst[KPT]; bool kval[KPT];
    const bf16_t* vsrc; unsigned vdst;
    constexpr int KSTRIDE = 64 * 1024;
#pragma unroll
    for (int j = 0; j < KPT; ++j) { const int ci = tid + 512 * j; kval[j] = ci < NKC; const int cic = kval[j] ? ci : 0; const int row = cic / KCH, cc = cic % KCH;
        kdst[j] = (unsigned)(OFF_K + row * PK + cc * 16); kstr[j] = KSTRIDE; const size_t kt = (size_t)b * S_ + row;
        if (cc < 8) ksrc[j] = A.k0 + kt * 1024 + h * 64 + cc * 8; else { ksrc[j] = A.k1 + kt * 32 + (cc - 8) * 8; kstr[j] = 64 * 32; } }
    { const int row = tid / VCH, cc = tid % VCH; vdst = (unsigned)(OFF_V + row * PV + cc * 16); vsrc = A.v + ((size_t)b * S_ + row) * 1024 + h * 64 + cc * 8; }
    u32x4 kst[KPT], vst;
#define M3_LOADK(tile) do { _Pragma("unroll") for (int j = 0; j < KPT; ++j) if (kval[j]) kst[j] = *(const u32x4*)(ksrc[j] + (size_t)(tile) * kstr[j]); } while (0)
#define M3_LOADV(tile) do { vst = *(const u32x4*)(vsrc + (size_t)(tile) * KSTRIDE); } while (0)
#define M3_STOREK(buf) do { _Pragma("unroll") for (int j = 0; j < KPT; ++j) if (kval[j]) *(LAS u32x4*)(lds + kdst[j] + (buf) * KB) = kst[j]; } while (0)
#define M3_STOREV(boff) do { *(LAS u32x4*)(lds + vdst + (boff)) = vst; } while (0)
    LAS float* scr = (LAS float*)(lds + OFF_SCR) + wid * 64;
#define M3_ROWMAX(P0, P1, rm) do { float a_ = max3f(P0[0], P0[1], P1[0]), b_ = max3f(P0[2], P0[3], P1[1]); a_ = max3f(a_, P1[2], P1[3]); \
        _Pragma("unroll") for (int r = 4; r < 16; r += 4) { a_ = max3f(a_, P0[r], P0[r + 1]); b_ = max3f(b_, P0[r + 2], P0[r + 3]); a_ = max3f(a_, P1[r], P1[r + 1]); b_ = max3f(b_, P1[r + 2], P1[r + 3]); } \
        rm = fmaxf(a_, b_); rm = fmaxf(rm, __shfl_xor(rm, 32)); } while (0)
    f32x16 o[ND0], negm;
#pragma unroll
    for (int r = 0; r < 16; ++r) negm[r] = 0.f;
#pragma unroll
    for (int d0 = 0; d0 < ND0; ++d0)
#pragma unroll
        for (int r = 0; r < 16; ++r) o[d0][r] = 0.f;
    float lsum = 0.f;
    f32x16 pA0, pA1, pB0, pB1;
    { u32x4 k1st[KPT];
      M3_LOADK(0); M3_LOADV(0);
#pragma unroll
      for (int j = 0; j < KPT; ++j) if (kval[j]) k1st[j] = *(const u32x4*)(ksrc[j] + (size_t)kstr[j]);
      M3_STOREK(0); M3_STOREV(0);
#pragma unroll
      for (int j = 0; j < KPT; ++j) if (kval[j]) *(LAS u32x4*)(lds + kdst[j] + KB) = k1st[j]; }
    __syncthreads();
    { const LAS unsigned char* kb_ = lds + OFF_K + r32 * PK + hi * 16; pA0 = negm; pA1 = negm;
#pragma unroll
      for (int ds = 0; ds < NDS; ++ds) { const bf16x8 a0_ = *(const LAS bf16x8*)(kb_ + ds * 32), a1_ = *(const LAS bf16x8*)(kb_ + 32 * PK + ds * 32);
          pA0 = __builtin_amdgcn_mfma_f32_32x32x16_bf16(a0_, qf[ds], pA0, 0, 0, 0); pA1 = __builtin_amdgcn_mfma_f32_32x32x16_bf16(a1_, qf[ds], pA1, 0, 0, 0); } }
    { float rm; M3_ROWMAX(pA0, pA1, rm);
#pragma unroll
      for (int r = 0; r < 16; ++r) { pA0[r] -= rm; pA1[r] -= rm; negm[r] = -rm; } }
    __syncthreads();
    bf16x8 kf0_, kf1_, kf2_, kf3_;
    { const LAS unsigned char* kb1_ = lds + OFF_K + KB + r32 * PK + hi * 16; kf0_ = *(const LAS bf16x8*)(kb1_); kf1_ = *(const LAS bf16x8*)(kb1_ + 32 * PK); kf2_ = *(const LAS bf16x8*)(kb1_ + 32); kf3_ = *(const LAS bf16x8*)(kb1_ + 32 + 32 * PK); }
    int vc_ = 0, vn_ = VB, vf3_ = 2 * VB;
#define M3_KF(i, kb_) (*(const LAS bf16x8*)((kb_) + ((i) >> 1) * 32 + ((i) & 1) * 32 * PK))
#define M3_EXPAIR(P, r, S, W) do { if (ABL != 1) { P[r] = fast_exp2(P[r]); P[(r) + 1] = fast_exp2(P[(r) + 1]); } sacc_ += P[r] + P[(r) + 1]; pw_[S][W] = cvt_pk_bf16(P[r], P[(r) + 1]); } while (0)
#define M3_EXPK(P, r, S, W) do { if (ABL != 1) { P[r] = fast_exp2(P[r]); P[(r) + 1] = fast_exp2(P[(r) + 1]); } pw_[S][W] = cvt_pk_bf16(P[r], P[(r) + 1]); } while (0)
#define M3_VF(i, vb_, dst) do { const s16x4 lo_ = vtr((vb_) + (unsigned)(16 * ((i) & 3) * PV + ((i) >> 2) * 64)), hh_ = vtr((vb_) + (unsigned)(16 * ((i) & 3) * PV + 8 * PV + ((i) >> 2) * 64)); \
        dst = (bf16x8){lo_[0], lo_[1], lo_[2], lo_[3], hh_[0], hh_[1], hh_[2], hh_[3]}; } while (0)

#define M3_MX3(a, b, c) __builtin_fmaxf(__builtin_fmaxf((a), (b)), (c))
#define M3_STEP(PC0, PC1, PN0, PN1, t, LDK) do { const int buf_ = (t) & 1; \
        if (ABL != 4) { if (LDK) M3_LOADK((t) + 2); M3_LOADV((t) + 1); } \
        const LAS unsigned char* kb_ = lds + OFF_K + (buf_ ^ 1) * KB + r32 * PK + hi * 16; \
        const unsigned vb_ = (unsigned)(uintptr_t)(lds + OFF_V + vc_) + (unsigned)((4 * hi + ((lane & 15) >> 2)) * PV + ((((lane >> 4) & 1) * 16 + (lane & 3) * 4) * 2)); \
        float sacc_ = 0.f; u32x4 pw_[4]; SBAR_; \
        if (ABL != 3) { PN0 = __builtin_amdgcn_mfma_f32_32x32x16_bf16(kf0_, qf[0], negm, 0, 0, 0); } else { PN0 = negm; PN0[0] += (float)kf0_[0] + (float)qf[0][0]; } kf0_ = M3_KF(4, kb_); M3_EXPK(PC0, 0, 0, 0); M3_EXPK(PC0, 2, 0, 1); asm volatile("" : "+v"(pw_[0])); SBAR_; \
        if (ABL != 3) { PN1 = __builtin_amdgcn_mfma_f32_32x32x16_bf16(kf1_, qf[0], negm, 0, 0, 0); } else { PN1 = negm; PN1[0] += (float)kf1_[0] + (float)qf[0][0]; } kf1_ = M3_KF(5, kb_); M3_EXPK(PC0, 4, 0, 2); asm volatile("" : "+v"(pw_[0])); SBAR_; \
        if (ABL != 3) { PN0 = __builtin_amdgcn_mfma_f32_32x32x16_bf16(kf2_, qf[1], PN0, 0, 0, 0); } else { PN0 = PN0; PN0[0] += (float)kf2_[0] + (float)qf[1][0]; } kf2_ = M3_KF(6, kb_); M3_EXPK(PC0, 6, 0, 3); asm volatile("" : "+v"(pw_[0])); SBAR_; \
        if (ABL != 3) { PN1 = __builtin_amdgcn_mfma_f32_32x32x16_bf16(kf3_, qf[1], PN1, 0, 0, 0); } else { PN1 = PN1; PN1[0] += (float)kf3_[0] + (float)qf[1][0]; } kf3_ = M3_KF(7, kb_); M3_EXPK(PC0, 8, 1, 0); M3_EXPK(PC0, 10, 1, 1); asm volatile("" : "+v"(pw_[1])); SBAR_; \
        if (ABL != 3) { PN0 = __builtin_amdgcn_mfma_f32_32x32x16_bf16(kf0_, qf[2], PN0, 0, 0, 0); } else { PN0 = PN0; PN0[0] += (float)kf0_[0] + (float)qf[2][0]; } kf0_ = M3_KF(8, kb_); M3_EXPK(PC0, 12, 1, 2); asm volatile("" : "+v"(pw_[1])); SBAR_; \
        if (ABL != 3) { PN1 = __builtin_amdgcn_mfma_f32_32x32x16_bf16(kf1_, qf[2], PN1, 0, 0, 0); } else { PN1 = PN1; PN1[0] += (float)kf1_[0] + (float)qf[2][0]; } kf1_ = M3_KF(9, kb_); M3_EXPK(PC0, 14, 1, 3); asm volatile("" : "+v"(pw_[1])); SBAR_; \
        if (ABL != 3) { PN0 = __builtin_amdgcn_mfma_f32_32x32x16_bf16(kf2_, qf[3], PN0, 0, 0, 0); } else { PN0 = PN0; PN0[0] += (float)kf2_[0] + (float)qf[3][0]; } kf2_ = M3_KF(10, kb_); M3_EXPK(PC1, 0, 2, 0); M3_EXPK(PC1, 2, 2, 1); asm volatile("" : "+v"(pw_[2])); SBAR_; \
        if (ABL != 3) { PN1 = __builtin_amdgcn_mfma_f32_32x32x16_bf16(kf3_, qf[3], PN1, 0, 0, 0); } else { PN1 = PN1; PN1[0] += (float)kf3_[0] + (float)qf[3][0]; } kf3_ = M3_KF(11, kb_); M3_EXPK(PC1, 4, 2, 2); asm volatile("" : "+v"(pw_[2])); SBAR_; \
        if (ABL != 3) { PN0 = __builtin_amdgcn_mfma_f32_32x32x16_bf16(kf0_, qf[4], PN0, 0, 0, 0); } else { PN0 = PN0; PN0[0] += (float)kf0_[0] + (float)qf[4][0]; } M3_EXPK(PC1, 6, 2, 3); asm volatile("" : "+v"(pw_[2])); SBAR_; \
        if (ABL != 3) { PN1 = __builtin_amdgcn_mfma_f32_32x32x16_bf16(kf1_, qf[4], PN1, 0, 0, 0); } else { PN1 = PN1; PN1[0] += (float)kf1_[0] + (float)qf[4][0]; } M3_EXPK(PC1, 8, 3, 0); M3_EXPK(PC1, 10, 3, 1); asm volatile("" : "+v"(pw_[3])); SBAR_; \
        if (ABL != 3) { PN0 = __builtin_amdgcn_mfma_f32_32x32x16_bf16(kf2_, qf[5], PN0, 0, 0, 0); } else { PN0 = PN0; PN0[0] += (float)kf2_[0] + (float)qf[5][0]; } M3_EXPK(PC1, 12, 3, 2); asm volatile("" : "+v"(pw_[3])); SBAR_; \
        if (ABL != 3) { PN1 = __builtin_amdgcn_mfma_f32_32x32x16_bf16(kf3_, qf[5], PN1, 0, 0, 0); } else { PN1 = PN1; PN1[0] += (float)kf3_[0] + (float)qf[5][0]; } M3_EXPK(PC1, 14, 3, 3); asm volatile("" : "+v"(pw_[3])); SBAR_; \
        bf16x8 vf0_, vf1_; M3_VF(0, vb_, vf0_); M3_VF(1, vb_, vf1_); \
        float ma_ = M3_MX3(PN0[0], PN0[1], PN1[0]), mb_ = M3_MX3(PN0[2], PN0[3], PN1[1]); SBAR_; \
        if (ABL != 2) { o[0] = __builtin_amdgcn_mfma_f32_32x32x16_bf16(__builtin_bit_cast(bf16x8, pw_[0]), vf0_, o[0], 0, 0, 0); } else { o[0][0] += __builtin_bit_cast(float, pw_[0][0]) + (float)vf0_[0]; } M3_VF(2, vb_, vf0_); sacc_ += (PC0[0] + PC0[1]) + (PC0[2] + PC0[3]); ma_ = M3_MX3(ma_, PN1[2], PN1[3]); ma_ = M3_MX3(ma_, PN0[4], PN0[5]); asm volatile("" : "+v"(ma_), "+v"(mb_), "+v"(sacc_)); SBAR_; \
        if (ABL != 2) { o[0] = __builtin_amdgcn_mfma_f32_32x32x16_bf16(__builtin_bit_cast(bf16x8, pw_[1]), vf1_, o[0], 0, 0, 0); } else { o[0][0] += __builtin_bit_cast(float, pw_[1][0]) + (float)vf1_[0]; } M3_VF(3, vb_, vf1_); sacc_ += (PC0[4] + PC0[5]) + (PC0[6] + PC0[7]); mb_ = M3_MX3(mb_, PN0[6], PN0[7]); ma_ = M3_MX3(ma_, PN1[4], PN1[5]); asm volatile("" : "+v"(ma_), "+v"(mb_), "+v"(sacc_)); SBAR_; \
        if (ABL != 2) { o[0] = __builtin_amdgcn_mfma_f32_32x32x16_bf16(__builtin_bit_cast(bf16x8, pw_[2]), vf0_, o[0], 0, 0, 0); } else { o[0][0] += __builtin_bit_cast(float, pw_[2][0]) + (float)vf0_[0]; } M3_VF(4, vb_, vf0_); sacc_ += (PC0[8] + PC0[9]) + (PC0[10] + PC0[11]); mb_ = M3_MX3(mb_, PN1[6], PN1[7]); ma_ = M3_MX3(ma_, PN0[8], PN0[9]); asm volatile("" : "+v"(ma_), "+v"(mb_), "+v"(sacc_)); SBAR_; \
        if (ABL != 2) { o[0] = __builtin_amdgcn_mfma_f32_32x32x16_bf16(__builtin_bit_cast(bf16x8, pw_[3]), vf1_, o[0], 0, 0, 0); } else { o[0][0] += __builtin_bit_cast(float, pw_[3][0]) + (float)vf1_[0]; } M3_VF(5, vb_, vf1_); sacc_ += (PC0[12] + PC0[13]) + (PC0[14] + PC0[15]); mb_ = M3_MX3(mb_, PN0[10], PN0[11]); ma_ = M3_MX3(ma_, PN1[8], PN1[9]); asm volatile("" : "+v"(ma_), "+v"(mb_), "+v"(sacc_)); SBAR_; \
        if (ABL != 4) { if (LDK) M3_STOREK(buf_); M3_STOREV(vn_); } \
        if (ABL != 5) { asm volatile("s_waitcnt lgkmcnt(0)\n\ts_barrier" ::: "memory"); } SBAR_; \
        if (ABL != 2) { o[1] = __builtin_amdgcn_mfma_f32_32x32x16_bf16(__builtin_bit_cast(bf16x8, pw_[0]), vf0_, o[1], 0, 0, 0); } else { o[1][0] += __builtin_bit_cast(float, pw_[0][0]) + (float)vf0_[0]; } M3_VF(6, vb_, vf0_); sacc_ += (PC1[0] + PC1[1]) + (PC1[2] + PC1[3]); mb_ = M3_MX3(mb_, PN1[10], PN1[11]); ma_ = M3_MX3(ma_, PN0[12], PN0[13]); asm volatile("" : "+v"(ma_), "+v"(mb_), "+v"(sacc_)); SBAR_; \
        if (ABL != 2) { o[1] = __builtin_amdgcn_mfma_f32_32x32x16_bf16(__builtin_bit_cast(bf16x8, pw_[1]), vf1_, o[1], 0, 0, 0); } else { o[1][0] += __builtin_bit_cast(float, pw_[1][0]) + (float)vf1_[0]; } M3_VF(7, vb_, vf1_); sacc_ += (PC1[4] + PC1[5]) + (PC1[6] + PC1[7]); mb_ = M3_MX3(mb_, PN0[14], PN0[15]); asm volatile("" : "+v"(ma_), "+v"(mb_), "+v"(sacc_)); SBAR_; \
        if (ABL != 2) { o[1] = __builtin_amdgcn_mfma_f32_32x32x16_bf16(__builtin_bit_cast(bf16x8, pw_[2]), vf0_, o[1], 0, 0, 0); } else { o[1][0] += __builtin_bit_cast(float, pw_[2][0]) + (float)vf0_[0]; } sacc_ += (PC1[8] + PC1[9]) + (PC1[10] + PC1[11]); ma_ = M3_MX3(ma_, PN1[12], PN1[13]); asm volatile("" : "+v"(ma_), "+v"(mb_), "+v"(sacc_)); SBAR_; \
        if (ABL != 2) { o[1] = __builtin_amdgcn_mfma_f32_32x32x16_bf16(__builtin_bit_cast(bf16x8, pw_[3]), vf1_, o[1], 0, 0, 0); } else { o[1][0] += __builtin_bit_cast(float, pw_[3][0]) + (float)vf1_[0]; } sacc_ += (PC1[12] + PC1[13]) + (PC1[14] + PC1[15]); mb_ = M3_MX3(mb_, PN1[14], PN1[15]); asm volatile("" : "+v"(ma_), "+v"(mb_), "+v"(sacc_)); SBAR_; \
        lsum += sacc_; \
        { const LAS unsigned char* kbn_ = lds + OFF_K + buf_ * KB + r32 * PK + hi * 16; kf0_ = M3_KF(0, kbn_); kf1_ = M3_KF(1, kbn_); kf2_ = M3_KF(2, kbn_); kf3_ = M3_KF(3, kbn_); } \
        { const int v_ = vc_; vc_ = vn_; vn_ = vf3_; vf3_ = v_; } \
        float rm_ = fmaxf(ma_, mb_); rm_ = fmaxf(rm_, __shfl_xor(rm_, 32)); \
        if (__any(rm_ > THR)) { const float dl_ = fmaxf(rm_, 0.f); const float f_ = fast_exp2(-dl_); lsum *= f_; \
            _Pragma("unroll") for (int r = 0; r < 16; ++r) { PN0[r] -= dl_; PN1[r] -= dl_; negm[r] -= dl_; } \
            if (hi == 0) scr[r32] = f_; \
            _Pragma("unroll") for (int r = 0; r < 16; ++r) { const float fr_ = scr[crow(r, hi)]; _Pragma("unroll") for (int d0 = 0; d0 < ND0; ++d0) o[d0][r] *= fr_; } } \
        } while (0)
#define M3_TAIL(PC0, PC1, t) do { const int buf_ = (t) & 1; \
        float sacc_ = 0.f; u32x4 pw_[4]; \
        _Pragma("unroll") for (int q = 0; q < 8; ++q) { M3_EXPAIR(PC0, 2 * q, q >> 2, q & 3); } \
        _Pragma("unroll") for (int q = 0; q < 8; ++q) { M3_EXPAIR(PC1, 2 * q, 2 + (q >> 2), q & 3); } \
        lsum += sacc_; \
        const unsigned vb_ = (unsigned)(uintptr_t)(lds + OFF_V + vc_) + (unsigned)((4 * hi + ((lane & 15) >> 2)) * PV + ((((lane >> 4) & 1) * 16 + (lane & 3) * 4) * 2)); \
        _Pragma("unroll") for (int i = 0; i < 8; ++i) { bf16x8 vf_; M3_VF(i, vb_, vf_); o[i >> 2] = __builtin_amdgcn_mfma_f32_32x32x16_bf16(__builtin_bit_cast(bf16x8, pw_[i & 3]), vf_, o[i >> 2], 0, 0, 0); } \
        __syncthreads(); } while (0)
    for (int t = 0; t < NT - 2; t += 2) { M3_STEP(pA0, pA1, pB0, pB1, t, 1); M3_STEP(pB0, pB1, pA0, pA1, t + 1, 1); }
    M3_STEP(pA0, pA1, pB0, pB1, NT - 2, 0);
    M3_TAIL(pB0, pB1, NT - 1);
    lsum += __shfl_xor(lsum, 32);
    if (hi == 0) scr[r32] = fast_rcp(lsum);
    LAS bf16_t* ost = (LAS bf16_t*)(lds + OFF_OST) + wid * 32 * DV;
#pragma unroll
    for (int r = 0; r < 16; ++r) { const int q = crow(r, hi); const float ri = scr[q];
#pragma unroll
        for (int d0 = 0; d0 < ND0; ++d0) { const float val = o[d0][r] * ri; ost[q * DV + d0 * 32 + r32] = (bf16_t)(cvt_pk_bf16(val, val) & 0xffffu); } }
    asm volatile("s_waitcnt lgkmcnt(0)" ::: "memory");
    { bf16_t* og = A.o + (size_t)wave_tok0 * LDO + h * DV;
#pragma unroll
      for (int i = 0; i < DV / 16; ++i) { const int id = i * 64 + lane; const int row = id / VCH, ch = id % VCH;
          const u32x4 v = *(const LAS u32x4*)(ost + row * DV + ch * 8); st_g<6>((u32x4*)(og + (size_t)row * LDO + ch * 8), v); } }
    __syncthreads();
#undef M3_LOADK
#undef M3_LOADV
#undef M3_STOREK
#undef M3_STOREV
#undef M3_ROWMAX
#undef M3_KF
#undef M3_EXPAIR
#undef M3_EXPK
#undef M3_VF
#undef M3_STEP
#undef M3_TAIL
#undef M3_MX3
}
#undef SBAR_
}

namespace att {
__device__ __forceinline__ void attn_unit_mla16(LAS unsigned char* lds, const AttnArgs& A, const int b, const int h, const int ub) {
    constexpr int DQK = 96, DV = 64, KROW = 256, PV = 160, KB = 64 * KROW, VB = 64 * PV;
    constexpr int OFF_K = 0, OFF_V = 2 * KB, OFF_OST = OFF_V + 2 * VB, OFF_END = OFF_OST + 8 * 32 * DV * 2;
    static_assert(OFF_END <= LDS_BYTES - 64, "attention LDS");
    constexpr int KCH = 12, VCH = 8, NKC = 64 * KCH, KPT = 2, LDQ = 768, LDO = 512, NT = 64;
    constexpr float THR = 8.0f;
    int tid_ = threadIdx.x; asm volatile("" : "+v"(tid_));
    const int tid = tid_, lane = tid & 63, lj = lane & 15, fq = lane >> 4; const int wid = __builtin_amdgcn_readfirstlane(tid >> 6);
    const int wave_tok0 = b * S_ + ub * 256 + wid * 32;
    bf16x8 qf[2][3];
#pragma unroll
    for (int g = 0; g < 2; ++g) { const bf16_t* qp = A.q + (size_t)(wave_tok0 + 16 * g + lj) * LDQ + h * DQK + fq * 8;
#pragma unroll
        for (int ds = 0; ds < 3; ++ds) qf[g][ds] = *(const bf16x8*)(qp + ds * 32); }
    const bf16_t* ksrc[KPT]; int kstr[KPT]; unsigned kdst[KPT]; bool kval[KPT];
    const bf16_t* vsrc; unsigned vdst;
    constexpr int KSTRIDE = 64 * 1024;
#pragma unroll
    for (int j = 0; j < KPT; ++j) { const int ci = tid + 512 * j; kval[j] = ci < NKC; const int cic = kval[j] ? ci : 0; const int row = cic / KCH, cc = cic % KCH;
        kdst[j] = (unsigned)(OFF_K + row * KROW + ((cc ^ (row & 15)) << 4)); kstr[j] = KSTRIDE; const size_t kt = (size_t)b * S_ + row;
        if (cc < 8) ksrc[j] = A.k0 + kt * 1024 + h * 64 + cc * 8; else { ksrc[j] = A.k1 + kt * 32 + (cc - 8) * 8; kstr[j] = 64 * 32; } }
    { const int row = tid / VCH, cc = tid % VCH; vdst = (unsigned)(OFF_V + row * PV + cc * 16); vsrc = A.v + ((size_t)b * S_ + row) * 1024 + h * 64 + cc * 8; }
    u32x4 kst[KPT], vst;
#define M16_LOADK(tile) do { _Pragma("unroll") for (int j = 0; j < KPT; ++j) if (kval[j]) kst[j] = *(const u32x4*)(ksrc[j] + (size_t)(tile) * kstr[j]); } while (0)
#define M16_LOADV(tile) do { vst = *(const u32x4*)(vsrc + (size_t)(tile) * KSTRIDE); } while (0)
#define M16_STOREK(buf) do { _Pragma("unroll") for (int j = 0; j < KPT; ++j) if (kval[j]) *(LAS u32x4*)(lds + kdst[j] + (buf) * KB) = kst[j]; } while (0)
#define M16_STOREV(buf) do { *(LAS u32x4*)(lds + vdst + (buf) * VB) = vst; } while (0)
#define M16_QK(SN, buf) do { const LAS unsigned char* kb_ = lds + OFF_K + (buf) * KB + lj * KROW; \
        _Pragma("unroll") for (int kt = 0; kt < 4; ++kt) _Pragma("unroll") for (int ds = 0; ds < 3; ++ds) { const bf16x8 a_ = *(const LAS bf16x8*)(kb_ + kt * 16 * KROW + (((4 * ds + fq) ^ lj) << 4)); \
            _Pragma("unroll") for (int g = 0; g < 2; ++g) SN[kt][g] = __builtin_amdgcn_mfma_f32_16x16x32_bf16(a_, qf[g][ds], ds == 0 ? negm[g] : SN[kt][g], 0, 0, 0); } } while (0)
#define M16_ROWMAX(SX, g, rm) do { float a_ = max3f(SX[0][g][0], SX[0][g][1], SX[0][g][2]), b_ = max3f(SX[0][g][3], SX[1][g][0], SX[1][g][1]); \
        a_ = max3f(a_, SX[1][g][2], SX[1][g][3]); b_ = max3f(b_, SX[2][g][0], SX[2][g][1]); a_ = max3f(a_, SX[2][g][2], SX[2][g][3]); b_ = max3f(b_, SX[3][g][0], SX[3][g][1]); a_ = max3f(a_, SX[3][g][2], SX[3][g][3]); \
        rm = fmaxf(a_, b_); rm = fmaxf(rm, __shfl_xor(rm, 16)); rm = fmaxf(rm, __shfl_xor(rm, 32)); } while (0)
    f32x4 o[2][4], negm[2]; float lsum[2] = {0.f, 0.f};
#pragma unroll
    for (int g = 0; g < 2; ++g) { negm[g] = (f32x4){0.f, 0.f, 0.f, 0.f};
#pragma unroll
        for (int dt = 0; dt < 4; ++dt) o[g][dt] = (f32x4){0.f, 0.f, 0.f, 0.f}; }
    f32x4 sA[4][2], sB[4][2];
    { u32x4 k1st[KPT];
      M16_LOADK(0); M16_LOADV(0);
#pragma unroll
      for (int j = 0; j < KPT; ++j) if (kval[j]) k1st[j] = *(const u32x4*)(ksrc[j] + (size_t)kstr[j]);
      M16_STOREK(0); M16_STOREV(0);
#pragma unroll
      for (int j = 0; j < KPT; ++j) if (kval[j]) *(LAS u32x4*)(lds + kdst[j] + KB) = k1st[j]; }
    __syncthreads();
    M16_QK(sA, 0);
#pragma unroll
    for (int g = 0; g < 2; ++g) { float rm; M16_ROWMAX(sA, g, rm);
#pragma unroll
        for (int kt = 0; kt < 4; ++kt) sA[kt][g] = sA[kt][g] - rm;
        negm[g] = (f32x4){-rm, -rm, -rm, -rm}; }
    __syncthreads();
    const int q_ = lj >> 2, p_ = lj & 3;
#define M16_STEP(SC, SN, t) do { const int buf_ = (t) & 1; \
        if ((t) + 2 < NT) M16_LOADK((t) + 2); if ((t) + 1 < NT) M16_LOADV((t) + 1); \
        if ((t) + 1 < NT) M16_QK(SN, buf_ ^ 1); \
        bf16x8 pa_[2][2]; \
        _Pragma("unroll") for (int g = 0; g < 2; ++g) { float ps_ = 0.f; \
            _Pragma("unroll") for (int kt = 0; kt < 4; ++kt) _Pragma("unroll") for (int e = 0; e < 4; ++e) { SC[kt][g][e] = fast_exp2(SC[kt][g][e]); ps_ += SC[kt][g][e]; } \
            lsum[g] += ps_; \
            _Pragma("unroll") for (int s = 0; s < 2; ++s) { u32x4 w_; w_.x = cvt_pk_bf16(SC[2 * s][g][0], SC[2 * s][g][1]); w_.y = cvt_pk_bf16(SC[2 * s][g][2], SC[2 * s][g][3]); \
                w_.z = cvt_pk_bf16(SC[2 * s + 1][g][0], SC[2 * s + 1][g][1]); w_.w = cvt_pk_bf16(SC[2 * s + 1][g][2], SC[2 * s + 1][g][3]); pa_[g][s] = __builtin_bit_cast(bf16x8, w_); } } \
        { const unsigned vb_ = (unsigned)(uintptr_t)(lds + OFF_V + buf_ * VB) + (unsigned)((4 * fq + q_) * PV + p_ * 8); \
          _Pragma("unroll") for (int s = 0; s < 2; ++s) _Pragma("unroll") for (int dt = 0; dt < 4; ++dt) { \
              const s16x4 lo_ = vtr(vb_ + (unsigned)(32 * s * PV + dt * 32)), hh_ = vtr(vb_ + (unsigned)((32 * s + 16) * PV + dt * 32)); \
              const bf16x8 vf_ = (bf16x8){lo_[0], lo_[1], lo_[2], lo_[3], hh_[0], hh_[1], hh_[2], hh_[3]}; \
              _Pragma("unroll") for (int g = 0; g < 2; ++g) o[g][dt] = __builtin_amdgcn_mfma_f32_16x16x32_bf16(pa_[g][s], vf_, o[g][dt], 0, 0, 0); } } \
        float rm0_ = 0.f, rm1_ = 0.f; \
        if ((t) + 1 < NT) { M16_ROWMAX(SN, 0, rm0_); M16_ROWMAX(SN, 1, rm1_); } \
        if (__any(fmaxf(rm0_, rm1_) > THR)) { \
            _Pragma("unroll") for (int g = 0; g < 2; ++g) { const float dl_ = fmaxf(g ? rm1_ : rm0_, 0.f); const float f_ = fast_exp2(-dl_); lsum[g] *= f_; \
                _Pragma("unroll") for (int kt = 0; kt < 4; ++kt) SN[kt][g] = SN[kt][g] - dl_; negm[g] = negm[g] - dl_; \
                _Pragma("unroll") for (int e = 0; e < 4; ++e) { const float fe_ = __shfl(f_, 4 * fq + e); _Pragma("unroll") for (int dt = 0; dt < 4; ++dt) o[g][dt][e] *= fe_; } } } \
        if ((t) + 2 < NT) M16_STOREK(buf_); if ((t) + 1 < NT) M16_STOREV(buf_ ^ 1); \
        __syncthreads(); } while (0)
    for (int t = 0; t < NT; t += 2) { M16_STEP(sA, sB, t); M16_STEP(sB, sA, t + 1); }
    LAS bf16_t* ost = (LAS bf16_t*)(lds + OFF_OST) + wid * 32 * DV;
#pragma unroll
    for (int g = 0; g < 2; ++g) { float l_ = lsum[g]; l_ += __shfl_xor(l_, 16); l_ += __shfl_xor(l_, 32); const float linv = fast_rcp(l_);
#pragma unroll
        for (int e = 0; e < 4; ++e) { const float li = __shfl(linv, 4 * fq + e);
#pragma unroll
            for (int dt = 0; dt < 4; ++dt) { const float val = o[g][dt][e] * li; ost[(16 * g + 4 * fq + e) * DV + 16 * dt + lj] = (bf16_t)(cvt_pk_bf16(val, val) & 0xffffu); } } }
    asm volatile("s_waitcnt lgkmcnt(0)" ::: "memory");
    { bf16_t* og = A.o + (size_t)wave_tok0 * LDO + h * DV;
#pragma unroll
      for (int i = 0; i < DV / 16; ++i) { const int id = i * 64 + lane; const int row = id / VCH, ch = id % VCH;
          const u32x4 v = *(const LAS u32x4*)(ost + row * DV + ch * 8); *(u32x4*)(og + (size_t)row * LDO + ch * 8) = v; } }
    __syncthreads();
#undef M16_LOADK
#undef M16_LOADV
#undef M16_STOREK
#undef M16_STOREV
#undef M16_QK
#undef M16_ROWMAX
#undef M16_STEP
}
}

namespace na2 {
typedef short v4i16_t __attribute__((ext_vector_type(4)));
constexpr int NS = 6, DPF = 5, TILE = 16384;
constexpr int OFF_RING = 0, OFF_OST = NS * TILE, OFF_TAB = OFF_OST + 8 * 2048, TAB_FLOATS = 8 * 465;
static_assert(OFF_TAB + TAB_FLOATS * 4 <= LDS_BYTES - 64, "na2 LDS");
__device__ __forceinline__ void glds16(const void* gsrc, unsigned lds_dst) { unsigned keep;
    asm volatile("s_mov_b32 %0, m0\n\ts_mov_b32 m0, %2\n\ts_nop 0\n\tglobal_load_lds_dwordx4 %1, off\n\ts_mov_b32 m0, %0" : "=&s"(keep) : "v"(gsrc), "s"(lds_dst) : "memory"); }
__device__ __forceinline__ s16x4 vtr(unsigned addr) { return __builtin_bit_cast(s16x4, __builtin_amdgcn_ds_read_tr16_b64_v4i16((LAS v4i16_t*)(uintptr_t)addr)); }
__device__ __forceinline__ int clampi(int v, int lo, int hi) { return v < lo ? lo : (v > hi ? hi : v); }
#define NA_WAITBAR(N) asm volatile("s_waitcnt vmcnt(" #N ") lgkmcnt(0)\n\ts_barrier" ::: "memory")

__device__ __forceinline__ void na_phase(LAS unsigned char* lds, const bf16_t* qn, const bf16_t* kn, const bf16_t* vn, bf16_t* on, const float* rpb, const int vcu, const int G) {
    int tid_ = threadIdx.x; asm volatile("" : "+v"(tid_));
    const int tid = tid_, lane = tid & 63, lj = lane & 15, fq = lane >> 4; const int wid = __builtin_amdgcn_readfirstlane(tid >> 6);
    const int hl = wid >> 2, g = wid & 3; const int csg = (g == 0) ? 0 : (g == 1 ? 8 : (g == 2 ? 24 : 32));
    LAS float* tab = (LAS float*)(lds + OFF_TAB);
    { float tv[8];
#pragma unroll
      for (int k = 0; k < 8; ++k) { const int i = tid + NTHREADS * k; tv[k] = (i < TAB_FLOATS) ? rpb[i] : 0.f; }
#pragma unroll
      for (int k = 0; k < 8; ++k) { const int i = tid + NTHREADS * k; if (i < TAB_FLOATS) tab[i] = tv[k] * LOG2E; } }
    const unsigned lds0 = (unsigned)(uintptr_t)lds;
    if (vcu >= 2048) { __syncthreads(); return; }
    const int nunits = (2048 - vcu + G - 1) / G; const int total = nunits * 17;
    unsigned offK[2], offV[2], dstw[2];
#pragma unroll
    for (int p = 0; p < 2; ++p) { const int ii = wid * 2 + p, row = 4 * ii + (lane >> 4), cp = lane & 15;
        offK[p] = (unsigned)(row * 1024 + ((cp ^ (row & 15)) << 4)); offV[p] = (unsigned)(row * 1024 + ((cp ^ ((row & 7) << 1)) << 4)); dstw[p] = lds0 + OFF_RING + ii * 1024; }
#define NA_ISSUE(tau, slot) do { const int n_ = (tau) / 17, i_ = (tau) - 17 * n_; const int U_ = vcu + n_ * G; const int b_ = U_ >> 8, hp_ = (U_ >> 6) & 3, r_ = U_ & 63; \
        const int kr_ = (i_ == 0) ? r_ : clampi(r_ - 4, 0, 56) + ((i_ - 1) & 7); const bf16_t* src_ = (i_ == 0) ? qn : (i_ < 9 ? kn : vn); \
        const char* base_ = (const char*)(src_ + ((size_t)(b_ * S_ + kr_ * 64) * 512 + hp_ * 128)); \
        _Pragma("unroll") for (int p = 0; p < 2; ++p) glds16(base_ + (i_ < 9 ? offK[p] : offV[p]), (unsigned)__builtin_amdgcn_readfirstlane(dstw[p] + (slot) * TILE)); } while (0)
    int islot = 0;
#pragma unroll
    for (int d = 0; d < DPF; ++d) { if (d < total) { NA_ISSUE(d, islot); islot = (islot + 1 == NS) ? 0 : islot + 1; } }
    int cslot = 0;
    for (int n = 0; n < nunits; ++n) {
        const int U = vcu + n * G; const int b = U >> 8, hp = (U >> 6) & 3, r = U & 63; const int rs = clampi(r - 4, 0, 56); const int head = hp * 2 + hl;
        const int tok0 = b * S_ + r * 64 + 16 * g;
        bf16x8 qf[2];
        f32x4 s[8][2]; bf16x8 pa[8]; f32x4 o[4]; float lsum = 0.f;
#pragma unroll
        for (int dt = 0; dt < 4; ++dt) o[dt] = (f32x4){0.f, 0.f, 0.f, 0.f};
#pragma clang loop unroll(full)
        for (int i0 = 0; i0 < 17; ++i0) {
            const int tau = n * 17 + i0; const int i = i0 - 1;
            if (tau + DPF <= total) NA_WAITBAR(8); else NA_WAITBAR(0);
            if (tau + DPF < total) { NA_ISSUE(tau + DPF, islot); islot = (islot + 1 == NS) ? 0 : islot + 1; }
            const unsigned sbase = lds0 + OFF_RING + cslot * TILE; cslot = (cslot + 1 == NS) ? 0 : cslot + 1;
            if (i0 == 0) {
                const int kc = 16 * g + lj;
#pragma unroll
                for (int ds = 0; ds < 2; ++ds) { const int c = hl * 8 + ds * 4 + fq; qf[ds] = *(const LAS bf16x8*)(uintptr_t)(sbase + kc * 256 + ((c ^ (kc & 15)) << 4)); }
            } else if (i < 8) {
#pragma unroll
                for (int ct = 0; ct < 2; ++ct) { s[i][ct] = (f32x4){0.f, 0.f, 0.f, 0.f}; const int kc = csg + 16 * ct + lj;
#pragma unroll
                    for (int ds = 0; ds < 2; ++ds) { const int c = hl * 8 + ds * 4 + fq; const bf16x8 a = *(const LAS bf16x8*)(uintptr_t)(sbase + kc * 256 + ((c ^ (kc & 15)) << 4));
                        s[i][ct] = __builtin_amdgcn_mfma_f32_16x16x32_bf16(a, qf[ds], s[i][ct], 0, 0, 0); } }
                if (i == 7) {
                    const int c = 16 * g + lj, cs = clampi(c - 8, 0, 48); float m = -1e30f;
#pragma unroll
                    for (int t = 0; t < 8; ++t) { const LAS float* trow = tab + head * 465 + (rs + t - r + 7) * 31;
#pragma unroll
                        for (int ct = 0; ct < 2; ++ct)
#pragma unroll
                            for (int e = 0; e < 4; ++e) { const int kc = csg + 16 * ct + 4 * fq + e; const bool v = (unsigned)(kc - cs) < 16u; const float bias = trow[v ? (kc - c + 15) : 0];
                                const float x = v ? s[t][ct][e] + bias : -1e30f; s[t][ct][e] = x; m = fmaxf(m, x); } }
                    m = fmaxf(m, __shfl_xor(m, 16)); m = fmaxf(m, __shfl_xor(m, 32));
#pragma unroll
                    for (int t = 0; t < 8; ++t) {
#pragma unroll
                        for (int ct = 0; ct < 2; ++ct)
#pragma unroll
                            for (int e = 0; e < 4; ++e) { const float p = fast_exp2(s[t][ct][e] - m); s[t][ct][e] = p; lsum += p; }
                        u32x4 w; w.x = cvt_pk_bf16(s[t][0][0], s[t][0][1]); w.y = cvt_pk_bf16(s[t][0][2], s[t][0][3]); w.z = cvt_pk_bf16(s[t][1][0], s[t][1][1]); w.w = cvt_pk_bf16(s[t][1][2], s[t][1][3]);
                        pa[t] = __builtin_bit_cast(bf16x8, w); }
                    lsum += __shfl_xor(lsum, 16); lsum += __shfl_xor(lsum, 32);
                }
            } else {
                const int t = i - 8; const int q = lj >> 2, p = lj & 3;
#pragma unroll
                for (int dt = 0; dt < 4; ++dt) { const int c = hl * 8 + 2 * dt + (p >> 1); s16x4 tr[2];
#pragma unroll
                    for (int ct = 0; ct < 2; ++ct) { const int kc = csg + 16 * ct + 4 * fq + q; tr[ct] = vtr(sbase + kc * 256 + ((c ^ ((kc & 7) << 1)) << 4) + (p & 1) * 8); }
                    const bf16x8 vf = (bf16x8){tr[0][0], tr[0][1], tr[0][2], tr[0][3], tr[1][0], tr[1][1], tr[1][2], tr[1][3]};
                    o[dt] = __builtin_amdgcn_mfma_f32_16x16x32_bf16(pa[t], vf, o[dt], 0, 0, 0); }
                if (i == 15) {
                    const float linv = fast_rcp(lsum); float li[4];
#pragma unroll
                    for (int e = 0; e < 4; ++e) li[e] = __shfl(linv, 4 * fq + e);
                    LAS bf16_t* ost = (LAS bf16_t*)(lds + OFF_OST) + wid * 1024;
#pragma unroll
                    for (int dt = 0; dt < 4; ++dt)
#pragma unroll
                        for (int e = 0; e < 4; ++e) { const float val = o[dt][e] * li[e]; ost[(4 * fq + e) * 64 + 16 * dt + lj] = (bf16_t)(cvt_pk_bf16(val, val) & 0xffffu); }
                    asm volatile("s_waitcnt lgkmcnt(0)" ::: "memory");
                    bf16_t* og = on + (size_t)tok0 * 512 + head * 64;
#pragma unroll
                    for (int k = 0; k < 2; ++k) { const int id = lane + 64 * k, row = id >> 3, ch = id & 7; const u32x4 v = *(const LAS u32x4*)(ost + row * 64 + ch * 8); st_g<6>((u32x4*)(og + (size_t)row * 512 + ch * 8), v); }
                }
            }
        }
    }
    asm volatile("s_waitcnt vmcnt(0) lgkmcnt(0)" ::: "memory");
    __syncthreads();
#undef NA_ISSUE
}
#undef NA_WAITBAR
}

namespace na3 {
typedef short v4i16_t __attribute__((ext_vector_type(4)));
constexpr int NS = 6, DPF = 5, TILE = 16384;
constexpr int OFF_RING = 0, OFF_OST = NS * TILE, OFF_TAB = OFF_OST + 8 * 2048, TAB_FLOATS = 8 * 465;
static_assert(OFF_TAB + TAB_FLOATS * 4 <= LDS_BYTES - 64, "na3 LDS");
__device__ __forceinline__ void glds16(const void* gsrc, unsigned lds_dst) { unsigned keep;
    asm volatile("s_mov_b32 %0, m0\n\ts_mov_b32 m0, %2\n\ts_nop 0\n\tglobal_load_lds_dwordx4 %1, off\n\ts_mov_b32 m0, %0" : "=&s"(keep) : "v"(gsrc), "s"(lds_dst) : "memory"); }
__device__ __forceinline__ s16x4 vtr(unsigned addr) { return __builtin_bit_cast(s16x4, __builtin_amdgcn_ds_read_tr16_b64_v4i16((LAS v4i16_t*)(uintptr_t)addr)); }
__device__ __forceinline__ int clampi(int v, int lo, int hi) { return v < lo ? lo : (v > hi ? hi : v); }
#define NA_WAITBAR(N) asm volatile("s_waitcnt vmcnt(" #N ") lgkmcnt(0)\n\ts_barrier" ::: "memory")

__device__ __forceinline__ void na_phase(LAS unsigned char* lds, const bf16_t* qn, const bf16_t* kn, const bf16_t* vn, bf16_t* on, const float* rpb, const int vcu, const int G, const int bal) {
    int tid_ = threadIdx.x; asm volatile("" : "+v"(tid_));
    const int tid = tid_, lane = tid & 63, lj = lane & 15, fq = lane >> 4; const int wid = __builtin_amdgcn_readfirstlane(tid >> 6);
    const int hl = wid >> 2, g = wid & 3; const int csg = (g == 0) ? 0 : (g == 1 ? 8 : (g == 2 ? 24 : 32));
    LAS float* tab = (LAS float*)(lds + OFF_TAB);
    { float tv[8];
#pragma unroll
      for (int k = 0; k < 8; ++k) { const int i = tid + NTHREADS * k; tv[k] = (i < TAB_FLOATS) ? rpb[i] : 0.f; }
#pragma unroll
      for (int k = 0; k < 8; ++k) { const int i = tid + NTHREADS * k; if (i < TAB_FLOATS) tab[i] = tv[k] * LOG2E; } }
    const unsigned lds0 = (unsigned)(uintptr_t)lds;
    if (bal < 0 && vcu >= 1024) { __syncthreads(); return; }
    const int nunits = (bal < 0) ? (1024 - vcu + G - 1) / G : (bal == 128 ? 3 : 5); const int total = nunits * 20;
#define NA_UNIT(n) ((bal < 0 || (n) < 3) ? (vcu + (n) * G) : (768 + 2 * bal + ((n) - 3)))
    unsigned offK[2], offV[2], dstw[2];
#pragma unroll
    for (int p = 0; p < 2; ++p) { const int ii = wid * 2 + p, row = 4 * ii + (lane >> 4), cp = lane & 15;
        offK[p] = (unsigned)(row * 1024 + ((cp ^ (row & 15)) << 4)); offV[p] = (unsigned)(row * 1024 + ((cp ^ ((row & 7) << 1)) << 4)); dstw[p] = lds0 + OFF_RING + ii * 1024; }
#define NA_ISSUE(tau, slot) do { const int n_ = (tau) / 20, i_ = (tau) - 20 * n_; const int U_ = NA_UNIT(n_); const int b_ = U_ >> 7, hp_ = (U_ >> 5) & 3, r_ = (U_ & 31) * 2; \
        const int kr_ = (i_ < 2) ? (r_ + i_) : clampi(clampi(r_ - 4, 0, 56) + ((i_ < 11) ? (i_ - 2) : (i_ - 11)), 0, 63); const bf16_t* src_ = (i_ < 2) ? qn : (i_ < 11 ? kn : vn); \
        const char* base_ = (const char*)(src_ + ((size_t)(b_ * S_ + kr_ * 64) * 512 + hp_ * 128)); \
        _Pragma("unroll") for (int p = 0; p < 2; ++p) glds16(base_ + (i_ < 11 ? offK[p] : offV[p]), (unsigned)__builtin_amdgcn_readfirstlane(dstw[p] + (slot) * TILE)); } while (0)
    int islot = 0;
#pragma unroll
    for (int d = 0; d < DPF; ++d) { if (d < total) { NA_ISSUE(d, islot); islot = (islot + 1 == NS) ? 0 : islot + 1; } }
    int cslot = 0;
    for (int n = 0; n < nunits; ++n) {
        const int U = NA_UNIT(n); const int b = U >> 7, hp = (U >> 5) & 3, r = (U & 31) * 2; const int rs = clampi(r - 4, 0, 56); const int dsh = clampi(r - 3, 0, 56) - rs;
        const int head = hp * 2 + hl;
        const int tok0 = b * S_ + r * 64 + 16 * g;
        bf16x8 qf[2][2];
        f32x4 s[2][9][2]; bf16x8 pa[2][9]; f32x4 o[2][4]; float lsum[2] = {0.f, 0.f};
#pragma unroll
        for (int j = 0; j < 2; ++j)
#pragma unroll
            for (int dt = 0; dt < 4; ++dt) o[j][dt] = (f32x4){0.f, 0.f, 0.f, 0.f};
#pragma clang loop unroll(full)
        for (int i0 = 0; i0 < 20; ++i0) {
            const int tau = n * 20 + i0;
            if (tau + DPF <= total) NA_WAITBAR(8); else NA_WAITBAR(0);
            if (tau + DPF < total) { NA_ISSUE(tau + DPF, islot); islot = (islot + 1 == NS) ? 0 : islot + 1; }
            const unsigned sbase = lds0 + OFF_RING + cslot * TILE; cslot = (cslot + 1 == NS) ? 0 : cslot + 1;
            if (i0 < 2) {
                const int kc = 16 * g + lj;
#pragma unroll
                for (int ds = 0; ds < 2; ++ds) { const int c = hl * 8 + ds * 4 + fq; qf[i0][ds] = *(const LAS bf16x8*)(uintptr_t)(sbase + kc * 256 + ((c ^ (kc & 15)) << 4)); }
            } else if (i0 < 11) {
                const int t = i0 - 2;
#pragma unroll
                for (int ct = 0; ct < 2; ++ct) { const int kc = csg + 16 * ct + lj; s[0][t][ct] = (f32x4){0.f, 0.f, 0.f, 0.f}; s[1][t][ct] = (f32x4){0.f, 0.f, 0.f, 0.f};
#pragma unroll
                    for (int ds = 0; ds < 2; ++ds) { const int c = hl * 8 + ds * 4 + fq; const bf16x8 a = *(const LAS bf16x8*)(uintptr_t)(sbase + kc * 256 + ((c ^ (kc & 15)) << 4));
                        s[0][t][ct] = __builtin_amdgcn_mfma_f32_16x16x32_bf16(a, qf[0][ds], s[0][t][ct], 0, 0, 0); s[1][t][ct] = __builtin_amdgcn_mfma_f32_16x16x32_bf16(a, qf[1][ds], s[1][t][ct], 0, 0, 0); } }
                if (i0 == 10) {
                    const int c = 16 * g + lj, cs = clampi(c - 8, 0, 48);
#pragma unroll
                    for (int j = 0; j < 2; ++j) { float m = -1e30f; const int dj = j ? dsh : 0;
#pragma unroll
                        for (int t2 = 0; t2 < 9; ++t2) { const bool tv = (unsigned)(t2 - dj) < 8u; const int drr = tv ? (rs + t2 - (r + j) + 7) : 0; const LAS float* trow = tab + head * 465 + drr * 31;
#pragma unroll
                            for (int ct = 0; ct < 2; ++ct)
#pragma unroll
                                for (int e = 0; e < 4; ++e) { const int kc = csg + 16 * ct + 4 * fq + e; const bool v = tv && ((unsigned)(kc - cs) < 16u); const float bias = trow[v ? (kc - c + 15) : 0];
                                    const float x = v ? s[j][t2][ct][e] + bias : -1e30f; s[j][t2][ct][e] = x; m = fmaxf(m, x); } }
                        m = fmaxf(m, __shfl_xor(m, 16)); m = fmaxf(m, __shfl_xor(m, 32));
                        float ls = 0.f;
#pragma unroll
                        for (int t2 = 0; t2 < 9; ++t2) {
#pragma unroll
                            for (int ct = 0; ct < 2; ++ct)
#pragma unroll
                                for (int e = 0; e < 4; ++e) { const float p = fast_exp2(s[j][t2][ct][e] - m); s[j][t2][ct][e] = p; ls += p; }
                            u32x4 w; w.x = cvt_pk_bf16(s[j][t2][0][0], s[j][t2][0][1]); w.y = cvt_pk_bf16(s[j][t2][0][2], s[j][t2][0][3]); w.z = cvt_pk_bf16(s[j][t2][1][0], s[j][t2][1][1]); w.w = cvt_pk_bf16(s[j][t2][1][2], s[j][t2][1][3]);
                            pa[j][t2] = __builtin_bit_cast(bf16x8, w); }
                        ls += __shfl_xor(ls, 16); ls += __shfl_xor(ls, 32); lsum[j] = ls; }
                }
            } else {
                const int t = i0 - 11; const int q = lj >> 2, p = lj & 3;
#pragma unroll
                for (int dt = 0; dt < 4; ++dt) { const int c = hl * 8 + 2 * dt + (p >> 1); s16x4 tr[2];
#pragma unroll
                    for (int ct = 0; ct < 2; ++ct) { const int kc = csg + 16 * ct + 4 * fq + q; tr[ct] = vtr(sbase + kc * 256 + ((c ^ ((kc & 7) << 1)) << 4) + (p & 1) * 8); }
                    const bf16x8 vf = (bf16x8){tr[0][0], tr[0][1], tr[0][2], tr[0][3], tr[1][0], tr[1][1], tr[1][2], tr[1][3]};
                    o[0][dt] = __builtin_amdgcn_mfma_f32_16x16x32_bf16(pa[0][t], vf, o[0][dt], 0, 0, 0); o[1][dt] = __builtin_amdgcn_mfma_f32_16x16x32_bf16(pa[1][t], vf, o[1][dt], 0, 0, 0); }
                if (i0 == 19) {
                    LAS bf16_t* ost = (LAS bf16_t*)(lds + OFF_OST) + wid * 1024;
#pragma unroll
                    for (int j = 0; j < 2; ++j) { const float linv = fast_rcp(lsum[j]); float li[4];
#pragma unroll
                        for (int e = 0; e < 4; ++e) li[e] = __shfl(linv, 4 * fq + e);
#pragma unroll
                        for (int dt = 0; dt < 4; ++dt)
#pragma unroll
                            for (int e = 0; e < 4; ++e) { const float val = o[j][dt][e] * li[e]; ost[(4 * fq + e) * 64 + 16 * dt + lj] = (bf16_t)(cvt_pk_bf16(val, val) & 0xffffu); }
                        asm volatile("s_waitcnt lgkmcnt(0)" ::: "memory");
                        bf16_t* og = on + (size_t)(tok0 + j * 64) * 512 + head * 64;
#pragma unroll
                        for (int k = 0; k < 2; ++k) { const int id = lane + 64 * k, row = id >> 3, ch = id & 7; const u32x4 v = *(const LAS u32x4*)(ost + row * 64 + ch * 8); st_g<6>((u32x4*)(og + (size_t)row * 512 + ch * 8), v); }
                        asm volatile("s_waitcnt lgkmcnt(0)" ::: "memory"); }
                }
            }
        }
    }
    asm volatile("s_waitcnt vmcnt(0) lgkmcnt(0)" ::: "memory");
    __syncthreads();
#undef NA_ISSUE
#undef NA_UNIT
}
#undef NA_WAITBAR
}

struct HalfMap { int drow; float cs; bool rp; bool valid; };
template <int NTB>
__device__ __forceinline__ void p0_item64(const float* W, int ldw, int k0, int n0, bf16_t* WT, int ldwt, const HalfMap h0, const HalfMap h1, int dk0, const float* g, LAS float* scr, int lane) {
    const int n4 = (lane & 15) * 4, kq = lane >> 4; const bool hv = (n4 < 32) ? h0.valid : h1.valid; const float cs = (n4 < 32) ? h0.cs : h1.cs;
    f32x4 v[16];
#pragma unroll
    for (int j = 0; j < 16; ++j) { v[j] = (f32x4){0.f, 0.f, 0.f, 0.f}; if (hv) v[j] = ld_g<12>((const f32x4*)(W + (size_t)(k0 + 4 * j + kq) * ldw + n0 + n4)); }
#pragma unroll
    for (int j = 0; j < 16; ++j) { const int k = 4 * j + kq; float sc = cs; if (g) sc *= g[k0 + k];
#pragma unroll
        for (int e = 0; e < 4; ++e) scr[(n4 + e) * 65 + k] = v[j][e] * sc; }
    asm volatile("s_waitcnt lgkmcnt(0)" ::: "memory");
    const int c = lane & 7;
#pragma unroll
    for (int j = 0; j < 8; ++j) { const int nn = 8 * j + (lane >> 3); const LAS float* s = scr + nn * 65 + 8 * c;
        u32x4 o; o.x = cvt_pk_bf16(s[0], s[1]); o.y = cvt_pk_bf16(s[2], s[3]); o.z = cvt_pk_bf16(s[4], s[5]); o.w = cvt_pk_bf16(s[6], s[7]);
        const bool hi_ = nn >= 32; const int w = nn & 31; const bool rp = hi_ ? h1.rp : h0.rp; const int nd = rp ? ((w & 16) + 2 * (w & 7) + ((w >> 3) & 1)) : w;
        const int drow = (hi_ ? h1.drow : h0.drow) + nd;
        if (hi_ ? h1.valid : h0.valid) st_g<NTB>((u32x4*)(WT + (size_t)drow * ldwt + dk0 + k0 + 8 * c), o); }
    asm volatile("s_waitcnt lgkmcnt(0)" ::: "memory");
}
template <int NTB, int HALF = -1>
__device__ __forceinline__ void p0_rows(const float* src, bf16_t* dst, float* rstd, int nrows, int gw, int NGW, int lane) {
#define P0_ROW(m) (HALF < 0 ? (m) : ((((m) >> 11) << 12) | (HALF << 11) | ((m) & 2047)))
    f32x4 nx[4];
    if (gw < nrows) { const f32x4* xr = (const f32x4*)(src + (size_t)P0_ROW(gw) * D_) + lane;
#pragma unroll
        for (int j = 0; j < 4; ++j) nx[j] = ld_g<12>(xr + 64 * j); }
    for (int m = gw; m < nrows; m += NGW) {
        f32x4 v[4]; float s = 0.f;
#pragma unroll
        for (int j = 0; j < 4; ++j) { v[j] = nx[j]; s += (v[j][0] * v[j][0] + v[j][1] * v[j][1]) + (v[j][2] * v[j][2] + v[j][3] * v[j][3]); }
        { const int nm = m + NGW; if (nm < nrows) { const f32x4* xr = (const f32x4*)(src + (size_t)P0_ROW(nm) * D_) + lane;
#pragma unroll
            for (int j = 0; j < 4; ++j) nx[j] = ld_g<12>(xr + 64 * j); } }
        s = wave_sum(s);
        const int row = P0_ROW(m);
        u32x2* o8 = (u32x2*)(dst + (size_t)row * D_) + lane;
#pragma unroll
        for (int j = 0; j < 4; ++j) { u32x2 w; w.x = cvt_pk_bf16(v[j][0], v[j][1]); w.y = cvt_pk_bf16(v[j][2], v[j][3]); st_g<NTB>(o8 + 64 * j, w); }
        if (lane == 0) rstd[row] = rsqrtf(s * (1.0f / 1024.0f) + EPS_);
    }
#undef P0_ROW
}

#define PX(P) ((P).in[0])
#define PMEM(P) ((P).in[1])
#define PGMIX(P) ((P).in[2])
#define PWIN(P) ((P).in[3])
#define PRPB(P) ((P).in[4])
#define PQN(P) ((P).in[5])
#define PWUQ(P) ((P).in[6])
#define PKVN(P) ((P).in[7])
#define PWUKV(P) ((P).in[8])
#define PGMEM(P) ((P).in[9])
#define PWMEMKV(P) ((P).in[10])
#define PWOUT(P) ((P).in[14])
#define PGFFN(P) ((P).in[15])
#define PWROUTER(P) ((P).in[16])
#define PBROUTER(P) ((P).in[17])
#define PWGATE(P) ((P).in[18])
#define PWUP(P) ((P).in[19])
#define PWDOWN(P) ((P).in[20])
#define PGFINAL(P) ((P).in[21])
typedef Args Ptrs;

#ifndef XH_SPLIT
#define XH_SPLIT 1
#endif
#define XH_FLAG 3700
#ifndef EX_K1
#define EX_K1 3
#endif
#ifndef EX_K2
#define EX_K2 2
#endif
#ifndef EX_K3
#define EX_K3 0
#endif
#ifndef EX_K1A
#define EX_K1A 0
#endif
#ifndef EX_P3
#define EX_P3 1
#endif
constexpr int EX_N1A = 768 * EX_K1A, EX_N1 = 768 * EX_K1, EX_N2 = 1024 * EX_K2, EX_N3 = 1024 * EX_K3, EX_TAILS = EX_N1A + EX_N1 + EX_N2 + EX_N3;
constexpr int EX_NP3 = EX_P3 ? (3 * 16 * 256 - EX_TAILS) : 0, EX_DEFER = EX_TAILS + EX_NP3;
static_assert(EX_DEFER <= 3 * 16 * 256, "deferred expert items");
struct ExItem { const float* W; bf16_t* WT; const float* g; int k0, n0, d0; };
__device__ __forceinline__ ExItem ex_decode(const Ptrs& P, int r) {
    const int kind = r >> 12, rr = r & 4095; const int e = rr >> 8, q = rr & 255, kb = q >> 4, n0 = (q & 15) * 64; ExItem it; it.k0 = kb * 64; it.n0 = n0;
    if (kind == 2) { it.W = PWDOWN(P) + (size_t)e * 1048576; it.WT = (bf16_t*)(P.ws + WS_WD) + (size_t)e * 1048576; it.g = nullptr; it.d0 = n0; }
    else { it.W = (kind == 0 ? PWGATE(P) : PWUP(P)) + (size_t)e * 1048576; it.WT = (bf16_t*)(P.ws + WS_WGU) + (size_t)e * 2097152; it.g = PGFFN(P); it.d0 = (n0 >> 7) * 256 + (n0 & 127) + (kind == 1 ? 128 : 0); }
    return it;
}
__device__ __forceinline__ void ex_load(const ExItem& it, int lane, f32x4 (&v)[16]) {
    const int n4 = (lane & 15) * 4, kq = lane >> 4;
#pragma unroll
    for (int j = 0; j < 16; ++j) v[j] = ld_g<12>((const f32x4*)(it.W + (size_t)(it.k0 + 4 * j + kq) * 1024 + it.n0 + n4));
}
__device__ __forceinline__ void ex_finish(const ExItem& it, const f32x4 (&v)[16], LAS float* scr, int lane) {
    const int n4 = (lane & 15) * 4, kq = lane >> 4;
#pragma unroll
    for (int j = 0; j < 16; ++j) { const int k = 4 * j + kq; const float sc = it.g ? it.g[it.k0 + k] : 1.0f;
#pragma unroll
        for (int e = 0; e < 4; ++e) scr[(n4 + e) * 65 + k] = v[j][e] * sc; }
    asm volatile("s_waitcnt lgkmcnt(0)" ::: "memory");
    const int c = lane & 7;
#pragma unroll
    for (int j = 0; j < 8; ++j) { const int nn = 8 * j + (lane >> 3); const LAS float* s_ = scr + nn * 65 + 8 * c;
        u32x4 o; o.x = cvt_pk_bf16(s_[0], s_[1]); o.y = cvt_pk_bf16(s_[2], s_[3]); o.z = cvt_pk_bf16(s_[4], s_[5]); o.w = cvt_pk_bf16(s_[6], s_[7]);
        st_g<10>((u32x4*)(it.WT + (size_t)(it.d0 + nn) * 1024 + it.k0 + 8 * c), o); }
    asm volatile("s_waitcnt lgkmcnt(0)" ::: "memory");
}
template <bool PIPE = true>
__device__ __forceinline__ void p0_expert_range(const Ptrs& P, LAS unsigned char* lds, int first, int count, int widx, int nw, int wave, int lane) {
    asm volatile("" : "+v"(lane));
    LAS float* scr = (LAS float*)(lds + wave * 16640);
    if constexpr (!PIPE) { for (int it = first + widx; it < first + count; it += nw) { f32x4 v[16]; const ExItem ii = ex_decode(P, it); ex_load(ii, lane, v); ex_finish(ii, v, scr, lane); } return; }
    const int end = first + count; int it = __builtin_amdgcn_readfirstlane(first + widx); nw = __builtin_amdgcn_readfirstlane(nw);
    f32x4 va[16], vb[16]; ExItem ia, ib;
    if (it < end) { ia = ex_decode(P, it); ex_load(ia, lane, va); }
    while (it < end) {
        const int it2 = it + nw; const bool h2 = it2 < end;
        if (h2) { ib = ex_decode(P, it2); ex_load(ib, lane, vb); }
        ex_finish(ia, va, scr, lane);
        const int it3 = it2 + nw;
        if (it3 < end) { ia = ex_decode(P, it3); ex_load(ia, lane, va); }
        if (h2) ex_finish(ib, vb, scr, lane);
        it = it3;
    }
}
__device__ __forceinline__ void phase0(const Ptrs& P, LAS unsigned char* lds, int gw, int NGW, int wave, int lane) {
    LAS float* scr = (LAS float*)(lds + wave * 16640);
    bf16_t* win = (bf16_t*)(P.ws + WS_WIN); bf16_t* wuq = (bf16_t*)(P.ws + WS_WUQ); bf16_t* wukv = (bf16_t*)(P.ws + WS_WUKV); bf16_t* wmk = (bf16_t*)(P.ws + WS_WMK);
    bf16_t* wo = (bf16_t*)(P.ws + WS_WO); bf16_t* wout = (bf16_t*)(P.ws + WS_WOUT); bf16_t* wgu = (bf16_t*)(P.ws + WS_WGU); bf16_t* wd = (bf16_t*)(P.ws + WS_WD);
    constexpr int I_E = 16 * 16, I_IN = 16 * 91, I_UQ = 6 * 12, I_UKV = 4 * 16, I_MK = 16 * 16, I_O = 8 * 16, I_OUT = 16 * 16;
    constexpr int NITEMS = 3 * 16 * I_E + I_IN + I_UQ + I_UKV + I_MK + 3 * I_O + I_OUT;
    p0_expert_range<false>(P, lds, EX_DEFER, 3 * 16 * I_E - EX_DEFER, gw, NGW, wave, lane);
    for (int it = gw; it < NITEMS - 3 * 16 * I_E; it += NGW) {
        int r = it;
        if (r < I_IN) { const int kb = r / 91, n0 = (r % 91) * 64; HalfMap hm[2];
#pragma unroll
            for (int hh = 0; hh < 2; ++hh) { const int n = n0 + 32 * hh; hm[hh].valid = n < INC_; hm[hh].drow = n < 2208 ? n : n + 96; hm[hh].cs = n < 512 ? C_NA : ((n >= 2208 && n < 2720) ? C_MEM : 1.0f); hm[hh].rp = (n == 2176); }
            p0_item64<7>(PWIN(P), INC_, kb * 64, n0, win, 1024, hm[0], hm[1], 0, PGMIX(P), scr, lane); continue; } r -= I_IN;
        if (r < I_UQ) { const int kb = r / 12, nb = (r % 12) * 2, n0 = nb * 32;
            p0_item64<7>(PWUQ(P), 768, kb * 64, n0, wuq, 384, HalfMap{n0, C_MLA, (nb % 3) == 2, true}, HalfMap{n0 + 32, C_MLA, ((nb + 1) % 3) == 2, true}, 0, PQN(P), scr, lane); continue; } r -= I_UQ;
        if (r < I_UKV) { const int kb = r / 16, nb = (r % 16) * 2, n0 = nb * 32; const int hh = nb >> 2, part = nb & 3; const int dr = (part < 2) ? (hh * 64 + part * 32) : (512 + hh * 64 + (part - 2) * 32);
            p0_item64<7>(PWUKV(P), 1024, kb * 64, n0, wukv, 384, HalfMap{dr, 1.0f, false, true}, HalfMap{dr + 32, 1.0f, false, true}, 0, PKVN(P), scr, lane); continue; } r -= I_UKV;
        if (r < I_MK) { const int kb = r / 16, n0 = (r % 16) * 64; p0_item64<7>(PWMEMKV(P), 1024, kb * 64, n0, wmk, 1024, HalfMap{n0, 1.0f, false, true}, HalfMap{n0 + 32, 1.0f, false, true}, 0, PGMEM(P), scr, lane); continue; } r -= I_MK;
        if (r < 3 * I_O) { const int br = r / I_O, q = r % I_O, kb = q / 16, n0 = (q % 16) * 64; p0_item64<7>(P.in[11 + br], 1024, kb * 64, n0, wo, 1536, HalfMap{n0, 1.0f, false, true}, HalfMap{n0 + 32, 1.0f, false, true}, br * 512, nullptr, scr, lane); continue; } r -= 3 * I_O;
        { const int kb = r / 16, n0 = (r % 16) * 64; p0_item64<7>(PWOUT(P), 1024, kb * 64, n0, wout, 1024, HalfMap{n0, 1.0f, false, true}, HalfMap{n0 + 32, 1.0f, false, true}, 0, nullptr, scr, lane); }
    }
    for (int i = gw * 64 + lane; i < 12288; i += NGW * 64) ((u32x4*)(win + (size_t)2208 * 1024))[i] = (u32x4){0u, 0u, 0u, 0u};
    bf16_t* xb = XB_PTR(P); float* rstd_x = (float*)(P.ws + WS_RSTDX);
    if (XH_SPLIT && NGW == 2048) p0_rows<11, 0>(PX(P), xb, rstd_x, T_ / 2, gw, NGW, lane);
    else p0_rows<11>(PX(P), xb, rstd_x, T_, gw, NGW, lane);
    bf16_t* memb = (bf16_t*)(P.ws + WS_MEMB); float* rstd_m = (float*)(P.ws + WS_RSTDM);
    p0_rows<11>(PMEM(P), memb, rstd_m, 2048, gw, NGW, lane);
    if (gw == NGW - 1) { float* rope = (float*)(P.ws + WS_ROPE);
        for (int i = lane; i < 512; i += 64) { const int pos = i >> 3, fi = i & 7; const float inv = exp2f(-(float)fi * 1.6609640474436813f); const float ang = (float)pos * inv;
            float rev = ang * 0.15915494309189535f; rev -= floorf(rev); rope[2 * i] = __builtin_amdgcn_cosf(rev); rope[2 * i + 1] = __builtin_amdgcn_sinf(rev); } }
}

__device__ __forceinline__ void phase6(const Ptrs& P, LAS unsigned char* lds, int gw, int NGW, int lane) {
    LAS float* wrT = (LAS float*)lds;
    { f32x4 wv[8]; float gv[8];
#pragma unroll
      for (int k = 0; k < 8; ++k) { const int q = threadIdx.x + NTHREADS * k; wv[k] = ((const f32x4*)PWROUTER(P))[q]; gv[k] = PGFFN(P)[q >> 2]; }
#pragma unroll
      for (int k = 0; k < 8; ++k) { const int q = threadIdx.x + NTHREADS * k; const int d = q >> 2, e0 = (q & 3) * 4;
#pragma unroll
          for (int c = 0; c < 4; ++c) wrT[(e0 + c) * 1024 + d] = wv[k][c] * gv[k]; } }
    __syncthreads();
    const bf16_t* dbuf = (const bf16_t*)(P.ws + WS_H); bf16_t* hb = (bf16_t*)(P.ws + WS_HB); float* rstd_h = (float*)(P.ws + WS_RSTDH); float* aff = (float*)(P.ws + WS_AFF);
    const int b5 = (lane >> 5) & 1, b4 = (lane >> 4) & 1, b3 = (lane >> 3) & 1, b2 = (lane >> 2) & 1; const int e_me = 8 * b5 + 4 * b4 + 2 * b3 + b2;
    const float bias = PBROUTER(P)[e_me];
#if MK_XB_HB
    const bf16_t* xsrc = XB_PTR(P);
    u32x2 xn[4], dn[4];
    if (gw < T_) { const u32x2* xr = (const u32x2*)(xsrc + (size_t)gw * D_) + lane; const u32x2* dr = (const u32x2*)(dbuf + (size_t)gw * D_) + lane;
#else
    f32x4 xn[4]; u32x2 dn[4];
    if (gw < T_) { const f32x4* xr = (const f32x4*)(PX(P) + (size_t)gw * D_) + lane; const u32x2* dr = (const u32x2*)(dbuf + (size_t)gw * D_) + lane;
#endif
#pragma unroll
        for (int j = 0; j < 4; ++j) { xn[j] = ld_g<13>(xr + 64 * j); dn[j] = ld_g<13>(dr + 64 * j); } }
    for (int row = gw; row < T_; row += NGW) {
        asm volatile("" ::: "memory");
        f32x4 v[4]; float ss = 0.f;
#pragma unroll
        for (int j = 0; j < 4; ++j) {
#if MK_XB_HB
            v[j][0] = bflo(xn[j].x); v[j][1] = bfhi(xn[j].x); v[j][2] = bflo(xn[j].y); v[j][3] = bfhi(xn[j].y);
#else
            v[j] = xn[j];
#endif
            const u32x2 w = dn[j]; v[j][0] += bflo(w.x); v[j][1] += bfhi(w.x); v[j][2] += bflo(w.y); v[j][3] += bfhi(w.y);
            ss += (v[j][0] * v[j][0] + v[j][1] * v[j][1]) + (v[j][2] * v[j][2] + v[j][3] * v[j][3]); }
        { const int nrow = row + NGW; if (nrow < T_) {
#if MK_XB_HB
            const u32x2* xr = (const u32x2*)(xsrc + (size_t)nrow * D_) + lane;
#else
            const f32x4* xr = (const f32x4*)(PX(P) + (size_t)nrow * D_) + lane;
#endif
            const u32x2* dr = (const u32x2*)(dbuf + (size_t)nrow * D_) + lane;
#pragma unroll
            for (int j = 0; j < 4; ++j) { xn[j] = ld_g<13>(xr + 64 * j); dn[j] = ld_g<13>(dr + 64 * j); } } }
        u32x2* o8 = (u32x2*)(hb + (size_t)row * D_) + lane;
#pragma unroll
        for (int j = 0; j < 4; ++j) { u32x2 w; w.x = cvt_pk_bf16(v[j][0], v[j][1]); w.y = cvt_pk_bf16(v[j][2], v[j][3]); st_g<8>(o8 + 64 * j, w); }
        float a[16];
#pragma unroll
        for (int e = 0; e < 16; ++e) { float s = 0.f;
#pragma unroll
            for (int j = 0; j < 4; ++j) { const f32x4 w = *(const LAS f32x4*)(wrT + e * 1024 + 4 * lane + 256 * j); s += (v[j][0] * w[0] + v[j][1] * w[1]) + (v[j][2] * w[2] + v[j][3] * w[3]); }
            asm volatile("" : "+v"(s) :: "memory"); a[e] = s; }
        ss = wave_sum(ss); const float rstd = rsqrtf(ss * (1.0f / 1024.0f) + EPS_);
        if (lane == 0) rstd_h[row] = rstd;
        float a8[8], a4[4], a2[2], a1;
#pragma unroll
        for (int k = 0; k < 8; ++k) { const float send = b5 ? a[k] : a[k + 8]; const float recv = __shfl_xor(send, 32); a8[k] = (b5 ? a[k + 8] : a[k]) + recv; }
#pragma unroll
        for (int k = 0; k < 4; ++k) { const float send = b4 ? a8[k] : a8[k + 4]; const float recv = __shfl_xor(send, 16); a4[k] = (b4 ? a8[k + 4] : a8[k]) + recv; }
#pragma unroll
        for (int k = 0; k < 2; ++k) { const float send = b3 ? a4[k] : a4[k + 2]; const float recv = __shfl_xor(send, 8); a2[k] = (b3 ? a4[k + 2] : a4[k]) + recv; }
        { const float send = b2 ? a2[0] : a2[1]; const float recv = __shfl_xor(send, 4); a1 = (b2 ? a2[1] : a2[0]) + recv; }
        a1 += __shfl_xor(a1, 2); a1 += __shfl_xor(a1, 1);
        const float logit = a1 * rstd + bias;
        float mx = logit; mx = fmaxf(mx, __shfl_xor(mx, 4)); mx = fmaxf(mx, __shfl_xor(mx, 8)); mx = fmaxf(mx, __shfl_xor(mx, 16)); mx = fmaxf(mx, __shfl_xor(mx, 32));
        const float pe = expf(logit - mx); float sm = pe; sm += __shfl_xor(sm, 4); sm += __shfl_xor(sm, 8); sm += __shfl_xor(sm, 16); sm += __shfl_xor(sm, 32);
        if ((lane & 3) == 0) aff[(size_t)row * 16 + e_me] = pe / sm;
    }
    __syncthreads();
}

__device__ __forceinline__ void phase7(const Ptrs& P, LAS unsigned char* lds, int G) {
    LAS unsigned* keys = (LAS unsigned*)lds;
    LAS unsigned* hist = keys + 4096;
    LAS unsigned* misc = hist + 256;
    LAS int* tokl = (LAS int*)(misc + 32);
    int tid_ = threadIdx.x; asm volatile("" : "+v"(tid_));
    const int tid = tid_, lane = tid & 63, wid = tid >> 6;
    const float* aff = (const float*)(P.ws + WS_AFF); int* idx = (int*)(P.ws + WS_IDX); float* gsel = (float*)(P.ws + WS_GSEL); int* sel = (int*)(P.ws + WS_SEL);
    const bf16_t* hb = (const bf16_t*)(P.ws + WS_HB); bf16_t* xs = (bf16_t*)(P.ws + WS_XS); const float* rstd_h = (const float*)(P.ws + WS_RSTDH); float* rstd_xs = (float*)(P.ws + WS_RSTDXS);
    for (int task = blockIdx.x; task < 128; task += G) {
        const int b = task >> 4, e = task & 15;
        { float kvv[8];
#pragma unroll
          for (int k = 0; k < 8; ++k) kvv[k] = aff[((size_t)b * S_ + tid + NTHREADS * k) * 16 + e];
#pragma unroll
          for (int k = 0; k < 8; ++k) keys[tid + NTHREADS * k] = __float_as_uint(kvv[k]); }
        if (tid == 0) { misc[0] = 0u; misc[1] = 512u; }
        __syncthreads();
        for (int shift = 24; shift >= 0; shift -= 8) {
            if (tid < 256) hist[tid] = 0u;
            __syncthreads();
            const unsigned prefix = misc[0];
#pragma unroll
            for (int j = 0; j < 8; ++j) { const unsigned k = keys[tid * 8 + j]; if (shift == 24 || (k >> (shift + 8)) == prefix) __hip_atomic_fetch_add(&hist[(k >> shift) & 255u], 1u, __ATOMIC_RELAXED, __HIP_MEMORY_SCOPE_WORKGROUP); }
            __syncthreads();
            if (wid == 0) {
                const unsigned kk = misc[1];
                const unsigned h0 = hist[4 * lane], h1 = hist[4 * lane + 1], h2 = hist[4 * lane + 2], h3 = hist[4 * lane + 3];
                const unsigned s = h0 + h1 + h2 + h3;
                unsigned incl = s;
#pragma unroll
                for (int o = 1; o < 64; o <<= 1) { const unsigned t = __shfl_down(incl, o); if (lane + o < 64) incl += t; }
                const unsigned excl = incl - s;
                if (excl < kk && kk <= incl) {
                    unsigned rem = kk - excl; unsigned bin;
                    if (rem <= h3) { bin = 3; } else { rem -= h3; if (rem <= h2) { bin = 2; } else { rem -= h2; if (rem <= h1) { bin = 1; } else { rem -= h1; bin = 0; } } }
                    misc[0] = (prefix << 8) | (unsigned)(4 * lane + bin); misc[1] = rem;
                }
            }
            __syncthreads();
        }
        const unsigned thr = misc[0], kk = misc[1];
        unsigned kv[8]; unsigned cg_ = 0, ce = 0;
#pragma unroll
        for (int j = 0; j < 8; ++j) { kv[j] = keys[tid * 8 + j]; cg_ += kv[j] > thr ? 1u : 0u; ce += kv[j] == thr ? 1u : 0u; }
        unsigned ig = cg_, ie = ce;
#pragma unroll
        for (int o = 1; o < 64; o <<= 1) { const unsigned tg = __shfl_up(ig, o), te = __shfl_up(ie, o); if (lane >= o) { ig += tg; ie += te; } }
        if (lane == 63) { misc[8 + wid] = ig; misc[16 + wid] = ie; }
        __syncthreads();
        unsigned bg = ig - cg_, be = ie - ce;
        for (int w = 0; w < wid; ++w) { bg += misc[8 + w]; be += misc[16 + w]; }
#pragma unroll
        for (int j = 0; j < 8; ++j) { const int t = tid * 8 + j; const bool isg = kv[j] > thr, ise = kv[j] == thr; const bool s_ = isg || (ise && be < kk);
            const unsigned slot = bg + (be < kk ? be : kk);
            if (s_) { idx[task * 512 + slot] = t; gsel[task * 512 + slot] = __uint_as_float(kv[j]); tokl[slot] = t; }
            sel[((size_t)b * S_ + t) * 16 + e] = s_ ? (int)slot : -1;
            bg += isg ? 1u : 0u; be += ise ? 1u : 0u; }
        __syncthreads();
        { const int t = tokl[tid]; rstd_xs[(size_t)task * 512 + tid] = rstd_h[(size_t)b * S_ + t]; }
        __syncthreads();
    }
}

__device__ __forceinline__ void phase10(const Ptrs& P, int gw, int NGW, int lane) {
    const bf16_t* hbb = (const bf16_t*)(P.ws + WS_HB); const bf16_t* ybuf = (const bf16_t*)(P.ws + WS_XS); const int* sel = (const int*)(P.ws + WS_SEL);
    f32x4 gf[4];
#pragma unroll
    for (int j = 0; j < 4; ++j) gf[j] = ((const f32x4*)PGFINAL(P))[lane + 64 * j];
    u32x2 hw[4]; int sv = -1;
    if (gw < T_) { const u32x2* hr = (const u32x2*)(hbb + (size_t)gw * D_) + lane;
#pragma unroll
        for (int j = 0; j < 4; ++j) hw[j] = ld_g<14>(hr + 64 * j);
        sv = sel[(size_t)gw * 16 + (lane & 15)]; }
    for (int row = gw; row < T_; row += NGW) {
        f32x4 v[4];
#pragma unroll
        for (int j = 0; j < 4; ++j) { v[j][0] = bflo(hw[j].x); v[j][1] = bfhi(hw[j].x); v[j][2] = bflo(hw[j].y); v[j][3] = bfhi(hw[j].y); }
        const int svc = sv; const int b = row >> 12;
        unsigned mask = (unsigned)(__ballot(svc >= 0) & 0xffffull);
        const int nrow = row + NGW;
        if (nrow < T_) { const u32x2* hr = (const u32x2*)(hbb + (size_t)nrow * D_) + lane;
#pragma unroll
            for (int j = 0; j < 4; ++j) hw[j] = ld_g<14>(hr + 64 * j);
            sv = sel[(size_t)nrow * 16 + (lane & 15)]; }
        while (mask) {
            const int e0 = __builtin_ctz(mask); mask &= mask - 1u; const bool two = mask != 0u; const int e1 = two ? __builtin_ctz(mask) : e0; if (two) mask &= mask - 1u;
            const int s0 = __builtin_amdgcn_readlane(svc, e0), s1 = __builtin_amdgcn_readlane(svc, e1);
            const u32x2* y0 = (const u32x2*)(ybuf + ((size_t)(b * 16 + e0) * 512 + s0) * D_) + lane; const u32x2* y1 = (const u32x2*)(ybuf + ((size_t)(b * 16 + e1) * 512 + s1) * D_) + lane;
            u32x2 w0[4], w1[4];
#pragma unroll
            for (int j = 0; j < 4; ++j) { w0[j] = ld_g<14>(y0 + 64 * j); w1[j] = ld_g<14>(y1 + 64 * j); }
            const float f1 = two ? 1.0f : 0.0f;
#pragma unroll
            for (int j = 0; j < 4; ++j) { v[j][0] += bflo(w0[j].x) + f1 * bflo(w1[j].x); v[j][1] += bfhi(w0[j].x) + f1 * bfhi(w1[j].x); v[j][2] += bflo(w0[j].y) + f1 * bflo(w1[j].y); v[j][3] += bfhi(w0[j].y) + f1 * bfhi(w1[j].y); }
        }
        float ss = 0.f;
#pragma unroll
        for (int j = 0; j < 4; ++j) ss += (v[j][0] * v[j][0] + v[j][1] * v[j][1]) + (v[j][2] * v[j][2] + v[j][3] * v[j][3]);
        ss = wave_sum(ss); const float rs = rsqrtf(ss * (1.0f / 1024.0f) + EPS_);
        f32x4* orow = (f32x4*)(P.out + (size_t)row * D_) + lane;
#pragma unroll
        for (int j = 0; j < 4; ++j) st_g<9>(orow + 64 * j, v[j] * rs * gf[j]);
    }
}

#ifndef MK_LAUNCHES
#define MK_LAUNCHES 1
#endif
constexpr int NPHASES = 11;

__global__ void __launch_bounds__(NTHREADS, 2) mk_fwd(Args args) {
    extern __shared__ __attribute__((aligned(16))) unsigned char lds_raw[];
    LAS unsigned char* lds = (LAS unsigned char*)lds_raw;
    cg::grid_group grid = cg::this_grid();
    const int tid = threadIdx.x, lane = tid & 63; const int wave = __builtin_amdgcn_readfirstlane(tid >> 6);
    const int G = gridDim.x; int bx = blockIdx.x; int vcu = (G % 8 == 0) ? (bx % 8) * (G / 8) + bx / 8 : bx;
    int gw = vcu * 8 + wave; const int NGW = G * 8;
    const Args& P = args;
    unsigned char* ws = args.ws; unsigned char* dob = (unsigned char*)args.out;
    const int lo = args.ph_lo, hi = args.ph_hi;
    volatile LAS unsigned* xst = (volatile LAS unsigned*)(lds + LDS_BYTES - 16);
    if (tid < 12) ((volatile LAS unsigned*)(lds + LDS_BYTES - 48))[tid] = 0u;
    __syncthreads();
    XcdBarrier xbar; xbar.bar = (unsigned*)(args.ws + WS_CTL); xbar.x = 0; xbar.st = xst;
    if (args.coop) xbar = xcd_barrier_post((unsigned*)(args.ws + WS_CTL), xst);
#ifndef MK_ONLY
#define MK_ONLY -1
#endif
#define IN(k) ((MK_ONLY < 0 || MK_ONLY == (k)) && lo <= (k) && (k) < hi)
#ifndef MK_REPEAT
#define MK_REPEAT -1
#endif
#define REPS(k) ((MK_REPEAT == (k)) ? 2 : 1)
#ifndef MLA_CALL
#define MLA_CALL att::attn_unit_mla3<0>(lds, A, bh >> 3, bh & 7, U & 15)
#endif
#ifndef ATT_MEM_CALL
#define ATT_MEM_CALL att::attn_unit<128, 128, 1, false>(lds, A, bh >> 2, bh & 3, U & 15)
#endif
#ifndef NA_NS
#define NA_NS na3
#endif
#ifndef MK_NA_V1
#define MK_NA_V1 0
#endif
#ifndef MK_CG_SEAMS
#define MK_CG_SEAMS 0
#endif
#define SEAM(k) do { if (IN(k) && IN((k) + 1)) { if ((k) < MK_CG_SEAMS) grid.sync(); else xcd_barrier(xbar); } } while (0)

    if (args.pad == 0x5eed) grid.sync();
    if (IN(0)) for (int rep = 0; rep < REPS(0); ++rep) { if (rep) xcd_barrier(xbar); phase0(P, lds, gw, NGW, wave, lane); }
    SEAM(0);
#ifndef MK_XCC_ORDER
#define MK_XCC_ORDER 0
#endif
    if (MK_XCC_ORDER && args.coop && lo == 0 && hi > 1 && (G % 8) == 0) {
        if (tid == 0) { unsigned* bar = (unsigned*)(args.ws + WS_CTL); bool ok = true;
#pragma unroll
            for (unsigned j = 0; j < 16; ++j) { const unsigned c = xb_ld(&bar[XB_XCNT(j)]); ok = ok && (c == (j < 8 ? (unsigned)(G / 8) : 0u)); }
            ((volatile LAS unsigned*)(lds + LDS_BYTES - 32))[0] = ok ? 1u : 0u; }
        __syncthreads();
        if (((volatile LAS unsigned*)(lds + LDS_BYTES - 32))[0]) { bx = (int)(xst[2] * 8u + xst[3]); vcu = (bx % 8) * (G / 8) + bx / 8; gw = vcu * 8 + wave; }
        __syncthreads();
    }
    if (IN(1)) for (int rep = 0; rep < REPS(1); ++rep) { if (rep) xcd_barrier(xbar);
        SchedP1 S{bx, G, (const char*)XB_PTR(P), (const char*)(ws + WS_WIN), (const char*)(ws + WS_MEMB), (const char*)(ws + WS_WMK)};
        EpiP1 E{(const float*)(ws + WS_RSTDX), (const float*)(ws + WS_RSTDM), (bf16_t*)(ws + WS_NA), (bf16_t*)(ws + WS_ZC), (bf16_t*)(ws + WS_ZQM), (bf16_t*)(ws + WS_ZG), (bf16_t*)(ws + WS_KVMEM),
                (bf16_t*)(dob + DO_KPE), (float*)(ws + WS_SSQQ), (float*)(ws + WS_SSQKV), (const float*)(ws + WS_ROPE),
                (unsigned*)(ws + WS_CTL) + XH_FLAG, (XH_SPLIT && G == 256) ? 96u : 0u,
                __builtin_amdgcn_make_buffer_rsrc((void*)ws, (short)0, (int)WS_END, 0x00020000), (const char*)ws};
#ifndef MK_P1_SKEW
#define MK_P1_SKEW 1300
#endif
        if (XH_SPLIT && G == 256) {
            if (bx >= 160) {
                p0_rows<11, 1>(PX(P), XB_PTR(P), (float*)(ws + WS_RSTDX), T_ / 2, (bx - 160) * 8 + wave, 768, lane);
                asm volatile("s_waitcnt vmcnt(0)" ::: "memory");
                __syncthreads();
                if (tid == 0) { __builtin_amdgcn_fence(__ATOMIC_RELEASE, "agent"); __hip_atomic_fetch_add((unsigned*)(ws + WS_CTL) + XH_FLAG, 1u, __ATOMIC_RELAXED, __HIP_MEMORY_SCOPE_AGENT); }
            }
        }
        else if (EX_N1A > 0 && G == 256) { if (bx >= 160) p0_expert_range(P, lds, 0, EX_N1A, (bx - 160) * 8 + wave, 768, wave, lane); __syncthreads(); }
        else if (MK_P1_SKEW > 0 && G == 256) {
            const unsigned long long dly = (bx >= 160) ? (unsigned long long)MK_P1_SKEW : 0ull;
            const unsigned long long t0 = __builtin_amdgcn_s_memrealtime();
            while (__builtin_amdgcn_s_memrealtime() - t0 < dly) __builtin_amdgcn_s_sleep(32);
        }
        pg8::gemm_phase<EpiP1, SchedP1, false>(lds, 1024, 1024, S, E);
        if (EX_DEFER > 0) { if (G == 256) { if (bx >= 160) p0_expert_range(P, lds, EX_N1A, EX_N1, (bx - 160) * 8 + wave, 768, wave, lane); }
                            else p0_expert_range(P, lds, 0, EX_TAILS, gw, NGW, wave, lane); }
    }
    SEAM(1);
    if (IN(2)) for (int rep = 0; rep < REPS(2); ++rep) { if (rep) xcd_barrier(xbar);
        SchedP2 S{bx, G, (const char*)(ws + WS_ZC), (const char*)(ws + WS_WUQ), (const char*)(ws + WS_WUKV)};
        EpiP2 E{(const float*)(ws + WS_SSQQ), (const float*)(ws + WS_SSQKV), (bf16_t*)(dob + DO_QMLA), (bf16_t*)(dob + DO_KVBUF), (const float*)(ws + WS_ROPE)};
        pg8::gemm_phase<EpiP2, SchedP2, false>(lds, 768, 384, S, E);
        if (EX_N2 > 0 && G == 256 && bx >= 128) p0_expert_range(P, lds, EX_N1A + EX_N1, EX_N2, (bx - 128) * 8 + wave, 1024, wave, lane);
    }
    SEAM(2);
#ifndef EX_SLOTS
#define EX_SLOTS 7
#endif
#define EX_P3_RUN do { p0_expert_range(P, lds, EX_TAILS, EX_NP3, vcu * 8 + wave, G * 8, wave, lane); __syncthreads(); exdone_ = true; } while (0)
    if (IN(3)) {
        bool exdone_ = true;
#ifdef MK_ABL
        { att::AttnArgs A{(const bf16_t*)(dob + DO_QMLA), (const bf16_t*)(dob + DO_KVBUF), (const bf16_t*)(dob + DO_KPE), (const bf16_t*)(dob + DO_KVBUF) + 512, (bf16_t*)(ws + WS_ZC), nullptr};
          for (int U = vcu; U < 1024; U += G) { const int bh = U >> 4; att::attn_unit_mla3<MK_ABL>(lds, A, bh >> 3, bh & 7, U & 15); } xcd_barrier(xbar); }
#endif
        { att::AttnArgs A{(const bf16_t*)(dob + DO_QMLA), (const bf16_t*)(dob + DO_KVBUF), (const bf16_t*)(dob + DO_KPE), (const bf16_t*)(dob + DO_KVBUF) + 512, (bf16_t*)(ws + WS_ZC), nullptr};
          for (int rep = 0; rep < REPS(30); ++rep) { if (rep) xcd_barrier(xbar);
          int it_ = 0; const int slot_ = vcu % EX_SLOTS; exdone_ = (EX_NP3 == 0) || rep > 0;
          for (int U = vcu; U < 1024; U += G, ++it_) {
              if (!exdone_ && it_ == slot_) { EX_P3_RUN; }
              const int bh = U >> 4; MLA_CALL; }
          if (!exdone_ && slot_ <= 4) { EX_P3_RUN; } } }
        NA_NS::na_phase(lds, (const bf16_t*)(ws + WS_NA), (const bf16_t*)(ws + WS_NA) + (size_t)T_ * 512, (const bf16_t*)(ws + WS_NA) + (size_t)2 * T_ * 512, (bf16_t*)(ws + WS_NA), args.in[4], vcu, G, -1);
        if (!exdone_ && (vcu % EX_SLOTS) == 5) { EX_P3_RUN; }
        { att::AttnArgs A{(const bf16_t*)(ws + WS_ZQM), (const bf16_t*)(ws + WS_KVMEM), nullptr, (const bf16_t*)(ws + WS_KVMEM) + 512, (bf16_t*)(ws + WS_ZQM), nullptr};
          for (int U = vcu; U < 512; U += G) { const int bh = U >> 4; ATT_MEM_CALL; } }
        if (!exdone_) { EX_P3_RUN; }
    }
    SEAM(3);
    if (IN(4)) for (int rep = 0; rep < REPS(4); ++rep) { if (rep) xcd_barrier(xbar);
        SchedP4 S{bx, G, (const char*)(ws + WS_NA), (const char*)(ws + WS_ZC), (const char*)(ws + WS_ZQM), (const char*)(ws + WS_WO)};
#ifndef MK_P4_NOHOOK
#define MK_P4_NOHOOK 0
#endif
        EpiP4 E{(const bf16_t*)(ws + WS_ZG), (bf16_t*)(dob + DO_MERGED), (MK_P4_NOHOOK && REPS(4) == 2 && rep == 0) ? 1 : 0};
#ifndef MK_P4_SKEW
#define MK_P4_SKEW 0
#endif
        if (MK_P4_SKEW > 0) {
            const unsigned long long dly = (bx & 8) ? (unsigned long long)MK_P4_SKEW : 0ull;
            const unsigned long long t0 = __builtin_amdgcn_s_memrealtime();
            while (__builtin_amdgcn_s_memrealtime() - t0 < dly) __builtin_amdgcn_s_sleep(32);
        }
        pg8::gemm_phase<EpiP4, SchedP4, true>(lds, 512, 1536, S, E);
    }
    SEAM(4);
    if (IN(5)) for (int rep = 0; rep < REPS(5); ++rep) { if (rep) xcd_barrier(xbar);
        SchedP5 S{bx, G, (const char*)(dob + DO_MERGED), (const char*)(ws + WS_WOUT)};
        EpiP5 E{(bf16_t*)(ws + WS_H)};
        pg8::gemm_phase<EpiP5, SchedP5, false>(lds, 1024, 1024, S, E);
    }
    SEAM(5);
    if (IN(6)) for (int rep = 0; rep < REPS(6); ++rep) { if (rep) xcd_barrier(xbar); phase6(P, lds, gw, NGW, lane); }
    SEAM(6);
    if (IN(7)) for (int rep = 0; rep < REPS(7); ++rep) { if (rep) xcd_barrier(xbar); phase7(P, lds, G);
        if (EX_N3 > 0 && G == 256 && (int)blockIdx.x >= 128) p0_expert_range(P, lds, EX_N1A + EX_N1 + EX_N2, EX_N3, ((int)blockIdx.x - 128) * 8 + wave, 1024, wave, lane); }
    SEAM(7);
    if (IN(8)) for (int rep = 0; rep < REPS(8); ++rep) { if (rep) xcd_barrier(xbar);
        SchedP8 S{bx, G, (const char*)(ws + WS_HB), (const char*)(ws + WS_WGU)};
        EpiP8 E{(const float*)(ws + WS_RSTDXS), (bf16_t*)(dob + DO_ACT)};
        LAS int* gtab = (LAS int*)(lds + pg8::STAGE_BYTES);
        { const int* idxg = (const int*)(ws + WS_IDX); pg8::Unit u_; int rowv[8], tokv[8];
#pragma unroll
          for (int i = 0; i < 8; ++i) { rowv[i] = S.next(i, u_) ? u_.pm * 256 + (tid & 255) : -1; }
#pragma unroll
          for (int i = 0; i < 8; ++i) tokv[i] = (rowv[i] >= 0) ? idxg[rowv[i]] : 0;
#pragma unroll
          for (int i = 0; i < 8; ++i) if (rowv[i] >= 0 && tid < 256) gtab[i * 256 + tid] = tokv[i] + (rowv[i] >> 13) * S_;
          __syncthreads(); }
        pg8::gemm_phase<EpiP8, SchedP8, false, true>(lds, 1024, 1024, S, E, gtab);
    }
    SEAM(8);
    if (IN(9)) for (int rep = 0; rep < REPS(9); ++rep) { if (rep) xcd_barrier(xbar);
        SchedP9 S{bx, G, (const char*)(dob + DO_ACT), (const char*)(ws + WS_WD)};
        EpiP9 E{(const float*)(ws + WS_GSEL), (bf16_t*)(ws + WS_XS)};
        pg8::gemm_phase<EpiP9, SchedP9, false>(lds, 1024, 1024, S, E);
    }
    SEAM(9);
    if (IN(10)) for (int rep = 0; rep < REPS(10); ++rep) { if (rep) xcd_barrier(xbar); phase10(P, gw, NGW, lane); }
#undef IN
#undef SEAM
}

extern "C" void kernel_launch(void* const* d_in, const int* in_sizes, int n_in, void* d_out, int out_size, void* d_ws, size_t ws_size, hipStream_t stream) {
    static int grid = 0;
    if (grid == 0) {
        if (n_in != 22 || out_size != T_ * D_ || ws_size < WS_END) { fprintf(stderr, "kernel_launch: unexpected shapes (n_in %d out %d ws %zu)\n", n_in, out_size, ws_size); grid = -1; return; }
        int dev = 0, cus = 0, per_cu = 0;
        hipGetDevice(&dev); hipDeviceGetAttribute(&cus, hipDeviceAttributeMultiprocessorCount, dev);
        if (hipFuncSetAttribute((const void*)mk_fwd, hipFuncAttributeMaxDynamicSharedMemorySize, LDS_BYTES) != hipSuccess) { fprintf(stderr, "kernel_launch: hipFuncSetAttribute failed\n"); grid = -1; return; }
        hipOccupancyMaxActiveBlocksPerMultiprocessor(&per_cu, (const void*)mk_fwd, NTHREADS, LDS_BYTES);
        (void)hipGetLastError();
        if (per_cu < 1) { fprintf(stderr, "kernel_launch: occupancy query says %d blocks per CU\n", per_cu); per_cu = 1; }
        grid = cus * 1;
        fprintf(stderr, "kernel_launch: cus %d per_cu %d grid %d ws %zu\n", cus, per_cu, grid, ws_size);
    }
    if (grid < 0) return;
    if (hipMemsetAsync((char*)d_ws + WS_CTL, 0, CTL_BYTES, stream) != hipSuccess) { fprintf(stderr, "kernel_launch: memset failed\n"); return; }
    Args a{};
    for (int i = 0; i < 22; ++i) a.in[i] = (const float*)d_in[i];
    a.out = (float*)d_out; a.ws = (unsigned char*)d_ws;
#if MK_LAUNCHES == 1
    a.ph_lo = 0; a.ph_hi = NPHASES; a.coop = 1;
    void* kargs[] = {&a};
    hipError_t e = hipLaunchCooperativeKernel((const void*)mk_fwd, dim3(grid), dim3(NTHREADS), kargs, LDS_BYTES, stream);
    if (e != hipSuccess) fprintf(stderr, "kernel_launch: cooperative launch failed: %s (grid %d)\n", hipGetErrorString(e), grid);
#else
    for (int p = 0; p < NPHASES; ++p) { a.ph_lo = p; a.ph_hi = p + 1; a.coop = 0; hipLaunchKernelGGL(mk_fwd, dim3(grid), dim3(NTHREADS), LDS_BYTES, stream, a); }
#endif
}
```

```cpp
#include <hip/hip_runtime.h>
#include <hip/hip_cooperative_groups.h>
#include <cstdio>
#include <cstdint>
namespace cg = cooperative_groups;

#define LAS __attribute__((address_space(3)))
typedef unsigned short bf16_t;
typedef short bf16x8 __attribute__((ext_vector_type(8)));
typedef short s16x4 __attribute__((ext_vector_type(4)));
typedef float f32x2 __attribute__((ext_vector_type(2)));
typedef float f32x4 __attribute__((ext_vector_type(4)));
typedef float f32x16 __attribute__((ext_vector_type(16)));
typedef unsigned u32x2 __attribute__((ext_vector_type(2)));
typedef unsigned u32x4 __attribute__((ext_vector_type(4)));

constexpr int T_ = 32768, S_ = 4096, D_ = 1024, NB_ = 8, INC_ = 5792, NZ_ = 5888;
constexpr float EPS_ = 1e-6f;
constexpr float LOG2E = 1.4426950408889634f;
constexpr float C_NA = 0.125f * LOG2E, C_MLA = 0.10206207261596577f * LOG2E, C_MEM = 0.08838834764831845f * LOG2E;

constexpr size_t MiB = (size_t)1 << 20;
constexpr size_t WS_WIN = 0;
constexpr size_t WS_WUQ = 12 * MiB;
constexpr size_t WS_WUKV = 13 * MiB;
constexpr size_t WS_WMK = 14 * MiB;
constexpr size_t WS_WO = 16 * MiB;
constexpr size_t WS_WOUT = 19 * MiB;
constexpr size_t WS_WGU = 21 * MiB;
constexpr size_t WS_WD = 85 * MiB;
constexpr size_t WS_RSTDX = 117 * MiB;
constexpr size_t WS_RSTDM = WS_RSTDX + 128 * 1024;
constexpr size_t WS_RSTDH = WS_RSTDM + 128 * 1024;
constexpr size_t WS_ROPE = WS_RSTDH + 128 * 1024;
constexpr size_t WS_RSTDXS = WS_ROPE + 128 * 1024;
constexpr size_t WS_GSEL = WS_RSTDXS + 256 * 1024;
constexpr size_t WS_IDX = WS_GSEL + 256 * 1024;
constexpr size_t WS_SSQQ = 119 * MiB;
constexpr size_t WS_SSQKV = 121 * MiB;
constexpr size_t WS_AFF = 122 * MiB;
constexpr size_t WS_SEL = 124 * MiB;
constexpr size_t WS_MEMB = 126 * MiB;
constexpr size_t WS_KVMEM = 130 * MiB;
constexpr size_t WS_ZG = 134 * MiB;
constexpr size_t WS_H = 134 * MiB;
constexpr size_t WS_HB = 262 * MiB;
constexpr size_t WS_NA = 326 * MiB;
constexpr size_t WS_XS = 326 * MiB;
constexpr size_t WS_ZC = 422 * MiB;
constexpr size_t WS_ZQM = 470 * MiB;
constexpr size_t WS_CTL = 502 * MiB;
constexpr size_t CTL_BYTES = 16384;
constexpr size_t WS_END = 503 * MiB;
constexpr size_t DO_XB = 0, DO_QMLA = 0, DO_KVBUF = 48 * MiB, DO_KPE = 112 * MiB, DO_MERGED = 0, DO_ACT = 0;

constexpr int LDS_BYTES = 147456;
constexpr int NTHREADS = 512;

typedef __bf16 bf16x2_t __attribute__((ext_vector_type(2)));
__device__ __forceinline__ unsigned cvt_pk_bf16(float lo, float hi) { const f32x2 v = {lo, hi}; const bf16x2_t b = __builtin_convertvector(v, bf16x2_t); return __builtin_bit_cast(unsigned, b); }
__device__ __forceinline__ float bf2f(unsigned short b) { return __uint_as_float(((unsigned)b) << 16); }
__device__ __forceinline__ float bflo(unsigned w) { return __uint_as_float(w << 16); }
__device__ __forceinline__ float bfhi(unsigned w) { return __uint_as_float(w & 0xffff0000u); }
__device__ __forceinline__ float wave_sum(float v) {
#pragma unroll
    for (int o = 1; o < 64; o <<= 1) v += __shfl_xor(v, o);
    return v;
}
__device__ __forceinline__ float fast_exp2(float x) { return __builtin_amdgcn_exp2f(x); }
__device__ __forceinline__ float fast_rcp(float x) { return __builtin_amdgcn_rcpf(x); }
__device__ __forceinline__ int crow(int r, int hi) { return (r & 3) + 8 * (r >> 2) + 4 * hi; }


#define XB_TMO      128
#define XB_XCNT(j)  (256  + 64 * (j))
#define XB_XSUB(j)  (1280 + 64 * (j))
#define XB_XGEN(j)  (2304 + 64 * (j))
#define XB_TOP      3328
#define XB_TOPGEN   3392
#define XCD_BAR_WORDS 3456
#define XB_SPIN_CAP (1u << 18)
__device__ __forceinline__ unsigned xb_ld(unsigned* p)              { return __hip_atomic_load(p, __ATOMIC_RELAXED, __HIP_MEMORY_SCOPE_AGENT); }
__device__ __forceinline__ unsigned xb_add(unsigned* p, unsigned v) { return __hip_atomic_fetch_add(p, v, __ATOMIC_RELAXED, __HIP_MEMORY_SCOPE_AGENT); }
__device__ __forceinline__ unsigned xb_xcc_id() { return (unsigned)__builtin_amdgcn_s_getreg((3 << 11) | 20) & 0xFu; }
#define XB_SPIN(cond, bar) do { unsigned _sp = 0; while (cond) { __builtin_amdgcn_s_sleep(1); \
    if ((++_sp & 255u) == 0u) { if (xb_ld(&(bar)[XB_TMO])) break; if (_sp > XB_SPIN_CAP) { atomicAdd(&(bar)[XB_TMO], 1u); break; } } } } while (0)
struct XcdBarrier { unsigned* bar; unsigned x; volatile LAS unsigned* st; };
__device__ __forceinline__ XcdBarrier xcd_barrier_post(unsigned* bar, volatile LAS unsigned* st) {
    XcdBarrier b; b.bar = bar; b.x = xb_xcc_id(); b.st = st;
    if (threadIdx.x == 0) { const unsigned rank = xb_add(&bar[XB_XCNT(b.x)], 1u); st[2] = rank; st[3] = b.x; }
    return b;
}
__device__ __forceinline__ void xcd_barrier_complete(unsigned* bar, unsigned x, unsigned& nloc, unsigned& nx) {
    const unsigned G = gridDim.x * gridDim.y * gridDim.z;
    unsigned sum, cnt, mine, sp = 0u;
    for (;;) {
        sum = 0u; cnt = 0u; mine = 0u;
#pragma unroll
        for (unsigned j = 0; j < 16; ++j) { const unsigned c = xb_ld(&bar[XB_XCNT(j)]); sum += c; cnt += (c > 0u) ? 1u : 0u; mine = (j == x) ? c : mine; }
        if (sum == G) break;
        __builtin_amdgcn_s_sleep(1);
        if ((++sp & 255u) == 0u) { if (xb_ld(&bar[XB_TMO])) break; if (sp > XB_SPIN_CAP) { atomicAdd(&bar[XB_TMO], 1u); break; } }
    }
    nloc = mine > 0u ? mine : 1u; nx = cnt > 0u ? cnt : 1u;
}
__device__ __forceinline__ void xcd_barrier(const XcdBarrier& b) {
    asm volatile("s_waitcnt vmcnt(0)" ::: "memory");
    __syncthreads();
    if (threadIdx.x == 0) {
        unsigned* bar = b.bar;
        __builtin_amdgcn_s_waitcnt(0);
        unsigned nloc = b.st[0], nx = b.st[1];
        if (nloc == 0u) { xcd_barrier_complete(bar, b.x, nloc, nx); b.st[0] = nloc; b.st[1] = nx; }
        const unsigned old = xb_add(&bar[XB_XSUB(b.x)], 1u);
        const unsigned gen = old / nloc;
        if (old + 1u == (gen + 1u) * nloc) {
            __builtin_amdgcn_fence(__ATOMIC_RELEASE, "agent");
            asm volatile("s_waitcnt vmcnt(0)" ::: "memory");
            const unsigned og = xb_add(&bar[XB_TOP], 1u);
            const unsigned tg = og / nx;
            if (og + 1u == (tg + 1u) * nx) xb_add(&bar[XB_TOPGEN], 1u);
            else XB_SPIN(xb_ld(&bar[XB_TOPGEN]) == tg, bar);
            __builtin_amdgcn_fence(__ATOMIC_ACQUIRE, "agent");
            xb_add(&bar[XB_XGEN(b.x)], 1u);
            asm volatile("s_waitcnt vmcnt(0)" ::: "memory");
        } else {
            XB_SPIN(xb_ld(&bar[XB_XGEN(b.x)]) == gen, bar);
            __builtin_amdgcn_fence(__ATOMIC_ACQUIRE, "agent");
            asm volatile("s_waitcnt vmcnt(0)" ::: "memory");
        }
    }
    __syncthreads();
}

struct Args { const float* in[22]; float* out; unsigned char* ws; int ph_lo, ph_hi, coop, pad; };

#ifndef MK_NT
#define MK_NT 0x3001
#endif
template <int BIT, class V> __device__ __forceinline__ void st_g(V* p, const V v) { if constexpr ((MK_NT >> BIT) & 1) __builtin_nontemporal_store(v, p); else *p = v; }
template <int BIT, class V> __device__ __forceinline__ V ld_g(const V* p) { if constexpr ((MK_NT >> BIT) & 1) return __builtin_nontemporal_load(p); else return *p; }
#ifndef MK_XB_HB
#define MK_XB_HB 0
#endif
#if MK_XB_HB
#define XB_PTR(P) ((bf16_t*)((P).ws + WS_HB))
#else
#define XB_PTR(P) ((bf16_t*)(((unsigned char*)(P).out) + DO_XB))
#endif

namespace pg8 {
#ifndef PG8_WGM
#define PG8_WGM 8
#endif
constexpr int BM = 256, BK = 64, HALF = 128, HTB = HALF * BK * 2, STAGE_BYTES = 8 * HTB, NXCD = 8, WGM = PG8_WGM;
__device__ __forceinline__ int lds_byte(int r, int c) { const int st = (r >> 4) * 2 + (c >> 5), rr = r & 15, cc = c & 31, ob = rr * 64 + cc * 2; return st * 1024 + (ob ^ (((ob >> 9) & 1) << 5)); }
__device__ __forceinline__ void stage_rc(int b, int& R, int& C) { const int st = b / 1024, sb = b % 1024, swz = sb ^ (((sb >> 9) & 1) << 5); R = (st >> 1) * 16 + swz / 64; C = (st & 1) * 32 + (swz % 64) / 2; }
__device__ __forceinline__ int perm32(int rho) { const int n = rho >> 4, i = rho & 15; return 8 * (i >> 2) + 4 * n + (i & 3); }

struct Unit { int pm, pn, kind, nt, aux; const char* A; const char* A1; const char* A2; const char* B; };

__device__ __forceinline__ void tile_order(int L, int nM, int nN, int& pm, int& pn) {
    const int nwg = nM * nN; int wgid = L;
    { const int q = nwg / NXCD, r = nwg % NXCD, xcd = wgid % NXCD, off = wgid / NXCD; wgid = (xcd < r ? xcd * (q + 1) : r * (q + 1) + (xcd - r) * q) + off; }
    const int nig = WGM * nN, gid = wgid / nig, fm = gid * WGM, gsz = (nM - fm) < WGM ? (nM - fm) : WGM;
    pm = fm + ((wgid % nig) % gsz); pn = (wgid % nig) / gsz;
}

template <class Epi, class Sched, bool SEG3, bool GATHER = false>
__device__ __forceinline__ void gemm_phase(LAS unsigned char* lds, const int lda, const int ldb, const Sched& S, const Epi& E, const LAS int* gtab = nullptr) {
    int tid_ = threadIdx.x; asm volatile("" : "+v"(tid_));
    const int tid = tid_, wid = __builtin_amdgcn_readfirstlane(tid >> 6), lane = tid & 63, wr = wid >> 2, wc = wid & 3, fr = lane & 15, fq = lane >> 4;
    unsigned voffA[2], voffB[2]; int gR[2]; unsigned gC[2];
#pragma unroll
    for (int i = 0; i < 2; ++i) { int R, C; stage_rc(tid * 16 + i * 8192, R, C); gR[i] = R; gC[i] = (unsigned)C * 2u; const int Rb = Epi::PERM ? ((R & ~31) + perm32(R & 31)) : R;
        voffA[i] = (unsigned)(R * lda + C) * 2u; voffB[i] = (unsigned)(Rb * ldb + C) * 2u; }
    const size_t kstep = (size_t)(BK * 2);
    const size_t hstepA = (size_t)HALF * lda * 2, hstepB = (size_t)HALF * ldb * 2;
    const unsigned ldsw = (unsigned)wid * 1024u;
    const int aoff = lds_byte(wr * 64 + fr, fq * 8), boff = lds_byte(wc * 32 + fr, fq * 8);
#define PG8_SA(b, h) (((b) * 2 + (h)) * HTB)
#define PG8_SB(b, h) ((4 + (b) * 2 + (h)) * HTB)
#define PG8_STAGE(bufoff, gbase, voff) do { _Pragma("unroll") for (int _i = 0; _i < 2; ++_i) \
        __builtin_amdgcn_global_load_lds((const unsigned*)((const char*)(gbase) + (voff)[_i]), (LAS unsigned*)(lds + (bufoff) + ldsw + _i * 8192), 16, 0, 0); } while (0)
#define PG8_GLOAD(dst, ord) do { _Pragma("unroll") for (int _h = 0; _h < 2; ++_h) _Pragma("unroll") for (int _i = 0; _i < 2; ++_i) dst[_h][_i] = (unsigned)gtab[(ord) * 256 + _h * 128 + gR[_i]] * (unsigned)(lda * 2) + gC[_i]; } while (0)
#define PG8_STAGE_A(bufoff, kptr, h, VS) do { if constexpr (GATHER) { PG8_STAGE(bufoff, kptr, VS[h]); } else { PG8_STAGE(bufoff, (kptr) + (h) * hstepA, voffA); } } while (0)
#define PG8_LDA(dst, b, h) do { _Pragma("unroll") for (int m = 0; m < 4; ++m) _Pragma("unroll") for (int k = 0; k < 2; ++k) dst[m][k] = *(const LAS bf16x8*)(lds + PG8_SA(b, h) + aoff + m * 2048 + k * 1024); } while (0)
#define PG8_LDB(dst, b, h) do { _Pragma("unroll") for (int n = 0; n < 2; ++n) _Pragma("unroll") for (int k = 0; k < 2; ++k) dst[n][k] = *(const LAS bf16x8*)(lds + PG8_SB(b, h) + boff + n * 2048 + k * 1024); } while (0)
#define PG8_MMA(ai, bj, At, Bt) do { __builtin_amdgcn_s_setprio(1); _Pragma("unroll") for (int m = 0; m < 4; ++m) _Pragma("unroll") for (int n = 0; n < 2; ++n) _Pragma("unroll") for (int k = 0; k < 2; ++k) \
        acc[ai][bj][m][n] = __builtin_amdgcn_mfma_f32_16x16x32_bf16(Bt[n][k], At[m][k], acc[ai][bj][m][n], 0, 0, 0); __builtin_amdgcn_s_setprio(0); } while (0)
#define PG8_WAIT_V(n) asm volatile("s_waitcnt vmcnt(" #n ")" ::: "memory")
#define PG8_WAIT_L(n) asm volatile("s_waitcnt lgkmcnt(" #n ")" ::: "memory")
#define PG8_BAR __builtin_amdgcn_s_barrier()
#define PG8_SCHED __builtin_amdgcn_sched_barrier(0)
#define PG8_TA(u, kt) (SEG3 ? (((kt) < 8 ? (u).A : ((kt) < 16 ? (u).A1 : (u).A2)) + (size_t)((kt) & 7) * kstep) : ((u).A + (size_t)(kt) * kstep))
#define PG8_TB(u, kt) ((u).B + (size_t)(kt) * kstep)
    Unit cur, nxt; int ui = 0;
    if (!S.next(0, cur)) return;
    f32x4 acc[2][2][4][2];
#pragma unroll
    for (int a = 0; a < 2; ++a)
#pragma unroll
        for (int b = 0; b < 2; ++b)
#pragma unroll
            for (int m = 0; m < 4; ++m)
#pragma unroll
                for (int n = 0; n < 2; ++n) acc[a][b][m][n] = (f32x4){0.f, 0.f, 0.f, 0.f};
    bf16x8 At[4][2], B0[2][2], B1[2][2];
    unsigned vC[2][2], vN[2][2];
#pragma unroll
    for (int _h = 0; _h < 2; ++_h)
#pragma unroll
        for (int _i = 0; _i < 2; ++_i) { vC[_h][_i] = 0u; vN[_h][_i] = 0u; }
    if constexpr (GATHER) { PG8_GLOAD(vC, cur.aux); }
    {
        const char* cA = PG8_TA(cur, 0); const char* cB = PG8_TB(cur, 0);
        PG8_STAGE(PG8_SB(0, 0), cB, voffB); PG8_STAGE(PG8_SB(0, 1), cB + hstepB, voffB); PG8_STAGE_A(PG8_SA(0, 0), cA, 0, vC); PG8_STAGE_A(PG8_SA(0, 1), cA, 1, vC);
        if (wr == 1) PG8_BAR;
        PG8_WAIT_V(2); PG8_BAR;
        const char* cA1 = PG8_TA(cur, 1); const char* cB1 = PG8_TB(cur, 1);
        PG8_STAGE(PG8_SB(1, 0), cB1, voffB); PG8_STAGE_A(PG8_SA(1, 0), cA1, 0, vC); PG8_STAGE(PG8_SB(1, 1), cB1 + hstepB, voffB);
        PG8_WAIT_V(6); PG8_BAR;
    }
    for (;;) {
        const bool has_next = S.next(ui + 1, nxt);
        if constexpr (GATHER) { if (has_next) PG8_GLOAD(vN, nxt.aux); }
        const int nt = cur.nt;
        for (int t = 0; t < nt; t += 2) {
            const bool last = (t == nt - 2);
            const char* a1 = PG8_TA(cur, t + 1);
            const char* a2; const char* b2;
            if (last) { if (has_next) { a2 = PG8_TA(nxt, 0); b2 = PG8_TB(nxt, 0); } else { a2 = PG8_TA(cur, 0); b2 = PG8_TB(cur, 0); } }
            else { a2 = PG8_TA(cur, t + 2); b2 = PG8_TB(cur, t + 2); }
            const char* a3 = a2 + kstep; const char* b3 = b2 + kstep;
            unsigned vS[2][2];
#pragma unroll
            for (int _h = 0; _h < 2; ++_h)
#pragma unroll
                for (int _i = 0; _i < 2; ++_i) vS[_h][_i] = (last && has_next) ? vN[_h][_i] : vC[_h][_i];
            if constexpr (Epi::HAS_MID) { if (t > 0 && (t & 7) == 0) E.mid(acc, cur, t >> 3, wr, wc, fr, fq); }
            PG8_LDB(B0, 0, 0); PG8_LDB(B1, 0, 1); PG8_SCHED; PG8_LDA(At, 0, 0); PG8_STAGE_A(PG8_SA(1, 1), a1, 1, vC);
            PG8_WAIT_V(8); PG8_WAIT_L(0); PG8_BAR; PG8_MMA(0, 0, At, B0); PG8_MMA(0, 1, At, B1); PG8_BAR; PG8_SCHED;
            PG8_LDA(At, 0, 1); PG8_STAGE(PG8_SB(0, 0), b2, voffB); PG8_STAGE(PG8_SB(0, 1), b2 + hstepB, voffB); PG8_STAGE_A(PG8_SA(0, 0), a2, 0, vS);
            PG8_WAIT_V(8); PG8_WAIT_L(0); PG8_BAR; PG8_MMA(1, 0, At, B0); PG8_MMA(1, 1, At, B1); PG8_BAR; PG8_SCHED;
            PG8_LDB(B0, 1, 0); PG8_LDB(B1, 1, 1); PG8_SCHED; PG8_LDA(At, 1, 0); PG8_STAGE_A(PG8_SA(0, 1), a2, 1, vS);
            PG8_WAIT_V(8); PG8_WAIT_L(0); PG8_BAR; PG8_MMA(0, 0, At, B0); PG8_MMA(0, 1, At, B1); PG8_BAR; PG8_SCHED;
            PG8_LDA(At, 1, 1); PG8_STAGE(PG8_SB(1, 0), b3, voffB); PG8_STAGE(PG8_SB(1, 1), b3 + hstepB, voffB); PG8_STAGE_A(PG8_SA(1, 0), a3, 0, vS);
            PG8_WAIT_V(8); PG8_WAIT_L(0); PG8_BAR; PG8_MMA(1, 0, At, B0); PG8_MMA(1, 1, At, B1); PG8_BAR; PG8_SCHED;
        }
        if (wr == 0) PG8_BAR;
        E(acc, cur, wr, wc, fr, fq);
        if (!has_next) break;
        if constexpr (Epi::HAS_GATE) E.gate(ui + 1);
#pragma unroll
        for (int a = 0; a < 2; ++a)
#pragma unroll
            for (int b = 0; b < 2; ++b)
#pragma unroll
                for (int m = 0; m < 4; ++m)
#pragma unroll
                    for (int n = 0; n < 2; ++n) acc[a][b][m][n] = (f32x4){0.f, 0.f, 0.f, 0.f};
        cur = nxt; ++ui;
#pragma unroll
        for (int _h = 0; _h < 2; ++_h)
#pragma unroll
            for (int _i = 0; _i < 2; ++_i) vC[_h][_i] = vN[_h][_i];
        if (wr == 1) PG8_BAR;
    }
    PG8_WAIT_V(0);
    PG8_BAR;
#undef PG8_SA
#undef PG8_SB
#undef PG8_STAGE
#undef PG8_STAGE_A
#undef PG8_GLOAD
#undef PG8_LDA
#undef PG8_LDB
#undef PG8_MMA
#undef PG8_WAIT_V
#undef PG8_WAIT_L
#undef PG8_BAR
#undef PG8_SCHED
#undef PG8_TA
#undef PG8_TB
}
}

__device__ __forceinline__ u32x4 pack8(const f32x4 v0, const f32x4 v1) { u32x4 w; w.x = cvt_pk_bf16(v0[0], v0[1]); w.y = cvt_pk_bf16(v0[2], v0[3]); w.z = cvt_pk_bf16(v1[0], v1[1]); w.w = cvt_pk_bf16(v1[2], v1[3]); return w; }
__device__ __forceinline__ void rope8(f32x4& v0, f32x4& v1, int row, int fq, const float* rope) {
    const int t = row & (S_ - 1); const int pos = (fq >> 1) ? (t & 63) : (t >> 6);
    const f32x4* cs = (const f32x4*)(rope + (pos * 8 + 4 * (fq & 1)) * 2);
    const f32x4 c01 = cs[0], c23 = cs[1];
    float a, b;
    a = v0[0]; b = v0[1]; v0[0] = a * c01[0] - b * c01[1]; v0[1] = a * c01[1] + b * c01[0];
    a = v0[2]; b = v0[3]; v0[2] = a * c01[2] - b * c01[3]; v0[3] = a * c01[3] + b * c01[2];
    a = v1[0]; b = v1[1]; v1[0] = a * c23[0] - b * c23[1]; v1[1] = a * c23[1] + b * c23[0];
    a = v1[2]; b = v1[3]; v1[2] = a * c23[2] - b * c23[3]; v1[3] = a * c23[3] + b * c23[2];
}

#ifndef MK_GATE_U8
#define MK_GATE_U8 0
#endif
__device__ __forceinline__ unsigned gate_q(float x) { x = fminf(fmaxf(x, -30.f), 30.f); const float sg = fast_rcp(1.0f + fast_exp2(-LOG2E * x)); return (unsigned)fminf(fmaxf(__builtin_rintf(sg * 255.0f), 1.0f), 255.0f); }
__device__ __forceinline__ u32x2 gate_pack8(const f32x4 v0, const f32x4 v1) { u32x2 w;
    w.x = gate_q(v0[0]) | (gate_q(v0[1]) << 8) | (gate_q(v0[2]) << 16) | (gate_q(v0[3]) << 24); w.y = gate_q(v1[0]) | (gate_q(v1[1]) << 8) | (gate_q(v1[2]) << 16) | (gate_q(v1[3]) << 24); return w; }
__device__ __forceinline__ float ub(unsigned w, int k) { return (float)((w >> (8 * k)) & 0xffu); }
__device__ __forceinline__ float sig_den(float x) { x = fminf(fmaxf(x, -30.f), 30.f); return 1.0f + fast_exp2(-LOG2E * x); }
#ifndef MK_SC1_P1
#define MK_SC1_P1 0
#endif
struct EpiP1 {
    static constexpr bool PERM = true, HAS_MID = false, HAS_GATE = true;
    const float* rstd_x; const float* rstd_m; bf16_t* na; bf16_t* zc; bf16_t* zqm; bf16_t* zg; bf16_t* kvmem; bf16_t* kpe; float* ssq_q; float* ssq_kv; const float* rope;
    unsigned* xflag; unsigned xneed;
    __device__ __forceinline__ void gate(int ui) const {
        if (xneed != 0u && ui == 4) {
            if (threadIdx.x == 0) { unsigned sp = 0u; while (__hip_atomic_load(xflag, __ATOMIC_RELAXED, __HIP_MEMORY_SCOPE_AGENT) < xneed) { __builtin_amdgcn_s_sleep(2); if (++sp > (1u << 22)) break; }
                __builtin_amdgcn_fence(__ATOMIC_ACQUIRE, "agent"); }
            __syncthreads();
        }
    }
    __amdgpu_buffer_rsrc_t wsr; const char* wsb;
    __device__ __forceinline__ void operator()(const f32x4 (&acc)[2][2][4][2], const pg8::Unit& u, int wr, int wc, int fr, int fq) const {
        const int row0 = u.pm * 256 + wr * 64 + fr; const int pn = u.pn;
        bf16_t* base; int ld, colt; const float* rsp;
        if (u.kind == 0) { rsp = rstd_x;
            if (pn < 6) { base = na + (size_t)(pn >> 1) * T_ * 512; ld = 512; colt = (pn & 1) * 256; }
            else if (pn < 9) { base = zc; ld = 768; colt = (pn - 6) * 256; }
            else if (pn < 11) { base = zqm; ld = 512; colt = (pn - 9) * 256; }
            else { base = zg; ld = 3072; colt = (pn - 11) * 256; } }
        else { rsp = rstd_m; base = kvmem; ld = 1024; colt = pn * 256; }
        const int col0 = colt + wc * 32 + 8 * fq;
        const bool stats = (u.kind == 0) && (pn >= 6) && (pn < 9); const bool isgate = (u.kind == 0) && (pn >= 11);
#pragma unroll
        for (int ai = 0; ai < 2; ++ai)
#pragma unroll
            for (int m = 0; m < 4; ++m) { const int row = row0 + ai * 128 + m * 16; const float rs = rsp[row]; bf16_t* rowp = base + (size_t)row * ld + col0;
#pragma unroll
                for (int bj = 0; bj < 2; ++bj) { f32x4 v0 = acc[ai][bj][m][0] * rs, v1 = acc[ai][bj][m][1] * rs;
#if !MK_GATE_U8
                    if (isgate) {
#pragma unroll
                        for (int e = 0; e < 4; ++e) { v0[e] = sig_den(v0[e]); v1[e] = sig_den(v1[e]); } }
#endif
#if MK_SC1_P1
                    __builtin_amdgcn_raw_buffer_store_b128(pack8(v0, v1), wsr, (int)((const char*)(rowp + bj * 128) - wsb), 0, 16);
#else
#if MK_GATE_U8
                    if (isgate) { st_g<0>((u32x2*)((unsigned char*)zg + (size_t)row * 3072 + col0 + bj * 128), gate_pack8(v0, v1)); continue; }
#endif
                    if (((MK_NT >> 16) & 1) && stats) *(u32x4*)(rowp + bj * 128) = pack8(v0, v1);
                    else st_g<0>((u32x4*)(rowp + bj * 128), pack8(v0, v1));
#endif
                    if (stats) { const int idx = (pn - 6) * 2 + bj;
                        if (idx < 5) { float s = (v0[0] * v0[0] + v0[1] * v0[1]) + (v0[2] * v0[2] + v0[3] * v0[3]) + (v1[0] * v1[0] + v1[1] * v1[1]) + (v1[2] * v1[2] + v1[3] * v1[3]);
                            s += __shfl_xor(s, 16); s += __shfl_xor(s, 32);
                            if (fq == 0) { if (idx < 3) ssq_q[(size_t)row * 12 + idx * 4 + wc] = s; else ssq_kv[(size_t)row * 8 + (idx - 3) * 4 + wc] = s; } }
                        else if (wc == 0) { rope8(v0, v1, row, fq, rope); *(u32x4*)(kpe + (size_t)row * 32 + 8 * fq) = pack8(v0, v1); } } } }
    }
};
struct SchedP1 {
    int c, G; const char* xb; const char* win; const char* memb; const char* wmk;
    __device__ __forceinline__ bool next(int i, pg8::Unit& u) const {
        const int L = i * G + c; int pm, pn;
        if (L < 2944) { pg8::tile_order(L, 128, 23, pm, pn); u.pm = pm; u.pn = pn; u.kind = 0; u.nt = 16; u.aux = 0; u.A = xb + (size_t)pm * 256 * 2048; u.B = win + (size_t)pn * 256 * 2048; u.A1 = u.A; u.A2 = u.A; return true; }
        if (L < 2976) { pg8::tile_order(L - 2944, 8, 4, pm, pn); u.pm = pm; u.pn = pn; u.kind = 1; u.nt = 16; u.aux = 0; u.A = memb + (size_t)pm * 256 * 2048; u.B = wmk + (size_t)pn * 256 * 2048; u.A1 = u.A; u.A2 = u.A; return true; }
        return false;
    }
};

struct EpiP2 {
    static constexpr bool PERM = true, HAS_MID = false, HAS_GATE = false;
    const float* ssq_q; const float* ssq_kv; bf16_t* qmla; bf16_t* kvbuf; const float* rope;
    __device__ __forceinline__ void operator()(const f32x4 (&acc)[2][2][4][2], const pg8::Unit& u, int wr, int wc, int fr, int fq) const {
        const int row0 = u.pm * 256 + wr * 64 + fr; const int pn = u.pn;
        float rs[2][4];
        if (u.kind == 0) {
#pragma unroll
            for (int ai = 0; ai < 2; ++ai)
#pragma unroll
                for (int m = 0; m < 4; ++m) { const f32x4* p = (const f32x4*)(ssq_q + (size_t)(row0 + ai * 128 + m * 16) * 12); const f32x4 a = p[0], b = p[1], c = p[2];
                    const float s = ((a[0] + a[1]) + (a[2] + a[3])) + ((b[0] + b[1]) + (b[2] + b[3])) + ((c[0] + c[1]) + (c[2] + c[3])); rs[ai][m] = rsqrtf(s * (1.0f / 384.0f) + EPS_); }
        } else {
#pragma unroll
            for (int ai = 0; ai < 2; ++ai)
#pragma unroll
                for (int m = 0; m < 4; ++m) { const f32x4* p = (const f32x4*)(ssq_kv + (size_t)(row0 + ai * 128 + m * 16) * 8); const f32x4 a = p[0], b = p[1];
                    const float s = ((a[0] + a[1]) + (a[2] + a[3])) + ((b[0] + b[1]) + (b[2] + b[3])); rs[ai][m] = rsqrtf(s * (1.0f / 256.0f) + EPS_); }
        }
        bf16_t* base = u.kind == 0 ? qmla : kvbuf; const int ld = u.kind == 0 ? 768 : 1024;
        const int col0 = pn * 256 + wc * 32 + 8 * fq;
#pragma unroll
        for (int bj = 0; bj < 2; ++bj) { const bool isrope = (u.kind == 0) && (((8 * pn + 4 * bj + wc) % 3) == 2);
#pragma unroll
            for (int ai = 0; ai < 2; ++ai)
#pragma unroll
                for (int m = 0; m < 4; ++m) { const int row = row0 + ai * 128 + m * 16; f32x4 v0 = acc[ai][bj][m][0] * rs[ai][m], v1 = acc[ai][bj][m][1] * rs[ai][m];
                    if (isrope) rope8(v0, v1, row, fq, rope);
                    st_g<1>((u32x4*)(base + (size_t)row * ld + col0 + bj * 128), pack8(v0, v1)); } }
    }
};
struct SchedP2 {
    int c, G; const char* zc; const char* wuq; const char* wukv;
    __device__ __forceinline__ bool next(int i, pg8::Unit& u) const {
        const int L = i * G + c; int pm, pn;
        if (L < 384) { pg8::tile_order(L, 128, 3, pm, pn); u.pm = pm; u.pn = pn; u.kind = 0; u.nt = 6; u.aux = 0; u.A = zc + (size_t)pm * 256 * 1536; u.B = wuq + (size_t)pn * 256 * 768; u.A1 = u.A; u.A2 = u.A; return true; }
        if (L < 896) { pg8::tile_order(L - 384, 128, 4, pm, pn); u.pm = pm; u.pn = pn; u.kind = 1; u.nt = 4; u.aux = 0; u.A = zc + (size_t)pm * 256 * 1536 + 768; u.B = wukv + (size_t)pn * 256 * 768; u.A1 = u.A; u.A2 = u.A; return true; }
        return false;
    }
};

struct EpiP4 {
    static constexpr bool PERM = true, HAS_MID = true, HAS_GATE = false;
    const bf16_t* zg; bf16_t* merged; int nohook;
#if MK_GATE_U8
    __device__ __forceinline__ void mid(f32x4 (&acc)[2][2][4][2], const pg8::Unit& u, int seg, int wr, int wc, int fr, int fq) const {
        if (nohook) return;
        const int row0 = u.pm * 256 + wr * 64 + fr; const int col0 = u.pn * 256 + wc * 32 + 8 * fq; const unsigned char* z8 = (const unsigned char*)zg;
        u32x2 ga[2][4][2], gb[2][4][2];
#pragma unroll
        for (int ai = 0; ai < 2; ++ai)
#pragma unroll
            for (int m = 0; m < 4; ++m) { const unsigned char* gp = z8 + (size_t)(row0 + ai * 128 + m * 16) * 3072 + col0 + (seg - 1) * 1024;
#pragma unroll
                for (int bj = 0; bj < 2; ++bj) { ga[ai][m][bj] = ld_g<15>((const u32x2*)(gp + bj * 128)); gb[ai][m][bj] = ld_g<15>((const u32x2*)(gp + 1024 + bj * 128)); } }
#pragma unroll
        for (int ai = 0; ai < 2; ++ai)
#pragma unroll
            for (int m = 0; m < 4; ++m)
#pragma unroll
                for (int bj = 0; bj < 2; ++bj)
#pragma unroll
                    for (int n = 0; n < 2; ++n) { const unsigned wa = ga[ai][m][bj][n], wb = gb[ai][m][bj][n];
#pragma unroll
                        for (int k = 0; k < 4; ++k) acc[ai][bj][m][n][k] *= ub(wa, k) * fast_rcp(ub(wb, k)); }
    }
    __device__ __forceinline__ void operator()(const f32x4 (&acc)[2][2][4][2], const pg8::Unit& u, int wr, int wc, int fr, int fq) const {
        const int row0 = u.pm * 256 + wr * 64 + fr; const int col0 = u.pn * 256 + wc * 32 + 8 * fq; const unsigned char* z8 = (const unsigned char*)zg;
#pragma unroll
        for (int ai = 0; ai < 2; ++ai) {
            u32x2 gg[4][2];
#pragma unroll
            for (int m = 0; m < 4; ++m) { const unsigned char* gp = z8 + (size_t)(row0 + ai * 128 + m * 16) * 3072 + col0 + 2048;
#pragma unroll
                for (int bj = 0; bj < 2; ++bj) gg[m][bj] = ld_g<15>((const u32x2*)(gp + bj * 128)); }
#pragma unroll
            for (int m = 0; m < 4; ++m) { const int row = row0 + ai * 128 + m * 16;
#pragma unroll
                for (int bj = 0; bj < 2; ++bj) { const u32x2 g = gg[m][bj]; f32x4 v0 = acc[ai][bj][m][0], v1 = acc[ai][bj][m][1];
#pragma unroll
                    for (int k = 0; k < 4; ++k) { v0[k] *= ub(g[0], k) * (1.0f / 255.0f); v1[k] *= ub(g[1], k) * (1.0f / 255.0f); }
                    st_g<2>((u32x4*)(merged + (size_t)row * 1024 + col0 + bj * 128), pack8(v0, v1)); } }
        }
    }
#else
    __device__ __forceinline__ void mid(f32x4 (&acc)[2][2][4][2], const pg8::Unit& u, int seg, int wr, int wc, int fr, int fq) const {
        if (nohook) return;
        const int row0 = u.pm * 256 + wr * 64 + fr; const int col0 = u.pn * 256 + wc * 32 + 8 * fq;
#pragma unroll
        for (int ai = 0; ai < 2; ++ai) {
            u32x4 ga[4][2], gb[4][2];
#pragma unroll
            for (int m = 0; m < 4; ++m) { const bf16_t* gp = zg + (size_t)(row0 + ai * 128 + m * 16) * 3072 + col0 + (seg - 1) * 1024;
#pragma unroll
                for (int bj = 0; bj < 2; ++bj) { ga[m][bj] = ld_g<15>((const u32x4*)(gp + bj * 128)); gb[m][bj] = ld_g<15>((const u32x4*)(gp + 1024 + bj * 128)); } }
#pragma unroll
            for (int m = 0; m < 4; ++m)
#pragma unroll
                for (int bj = 0; bj < 2; ++bj)
#pragma unroll
                    for (int e = 0; e < 4; ++e) { const unsigned wa = ga[m][bj][e], wb = gb[m][bj][e];
                        const float r0 = bflo(wb) * fast_rcp(bflo(wa)), r1 = bfhi(wb) * fast_rcp(bfhi(wa));
                        acc[ai][bj][m][e >> 1][(e & 1) * 2] *= r0; acc[ai][bj][m][e >> 1][(e & 1) * 2 + 1] *= r1; }
        }
    }
    __device__ __forceinline__ void operator()(const f32x4 (&acc)[2][2][4][2], const pg8::Unit& u, int wr, int wc, int fr, int fq) const {
        const int row0 = u.pm * 256 + wr * 64 + fr; const int col0 = u.pn * 256 + wc * 32 + 8 * fq;
#pragma unroll
        for (int ai = 0; ai < 2; ++ai) {
            u32x4 gg[4][2];
#pragma unroll
            for (int m = 0; m < 4; ++m) { const bf16_t* gp = zg + (size_t)(row0 + ai * 128 + m * 16) * 3072 + col0 + 2048;
#pragma unroll
                for (int bj = 0; bj < 2; ++bj) gg[m][bj] = ld_g<15>((const u32x4*)(gp + bj * 128)); }
#pragma unroll
            for (int m = 0; m < 4; ++m) { const int row = row0 + ai * 128 + m * 16;
#pragma unroll
                for (int bj = 0; bj < 2; ++bj) { const u32x4 g = gg[m][bj]; f32x4 v0 = acc[ai][bj][m][0], v1 = acc[ai][bj][m][1];
                    v0[0] *= fast_rcp(bflo(g[0])); v0[1] *= fast_rcp(bfhi(g[0])); v0[2] *= fast_rcp(bflo(g[1])); v0[3] *= fast_rcp(bfhi(g[1]));
                    v1[0] *= fast_rcp(bflo(g[2])); v1[1] *= fast_rcp(bfhi(g[2])); v1[2] *= fast_rcp(bflo(g[3])); v1[3] *= fast_rcp(bfhi(g[3]));
                    st_g<2>((u32x4*)(merged + (size_t)row * 1024 + col0 + bj * 128), pack8(v0, v1)); } }
        }
    }
#endif
};
struct SchedP4 {
    int c, G; const char* yna; const char* ymla; const char* ymem; const char* wo;
    __device__ __forceinline__ bool next(int i, pg8::Unit& u) const {
        const int L = i * G + c; int pm, pn; if (L >= 512) return false;
        pg8::tile_order(L, 128, 4, pm, pn); u.pm = pm; u.pn = pn; u.kind = 0; u.nt = 24; u.aux = 0;
        u.A = yna + (size_t)pm * 256 * 1024; u.A1 = ymla + (size_t)pm * 256 * 1024; u.A2 = ymem + (size_t)pm * 256 * 1024; u.B = wo + (size_t)pn * 256 * 3072; return true;
    }
};

struct EpiP5 {
    static constexpr bool PERM = true, HAS_MID = false, HAS_GATE = false;
    bf16_t* delta;
    __device__ __forceinline__ void operator()(const f32x4 (&acc)[2][2][4][2], const pg8::Unit& u, int wr, int wc, int fr, int fq) const {
        const int row0 = u.pm * 256 + wr * 64 + fr; const int col0 = u.pn * 256 + wc * 32 + 8 * fq;
#pragma unroll
        for (int ai = 0; ai < 2; ++ai)
#pragma unroll
            for (int m = 0; m < 4; ++m) { bf16_t* rowp = delta + (size_t)(row0 + ai * 128 + m * 16) * 1024 + col0;
#pragma unroll
                for (int bj = 0; bj < 2; ++bj) st_g<3>((u32x4*)(rowp + bj * 128), pack8(acc[ai][bj][m][0], acc[ai][bj][m][1])); }
    }
};
struct SchedP5 {
    int c, G; const char* merged; const char* wout;
    __device__ __forceinline__ bool next(int i, pg8::Unit& u) const {
        const int L = i * G + c; int pm, pn; if (L >= 512) return false;
        pg8::tile_order(L, 128, 4, pm, pn); u.pm = pm; u.pn = pn; u.kind = 0; u.nt = 16; u.aux = 0;
        u.A = merged + (size_t)pm * 256 * 2048; u.A1 = u.A; u.A2 = u.A; u.B = wout + (size_t)pn * 256 * 2048; return true;
    }
};

struct EpiP8 {
    static constexpr bool PERM = true, HAS_MID = false, HAS_GATE = false;
    const float* rstd_xs; bf16_t* act;
    __device__ __forceinline__ void operator()(const f32x4 (&acc)[2][2][4][2], const pg8::Unit& u, int wr, int wc, int fr, int fq) const {
        const int row0 = u.pm * 256 + wr * 64 + fr; const int col0 = u.pn * 128 + wc * 32 + 8 * fq;
#pragma unroll
        for (int ai = 0; ai < 2; ++ai)
#pragma unroll
            for (int m = 0; m < 4; ++m) { const int row = row0 + ai * 128 + m * 16; const float rs = rstd_xs[row]; f32x4 o[2];
#pragma unroll
                for (int n = 0; n < 2; ++n)
#pragma unroll
                    for (int e = 0; e < 4; ++e) { const float hg = acc[ai][0][m][n][e] * rs, hu = acc[ai][1][m][n][e] * rs; o[n][e] = hg * fast_rcp(1.0f + fast_exp2(-LOG2E * hg)) * hu; }
                st_g<4>((u32x4*)(act + (size_t)row * 1024 + col0), pack8(o[0], o[1])); }
    }
};
struct SchedP8 {
    int c, G; const char* xs; const char* wgu;
    __device__ __forceinline__ bool next(int i, pg8::Unit& u) const {
        const int L = i * G + c; int pm, pn; if (L >= 2048) return false;
        const int e = L >> 7; pg8::tile_order(L & 127, 16, 8, pm, pn); const int b = pm >> 1, half = pm & 1; const int grow0 = (b * 16 + e) * 512 + half * 256;
        u.pm = grow0 >> 8; u.pn = pn; u.kind = 0; u.nt = 16; u.aux = i; u.A = xs; u.A1 = u.A; u.A2 = u.A; u.B = wgu + (size_t)(e * 2048 + pn * 256) * 2048; return true;
    }
};
struct EpiP9 {
    static constexpr bool PERM = true, HAS_MID = false, HAS_GATE = false;
    const float* gsel; bf16_t* ybuf;
    __device__ __forceinline__ void operator()(const f32x4 (&acc)[2][2][4][2], const pg8::Unit& u, int wr, int wc, int fr, int fq) const {
        const int row0 = u.pm * 256 + wr * 64 + fr; const int col0 = u.pn * 256 + wc * 32 + 8 * fq;
#pragma unroll
        for (int ai = 0; ai < 2; ++ai)
#pragma unroll
            for (int m = 0; m < 4; ++m) { const int row = row0 + ai * 128 + m * 16; const float gs = gsel[row];
#pragma unroll
                for (int bj = 0; bj < 2; ++bj) st_g<5>((u32x4*)(ybuf + (size_t)row * 1024 + col0 + bj * 128), pack8(acc[ai][bj][m][0] * gs, acc[ai][bj][m][1] * gs)); }
    }
};
struct SchedP9 {
    int c, G; const char* act; const char* wd;
    __device__ __forceinline__ bool next(int i, pg8::Unit& u) const {
        const int L = i * G + c; int pm, pn; if (L >= 1024) return false;
        const int e = L >> 6; pg8::tile_order(L & 63, 16, 4, pm, pn); const int b = pm >> 1, half = pm & 1; const int grow0 = (b * 16 + e) * 512 + half * 256;
        u.pm = grow0 >> 8; u.pn = pn; u.kind = 0; u.nt = 16; u.aux = e; u.A = act + (size_t)grow0 * 2048; u.A1 = u.A; u.A2 = u.A; u.B = wd + (size_t)(e * 1024 + pn * 256) * 2048; return true;
    }
};

struct EpiMoE {
    static constexpr bool PERM = true, HAS_MID = false, HAS_GATE = false;
    EpiP8 e8; EpiP9 e9;
    __device__ __forceinline__ void operator()(const f32x4 (&acc)[2][2][4][2], const pg8::Unit& u, int wr, int wc, int fr, int fq) const { if (u.kind == 0) e8(acc, u, wr, wc, fr, fq); else e9(acc, u, wr, wc, fr, fq); }
};
struct SchedMoE {
    int e, grow0; const char* hb; const char* act; const char* wgu; const char* wd;
    __device__ __forceinline__ bool next(int i, pg8::Unit& u) const {
        if (i >= 12) return false;
        u.pm = grow0 >> 8; u.nt = 16;
        if (i < 8) { u.pn = i; u.kind = 0; u.aux = 0; u.A = hb; u.B = wgu + (size_t)(e * 2048 + i * 256) * 2048; }
        else { u.pn = i - 8; u.kind = 1; u.aux = 1; u.A = act; u.B = wd + (size_t)(e * 1024 + (i - 8) * 256) * 2048; }
        u.A1 = u.A; u.A2 = u.A; return true;
    }
};

namespace att {
typedef short v4i16_t __attribute__((ext_vector_type(4)));
struct AttnArgs { const bf16_t* q; const bf16_t* k0; const bf16_t* k1; const bf16_t* v; bf16_t* o; const float* rpb; };
__device__ __forceinline__ s16x4 vtr(unsigned addr) { return __builtin_bit_cast(s16x4, __builtin_amdgcn_ds_read_tr16_b64_v4i16((LAS v4i16_t*)(uintptr_t)addr)); }
__device__ __forceinline__ float max3f(float a, float b, float c) { return __builtin_fmaxf(__builtin_fmaxf(a, b), c); }

template <int DQK, int DV, int MODE, bool PIPE>
__device__ __forceinline__ void attn_unit(LAS unsigned char* lds, const AttnArgs& A, const int b, const int h, const int ub) {
    constexpr int PK = DQK * 2 + 16, PV = DV * 2 + 64, KB = 64 * PK, VB = 64 * PV;
    constexpr int OFF_K = 0, OFF_V = 2 * KB, OFF_SCR = OFF_V + 2 * VB, OFF_OST = OFF_SCR + 8 * 256, OFF_END = OFF_OST + 8 * 32 * DV * 2;
    static_assert(OFF_END <= LDS_BYTES - 64, "attention LDS");
    constexpr int KCH = DQK / 8, VCH = DV / 8, NKC = 64 * KCH, NVC = 64 * VCH, KPT = (NKC + 511) / 512, VPT = (NVC + 511) / 512;
    constexpr int LDQ = (MODE == 0) ? 768 : 512, LDO = 512;
    constexpr int NDS = DQK / 16, ND0 = DV / 32;
    constexpr int NT = (MODE == 0) ? 64 : 4;
#ifndef ATT_THR
#define ATT_THR 8.0f
#endif
    constexpr float THR = ATT_THR;
    int tid_ = threadIdx.x; asm volatile("" : "+v"(tid_));
    const int tid = tid_, lane = tid & 63, r32 = lane & 31, hi = lane >> 5; const int wid = __builtin_amdgcn_readfirstlane(tid >> 6);
    const int wave_tok0 = b * S_ + ub * 256 + wid * 32;
    bf16x8 qf[NDS];
    { const bf16_t* qp = A.q + (size_t)(wave_tok0 + r32) * LDQ + h * DQK + hi * 8;
#pragma unroll
      for (int ds = 0; ds < NDS; ++ds) qf[ds] = *(const bf16x8*)(qp + ds * 16); }
    const bf16_t* ksrc[KPT]; int kstr[KPT]; unsigned kdst[KPT]; bool kval[KPT];
    const bf16_t* vsrc[VPT]; unsigned vdst[VPT];
    constexpr int KSTRIDE = 64 * 1024;
#pragma unroll
    for (int j = 0; j < KPT; ++j) { const int ci = tid + 512 * j; kval[j] = ci < NKC; const int cic = kval[j] ? ci : 0; const int row = cic / KCH, cc = cic % KCH;
        kdst[j] = (unsigned)(OFF_K + row * PK + cc * 16); kstr[j] = KSTRIDE;
        if (MODE == 0) { const size_t kt = (size_t)b * S_ + row; if (cc < 8) ksrc[j] = A.k0 + kt * 1024 + h * 64 + cc * 8; else { ksrc[j] = A.k1 + kt * 32 + (cc - 8) * 8; kstr[j] = 64 * 32; } }
        else { const size_t kr = (size_t)b * 256 + row; ksrc[j] = A.k0 + kr * 1024 + h * 128 + cc * 8; } }
#pragma unroll
    for (int j = 0; j < VPT; ++j) { const int ci = tid + 512 * j; const int row = ci / VCH, cc = ci % VCH;
        vdst[j] = (unsigned)(OFF_V + row * PV + cc * 16);
        if (MODE == 0) { const size_t kt = (size_t)b * S_ + row; vsrc[j] = A.v + kt * 1024 + h * 64 + cc * 8; }
        else { const size_t kr = (size_t)b * 256 + row; vsrc[j] = A.v + kr * 1024 + h * 128 + cc * 8; } }
    u32x4 kst[KPT], vst[VPT];
#define ATT_LOADK(tile) do { _Pragma("unroll") for (int j = 0; j < KPT; ++j) if (kval[j]) kst[j] = *(const u32x4*)(ksrc[j] + (size_t)(tile) * kstr[j]); } while (0)
#define ATT_LOADV(tile) do { _Pragma("unroll") for (int j = 0; j < VPT; ++j) vst[j] = *(const u32x4*)(vsrc[j] + (size_t)(tile) * KSTRIDE); } while (0)
#define ATT_STOREK(buf) do { _Pragma("unroll") for (int j = 0; j < KPT; ++j) if (kval[j]) *(LAS u32x4*)(lds + kdst[j] + (buf) * KB) = kst[j]; } while (0)
#define ATT_STOREV(buf) do { _Pragma("unroll") for (int j = 0; j < VPT; ++j) *(LAS u32x4*)(lds + vdst[j] + (buf) * VB) = vst[j]; } while (0)
    LAS float* scr = (LAS float*)(lds + OFF_SCR) + wid * 64;
#define ATT_QK(P0, P1, buf) do { const LAS unsigned char* kb_ = lds + OFF_K + (buf) * KB + r32 * PK + hi * 16; P0 = negm; P1 = negm; __builtin_amdgcn_s_setprio(1); \
        _Pragma("unroll") for (int ds = 0; ds < NDS; ++ds) { const bf16x8 a0_ = *(const LAS bf16x8*)(kb_ + ds * 32), a1_ = *(const LAS bf16x8*)(kb_ + 32 * PK + ds * 32); \
            P0 = __builtin_amdgcn_mfma_f32_32x32x16_bf16(a0_, qf[ds], P0, 0, 0, 0); P1 = __builtin_amdgcn_mfma_f32_32x32x16_bf16(a1_, qf[ds], P1, 0, 0, 0); } __builtin_amdgcn_s_setprio(0); } while (0)
#define ATT_ROWMAX(P0, P1, rm) do { float a_ = max3f(P0[0], P0[1], P1[0]), b_ = max3f(P0[2], P0[3], P1[1]); a_ = max3f(a_, P1[2], P1[3]); \
        _Pragma("unroll") for (int r = 4; r < 16; r += 4) { a_ = max3f(a_, P0[r], P0[r + 1]); b_ = max3f(b_, P0[r + 2], P0[r + 3]); a_ = max3f(a_, P1[r], P1[r + 1]); b_ = max3f(b_, P1[r + 2], P1[r + 3]); } \
        rm = fmaxf(a_, b_); rm = fmaxf(rm, __shfl_xor(rm, 32)); } while (0)
    f32x16 o[ND0], negm;
#pragma unroll
    for (int r = 0; r < 16; ++r) negm[r] = 0.f;
#pragma unroll
    for (int d0 = 0; d0 < ND0; ++d0)
#pragma unroll
        for (int r = 0; r < 16; ++r) o[d0][r] = 0.f;
    float lsum = 0.f;
    f32x16 pA0, pA1, pB0, pB1;
    { u32x4 k1st[KPT];
      ATT_LOADK(0); ATT_LOADV(0);
#pragma unroll
      for (int j = 0; j < KPT; ++j) if (kval[j]) k1st[j] = *(const u32x4*)(ksrc[j] + (size_t)kstr[j]);
      ATT_STOREK(0); ATT_STOREV(0);
#pragma unroll
      for (int j = 0; j < KPT; ++j) if (kval[j]) *(LAS u32x4*)(lds + kdst[j] + KB) = k1st[j]; }
    __syncthreads();
    ATT_QK(pA0, pA1, 0);
    { float rm; ATT_ROWMAX(pA0, pA1, rm);
#pragma unroll
      for (int r = 0; r < 16; ++r) { pA0[r] -= rm; pA1[r] -= rm; negm[r] = -rm; } }
    __syncthreads();
#ifndef ATT_SGB
#define ATT_SGB 1
#endif
#define ATT_STEP(PC0, PC1, PN0, PN1, t) do { const int buf_ = (t) & 1; \
        if ((t) + 2 < NT) ATT_LOADK((t) + 2); if ((t) + 1 < NT) ATT_LOADV((t) + 1); \
        if constexpr (!PIPE) { if ((t) > 0) { ATT_QK(PC0, PC1, buf_); float rm0_; ATT_ROWMAX(PC0, PC1, rm0_); \
            if (__any(rm0_ > THR)) { const float dl_ = fmaxf(rm0_, 0.f); const float f_ = fast_exp2(-dl_); lsum *= f_; \
                _Pragma("unroll") for (int r = 0; r < 16; ++r) { PC0[r] -= dl_; PC1[r] -= dl_; negm[r] -= dl_; } \
                if (hi == 0) scr[r32] = f_; \
                _Pragma("unroll") for (int r = 0; r < 16; ++r) { const float fr_ = scr[crow(r, hi)]; _Pragma("unroll") for (int d0 = 0; d0 < ND0; ++d0) o[d0][r] *= fr_; } } } } \
          \
        if constexpr (PIPE) { if ((t) + 1 < NT) ATT_QK(PN0, PN1, buf_ ^ 1); } \
        float ps_ = 0.f; \
        _Pragma("unroll") for (int r = 0; r < 16; ++r) { PC0[r] = fast_exp2(PC0[r]); PC1[r] = fast_exp2(PC1[r]); ps_ += PC0[r] + PC1[r]; } \
        lsum += ps_; \
        bf16x8 pa_[4]; \
        _Pragma("unroll") for (int s = 0; s < 2; ++s) { u32x4 w_; \
            w_.x = cvt_pk_bf16(PC0[8 * s + 0], PC0[8 * s + 1]); w_.y = cvt_pk_bf16(PC0[8 * s + 2], PC0[8 * s + 3]); w_.z = cvt_pk_bf16(PC0[8 * s + 4], PC0[8 * s + 5]); w_.w = cvt_pk_bf16(PC0[8 * s + 6], PC0[8 * s + 7]); pa_[s] = __builtin_bit_cast(bf16x8, w_); \
            w_.x = cvt_pk_bf16(PC1[8 * s + 0], PC1[8 * s + 1]); w_.y = cvt_pk_bf16(PC1[8 * s + 2], PC1[8 * s + 3]); w_.z = cvt_pk_bf16(PC1[8 * s + 4], PC1[8 * s + 5]); w_.w = cvt_pk_bf16(PC1[8 * s + 6], PC1[8 * s + 7]); pa_[2 + s] = __builtin_bit_cast(bf16x8, w_); } \
          \
        { const unsigned vb_ = (unsigned)(uintptr_t)(lds + OFF_V + buf_ * VB) + (unsigned)((4 * hi + ((lane & 15) >> 2)) * PV + ((((lane >> 4) & 1) * 16 + (lane & 3) * 4) * 2)); \
          __builtin_amdgcn_s_setprio(1); \
          _Pragma("unroll") for (int d0 = 0; d0 < ND0; ++d0) _Pragma("unroll") for (int s = 0; s < 4; ++s) { \
              const s16x4 lo_ = vtr(vb_ + (unsigned)(16 * s * PV + d0 * 64)), hh_ = vtr(vb_ + (unsigned)(16 * s * PV + 8 * PV + d0 * 64)); \
              const bf16x8 vf_ = (bf16x8){lo_[0], lo_[1], lo_[2], lo_[3], hh_[0], hh_[1], hh_[2], hh_[3]}; \
              o[d0] = __builtin_amdgcn_mfma_f32_32x32x16_bf16(pa_[s], vf_, o[d0], 0, 0, 0); } \
          __builtin_amdgcn_s_setprio(0); } \
        float rm_ = 0.f; \
        if constexpr (PIPE) { if ((t) + 1 < NT) ATT_ROWMAX(PN0, PN1, rm_); } \
        if (ATT_SGB && PIPE) { _Pragma("unroll") for (int g_ = 0; g_ < 12 + 4 * ND0; ++g_) { __builtin_amdgcn_sched_group_barrier(0x008, 1, 0); __builtin_amdgcn_sched_group_barrier(0x100, 2, 0); __builtin_amdgcn_sched_group_barrier(0x002, 6, 0); } } \
          \
        if constexpr (PIPE) { if (__any(rm_ > THR)) { const float dl_ = fmaxf(rm_, 0.f); const float f_ = fast_exp2(-dl_); lsum *= f_; \
            _Pragma("unroll") for (int r = 0; r < 16; ++r) { PN0[r] -= dl_; PN1[r] -= dl_; negm[r] -= dl_; } \
            if (hi == 0) scr[r32] = f_; \
            _Pragma("unroll") for (int r = 0; r < 16; ++r) { const float fr_ = scr[crow(r, hi)]; _Pragma("unroll") for (int d0 = 0; d0 < ND0; ++d0) o[d0][r] *= fr_; } } } \
        if ((t) + 2 < NT) ATT_STOREK(buf_); if ((t) + 1 < NT) ATT_STOREV(buf_ ^ 1); \
        __syncthreads(); } while (0)
    if constexpr (PIPE) { for (int t = 0; t < NT; t += 2) { ATT_STEP(pA0, pA1, pB0, pB1, t); ATT_STEP(pB0, pB1, pA0, pA1, t + 1); } }
    else { for (int t = 0; t < NT; ++t) { ATT_STEP(pA0, pA1, pB0, pB1, t); } }
    lsum += __shfl_xor(lsum, 32);
    if (hi == 0) scr[r32] = fast_rcp(lsum);
    LAS bf16_t* ost = (LAS bf16_t*)(lds + OFF_OST) + wid * 32 * DV;
#pragma unroll
    for (int r = 0; r < 16; ++r) { const int q = crow(r, hi); const float ri = scr[q];
#pragma unroll
        for (int d0 = 0; d0 < ND0; ++d0) { const float val = o[d0][r] * ri; ost[q * DV + d0 * 32 + r32] = (bf16_t)(cvt_pk_bf16(val, val) & 0xffffu); } }
    asm volatile("s_waitcnt lgkmcnt(0)" ::: "memory");
    { bf16_t* og = A.o + (size_t)wave_tok0 * LDO + h * DV;
#pragma unroll
      for (int i = 0; i < DV / 16; ++i) { const int id = i * 64 + lane; const int row = id / VCH, ch = id % VCH;
          const u32x4 v = *(const LAS u32x4*)(ost + row * DV + ch * 8); st_g<6>((u32x4*)(og + (size_t)row * LDO + ch * 8), v); } }
    __syncthreads();
#undef ATT_LOADK
#undef ATT_LOADV
#undef ATT_STOREK
#undef ATT_STOREV
#undef ATT_QK
#undef ATT_ROWMAX
#undef ATT_STEP
}
}

namespace att {
#define SBAR_ __builtin_amdgcn_sched_barrier(0)
template <int ABL>
__device__ __forceinline__ void attn_unit_mla3(LAS unsigned char* lds, const AttnArgs& A, const int b, const int h, const int ub) {
    constexpr int DQK = 96, DV = 64;
    constexpr int PK = DQK * 2 + 16, PV = DV * 2 + 64, KB = 64 * PK, VB = 64 * PV;
    constexpr int OFF_K = 0, OFF_V = 2 * KB, OFF_SCR = OFF_V + 2 * VB, OFF_OST = OFF_SCR + 8 * 256, OFF_END = OFF_OST + 8 * 32 * DV * 2;
    static_assert(OFF_END <= LDS_BYTES - 64, "attention LDS");
    constexpr int KCH = DQK / 8, VCH = DV / 8, NKC = 64 * KCH, KPT = 2;
    constexpr int LDQ = 768, LDO = 512, NDS = DQK / 16, ND0 = DV / 32, NT = 64;
#ifndef ATT_THR
#define ATT_THR 8.0f
#endif
    constexpr float THR = ATT_THR;
    int tid_ = threadIdx.x; asm volatile("" : "+v"(tid_));
    const int tid = tid_, lane = tid & 63, r32 = lane & 31, hi = lane >> 5; const int wid = __builtin_amdgcn_readfirstlane(tid >> 6);
    const int wave_tok0 = b * S_ + ub * 256 + wid * 32;
    bf16x8 qf[NDS];
    { const bf16_t* qp = A.q + (size_t)(wave_tok0 + r32) * LDQ + h * DQK + hi * 8;
#pragma unroll
      for (int ds = 0; ds < NDS; ++ds) qf[ds] = ld_g<17>((const bf16x8*)(qp + ds * 16)); }
    const bf16_t* ksrc[KPT]; int kstr[KPT]; unsigned kdst[KPT]; bool kval[KPT];
    const bf16_t* vsrc; unsigned vdst;
    constexpr int KSTRIDE = 64 * 1024;
#pragma unroll
    for (int j = 0; j < KPT; ++j) { const int ci = tid + 512 * j; kval[j] = ci < NKC; const int cic = kval[j] ? ci : 0; const int row = cic / KCH, cc = cic % KCH;
        kdst[j] = (unsigned)(OFF_K + row * PK + cc * 16); kstr[j] = KSTRIDE; const size_t kt = (size_t)b * S_ + row;
        if (cc < 8) ksrc[j] = A.k0 + kt * 1024 + h * 64 + cc * 8; else { ksrc[j] = A.k1 + kt * 32 + (cc - 8) * 8; kstr[j] = 64 * 32; } }
    { const int row = tid / VCH, cc = tid % VCH; vdst = (unsigned)(OFF_V + row * PV + cc * 16); vsrc = A.v + ((size_t)b * S_ + row) * 1024 + h * 64 + cc * 8; }
    u32x4 kst[KPT], vst;
#define M3_LOADK(tile) do { _Pragma("unroll") for (int j = 0; j < KPT; ++j) if (kval[j]) kst[j] = *(const u32x4*)(ksrc[j] + (size_t)(tile) * kstr[j]); } while (0)
#define M3_LOADV(tile) do { vst = *(const u32x4*)(vsrc + (size_t)(tile) * KSTRIDE); } while (0)
#define M3_STOREK(buf) do { _Pragma("unroll") for (int j = 0; j < KPT; ++j) if (kval[j]) *(LAS u32x4*)(lds + kdst[j] + (buf) * KB) = kst[j]; } while (0)
#define M3_STOREV(buf) do { *(LAS u32x4*)(lds + vdst + (buf) * VB) = vst; } while (0)
    LAS float* scr = (LAS float*)(lds + OFF_SCR) + wid * 64;
#define M3_ROWMAX(P0, P1, rm) do { float a_ = max3f(P0[0], P0[1], P1[0]), b_ = max3f(P0[2], P0[3], P1[1]); a_ = max3f(a_, P1[2], P1[3]); \
        _Pragma("unroll") for (int r = 4; r < 16; r += 4) { a_ = max3f(a_, P0[r], P0[r + 1]); b_ = max3f(b_, P0[r + 2], P0[r + 3]); a_ = max3f(a_, P1[r], P1[r + 1]); b_ = max3f(b_, P1[r + 2], P1[r + 3]); } \
        rm = fmaxf(a_, b_); rm = fmaxf(rm, __shfl_xor(rm, 32)); } while (0)
    f32x16 o[ND0], negm;
#pragma unroll
    for (int r = 0; r < 16; ++r) negm[r] = 0.f;
#pragma unroll
    for (int d0 = 0; d0 < ND0; ++d0)
#pragma unroll
        for (int r = 0; r < 16; ++r) o[d0][r] = 0.f;
    float lsum = 0.f;
    f32x16 pA0, pA1, pB0, pB1;
    { u32x4 k1st[KPT];
      M3_LOADK(0); M3_LOADV(0);
#pragma unroll
      for (int j = 0; j < KPT; ++j) if (kval[j]) k1st[j] = *(const u32x4*)(ksrc[j] + (size_t)kstr[j]);
      M3_STOREK(0); M3_STOREV(0);
#pragma unroll
      for (int j = 0; j < KPT; ++j) if (kval[j]) *(LAS u32x4*)(lds + kdst[j] + KB) = k1st[j]; }
    __syncthreads();
    { const LAS unsigned char* kb_ = lds + OFF_K + r32 * PK + hi * 16; pA0 = negm; pA1 = negm;
#pragma unroll
      for (int ds = 0; ds < NDS; ++ds) { const bf16x8 a0_ = *(const LAS bf16x8*)(kb_ + ds * 32), a1_ = *(const LAS bf16x8*)(kb_ + 32 * PK + ds * 32);
          pA0 = __builtin_amdgcn_mfma_f32_32x32x16_bf16(a0_, qf[ds], pA0, 0, 0, 0); pA1 = __builtin_amdgcn_mfma_f32_32x32x16_bf16(a1_, qf[ds], pA1, 0, 0, 0); } }
    { float rm; M3_ROWMAX(pA0, pA1, rm);
#pragma unroll
      for (int r = 0; r < 16; ++r) { pA0[r] -= rm; pA1[r] -= rm; negm[r] = -rm; } }
    __syncthreads();
#define M3_KF(i, kb_) (*(const LAS bf16x8*)((kb_) + ((i) >> 1) * 32 + ((i) & 1) * 32 * PK))
#define M3_EXPAIR(P, r, S, W) do { if (ABL != 1) { P[r] = fast_exp2(P[r]); P[(r) + 1] = fast_exp2(P[(r) + 1]); } sacc_ += P[r] + P[(r) + 1]; pw_[S][W] = cvt_pk_bf16(P[r], P[(r) + 1]); } while (0)
#define M3_EXPK(P, r, S, W) do { if (ABL != 1) { P[r] = fast_exp2(P[r]); P[(r) + 1] = fast_exp2(P[(r) + 1]); } pw_[S][W] = cvt_pk_bf16(P[r], P[(r) + 1]); } while (0)
#define M3_VF(i, vb_, dst) do { const s16x4 lo_ = vtr((vb_) + (unsigned)(16 * ((i) & 3) * PV + ((i) >> 2) * 64)), hh_ = vtr((vb_) + (unsigned)(16 * ((i) & 3) * PV + 8 * PV + ((i) >> 2) * 64)); \
        dst = (bf16x8){lo_[0], lo_[1], lo_[2], lo_[3], hh_[0], hh_[1], hh_[2], hh_[3]}; } while (0)

#define M3_MX3(a, b, c) __builtin_fmaxf(__builtin_fmaxf((a), (b)), (c))
#define M3_STEP(PC0, PC1, PN0, PN1, t, LDK) do { const int buf_ = (t) & 1; \
        if (ABL != 4) { if (LDK) M3_LOADK((t) + 2); M3_LOADV((t) + 1); } \
        const LAS unsigned char* kb_ = lds + OFF_K + (buf_ ^ 1) * KB + r32 * PK + hi * 16; \
        const unsigned vb_ = (unsigned)(uintptr_t)(lds + OFF_V + buf_ * VB) + (unsigned)((4 * hi + ((lane & 15) >> 2)) * PV + ((((lane >> 4) & 1) * 16 + (lane & 3) * 4) * 2)); \
        bf16x8 kf0_ = M3_KF(0, kb_), kf1_ = M3_KF(1, kb_), kf2_ = M3_KF(2, kb_), kf3_ = M3_KF(3, kb_); \
        float sacc_ = 0.f; u32x4 pw_[4]; SBAR_; \
        if (ABL != 3) { PN0 = __builtin_amdgcn_mfma_f32_32x32x16_bf16(kf0_, qf[0], negm, 0, 0, 0); } else { PN0 = negm; PN0[0] += (float)kf0_[0] + (float)qf[0][0]; } kf0_ = M3_KF(4, kb_); M3_EXPK(PC0, 0, 0, 0); M3_EXPK(PC0, 2, 0, 1); asm volatile("" : "+v"(pw_[0])); SBAR_; \
        if (ABL != 3) { PN1 = __builtin_amdgcn_mfma_f32_32x32x16_bf16(kf1_, qf[0], negm, 0, 0, 0); } else { PN1 = negm; PN1[0] += (float)kf1_[0] + (float)qf[0][0]; } kf1_ = M3_KF(5, kb_); M3_EXPK(PC0, 4, 0, 2); asm volatile("" : "+v"(pw_[0])); SBAR_; \
        if (ABL != 3) { PN0 = __builtin_amdgcn_mfma_f32_32x32x16_bf16(kf2_, qf[1], PN0, 0, 0, 0); } else { PN0 = PN0; PN0[0] += (float)kf2_[0] + (float)qf[1][0]; } kf2_ = M3_KF(6, kb_); M3_EXPK(PC0, 6, 0, 3); asm volatile("" : "+v"(pw_[0])); SBAR_; \
        if (ABL != 3) { PN1 = __builtin_amdgcn_mfma_f32_32x32x16_bf16(kf3_, qf[1], PN1, 0, 0, 0); } else { PN1 = PN1; PN1[0] += (float)kf3_[0] + (float)qf[1][0]; } kf3_ = M3_KF(7, kb_); M3_EXPK(PC0, 8, 1, 0); M3_EXPK(PC0, 10, 1, 1); asm volatile("" : "+v"(pw_[1])); SBAR_; \
        if (ABL != 3) { PN0 = __builtin_amdgcn_mfma_f32_32x32x16_bf16(kf0_, qf[2], PN0, 0, 0, 0); } else { PN0 = PN0; PN0[0] += (float)kf0_[0] + (float)qf[2][0]; } kf0_ = M3_KF(8, kb_); M3_EXPK(PC0, 12, 1, 2); asm volatile("" : "+v"(pw_[1])); SBAR_; \
        if (ABL != 3) { PN1 = __builtin_amdgcn_mfma_f32_32x32x16_bf16(kf1_, qf[2], PN1, 0, 0, 0); } else { PN1 = PN1; PN1[0] += (float)kf1_[0] + (float)qf[2][0]; } kf1_ = M3_KF(9, kb_); M3_EXPK(PC0, 14, 1, 3); asm volatile("" : "+v"(pw_[1])); SBAR_; \
        if (ABL != 3) { PN0 = __builtin_amdgcn_mfma_f32_32x32x16_bf16(kf2_, qf[3], PN0, 0, 0, 0); } else { PN0 = PN0; PN0[0] += (float)kf2_[0] + (float)qf[3][0]; } kf2_ = M3_KF(10, kb_); M3_EXPK(PC1, 0, 2, 0); M3_EXPK(PC1, 2, 2, 1); asm volatile("" : "+v"(pw_[2])); SBAR_; \
        if (ABL != 3) { PN1 = __builtin_amdgcn_mfma_f32_32x32x16_bf16(kf3_, qf[3], PN1, 0, 0, 0); } else { PN1 = PN1; PN1[0] += (float)kf3_[0] + (float)qf[3][0]; } kf3_ = M3_KF(11, kb_); M3_EXPK(PC1, 4, 2, 2); asm volatile("" : "+v"(pw_[2])); SBAR_; \
        if (ABL != 3) { PN0 = __builtin_amdgcn_mfma_f32_32x32x16_bf16(kf0_, qf[4], PN0, 0, 0, 0); } else { PN0 = PN0; PN0[0] += (float)kf0_[0] + (float)qf[4][0]; } M3_EXPK(PC1, 6, 2, 3); asm volatile("" : "+v"(pw_[2])); SBAR_; \
        if (ABL != 3) { PN1 = __builtin_amdgcn_mfma_f32_32x32x16_bf16(kf1_, qf[4], PN1, 0, 0, 0); } else { PN1 = PN1; PN1[0] += (float)kf1_[0] + (float)qf[4][0]; } M3_EXPK(PC1, 8, 3, 0); M3_EXPK(PC1, 10, 3, 1); asm volatile("" : "+v"(pw_[3])); SBAR_; \
        if (ABL != 3) { PN0 = __builtin_amdgcn_mfma_f32_32x32x16_bf16(kf2_, qf[5], PN0, 0, 0, 0); } else { PN0 = PN0; PN0[0] += (float)kf2_[0] + (float)qf[5][0]; } M3_EXPK(PC1, 12, 3, 2); asm volatile("" : "+v"(pw_[3])); SBAR_; \
        if (ABL != 3) { PN1 = __builtin_amdgcn_mfma_f32_32x32x16_bf16(kf3_, qf[5], PN1, 0, 0, 0); } else { PN1 = PN1; PN1[0] += (float)kf3_[0] + (float)qf[5][0]; } M3_EXPK(PC1, 14, 3, 3); asm volatile("" : "+v"(pw_[3])); SBAR_; \
        bf16x8 vf0_, vf1_; M3_VF(0, vb_, vf0_); M3_VF(1, vb_, vf1_); \
        float ma_ = M3_MX3(PN0[0], PN0[1], PN1[0]), mb_ = M3_MX3(PN0[2], PN0[3], PN1[1]); SBAR_; \
        if (ABL != 2) { o[0] = __builtin_amdgcn_mfma_f32_32x32x16_bf16(__builtin_bit_cast(bf16x8, pw_[0]), vf0_, o[0], 0, 0, 0); } else { o[0][0] += __builtin_bit_cast(float, pw_[0][0]) + (float)vf0_[0]; } M3_VF(2, vb_, vf0_); sacc_ += (PC0[0] + PC0[1]) + (PC0[2] + PC0[3]); ma_ = M3_MX3(ma_, PN1[2], PN1[3]); ma_ = M3_MX3(ma_, PN0[4], PN0[5]); asm volatile("" : "+v"(ma_), "+v"(mb_), "+v"(sacc_)); SBAR_; \
        if (ABL != 2) { o[0] = __builtin_amdgcn_mfma_f32_32x32x16_bf16(__builtin_bit_cast(bf16x8, pw_[1]), vf1_, o[0], 0, 0, 0); } else { o[0][0] += __builtin_bit_cast(float, pw_[1][0]) + (float)vf1_[0]; } M3_VF(3, vb_, vf1_); sacc_ += (PC0[4] + PC0[5]) + (PC0[6] + PC0[7]); mb_ = M3_MX3(mb_, PN0[6], PN0[7]); ma_ = M3_MX3(ma_, PN1[4], PN1[5]); asm volatile("" : "+v"(ma_), "+v"(mb_), "+v"(sacc_)); SBAR_; \
        if (ABL != 2) { o[0] = __builtin_amdgcn_mfma_f32_32x32x16_bf16(__builtin_bit_cast(bf16x8, pw_[2]), vf0_, o[0], 0, 0, 0); } else { o[0][0] += __builtin_bit_cast(float, pw_[2][0]) + (float)vf0_[0]; } M3_VF(4, vb_, vf0_); sacc_ += (PC0[8] + PC0[9]) + (PC0[10] + PC0[11]); mb_ = M3_MX3(mb_, PN1[6], PN1[7]); ma_ = M3_MX3(ma_, PN0[8], PN0[9]); asm volatile("" : "+v"(ma_), "+v"(mb_), "+v"(sacc_)); SBAR_; \
        if (ABL != 2) { o[0] = __builtin_amdgcn_mfma_f32_32x32x16_bf16(__builtin_bit_cast(bf16x8, pw_[3]), vf1_, o[0], 0, 0, 0); } else { o[0][0] += __builtin_bit_cast(float, pw_[3][0]) + (float)vf1_[0]; } M3_VF(5, vb_, vf1_); sacc_ += (PC0[12] + PC0[13]) + (PC0[14] + PC0[15]); mb_ = M3_MX3(mb_, PN0[10], PN0[11]); ma_ = M3_MX3(ma_, PN1[8], PN1[9]); asm volatile("" : "+v"(ma_), "+v"(mb_), "+v"(sacc_)); SBAR_; \
        if (ABL != 2) { o[1] = __builtin_amdgcn_mfma_f32_32x32x16_bf16(__builtin_bit_cast(bf16x8, pw_[0]), vf0_, o[1], 0, 0, 0); } else { o[1][0] += __builtin_bit_cast(float, pw_[0][0]) + (float)vf0_[0]; } M3_VF(6, vb_, vf0_); sacc_ += (PC1[0] + PC1[1]) + (PC1[2] + PC1[3]); mb_ = M3_MX3(mb_, PN1[10], PN1[11]); ma_ = M3_MX3(ma_, PN0[12], PN0[13]); asm volatile("" : "+v"(ma_), "+v"(mb_), "+v"(sacc_)); SBAR_; \
        if (ABL != 2) { o[1] = __builtin_amdgcn_mfma_f32_32x32x16_bf16(__builtin_bit_cast(bf16x8, pw_[1]), vf1_, o[1], 0, 0, 0); } else { o[1][0] += __builtin_bit_cast(float, pw_[1][0]) + (float)vf1_[0]; } M3_VF(7, vb_, vf1_); sacc_ += (PC1[4] + PC1[5]) + (PC1[6] + PC1[7]); mb_ = M3_MX3(mb_, PN0[14], PN0[15]); asm volatile("" : "+v"(ma_), "+v"(mb_), "+v"(sacc_)); SBAR_; \
        if (ABL != 2) { o[1] = __builtin_amdgcn_mfma_f32_32x32x16_bf16(__builtin_bit_cast(bf16x8, pw_[2]), vf0_, o[1], 0, 0, 0); } else { o[1][0] += __builtin_bit_cast(float, pw_[2][0]) + (float)vf0_[0]; } sacc_ += (PC1[8] + PC1[9]) + (PC1[10] + PC1[11]); ma_ = M3_MX3(ma_, PN1[12], PN1[13]); asm volatile("" : "+v"(ma_), "+v"(mb_), "+v"(sacc_)); SBAR_; \
        if (ABL != 2) { o[1] = __builtin_amdgcn_mfma_f32_32x32x16_bf16(__builtin_bit_cast(bf16x8, pw_[3]), vf1_, o[1], 0, 0, 0); } else { o[1][0] += __builtin_bit_cast(float, pw_[3][0]) + (float)vf1_[0]; } sacc_ += (PC1[12] + PC1[13]) + (PC1[14] + PC1[15]); mb_ = M3_MX3(mb_, PN1[14], PN1[15]); asm volatile("" : "+v"(ma_), "+v"(mb_), "+v"(sacc_)); SBAR_; \
        lsum += sacc_; \
        float rm_ = fmaxf(ma_, mb_); rm_ = fmaxf(rm_, __shfl_xor(rm_, 32)); \
        if (__any(rm_ > THR)) { const float dl_ = fmaxf(rm_, 0.f); const float f_ = fast_exp2(-dl_); lsum *= f_; \
            _Pragma("unroll") for (int r = 0; r < 16; ++r) { PN0[r] -= dl_; PN1[r] -= dl_; negm[r] -= dl_; } \
            if (hi == 0) scr[r32] = f_; \
            _Pragma("unroll") for (int r = 0; r < 16; ++r) { const float fr_ = scr[crow(r, hi)]; _Pragma("unroll") for (int d0 = 0; d0 < ND0; ++d0) o[d0][r] *= fr_; } } \
        if (ABL != 4) { if (LDK) M3_STOREK(buf_); M3_STOREV(buf_ ^ 1); } \
        if (ABL != 5) __syncthreads(); } while (0)
#define M3_TAIL(PC0, PC1, t) do { const int buf_ = (t) & 1; \
        float sacc_ = 0.f; u32x4 pw_[4]; \
        _Pragma("unroll") for (int q = 0; q < 8; ++q) { M3_EXPAIR(PC0, 2 * q, q >> 2, q & 3); } \
        _Pragma("unroll") for (int q = 0; q < 8; ++q) { M3_EXPAIR(PC1, 2 * q, 2 + (q >> 2), q & 3); } \
        lsum += sacc_; \
        const unsigned vb_ = (unsigned)(uintptr_t)(lds + OFF_V + buf_ * VB) + (unsigned)((4 * hi + ((lane & 15) >> 2)) * PV + ((((lane >> 4) & 1) * 16 + (lane & 3) * 4) * 2)); \
        _Pragma("unroll") for (int i = 0; i < 8; ++i) { bf16x8 vf_; M3_VF(i, vb_, vf_); o[i >> 2] = __builtin_amdgcn_mfma_f32_32x32x16_bf16(__builtin_bit_cast(bf16x8, pw_[i & 3]), vf_, o[i >> 2], 0, 0, 0); } \
        __syncthreads(); } while (0)
    for (int t = 0; t < NT - 2; t += 2) { M3_STEP(pA0, pA1, pB0, pB1, t, 1); M3_STEP(pB0, pB1, pA0, pA1, t + 1, 1); }
    M3_STEP(pA0, pA1, pB0, pB1, NT - 2, 0);
    M3_TAIL(pB0, pB1, NT - 1);
    lsum += __shfl_xor(lsum, 32);
    if (hi == 0) scr[r32] = fast_rcp(lsum);
    LAS bf16_t* ost = (LAS bf16_t*)(lds + OFF_OST) + wid * 32 * DV;
#pragma unroll
    for (int r = 0; r < 16; ++r) { const int q = crow(r, hi); const float ri = scr[q];
#pragma unroll
        for (int d0 = 0; d0 < ND0; ++d0) { const float val = o[d0][r] * ri; ost[q * DV + d0 * 32 + r32] = (bf16_t)(cvt_pk_bf16(val, val) & 0xffffu); } }
    asm volatile("s_waitcnt lgkmcnt(0)" ::: "memory");
    { bf16_t* og = A.o + (size_t)wave_tok0 * LDO + h * DV;
#pragma unroll
      for (int i = 0; i < DV / 16; ++i) { const int id = i * 64 + lane; const int row = id / VCH, ch = id % VCH;
          const u32x4 v = *(const LAS u32x4*)(ost + row * DV + ch * 8); st_g<6>((u32x4*)(og + (size_t)row * LDO + ch * 8), v); } }
    __syncthreads();
#undef M3_LOADK
#undef M3_LOADV
#undef M3_STOREK
#undef M3_STOREV
#undef M3_ROWMAX
#undef M3_KF
#undef M3_EXPAIR
#undef M3_EXPK
#undef M3_VF
#undef M3_STEP
#undef M3_TAIL
#undef M3_MX3
}
template <int ABL>
__device__ __forceinline__ void attn_unit_mla4(LAS unsigned char* lds, const AttnArgs& A, const int b, const int h, const int ub) {
    constexpr int DQK = 96, DV = 64;
    constexpr int PK = DQK * 2 + 16, PV = DV * 2 + 64, KB = 64 * PK, VB = 64 * PV;
    constexpr int OFF_K = 0, OFF_V = 2 * KB, OFF_SCR = OFF_V + 3 * VB, OFF_OST = OFF_SCR + 8 * 256, OFF_END = OFF_OST + 8 * 32 * DV * 2;
    static_assert(OFF_END <= LDS_BYTES - 64, "attention LDS");
    constexpr int KCH = DQK / 8, VCH = DV / 8, NKC = 64 * KCH, KPT = 2;
    constexpr int LDQ = 768, LDO = 512, NDS = DQK / 16, ND0 = DV / 32, NT = 64;
#ifndef ATT_THR
#define ATT_THR 8.0f
#endif
    constexpr float THR = ATT_THR;
    int tid_ = threadIdx.x; asm volatile("" : "+v"(tid_));
    const int tid = tid_, lane = tid & 63, r32 = lane & 31, hi = lane >> 5; const int wid = __builtin_amdgcn_readfirstlane(tid >> 6);
    const int wave_tok0 = b * S_ + ub * 256 + wid * 32;
    bf16x8 qf[NDS];
    { const bf16_t* qp = A.q + (size_t)(wave_tok0 + r32) * LDQ + h * DQK + hi * 8;
#pragma unroll
      for (int ds = 0; ds < NDS; ++ds) qf[ds] = ld_g<17>((const bf16x8*)(qp + ds * 16)); }
    const bf16_t* ksrc[KPT]; int kstr[KPT]; unsigned kdst[KPT]; bool kval[KPT];
    const bf16_t* vsrc; unsigned vdst;
    constexpr int KSTRIDE = 64 * 1024;
#pragma unroll
    for (int j = 0; j < KPT; ++j) { const int ci = tid + 512 * j; kval[j] = ci < NKC; const int cic = kval[j] ? ci : 0; const int row = cic / KCH, cc = cic % KCH;
        kdst[j] = (unsigned)(OFF_K + row * PK + cc * 16); kstr[j] = KSTRIDE; const size_t kt = (size_t)b * S_ + row;
        if (cc < 8) ksrc[j] = A.k0 + kt * 1024 + h * 64 + cc * 8; else { ksrc[j] = A.k1 + kt * 32 + (cc - 8) * 8; kstr[j] = 64 * 32; } }
    { const int row = tid / VCH, cc = tid % VCH; vdst = (unsigned)(OFF_V + row * PV + cc * 16); vsrc = A.v + ((size_t)b * S_ + row) * 1024 + h * 64 + cc * 8; }
    u32x4 kst[KPT], vst;
#define M3_LOADK(tile) do { _Pragma("unroll") for (int j = 0; j < KPT; ++j) if (kval[j]) kst[j] = *(const u32x4*)(ksrc[j] + (size_t)(tile) * kstr[j]); } while (0)
#define M3_LOADV(tile) do { vst = *(const u32x4*)(vsrc + (size_t)(tile) * KSTRIDE); } while (0)
#define M3_STOREK(buf) do { _Pragma("unroll") for (int j = 0; j < KPT; ++j) if (kval[j]) *(LAS u32x4*)(lds + kdst[j] + (buf) * KB) = kst[j]; } while (0)
#define M3_STOREV(boff) do { *(LAS u32x4*)(lds + vdst + (boff)) = vst; } while (0)
    LAS float* scr = (LAS float*)(lds + OFF_SCR) + wid * 64;
#define M3_ROWMAX(P0, P1, rm) do { float a_ = max3f(P0[0], P0[1], P1[0]), b_ = max3f(P0[2], P0[3], P1[1]); a_ = max3f(a_, P1[2], P1[3]); \
        _Pragma("unroll") for (int r = 4; r < 16; r += 4) { a_ = max3f(a_, P0[r], P0[r + 1]); b_ = max3f(b_, P0[r + 2], P0[r + 3]); a_ = max3f(a_, P1[r], P1[r + 1]); b_ = max3f(b_, P1[r + 2], P1[r + 3]); } \
        rm = fmaxf(a_, b_); rm = fmaxf(rm, __shfl_xor(rm, 32)); } while (0)
    f32x16 o[ND0], negm;
#pragma unroll
    for (int r = 0; r < 16; ++r) negm[r] = 0.f;
#pragma unroll
    for (int d0 = 0; d0 < ND0; ++d0)
#pragma unroll
        for (int r = 0; r < 16; ++r) o[d0][r] = 0.f;
    float lsum = 0.f;
    f32x16 pA0, pA1, pB0, pB1;
    { u32x4 k1st[KPT];
      M3_LOADK(0); M3_LOADV(0);
#pragma unroll
      for (int j = 0; j < KPT; ++j) if (kval[j]) k1st[j] = *(const u32x4*)(ksrc[j] + (size_t)kstr[j]);
      M3_STOREK(0); M3_STOREV(0);
#pragma unroll
      for (int j = 0; j < KPT; ++j) if (kval[j]) *(LAS u32x4*)(lds + kdst[j] + KB) = k1st[j]; }
    __syncthreads();
    { const LAS unsigned char* kb_ = lds + OFF_K + r32 * PK + hi * 16; pA0 = negm; pA1 = negm;
#pragma unroll
      for (int ds = 0; ds < NDS; ++ds) { const bf16x8 a0_ = *(const LAS bf16x8*)(kb_ + ds * 32), a1_ = *(const LAS bf16x8*)(kb_ + 32 * PK + ds * 32);
          pA0 = __builtin_amdgcn_mfma_f32_32x32x16_bf16(a0_, qf[ds], pA0, 0, 0, 0); pA1 = __builtin_amdgcn_mfma_f32_32x32x16_bf16(a1_, qf[ds], pA1, 0, 0, 0); } }
    { float rm; M3_ROWMAX(pA0, pA1, rm);
#pragma unroll
      for (int r = 0; r < 16; ++r) { pA0[r] -= rm; pA1[r] -= rm; negm[r] = -rm; } }
    __syncthreads();
    bf16x8 kf0_, kf1_, kf2_, kf3_;
    { const LAS unsigned char* kb1_ = lds + OFF_K + KB + r32 * PK + hi * 16; kf0_ = *(const LAS bf16x8*)(kb1_); kf1_ = *(const LAS bf16x8*)(kb1_ + 32 * PK); kf2_ = *(const LAS bf16x8*)(kb1_ + 32); kf3_ = *(const LAS bf16x8*)(kb1_ + 32 + 32 * PK); }
    int vc_ = 0, vn_ = VB, vf3_ = 2 * VB;
#define M3_KF(i, kb_) (*(const LAS bf16x8*)((kb_) + ((i) >> 1) * 32 + ((i) & 1) * 32 * PK))
#define M3_EXPAIR(P, r, S, W) do { if (ABL != 1) { P[r] = fast_exp2(P[r]); P[(r) + 1] = fast_exp2(P[(r) + 1]); } sacc_ += P[r] + P[(r) + 1]; pw_[S][W] = cvt_pk_bf16(P[r], P[(r) + 1]); } while (0)
#define M3_EXPK(P, r, S, W) do { if (ABL != 1) { P[r] = fast_exp2(P[r]); P[(r) + 1] = fast_exp2(P[(r) + 1]); } pw_[S][W] = cvt_pk_bf16(P[r], P[(r) + 1]); } while (0)
#define M3_VF(i, vb_, dst) do { const s16x4 lo_ = vtr((vb_) + (unsigned)(16 * ((i) & 3) * PV + ((i) >> 2) * 64)), hh_ = vtr((vb_) + (unsigned)(16 * ((i) & 3) * PV + 8 * PV + ((i) >> 2) * 64)); \
        dst = (bf16x8){lo_[0], lo_[1], lo_[2], lo_[3], hh_[0], hh_[1], hh_[2], hh_[3]}; } while (0)

#define M3_MX3(a, b, c) __builtin_fmaxf(__builtin_fmaxf((a), (b)), (c))
#define M3_STEP(PC0, PC1, PN0, PN1, t, LDK) do { const int buf_ = (t) & 1; \
        if (ABL != 4) { if (LDK) M3_LOADK((t) + 2); M3_LOADV((t) + 1); } \
        const LAS unsigned char* kb_ = lds + OFF_K + (buf_ ^ 1) * KB + r32 * PK + hi * 16; \
        const unsigned vb_ = (unsigned)(uintptr_t)(lds + OFF_V + vc_) + (unsigned)((4 * hi + ((lane & 15) >> 2)) * PV + ((((lane >> 4) & 1) * 16 + (lane & 3) * 4) * 2)); \
        float sacc_ = 0.f; u32x4 pw_[4]; SBAR_; \
        if (ABL != 3) { PN0 = __builtin_amdgcn_mfma_f32_32x32x16_bf16(kf0_, qf[0], negm, 0, 0, 0); } else { PN0 = negm; PN0[0] += (float)kf0_[0] + (float)qf[0][0]; } kf0_ = M3_KF(4, kb_); M3_EXPK(PC0, 0, 0, 0); M3_EXPK(PC0, 2, 0, 1); asm volatile("" : "+v"(pw_[0])); SBAR_; \
        if (ABL != 3) { PN1 = __builtin_amdgcn_mfma_f32_32x32x16_bf16(kf1_, qf[0], negm, 0, 0, 0); } else { PN1 = negm; PN1[0] += (float)kf1_[0] + (float)qf[0][0]; } kf1_ = M3_KF(5, kb_); M3_EXPK(PC0, 4, 0, 2); asm volatile("" : "+v"(pw_[0])); SBAR_; \
        if (ABL != 3) { PN0 = __builtin_amdgcn_mfma_f32_32x32x16_bf16(kf2_, qf[1], PN0, 0, 0, 0); } else { PN0 = PN0; PN0[0] += (float)kf2_[0] + (float)qf[1][0]; } kf2_ = M3_KF(6, kb_); M3_EXPK(PC0, 6, 0, 3); asm volatile("" : "+v"(pw_[0])); SBAR_; \
        if (ABL != 3) { PN1 = __builtin_amdgcn_mfma_f32_32x32x16_bf16(kf3_, qf[1], PN1, 0, 0, 0); } else { PN1 = PN1; PN1[0] += (float)kf3_[0] + (float)qf[1][0]; } kf3_ = M3_KF(7, kb_); M3_EXPK(PC0, 8, 1, 0); M3_EXPK(PC0, 10, 1, 1); asm volatile("" : "+v"(pw_[1])); SBAR_; \
        if (ABL != 3) { PN0 = __builtin_amdgcn_mfma_f32_32x32x16_bf16(kf0_, qf[2], PN0, 0, 0, 0); } else { PN0 = PN0; PN0[0] += (float)kf0_[0] + (float)qf[2][0]; } kf0_ = M3_KF(8, kb_); M3_EXPK(PC0, 12, 1, 2); asm volatile("" : "+v"(pw_[1])); SBAR_; \
        if (ABL != 3) { PN1 = __builtin_amdgcn_mfma_f32_32x32x16_bf16(kf1_, qf[2], PN1, 0, 0, 0); } else { PN1 = PN1; PN1[0] += (float)kf1_[0] + (float)qf[2][0]; } kf1_ = M3_KF(9, kb_); M3_EXPK(PC0, 14, 1, 3); asm volatile("" : "+v"(pw_[1])); SBAR_; \
        if (ABL != 3) { PN0 = __builtin_amdgcn_mfma_f32_32x32x16_bf16(kf2_, qf[3], PN0, 0, 0, 0); } else { PN0 = PN0; PN0[0] += (float)kf2_[0] + (float)qf[3][0]; } kf2_ = M3_KF(10, kb_); M3_EXPK(PC1, 0, 2, 0); M3_EXPK(PC1, 2, 2, 1); asm volatile("" : "+v"(pw_[2])); SBAR_; \
        if (ABL != 3) { PN1 = __builtin_amdgcn_mfma_f32_32x32x16_bf16(kf3_, qf[3], PN1, 0, 0, 0); } else { PN1 = PN1; PN1[0] += (float)kf3_[0] + (float)qf[3][0]; } kf3_ = M3_KF(11, kb_); M3_EXPK(PC1, 4, 2, 2); asm volatile("" : "+v"(pw_[2])); SBAR_; \
        if (ABL != 3) { PN0 = __builtin_amdgcn_mfma_f32_32x32x16_bf16(kf0_, qf[4], PN0, 0, 0, 0); } else { PN0 = PN0; PN0[0] += (float)kf0_[0] + (float)qf[4][0]; } M3_EXPK(PC1, 6, 2, 3); asm volatile("" : "+v"(pw_[2])); SBAR_; \
        if (ABL != 3) { PN1 = __builtin_amdgcn_mfma_f32_32x32x16_bf16(kf1_, qf[4], PN1, 0, 0, 0); } else { PN1 = PN1; PN1[0] += (float)kf1_[0] + (float)qf[4][0]; } M3_EXPK(PC1, 8, 3, 0); M3_EXPK(PC1, 10, 3, 1); asm volatile("" : "+v"(pw_[3])); SBAR_; \
        if (ABL != 3) { PN0 = __builtin_amdgcn_mfma_f32_32x32x16_bf16(kf2_, qf[5], PN0, 0, 0, 0); } else { PN0 = PN0; PN0[0] += (float)kf2_[0] + (float)qf[5][0]; } M3_EXPK(PC1, 12, 3, 2); asm volatile("" : "+v"(pw_[3])); SBAR_; \
        if (ABL != 3) { PN1 = __builtin_amdgcn_mfma_f32_32x32x16_bf16(kf3_, qf[5], PN1, 0, 0, 0); } else { PN1 = PN1; PN1[0] += (float)kf3_[0] + (float)qf[5][0]; } M3_EXPK(PC1, 14, 3, 3); asm volatile("" : "+v"(pw_[3])); SBAR_; \
        bf16x8 vf0_, vf1_; M3_VF(0, vb_, vf0_); M3_VF(1, vb_, vf1_); \
        float ma_ = M3_MX3(PN0[0], PN0[1], PN1[0]), mb_ = M3_MX3(PN0[2], PN0[3], PN1[1]); SBAR_; \
        if (ABL != 2) { o[0] = __builtin_amdgcn_mfma_f32_32x32x16_bf16(__builtin_bit_cast(bf16x8, pw_[0]), vf0_, o[0], 0, 0, 0); } else { o[0][0] += __builtin_bit_cast(float, pw_[0][0]) + (float)vf0_[0]; } M3_VF(2, vb_, vf0_); sacc_ += (PC0[0] + PC0[1]) + (PC0[2] + PC0[3]); ma_ = M3_MX3(ma_, PN1[2], PN1[3]); ma_ = M3_MX3(ma_, PN0[4], PN0[5]); asm volatile("" : "+v"(ma_), "+v"(mb_), "+v"(sacc_)); SBAR_; \
        if (ABL != 2) { o[0] = __builtin_amdgcn_mfma_f32_32x32x16_bf16(__builtin_bit_cast(bf16x8, pw_[1]), vf1_, o[0], 0, 0, 0); } else { o[0][0] += __builtin_bit_cast(float, pw_[1][0]) + (float)vf1_[0]; } M3_VF(3, vb_, vf1_); sacc_ += (PC0[4] + PC0[5]) + (PC0[6] + PC0[7]); mb_ = M3_MX3(mb_, PN0[6], PN0[7]); ma_ = M3_MX3(ma_, PN1[4], PN1[5]); asm volatile("" : "+v"(ma_), "+v"(mb_), "+v"(sacc_)); SBAR_; \
        if (ABL != 2) { o[0] = __builtin_amdgcn_mfma_f32_32x32x16_bf16(__builtin_bit_cast(bf16x8, pw_[2]), vf0_, o[0], 0, 0, 0); } else { o[0][0] += __builtin_bit_cast(float, pw_[2][0]) + (float)vf0_[0]; } M3_VF(4, vb_, vf0_); sacc_ += (PC0[8] + PC0[9]) + (PC0[10] + PC0[11]); mb_ = M3_MX3(mb_, PN1[6], PN1[7]); ma_ = M3_MX3(ma_, PN0[8], PN0[9]); asm volatile("" : "+v"(ma_), "+v"(mb_), "+v"(sacc_)); SBAR_; \
        if (ABL != 2) { o[0] = __builtin_amdgcn_mfma_f32_32x32x16_bf16(__builtin_bit_cast(bf16x8, pw_[3]), vf1_, o[0], 0, 0, 0); } else { o[0][0] += __builtin_bit_cast(float, pw_[3][0]) + (float)vf1_[0]; } M3_VF(5, vb_, vf1_); sacc_ += (PC0[12] + PC0[13]) + (PC0[14] + PC0[15]); mb_ = M3_MX3(mb_, PN0[10], PN0[11]); ma_ = M3_MX3(ma_, PN1[8], PN1[9]); asm volatile("" : "+v"(ma_), "+v"(mb_), "+v"(sacc_)); SBAR_; \
        if (ABL != 4) { if (LDK) M3_STOREK(buf_); M3_STOREV(vn_); } \
        if (ABL != 5) { asm volatile("s_waitcnt lgkmcnt(0)\n\ts_barrier" ::: "memory"); } SBAR_; \
        if (ABL != 2) { o[1] = __builtin_amdgcn_mfma_f32_32x32x16_bf16(__builtin_bit_cast(bf16x8, pw_[0]), vf0_, o[1], 0, 0, 0); } else { o[1][0] += __builtin_bit_cast(float, pw_[0][0]) + (float)vf0_[0]; } M3_VF(6, vb_, vf0_); sacc_ += (PC1[0] + PC1[1]) + (PC1[2] + PC1[3]); mb_ = M3_MX3(mb_, PN1[10], PN1[11]); ma_ = M3_MX3(ma_, PN0[12], PN0[13]); asm volatile("" : "+v"(ma_), "+v"(mb_), "+v"(sacc_)); SBAR_; \
        if (ABL != 2) { o[1] = __builtin_amdgcn_mfma_f32_32x32x16_bf16(__builtin_bit_cast(bf16x8, pw_[1]), vf1_, o[1], 0, 0, 0); } else { o[1][0] += __builtin_bit_cast(float, pw_[1][0]) + (float)vf1_[0]; } M3_VF(7, vb_, vf1_); sacc_ += (PC1[4] + PC1[5]) + (PC1[6] + PC1[7]); mb_ = M3_MX3(mb_, PN0[14], PN0[15]); asm volatile("" : "+v"(ma_), "+v"(mb_), "+v"(sacc_)); SBAR_; \
        if (ABL != 2) { o[1] = __builtin_amdgcn_mfma_f32_32x32x16_bf16(__builtin_bit_cast(bf16x8, pw_[2]), vf0_, o[1], 0, 0, 0); } else { o[1][0] += __builtin_bit_cast(float, pw_[2][0]) + (float)vf0_[0]; } sacc_ += (PC1[8] + PC1[9]) + (PC1[10] + PC1[11]); ma_ = M3_MX3(ma_, PN1[12], PN1[13]); asm volatile("" : "+v"(ma_), "+v"(mb_), "+v"(sacc_)); SBAR_; \
        if (ABL != 2) { o[1] = __builtin_amdgcn_mfma_f32_32x32x16_bf16(__builtin_bit_cast(bf16x8, pw_[3]), vf1_, o[1], 0, 0, 0); } else { o[1][0] += __builtin_bit_cast(float, pw_[3][0]) + (float)vf1_[0]; } sacc_ += (PC1[12] + PC1[13]) + (PC1[14] + PC1[15]); mb_ = M3_MX3(mb_, PN1[14], PN1[15]); asm volatile("" : "+v"(ma_), "+v"(mb_), "+v"(sacc_)); SBAR_; \
        lsum += sacc_; \
        { const LAS unsigned char* kbn_ = lds + OFF_K + buf_ * KB + r32 * PK + hi * 16; kf0_ = M3_KF(0, kbn_); kf1_ = M3_KF(1, kbn_); kf2_ = M3_KF(2, kbn_); kf3_ = M3_KF(3, kbn_); } \
        { const int v_ = vc_; vc_ = vn_; vn_ = vf3_; vf3_ = v_; } \
        float rm_ = fmaxf(ma_, mb_); rm_ = fmaxf(rm_, __shfl_xor(rm_, 32)); \
        if (__any(rm_ > THR)) { const float dl_ = fmaxf(rm_, 0.f); const float f_ = fast_exp2(-dl_); lsum *= f_; \
            _Pragma("unroll") for (int r = 0; r < 16; ++r) { PN0[r] -= dl_; PN1[r] -= dl_; negm[r] -= dl_; } \
            if (hi == 0) scr[r32] = f_; \
            _Pragma("unroll") for (int r = 0; r < 16; ++r) { const float fr_ = scr[crow(r, hi)]; _Pragma("unroll") for (int d0 = 0; d0 < ND0; ++d0) o[d0][r] *= fr_; } } \
        } while (0)
#define M3_TAIL(PC0, PC1, t) do { const int buf_ = (t) & 1; \
        float sacc_ = 0.f; u32x4 pw_[4]; \
        _Pragma("unroll") for (int q = 0; q < 8; ++q) { M3_EXPAIR(PC0, 2 * q, q >> 2, q & 3); } \
        _Pragma("unroll") for (int q = 0; q < 8; ++q) { M3_EXPAIR(PC1, 2 * q, 2 + (q >> 2), q & 3); } \
        lsum += sacc_; \
        const unsigned vb_ = (unsigned)(uintptr_t)(lds + OFF_V + vc_) + (unsigned)((4 * hi + ((lane & 15) >> 2)) * PV + ((((lane >> 4) & 1) * 16 + (lane & 3) * 4) * 2)); \
        _Pragma("unroll") for (int i = 0; i < 8; ++i) { bf16x8 vf_; M3_VF(i, vb_, vf_); o[i >> 2] = __builtin_amdgcn_mfma_f32_32x32x16_bf16(__builtin_bit_cast(bf16x8, pw_[i & 3]), vf_, o[i >> 2], 0, 0, 0); } \
        __syncthreads(); } while (0)
    for (int t = 0; t < NT - 2; t += 2) { M3_STEP(pA0, pA1, pB0, pB1, t, 1); M3_STEP(pB0, pB1, pA0, pA1, t + 1, 1); }
    M3_STEP(pA0, pA1, pB0, pB1, NT - 2, 0);
    M3_TAIL(pB0, pB1, NT - 1);
    lsum += __shfl_xor(lsum, 32);
    if (hi == 0) scr[r32] = fast_rcp(lsum);
    LAS bf16_t* ost = (LAS bf16_t*)(lds + OFF_OST) + wid * 32 * DV;
#pragma unroll
    for (int r = 0; r < 16; ++r) { const int q = crow(r, hi); const float ri = scr[q];
#pragma unroll
        for (int d0 = 0; d0 < ND0; ++d0) { const float val = o[d0][r] * ri; ost[q * DV + d0 * 32 + r32] = (bf16_t)(cvt_pk_bf16(val, val) & 0xffffu); } }
    asm volatile("s_waitcnt lgkmcnt(0)" ::: "memory");
    { bf16_t* og = A.o + (size_t)wave_tok0 * LDO + h * DV;
#pragma unroll
      for (int i = 0; i < DV / 16; ++i) { const int id = i * 64 + lane; const int row = id / VCH, ch = id % VCH;
          const u32x4 v = *(const LAS u32x4*)(ost + row * DV + ch * 8); st_g<6>((u32x4*)(og + (size_t)row * LDO + ch * 8), v); } }
    __syncthreads();
#undef M3_LOADK
#undef M3_LOADV
#undef M3_STOREK
#undef M3_STOREV
#undef M3_ROWMAX
#undef M3_KF
#undef M3_EXPAIR
#undef M3_EXPK
#undef M3_VF
#undef M3_STEP
#undef M3_TAIL
#undef M3_MX3
}
#undef SBAR_
}

namespace att {
__device__ __forceinline__ void attn_unit_mla16(LAS unsigned char* lds, const AttnArgs& A, const int b, const int h, const int ub) {
    constexpr int DQK = 96, DV = 64, KROW = 256, PV = 160, KB = 64 * KROW, VB = 64 * PV;
    constexpr int OFF_K = 0, OFF_V = 2 * KB, OFF_OST = OFF_V + 2 * VB, OFF_END = OFF_OST + 8 * 32 * DV * 2;
    static_assert(OFF_END <= LDS_BYTES - 64, "attention LDS");
    constexpr int KCH = 12, VCH = 8, NKC = 64 * KCH, KPT = 2, LDQ = 768, LDO = 512, NT = 64;
    constexpr float THR = 8.0f;
    int tid_ = threadIdx.x; asm volatile("" : "+v"(tid_));
    const int tid = tid_, lane = tid & 63, lj = lane & 15, fq = lane >> 4; const int wid = __builtin_amdgcn_readfirstlane(tid >> 6);
    const int wave_tok0 = b * S_ + ub * 256 + wid * 32;
    bf16x8 qf[2][3];
#pragma unroll
    for (int g = 0; g < 2; ++g) { const bf16_t* qp = A.q + (size_t)(wave_tok0 + 16 * g + lj) * LDQ + h * DQK + fq * 8;
#pragma unroll
        for (int ds = 0; ds < 3; ++ds) qf[g][ds] = *(const bf16x8*)(qp + ds * 32); }
    const bf16_t* ksrc[KPT]; int kstr[KPT]; unsigned kdst[KPT]; bool kval[KPT];
    const bf16_t* vsrc; unsigned vdst;
    constexpr int KSTRIDE = 64 * 1024;
#pragma unroll
    for (int j = 0; j < KPT; ++j) { const int ci = tid + 512 * j; kval[j] = ci < NKC; const int cic = kval[j] ? ci : 0; const int row = cic / KCH, cc = cic % KCH;
        kdst[j] = (unsigned)(OFF_K + row * KROW + ((cc ^ (row & 15)) << 4)); kstr[j] = KSTRIDE; const size_t kt = (size_t)b * S_ + row;
        if (cc < 8) ksrc[j] = A.k0 + kt * 1024 + h * 64 + cc * 8; else { ksrc[j] = A.k1 + kt * 32 + (cc - 8) * 8; kstr[j] = 64 * 32; } }
    { const int row = tid / VCH, cc = tid % VCH; vdst = (unsigned)(OFF_V + row * PV + cc * 16); vsrc = A.v + ((size_t)b * S_ + row) * 1024 + h * 64 + cc * 8; }
    u32x4 kst[KPT], vst;
#define M16_LOADK(tile) do { _Pragma("unroll") for (int j = 0; j < KPT; ++j) if (kval[j]) kst[j] = *(const u32x4*)(ksrc[j] + (size_t)(tile) * kstr[j]); } while (0)
#define M16_LOADV(tile) do { vst = *(const u32x4*)(vsrc + (size_t)(tile) * KSTRIDE); } while (0)
#define M16_STOREK(buf) do { _Pragma("unroll") for (int j = 0; j < KPT; ++j) if (kval[j]) *(LAS u32x4*)(lds + kdst[j] + (buf) * KB) = kst[j]; } while (0)
#define M16_STOREV(buf) do { *(LAS u32x4*)(lds + vdst + (buf) * VB) = vst; } while (0)
#define M16_QK(SN, buf) do { const LAS unsigned char* kb_ = lds + OFF_K + (buf) * KB + lj * KROW; \
        _Pragma("unroll") for (int kt = 0; kt < 4; ++kt) _Pragma("unroll") for (int ds = 0; ds < 3; ++ds) { const bf16x8 a_ = *(const LAS bf16x8*)(kb_ + kt * 16 * KROW + (((4 * ds + fq) ^ lj) << 4)); \
            _Pragma("unroll") for (int g = 0; g < 2; ++g) SN[kt][g] = __builtin_amdgcn_mfma_f32_16x16x32_bf16(a_, qf[g][ds], ds == 0 ? negm[g] : SN[kt][g], 0, 0, 0); } } while (0)
#define M16_ROWMAX(SX, g, rm) do { float a_ = max3f(SX[0][g][0], SX[0][g][1], SX[0][g][2]), b_ = max3f(SX[0][g][3], SX[1][g][0], SX[1][g][1]); \
        a_ = max3f(a_, SX[1][g][2], SX[1][g][3]); b_ = max3f(b_, SX[2][g][0], SX[2][g][1]); a_ = max3f(a_, SX[2][g][2], SX[2][g][3]); b_ = max3f(b_, SX[3][g][0], SX[3][g][1]); a_ = max3f(a_, SX[3][g][2], SX[3][g][3]); \
        rm = fmaxf(a_, b_); rm = fmaxf(rm, __shfl_xor(rm, 16)); rm = fmaxf(rm, __shfl_xor(rm, 32)); } while (0)
    f32x4 o[2][4], negm[2]; float lsum[2] = {0.f, 0.f};
#pragma unroll
    for (int g = 0; g < 2; ++g) { negm[g] = (f32x4){0.f, 0.f, 0.f, 0.f};
#pragma unroll
        for (int dt = 0; dt < 4; ++dt) o[g][dt] = (f32x4){0.f, 0.f, 0.f, 0.f}; }
    f32x4 sA[4][2], sB[4][2];
    { u32x4 k1st[KPT];
      M16_LOADK(0); M16_LOADV(0);
#pragma unroll
      for (int j = 0; j < KPT; ++j) if (kval[j]) k1st[j] = *(const u32x4*)(ksrc[j] + (size_t)kstr[j]);
      M16_STOREK(0); M16_STOREV(0);
#pragma unroll
      for (int j = 0; j < KPT; ++j) if (kval[j]) *(LAS u32x4*)(lds + kdst[j] + KB) = k1st[j]; }
    __syncthreads();
    M16_QK(sA, 0);
#pragma unroll
    for (int g = 0; g < 2; ++g) { float rm; M16_ROWMAX(sA, g, rm);
#pragma unroll
        for (int kt = 0; kt < 4; ++kt) sA[kt][g] = sA[kt][g] - rm;
        negm[g] = (f32x4){-rm, -rm, -rm, -rm}; }
    __syncthreads();
    const int q_ = lj >> 2, p_ = lj & 3;
#define M16_STEP(SC, SN, t) do { const int buf_ = (t) & 1; \
        if ((t) + 2 < NT) M16_LOADK((t) + 2); if ((t) + 1 < NT) M16_LOADV((t) + 1); \
        if ((t) + 1 < NT) M16_QK(SN, buf_ ^ 1); \
        bf16x8 pa_[2][2]; \
        _Pragma("unroll") for (int g = 0; g < 2; ++g) { float ps_ = 0.f; \
            _Pragma("unroll") for (int kt = 0; kt < 4; ++kt) _Pragma("unroll") for (int e = 0; e < 4; ++e) { SC[kt][g][e] = fast_exp2(SC[kt][g][e]); ps_ += SC[kt][g][e]; } \
            lsum[g] += ps_; \
            _Pragma("unroll") for (int s = 0; s < 2; ++s) { u32x4 w_; w_.x = cvt_pk_bf16(SC[2 * s][g][0], SC[2 * s][g][1]); w_.y = cvt_pk_bf16(SC[2 * s][g][2], SC[2 * s][g][3]); \
                w_.z = cvt_pk_bf16(SC[2 * s + 1][g][0], SC[2 * s + 1][g][1]); w_.w = cvt_pk_bf16(SC[2 * s + 1][g][2], SC[2 * s + 1][g][3]); pa_[g][s] = __builtin_bit_cast(bf16x8, w_); } } \
        { const unsigned vb_ = (unsigned)(uintptr_t)(lds + OFF_V + buf_ * VB) + (unsigned)((4 * fq + q_) * PV + p_ * 8); \
          _Pragma("unroll") for (int s = 0; s < 2; ++s) _Pragma("unroll") for (int dt = 0; dt < 4; ++dt) { \
              const s16x4 lo_ = vtr(vb_ + (unsigned)(32 * s * PV + dt * 32)), hh_ = vtr(vb_ + (unsigned)((32 * s + 16) * PV + dt * 32)); \
              const bf16x8 vf_ = (bf16x8){lo_[0], lo_[1], lo_[2], lo_[3], hh_[0], hh_[1], hh_[2], hh_[3]}; \
              _Pragma("unroll") for (int g = 0; g < 2; ++g) o[g][dt] = __builtin_amdgcn_mfma_f32_16x16x32_bf16(pa_[g][s], vf_, o[g][dt], 0, 0, 0); } } \
        float rm0_ = 0.f, rm1_ = 0.f; \
        if ((t) + 1 < NT) { M16_ROWMAX(SN, 0, rm0_); M16_ROWMAX(SN, 1, rm1_); } \
        if (__any(fmaxf(rm0_, rm1_) > THR)) { \
            _Pragma("unroll") for (int g = 0; g < 2; ++g) { const float dl_ = fmaxf(g ? rm1_ : rm0_, 0.f); const float f_ = fast_exp2(-dl_); lsum[g] *= f_; \
                _Pragma("unroll") for (int kt = 0; kt < 4; ++kt) SN[kt][g] = SN[kt][g] - dl_; negm[g] = negm[g] - dl_; \
                _Pragma("unroll") for (int e = 0; e < 4; ++e) { const float fe_ = __shfl(f_, 4 * fq + e); _Pragma("unroll") for (int dt = 0; dt < 4; ++dt) o[g][dt][e] *= fe_; } } } \
        if ((t) + 2 < NT) M16_STOREK(buf_); if ((t) + 1 < NT) M16_STOREV(buf_ ^ 1); \
        __syncthreads(); } while (0)
    for (int t = 0; t < NT; t += 2) { M16_STEP(sA, sB, t); M16_STEP(sB, sA, t + 1); }
    LAS bf16_t* ost = (LAS bf16_t*)(lds + OFF_OST) + wid * 32 * DV;
#pragma unroll
    for (int g = 0; g < 2; ++g) { float l_ = lsum[g]; l_ += __shfl_xor(l_, 16); l_ += __shfl_xor(l_, 32); const float linv = fast_rcp(l_);
#pragma unroll
        for (int e = 0; e < 4; ++e) { const float li = __shfl(linv, 4 * fq + e);
#pragma unroll
            for (int dt = 0; dt < 4; ++dt) { const float val = o[g][dt][e] * li; ost[(16 * g + 4 * fq + e) * DV + 16 * dt + lj] = (bf16_t)(cvt_pk_bf16(val, val) & 0xffffu); } } }
    asm volatile("s_waitcnt lgkmcnt(0)" ::: "memory");
    { bf16_t* og = A.o + (size_t)wave_tok0 * LDO + h * DV;
#pragma unroll
      for (int i = 0; i < DV / 16; ++i) { const int id = i * 64 + lane; const int row = id / VCH, ch = id % VCH;
          const u32x4 v = *(const LAS u32x4*)(ost + row * DV + ch * 8); *(u32x4*)(og + (size_t)row * LDO + ch * 8) = v; } }
    __syncthreads();
#undef M16_LOADK
#undef M16_LOADV
#undef M16_STOREK
#undef M16_STOREV
#undef M16_QK
#undef M16_ROWMAX
#undef M16_STEP
}
}

namespace na2 {
typedef short v4i16_t __attribute__((ext_vector_type(4)));
constexpr int NS = 6, DPF = 5, TILE = 16384;
constexpr int OFF_RING = 0, OFF_OST = NS * TILE, OFF_TAB = OFF_OST + 8 * 2048, TAB_FLOATS = 8 * 465;
static_assert(OFF_TAB + TAB_FLOATS * 4 <= LDS_BYTES - 64, "na2 LDS");
__device__ __forceinline__ void glds16(const void* gsrc, unsigned lds_dst) { unsigned keep;
    asm volatile("s_mov_b32 %0, m0\n\ts_mov_b32 m0, %2\n\ts_nop 0\n\tglobal_load_lds_dwordx4 %1, off\n\ts_mov_b32 m0, %0" : "=&s"(keep) : "v"(gsrc), "s"(lds_dst) : "memory"); }
__device__ __forceinline__ s16x4 vtr(unsigned addr) { return __builtin_bit_cast(s16x4, __builtin_amdgcn_ds_read_tr16_b64_v4i16((LAS v4i16_t*)(uintptr_t)addr)); }
__device__ __forceinline__ int clampi(int v, int lo, int hi) { return v < lo ? lo : (v > hi ? hi : v); }
#define NA_WAITBAR(N) asm volatile("s_waitcnt vmcnt(" #N ") lgkmcnt(0)\n\ts_barrier" ::: "memory")

__device__ __forceinline__ void na_phase(LAS unsigned char* lds, const bf16_t* qn, const bf16_t* kn, const bf16_t* vn, bf16_t* on, const float* rpb, const int vcu, const int G) {
    int tid_ = threadIdx.x; asm volatile("" : "+v"(tid_));
    const int tid = tid_, lane = tid & 63, lj = lane & 15, fq = lane >> 4; const int wid = __builtin_amdgcn_readfirstlane(tid >> 6);
    const int hl = wid >> 2, g = wid & 3; const int csg = (g == 0) ? 0 : (g == 1 ? 8 : (g == 2 ? 24 : 32));
    LAS float* tab = (LAS float*)(lds + OFF_TAB);
    { float tv[8];
#pragma unroll
      for (int k = 0; k < 8; ++k) { const int i = tid + NTHREADS * k; tv[k] = (i < TAB_FLOATS) ? rpb[i] : 0.f; }
#pragma unroll
      for (int k = 0; k < 8; ++k) { const int i = tid + NTHREADS * k; if (i < TAB_FLOATS) tab[i] = tv[k] * LOG2E; } }
    const unsigned lds0 = (unsigned)(uintptr_t)lds;
    if (vcu >= 2048) { __syncthreads(); return; }
    const int nunits = (2048 - vcu + G - 1) / G; const int total = nunits * 17;
    unsigned offK[2], offV[2], dstw[2];
#pragma unroll
    for (int p = 0; p < 2; ++p) { const int ii = wid * 2 + p, row = 4 * ii + (lane >> 4), cp = lane & 15;
        offK[p] = (unsigned)(row * 1024 + ((cp ^ (row & 15)) << 4)); offV[p] = (unsigned)(row * 1024 + ((cp ^ ((row & 7) << 1)) << 4)); dstw[p] = lds0 + OFF_RING + ii * 1024; }
#define NA_ISSUE(tau, slot) do { const int n_ = (tau) / 17, i_ = (tau) - 17 * n_; const int U_ = vcu + n_ * G; const int b_ = U_ >> 8, hp_ = (U_ >> 6) & 3, r_ = U_ & 63; \
        const int kr_ = (i_ == 0) ? r_ : clampi(r_ - 4, 0, 56) + ((i_ - 1) & 7); const bf16_t* src_ = (i_ == 0) ? qn : (i_ < 9 ? kn : vn); \
        const char* base_ = (const char*)(src_ + ((size_t)(b_ * S_ + kr_ * 64) * 512 + hp_ * 128)); \
        _Pragma("unroll") for (int p = 0; p < 2; ++p) glds16(base_ + (i_ < 9 ? offK[p] : offV[p]), (unsigned)__builtin_amdgcn_readfirstlane(dstw[p] + (slot) * TILE)); } while (0)
    int islot = 0;
#pragma unroll
    for (int d = 0; d < DPF; ++d) { if (d < total) { NA_ISSUE(d, islot); islot = (islot + 1 == NS) ? 0 : islot + 1; } }
    int cslot = 0;
    for (int n = 0; n < nunits; ++n) {
        const int U = vcu + n * G; const int b = U >> 8, hp = (U >> 6) & 3, r = U & 63; const int rs = clampi(r - 4, 0, 56); const int head = hp * 2 + hl;
        const int tok0 = b * S_ + r * 64 + 16 * g;
        bf16x8 qf[2];
        f32x4 s[8][2]; bf16x8 pa[8]; f32x4 o[4]; float lsum = 0.f;
#pragma unroll
        for (int dt = 0; dt < 4; ++dt) o[dt] = (f32x4){0.f, 0.f, 0.f, 0.f};
#pragma clang loop unroll(full)
        for (int i0 = 0; i0 < 17; ++i0) {
            const int tau = n * 17 + i0; const int i = i0 - 1;
            if (tau + DPF <= total) NA_WAITBAR(8); else NA_WAITBAR(0);
            if (tau + DPF < total) { NA_ISSUE(tau + DPF, islot); islot = (islot + 1 == NS) ? 0 : islot + 1; }
            const unsigned sbase = lds0 + OFF_RING + cslot * TILE; cslot = (cslot + 1 == NS) ? 0 : cslot + 1;
            if (i0 == 0) {
                const int kc = 16 * g + lj;
#pragma unroll
                for (int ds = 0; ds < 2; ++ds) { const int c = hl * 8 + ds * 4 + fq; qf[ds] = *(const LAS bf16x8*)(uintptr_t)(sbase + kc * 256 + ((c ^ (kc & 15)) << 4)); }
            } else if (i < 8) {
#pragma unroll
                for (int ct = 0; ct < 2; ++ct) { s[i][ct] = (f32x4){0.f, 0.f, 0.f, 0.f}; const int kc = csg + 16 * ct + lj;
#pragma unroll
                    for (int ds = 0; ds < 2; ++ds) { const int c = hl * 8 + ds * 4 + fq; const bf16x8 a = *(const LAS bf16x8*)(uintptr_t)(sbase + kc * 256 + ((c ^ (kc & 15)) << 4));
                        s[i][ct] = __builtin_amdgcn_mfma_f32_16x16x32_bf16(a, qf[ds], s[i][ct], 0, 0, 0); } }
                if (i == 7) {
                    const int c = 16 * g + lj, cs = clampi(c - 8, 0, 48); float m = -1e30f;
#pragma unroll
                    for (int t = 0; t < 8; ++t) { const LAS float* trow = tab + head * 465 + (rs + t - r + 7) * 31;
#pragma unroll
                        for (int ct = 0; ct < 2; ++ct)
#pragma unroll
                            for (int e = 0; e < 4; ++e) { const int kc = csg + 16 * ct + 4 * fq + e; const bool v = (unsigned)(kc - cs) < 16u; const float bias = trow[v ? (kc - c + 15) : 0];
                                const float x = v ? s[t][ct][e] + bias : -1e30f; s[t][ct][e] = x; m = fmaxf(m, x); } }
                    m = fmaxf(m, __shfl_xor(m, 16)); m = fmaxf(m, __shfl_xor(m, 32));
#pragma unroll
                    for (int t = 0; t < 8; ++t) {
#pragma unroll
                        for (int ct = 0; ct < 2; ++ct)
#pragma unroll
                            for (int e = 0; e < 4; ++e) { const float p = fast_exp2(s[t][ct][e] - m); s[t][ct][e] = p; lsum += p; }
                        u32x4 w; w.x = cvt_pk_bf16(s[t][0][0], s[t][0][1]); w.y = cvt_pk_bf16(s[t][0][2], s[t][0][3]); w.z = cvt_pk_bf16(s[t][1][0], s[t][1][1]); w.w = cvt_pk_bf16(s[t][1][2], s[t][1][3]);
                        pa[t] = __builtin_bit_cast(bf16x8, w); }
                    lsum += __shfl_xor(lsum, 16); lsum += __shfl_xor(lsum, 32);
                }
            } else {
                const int t = i - 8; const int q = lj >> 2, p = lj & 3;
#pragma unroll
                for (int dt = 0; dt < 4; ++dt) { const int c = hl * 8 + 2 * dt + (p >> 1); s16x4 tr[2];
#pragma unroll
                    for (int ct = 0; ct < 2; ++ct) { const int kc = csg + 16 * ct + 4 * fq + q; tr[ct] = vtr(sbase + kc * 256 + ((c ^ ((kc & 7) << 1)) << 4) + (p & 1) * 8); }
                    const bf16x8 vf = (bf16x8){tr[0][0], tr[0][1], tr[0][2], tr[0][3], tr[1][0], tr[1][1], tr[1][2], tr[1][3]};
                    o[dt] = __builtin_amdgcn_mfma_f32_16x16x32_bf16(pa[t], vf, o[dt], 0, 0, 0); }
                if (i == 15) {
                    const float linv = fast_rcp(lsum); float li[4];
#pragma unroll
                    for (int e = 0; e < 4; ++e) li[e] = __shfl(linv, 4 * fq + e);
                    LAS bf16_t* ost = (LAS bf16_t*)(lds + OFF_OST) + wid * 1024;
#pragma unroll
                    for (int dt = 0; dt < 4; ++dt)
#pragma unroll
                        for (int e = 0; e < 4; ++e) { const float val = o[dt][e] * li[e]; ost[(4 * fq + e) * 64 + 16 * dt + lj] = (bf16_t)(cvt_pk_bf16(val, val) & 0xffffu); }
                    asm volatile("s_waitcnt lgkmcnt(0)" ::: "memory");
                    bf16_t* og = on + (size_t)tok0 * 512 + head * 64;
#pragma unroll
                    for (int k = 0; k < 2; ++k) { const int id = lane + 64 * k, row = id >> 3, ch = id & 7; const u32x4 v = *(const LAS u32x4*)(ost + row * 64 + ch * 8); st_g<6>((u32x4*)(og + (size_t)row * 512 + ch * 8), v); }
                }
            }
        }
    }
    asm volatile("s_waitcnt vmcnt(0) lgkmcnt(0)" ::: "memory");
    __syncthreads();
#undef NA_ISSUE
}
#undef NA_WAITBAR
}

namespace na3 {
typedef short v4i16_t __attribute__((ext_vector_type(4)));
constexpr int NS = 6, DPF = 5, TILE = 16384;
constexpr int OFF_RING = 0, OFF_OST = NS * TILE, OFF_TAB = OFF_OST + 8 * 2048, TAB_FLOATS = 8 * 465;
static_assert(OFF_TAB + TAB_FLOATS * 4 <= LDS_BYTES - 64, "na3 LDS");
__device__ __forceinline__ void glds16(const void* gsrc, unsigned lds_dst) { unsigned keep;
    asm volatile("s_mov_b32 %0, m0\n\ts_mov_b32 m0, %2\n\ts_nop 0\n\tglobal_load_lds_dwordx4 %1, off\n\ts_mov_b32 m0, %0" : "=&s"(keep) : "v"(gsrc), "s"(lds_dst) : "memory"); }
__device__ __forceinline__ s16x4 vtr(unsigned addr) { return __builtin_bit_cast(s16x4, __builtin_amdgcn_ds_read_tr16_b64_v4i16((LAS v4i16_t*)(uintptr_t)addr)); }
__device__ __forceinline__ int clampi(int v, int lo, int hi) { return v < lo ? lo : (v > hi ? hi : v); }
#define NA_WAITBAR(N) asm volatile("s_waitcnt vmcnt(" #N ") lgkmcnt(0)\n\ts_barrier" ::: "memory")

__device__ __forceinline__ void na_phase(LAS unsigned char* lds, const bf16_t* qn, const bf16_t* kn, const bf16_t* vn, bf16_t* on, const float* rpb, const int vcu, const int G, const int bal) {
    int tid_ = threadIdx.x; asm volatile("" : "+v"(tid_));
    const int tid = tid_, lane = tid & 63, lj = lane & 15, fq = lane >> 4; const int wid = __builtin_amdgcn_readfirstlane(tid >> 6);
    const int hl = wid >> 2, g = wid & 3; const int csg = (g == 0) ? 0 : (g == 1 ? 8 : (g == 2 ? 24 : 32));
    LAS float* tab = (LAS float*)(lds + OFF_TAB);
    { float tv[8];
#pragma unroll
      for (int k = 0; k < 8; ++k) { const int i = tid + NTHREADS * k; tv[k] = (i < TAB_FLOATS) ? rpb[i] : 0.f; }
#pragma unroll
      for (int k = 0; k < 8; ++k) { const int i = tid + NTHREADS * k; if (i < TAB_FLOATS) tab[i] = tv[k] * LOG2E; } }
    const unsigned lds0 = (unsigned)(uintptr_t)lds;
    if (bal < 0 && vcu >= 1024) { __syncthreads(); return; }
    const int nunits = (bal < 0) ? (1024 - vcu + G - 1) / G : (bal == 128 ? 3 : 5); const int total = nunits * 20;
#define NA_UNIT(n) ((bal < 0 || (n) < 3) ? (vcu + (n) * G) : (768 + 2 * bal + ((n) - 3)))
    unsigned offK[2], offV[2], dstw[2];
#pragma unroll
    for (int p = 0; p < 2; ++p) { const int ii = wid * 2 + p, row = 4 * ii + (lane >> 4), cp = lane & 15;
        offK[p] = (unsigned)(row * 1024 + ((cp ^ (row & 15)) << 4)); offV[p] = (unsigned)(row * 1024 + ((cp ^ ((row & 7) << 1)) << 4)); dstw[p] = lds0 + OFF_RING + ii * 1024; }
#define NA_ISSUE(tau, slot) do { const int n_ = (tau) / 20, i_ = (tau) - 20 * n_; const int U_ = NA_UNIT(n_); const int b_ = U_ >> 7, hp_ = (U_ >> 5) & 3, r_ = (U_ & 31) * 2; \
        const int kr_ = (i_ < 2) ? (r_ + i_) : clampi(clampi(r_ - 4, 0, 56) + ((i_ < 11) ? (i_ - 2) : (i_ - 11)), 0, 63); const bf16_t* src_ = (i_ < 2) ? qn : (i_ < 11 ? kn : vn); \
        const char* base_ = (const char*)(src_ + ((size_t)(b_ * S_ + kr_ * 64) * 512 + hp_ * 128)); \
        _Pragma("unroll") for (int p = 0; p < 2; ++p) glds16(base_ + (i_ < 11 ? offK[p] : offV[p]), (unsigned)__builtin_amdgcn_readfirstlane(dstw[p] + (slot) * TILE)); } while (0)
    int islot = 0;
#pragma unroll
    for (int d = 0; d < DPF; ++d) { if (d < total) { NA_ISSUE(d, islot); islot = (islot + 1 == NS) ? 0 : islot + 1; } }
    int cslot = 0;
    for (int n = 0; n < nunits; ++n) {
        const int U = NA_UNIT(n); const int b = U >> 7, hp = (U >> 5) & 3, r = (U & 31) * 2; const int rs = clampi(r - 4, 0, 56); const int dsh = clampi(r - 3, 0, 56) - rs;
        const int head = hp * 2 + hl;
        const int tok0 = b * S_ + r * 64 + 16 * g;
        bf16x8 qf[2][2];
        f32x4 s[2][9][2]; bf16x8 pa[2][9]; f32x4 o[2][4]; float lsum[2] = {0.f, 0.f};
#pragma unroll
        for (int j = 0; j < 2; ++j)
#pragma unroll
            for (int dt = 0; dt < 4; ++dt) o[j][dt] = (f32x4){0.f, 0.f, 0.f, 0.f};
#pragma clang loop unroll(full)
        for (int i0 = 0; i0 < 20; ++i0) {
            const int tau = n * 20 + i0;
            if (tau + DPF <= total) NA_WAITBAR(8); else NA_WAITBAR(0);
            if (tau + DPF < total) { NA_ISSUE(tau + DPF, islot); islot = (islot + 1 == NS) ? 0 : islot + 1; }
            const unsigned sbase = lds0 + OFF_RING + cslot * TILE; cslot = (cslot + 1 == NS) ? 0 : cslot + 1;
            if (i0 < 2) {
                const int kc = 16 * g + lj;
#pragma unroll
                for (int ds = 0; ds < 2; ++ds) { const int c = hl * 8 + ds * 4 + fq; qf[i0][ds] = *(const LAS bf16x8*)(uintptr_t)(sbase + kc * 256 + ((c ^ (kc & 15)) << 4)); }
            } else if (i0 < 11) {
                const int t = i0 - 2;
#pragma unroll
                for (int ct = 0; ct < 2; ++ct) { const int kc = csg + 16 * ct + lj; s[0][t][ct] = (f32x4){0.f, 0.f, 0.f, 0.f}; s[1][t][ct] = (f32x4){0.f, 0.f, 0.f, 0.f};
#pragma unroll
                    for (int ds = 0; ds < 2; ++ds) { const int c = hl * 8 + ds * 4 + fq; const bf16x8 a = *(const LAS bf16x8*)(uintptr_t)(sbase + kc * 256 + ((c ^ (kc & 15)) << 4));
                        s[0][t][ct] = __builtin_amdgcn_mfma_f32_16x16x32_bf16(a, qf[0][ds], s[0][t][ct], 0, 0, 0); s[1][t][ct] = __builtin_amdgcn_mfma_f32_16x16x32_bf16(a, qf[1][ds], s[1][t][ct], 0, 0, 0); } }
                if (i0 == 10) {
                    const int c = 16 * g + lj, cs = clampi(c - 8, 0, 48);
#pragma unroll
                    for (int j = 0; j < 2; ++j) { float m = -1e30f; const int dj = j ? dsh : 0;
#pragma unroll
                        for (int t2 = 0; t2 < 9; ++t2) { const bool tv = (unsigned)(t2 - dj) < 8u; const int drr = tv ? (rs + t2 - (r + j) + 7) : 0; const LAS float* trow = tab + head * 465 + drr * 31;
#pragma unroll
                            for (int ct = 0; ct < 2; ++ct)
#pragma unroll
                                for (int e = 0; e < 4; ++e) { const int kc = csg + 16 * ct + 4 * fq + e; const bool v = tv && ((unsigned)(kc - cs) < 16u); const float bias = trow[v ? (kc - c + 15) : 0];
                                    const float x = v ? s[j][t2][ct][e] + bias : -1e30f; s[j][t2][ct][e] = x; m = fmaxf(m, x); } }
                        m = fmaxf(m, __shfl_xor(m, 16)); m = fmaxf(m, __shfl_xor(m, 32));
                        float ls = 0.f;
#pragma unroll
                        for (int t2 = 0; t2 < 9; ++t2) {
#pragma unroll
                            for (int ct = 0; ct < 2; ++ct)
#pragma unroll
                                for (int e = 0; e < 4; ++e) { const float p = fast_exp2(s[j][t2][ct][e] - m); s[j][t2][ct][e] = p; ls += p; }
                            u32x4 w; w.x = cvt_pk_bf16(s[j][t2][0][0], s[j][t2][0][1]); w.y = cvt_pk_bf16(s[j][t2][0][2], s[j][t2][0][3]); w.z = cvt_pk_bf16(s[j][t2][1][0], s[j][t2][1][1]); w.w = cvt_pk_bf16(s[j][t2][1][2], s[j][t2][1][3]);
                            pa[j][t2] = __builtin_bit_cast(bf16x8, w); }
                        ls += __shfl_xor(ls, 16); ls += __shfl_xor(ls, 32); lsum[j] = ls; }
                }
            } else {
                const int t = i0 - 11; const int q = lj >> 2, p = lj & 3;
#pragma unroll
                for (int dt = 0; dt < 4; ++dt) { const int c = hl * 8 + 2 * dt + (p >> 1); s16x4 tr[2];
#pragma unroll
                    for (int ct = 0; ct < 2; ++ct) { const int kc = csg + 16 * ct + 4 * fq + q; tr[ct] = vtr(sbase + kc * 256 + ((c ^ ((kc & 7) << 1)) << 4) + (p & 1) * 8); }
                    const bf16x8 vf = (bf16x8){tr[0][0], tr[0][1], tr[0][2], tr[0][3], tr[1][0], tr[1][1], tr[1][2], tr[1][3]};
                    o[0][dt] = __builtin_amdgcn_mfma_f32_16x16x32_bf16(pa[0][t], vf, o[0][dt], 0, 0, 0); o[1][dt] = __builtin_amdgcn_mfma_f32_16x16x32_bf16(pa[1][t], vf, o[1][dt], 0, 0, 0); }
                if (i0 == 19) {
                    LAS bf16_t* ost = (LAS bf16_t*)(lds + OFF_OST) + wid * 1024;
#pragma unroll
                    for (int j = 0; j < 2; ++j) { const float linv = fast_rcp(lsum[j]); float li[4];
#pragma unroll
                        for (int e = 0; e < 4; ++e) li[e] = __shfl(linv, 4 * fq + e);
#pragma unroll
                        for (int dt = 0; dt < 4; ++dt)
#pragma unroll
                            for (int e = 0; e < 4; ++e) { const float val = o[j][dt][e] * li[e]; ost[(4 * fq + e) * 64 + 16 * dt + lj] = (bf16_t)(cvt_pk_bf16(val, val) & 0xffffu); }
                        asm volatile("s_waitcnt lgkmcnt(0)" ::: "memory");
                        bf16_t* og = on + (size_t)(tok0 + j * 64) * 512 + head * 64;
#pragma unroll
                        for (int k = 0; k < 2; ++k) { const int id = lane + 64 * k, row = id >> 3, ch = id & 7; const u32x4 v = *(const LAS u32x4*)(ost + row * 64 + ch * 8); st_g<6>((u32x4*)(og + (size_t)row * 512 + ch * 8), v); }
                        asm volatile("s_waitcnt lgkmcnt(0)" ::: "memory"); }
                }
            }
        }
    }
    asm volatile("s_waitcnt vmcnt(0) lgkmcnt(0)" ::: "memory");
    __syncthreads();
#undef NA_ISSUE
#undef NA_UNIT
}
#undef NA_WAITBAR
}

struct HalfMap { int drow; float cs; bool rp; bool valid; };
template <int NTB>
__device__ __forceinline__ void p0_item64(const float* W, int ldw, int k0, int n0, bf16_t* WT, int ldwt, const HalfMap h0, const HalfMap h1, int dk0, const float* g, LAS float* scr, int lane) {
    const int n4 = (lane & 15) * 4, kq = lane >> 4; const bool hv = (n4 < 32) ? h0.valid : h1.valid; const float cs = (n4 < 32) ? h0.cs : h1.cs;
    f32x4 v[16];
#pragma unroll
    for (int j = 0; j < 16; ++j) { v[j] = (f32x4){0.f, 0.f, 0.f, 0.f}; if (hv) v[j] = ld_g<12>((const f32x4*)(W + (size_t)(k0 + 4 * j + kq) * ldw + n0 + n4)); }
#pragma unroll
    for (int j = 0; j < 16; ++j) { const int k = 4 * j + kq; float sc = cs; if (g) sc *= g[k0 + k];
#pragma unroll
        for (int e = 0; e < 4; ++e) scr[(n4 + e) * 65 + k] = v[j][e] * sc; }
    asm volatile("s_waitcnt lgkmcnt(0)" ::: "memory");
    const int c = lane & 7;
#pragma unroll
    for (int j = 0; j < 8; ++j) { const int nn = 8 * j + (lane >> 3); const LAS float* s = scr + nn * 65 + 8 * c;
        u32x4 o; o.x = cvt_pk_bf16(s[0], s[1]); o.y = cvt_pk_bf16(s[2], s[3]); o.z = cvt_pk_bf16(s[4], s[5]); o.w = cvt_pk_bf16(s[6], s[7]);
        const bool hi_ = nn >= 32; const int w = nn & 31; const bool rp = hi_ ? h1.rp : h0.rp; const int nd = rp ? ((w & 16) + 2 * (w & 7) + ((w >> 3) & 1)) : w;
        const int drow = (hi_ ? h1.drow : h0.drow) + nd;
        if (hi_ ? h1.valid : h0.valid) st_g<NTB>((u32x4*)(WT + (size_t)drow * ldwt + dk0 + k0 + 8 * c), o); }
    asm volatile("s_waitcnt lgkmcnt(0)" ::: "memory");
}
template <int NTB, int HALF = -1>
__device__ __forceinline__ void p0_rows(const float* src, bf16_t* dst, float* rstd, int nrows, int gw, int NGW, int lane) {
#define P0_ROW(m) (HALF < 0 ? (m) : ((((m) >> 11) << 12) | (HALF << 11) | ((m) & 2047)))
#define P0_LOAD(dstv, m) do { const f32x4* xr_ = (const f32x4*)(src + (size_t)P0_ROW(m) * D_) + lane; _Pragma("unroll") for (int j = 0; j < 4; ++j) dstv[j] = ld_g<12>(xr_ + 64 * j); } while (0)
#define P0_DONE(v, m) do { float s_ = 0.f; _Pragma("unroll") for (int j = 0; j < 4; ++j) s_ += (v[j][0] * v[j][0] + v[j][1] * v[j][1]) + (v[j][2] * v[j][2] + v[j][3] * v[j][3]); \
        s_ = wave_sum(s_); const int row_ = P0_ROW(m); u32x2* o8_ = (u32x2*)(dst + (size_t)row_ * D_) + lane; \
        _Pragma("unroll") for (int j = 0; j < 4; ++j) { u32x2 w_; w_.x = cvt_pk_bf16(v[j][0], v[j][1]); w_.y = cvt_pk_bf16(v[j][2], v[j][3]); st_g<NTB>(o8_ + 64 * j, w_); } \
        if (lane == 0) rstd[row_] = rsqrtf(s_ * (1.0f / 1024.0f) + EPS_); } while (0)
    f32x4 na[4], nb[4];
    if (gw < nrows) P0_LOAD(na, gw);
    if (gw + NGW < nrows) P0_LOAD(nb, gw + NGW);
    for (int m = gw; m < nrows; m += 2 * NGW) {
        f32x4 va[4], vb[4];
#pragma unroll
        for (int j = 0; j < 4; ++j) { va[j] = na[j]; vb[j] = nb[j]; }
        const bool hb_ = m + NGW < nrows;
        if (m + 2 * NGW < nrows) P0_LOAD(na, m + 2 * NGW);
        if (m + 3 * NGW < nrows) P0_LOAD(nb, m + 3 * NGW);
        P0_DONE(va, m);
        if (hb_) P0_DONE(vb, m + NGW);
    }
#undef P0_ROW
#undef P0_LOAD
#undef P0_DONE
}

#define PX(P) ((P).in[0])
#define PMEM(P) ((P).in[1])
#define PGMIX(P) ((P).in[2])
#define PWIN(P) ((P).in[3])
#define PRPB(P) ((P).in[4])
#define PQN(P) ((P).in[5])
#define PWUQ(P) ((P).in[6])
#define PKVN(P) ((P).in[7])
#define PWUKV(P) ((P).in[8])
#define PGMEM(P) ((P).in[9])
#define PWMEMKV(P) ((P).in[10])
#define PWOUT(P) ((P).in[14])
#define PGFFN(P) ((P).in[15])
#define PWROUTER(P) ((P).in[16])
#define PBROUTER(P) ((P).in[17])
#define PWGATE(P) ((P).in[18])
#define PWUP(P) ((P).in[19])
#define PWDOWN(P) ((P).in[20])
#define PGFINAL(P) ((P).in[21])
typedef Args Ptrs;

#ifndef XH_SPLIT
#define XH_SPLIT 1
#endif
#define XH_FLAG 3700
#ifndef EX_K1
#define EX_K1 3
#endif
#ifndef EX_K2
#define EX_K2 2
#endif
#ifndef EX_K3
#define EX_K3 0
#endif
#ifndef EX_K1A
#define EX_K1A 0
#endif
#ifndef EX_P3
#define EX_P3 1
#endif
constexpr int EX_N1A = 768 * EX_K1A, EX_N1 = 768 * EX_K1, EX_N2 = 1024 * EX_K2, EX_N3 = 1024 * EX_K3, EX_TAILS = EX_N1A + EX_N1 + EX_N2 + EX_N3;
constexpr int EX_NP3 = EX_P3 ? (3 * 16 * 256 - EX_TAILS) : 0, EX_DEFER = EX_TAILS + EX_NP3;
static_assert(EX_DEFER <= 3 * 16 * 256, "deferred expert items");
struct ExItem { const float* W; bf16_t* WT; const float* g; int k0, n0, d0; };
__device__ __forceinline__ ExItem ex_decode(const Ptrs& P, int r) {
    const int kind = r >> 12, rr = r & 4095; const int e = rr >> 8, q = rr & 255, kb = q >> 4, n0 = (q & 15) * 64; ExItem it; it.k0 = kb * 64; it.n0 = n0;
    if (kind == 2) { it.W = PWDOWN(P) + (size_t)e * 1048576; it.WT = (bf16_t*)(P.ws + WS_WD) + (size_t)e * 1048576; it.g = nullptr; it.d0 = n0; }
    else { it.W = (kind == 0 ? PWGATE(P) : PWUP(P)) + (size_t)e * 1048576; it.WT = (bf16_t*)(P.ws + WS_WGU) + (size_t)e * 2097152; it.g = PGFFN(P); it.d0 = (n0 >> 7) * 256 + (n0 & 127) + (kind == 1 ? 128 : 0); }
    return it;
}
__device__ __forceinline__ void ex_load(const ExItem& it, int lane, f32x4 (&v)[16]) {
    const int n4 = (lane & 15) * 4, kq = lane >> 4;
#pragma unroll
    for (int j = 0; j < 16; ++j) v[j] = ld_g<12>((const f32x4*)(it.W + (size_t)(it.k0 + 4 * j + kq) * 1024 + it.n0 + n4));
}
__device__ __forceinline__ void ex_finish(const ExItem& it, const f32x4 (&v)[16], LAS float* scr, int lane) {
    const int n4 = (lane & 15) * 4, kq = lane >> 4;
#pragma unroll
    for (int j = 0; j < 16; ++j) { const int k = 4 * j + kq; const float sc = it.g ? it.g[it.k0 + k] : 1.0f;
#pragma unroll
        for (int e = 0; e < 4; ++e) scr[(n4 + e) * 65 + k] = v[j][e] * sc; }
    asm volatile("s_waitcnt lgkmcnt(0)" ::: "memory");
    const int c = lane & 7;
#pragma unroll
    for (int j = 0; j < 8; ++j) { const int nn = 8 * j + (lane >> 3); const LAS float* s_ = scr + nn * 65 + 8 * c;
        u32x4 o; o.x = cvt_pk_bf16(s_[0], s_[1]); o.y = cvt_pk_bf16(s_[2], s_[3]); o.z = cvt_pk_bf16(s_[4], s_[5]); o.w = cvt_pk_bf16(s_[6], s_[7]);
        st_g<10>((u32x4*)(it.WT + (size_t)(it.d0 + nn) * 1024 + it.k0 + 8 * c), o); }
    asm volatile("s_waitcnt lgkmcnt(0)" ::: "memory");
}
template <bool PIPE = true>
__device__ __forceinline__ void p0_expert_range(const Ptrs& P, LAS unsigned char* lds, int first, int count, int widx, int nw, int wave, int lane) {
    asm volatile("" : "+v"(lane));
    LAS float* scr = (LAS float*)(lds + wave * 16640);
    if constexpr (!PIPE) { for (int it = first + widx; it < first + count; it += nw) { f32x4 v[16]; const ExItem ii = ex_decode(P, it); ex_load(ii, lane, v); ex_finish(ii, v, scr, lane); } return; }
    const int end = first + count; int it = __builtin_amdgcn_readfirstlane(first + widx); nw = __builtin_amdgcn_readfirstlane(nw);
    f32x4 va[16], vb[16]; ExItem ia, ib;
    if (it < end) { ia = ex_decode(P, it); ex_load(ia, lane, va); }
    while (it < end) {
        const int it2 = it + nw; const bool h2 = it2 < end;
        if (h2) { ib = ex_decode(P, it2); ex_load(ib, lane, vb); }
        ex_finish(ia, va, scr, lane);
        const int it3 = it2 + nw;
        if (it3 < end) { ia = ex_decode(P, it3); ex_load(ia, lane, va); }
        if (h2) ex_finish(ib, vb, scr, lane);
        it = it3;
    }
}
__device__ __forceinline__ void phase0(const Ptrs& P, LAS unsigned char* lds, int gw, int NGW, int wave, int lane) {
    LAS float* scr = (LAS float*)(lds + wave * 16640);
    bf16_t* win = (bf16_t*)(P.ws + WS_WIN); bf16_t* wuq = (bf16_t*)(P.ws + WS_WUQ); bf16_t* wukv = (bf16_t*)(P.ws + WS_WUKV); bf16_t* wmk = (bf16_t*)(P.ws + WS_WMK);
    bf16_t* wo = (bf16_t*)(P.ws + WS_WO); bf16_t* wout = (bf16_t*)(P.ws + WS_WOUT); bf16_t* wgu = (bf16_t*)(P.ws + WS_WGU); bf16_t* wd = (bf16_t*)(P.ws + WS_WD);
    constexpr int I_E = 16 * 16, I_IN = 16 * 91, I_UQ = 6 * 12, I_UKV = 4 * 16, I_MK = 16 * 16, I_O = 8 * 16, I_OUT = 16 * 16;
    constexpr int NITEMS = 3 * 16 * I_E + I_IN + I_UQ + I_UKV + I_MK + 3 * I_O + I_OUT;
    p0_expert_range<false>(P, lds, EX_DEFER, 3 * 16 * I_E - EX_DEFER, gw, NGW, wave, lane);
    for (int it = gw; it < NITEMS - 3 * 16 * I_E; it += NGW) {
        int r = it;
        if (r < I_IN) { const int kb = r / 91, n0 = (r % 91) * 64; HalfMap hm[2];
#pragma unroll
            for (int hh = 0; hh < 2; ++hh) { const int n = n0 + 32 * hh; hm[hh].valid = n < INC_; hm[hh].drow = n < 2208 ? n : n + 96; hm[hh].cs = n < 512 ? C_NA : ((n >= 2208 && n < 2720) ? C_MEM : 1.0f); hm[hh].rp = (n == 2176); }
            p0_item64<7>(PWIN(P), INC_, kb * 64, n0, win, 1024, hm[0], hm[1], 0, PGMIX(P), scr, lane); continue; } r -= I_IN;
        if (r < I_UQ) { const int kb = r / 12, nb = (r % 12) * 2, n0 = nb * 32;
            p0_item64<7>(PWUQ(P), 768, kb * 64, n0, wuq, 384, HalfMap{n0, C_MLA, (nb % 3) == 2, true}, HalfMap{n0 + 32, C_MLA, ((nb + 1) % 3) == 2, true}, 0, PQN(P), scr, lane); continue; } r -= I_UQ;
        if (r < I_UKV) { const int kb = r / 16, nb = (r % 16) * 2, n0 = nb * 32; const int hh = nb >> 2, part = nb & 3; const int dr = (part < 2) ? (hh * 64 + part * 32) : (512 + hh * 64 + (part - 2) * 32);
            p0_item64<7>(PWUKV(P), 1024, kb * 64, n0, wukv, 384, HalfMap{dr, 1.0f, false, true}, HalfMap{dr + 32, 1.0f, false, true}, 0, PKVN(P), scr, lane); continue; } r -= I_UKV;
        if (r < I_MK) { const int kb = r / 16, n0 = (r % 16) * 64; p0_item64<7>(PWMEMKV(P), 1024, kb * 64, n0, wmk, 1024, HalfMap{n0, 1.0f, false, true}, HalfMap{n0 + 32, 1.0f, false, true}, 0, PGMEM(P), scr, lane); continue; } r -= I_MK;
        if (r < 3 * I_O) { const int br = r / I_O, q = r % I_O, kb = q / 16, n0 = (q % 16) * 64; p0_item64<7>(P.in[11 + br], 1024, kb * 64, n0, wo, 1536, HalfMap{n0, 1.0f, false, true}, HalfMap{n0 + 32, 1.0f, false, true}, br * 512, nullptr, scr, lane); continue; } r -= 3 * I_O;
        { const int kb = r / 16, n0 = (r % 16) * 64; p0_item64<7>(PWOUT(P), 1024, kb * 64, n0, wout, 1024, HalfMap{n0, 1.0f, false, true}, HalfMap{n0 + 32, 1.0f, false, true}, 0, nullptr, scr, lane); }
    }
    for (int i = gw * 64 + lane; i < 12288; i += NGW * 64) ((u32x4*)(win + (size_t)2208 * 1024))[i] = (u32x4){0u, 0u, 0u, 0u};
    bf16_t* xb = XB_PTR(P); float* rstd_x = (float*)(P.ws + WS_RSTDX);
    if (XH_SPLIT && NGW == 2048) p0_rows<11, 0>(PX(P), xb, rstd_x, T_ / 2, gw, NGW, lane);
    else p0_rows<11>(PX(P), xb, rstd_x, T_, gw, NGW, lane);
    bf16_t* memb = (bf16_t*)(P.ws + WS_MEMB); float* rstd_m = (float*)(P.ws + WS_RSTDM);
    p0_rows<11>(PMEM(P), memb, rstd_m, 2048, gw, NGW, lane);
    if (gw == NGW - 1) { float* rope = (float*)(P.ws + WS_ROPE);
        for (int i = lane; i < 512; i += 64) { const int pos = i >> 3, fi = i & 7; const float inv = exp2f(-(float)fi * 1.6609640474436813f); const float ang = (float)pos * inv;
            float rev = ang * 0.15915494309189535f; rev -= floorf(rev); rope[2 * i] = __builtin_amdgcn_cosf(rev); rope[2 * i + 1] = __builtin_amdgcn_sinf(rev); } }
}

__device__ __forceinline__ void phase6(const Ptrs& P, LAS unsigned char* lds, int gw, int NGW, int lane) {
    LAS float* wrT = (LAS float*)lds;
    { f32x4 wv[8]; float gv[8];
#pragma unroll
      for (int k = 0; k < 8; ++k) { const int q = threadIdx.x + NTHREADS * k; wv[k] = ((const f32x4*)PWROUTER(P))[q]; gv[k] = PGFFN(P)[q >> 2]; }
#pragma unroll
      for (int k = 0; k < 8; ++k) { const int q = threadIdx.x + NTHREADS * k; const int d = q >> 2, e0 = (q & 3) * 4;
#pragma unroll
          for (int c = 0; c < 4; ++c) wrT[(e0 + c) * 1024 + d] = wv[k][c] * gv[k]; } }
    __syncthreads();
    const bf16_t* dbuf = (const bf16_t*)(P.ws + WS_H); bf16_t* hb = (bf16_t*)(P.ws + WS_HB); float* rstd_h = (float*)(P.ws + WS_RSTDH); float* aff = (float*)(P.ws + WS_AFF);
    const int b5 = (lane >> 5) & 1, b4 = (lane >> 4) & 1, b3 = (lane >> 3) & 1, b2 = (lane >> 2) & 1; const int e_me = 8 * b5 + 4 * b4 + 2 * b3 + b2;
    const float bias = PBROUTER(P)[e_me];
#if MK_XB_HB
    const bf16_t* xsrc = XB_PTR(P);
    u32x2 xn[4], dn[4];
    if (gw < T_) { const u32x2* xr = (const u32x2*)(xsrc + (size_t)gw * D_) + lane; const u32x2* dr = (const u32x2*)(dbuf + (size_t)gw * D_) + lane;
#else
    f32x4 xn[4]; u32x2 dn[4];
    if (gw < T_) { const f32x4* xr = (const f32x4*)(PX(P) + (size_t)gw * D_) + lane; const u32x2* dr = (const u32x2*)(dbuf + (size_t)gw * D_) + lane;
#endif
#pragma unroll
        for (int j = 0; j < 4; ++j) { xn[j] = ld_g<13>(xr + 64 * j); dn[j] = ld_g<13>(dr + 64 * j); } }
    for (int row = gw; row < T_; row += NGW) {
        asm volatile("" ::: "memory");
        f32x4 v[4]; float ss = 0.f;
#pragma unroll
        for (int j = 0; j < 4; ++j) {
#if MK_XB_HB
            v[j][0] = bflo(xn[j].x); v[j][1] = bfhi(xn[j].x); v[j][2] = bflo(xn[j].y); v[j][3] = bfhi(xn[j].y);
#else
            v[j] = xn[j];
#endif
            const u32x2 w = dn[j]; v[j][0] += bflo(w.x); v[j][1] += bfhi(w.x); v[j][2] += bflo(w.y); v[j][3] += bfhi(w.y);
            ss += (v[j][0] * v[j][0] + v[j][1] * v[j][1]) + (v[j][2] * v[j][2] + v[j][3] * v[j][3]); }
        { const int nrow = row + NGW; if (nrow < T_) {
#if MK_XB_HB
            const u32x2* xr = (const u32x2*)(xsrc + (size_t)nrow * D_) + lane;
#else
            const f32x4* xr = (const f32x4*)(PX(P) + (size_t)nrow * D_) + lane;
#endif
            const u32x2* dr = (const u32x2*)(dbuf + (size_t)nrow * D_) + lane;
#pragma unroll
            for (int j = 0; j < 4; ++j) { xn[j] = ld_g<13>(xr + 64 * j); dn[j] = ld_g<13>(dr + 64 * j); } } }
        u32x2* o8 = (u32x2*)(hb + (size_t)row * D_) + lane;
#pragma unroll
        for (int j = 0; j < 4; ++j) { u32x2 w; w.x = cvt_pk_bf16(v[j][0], v[j][1]); w.y = cvt_pk_bf16(v[j][2], v[j][3]); st_g<8>(o8 + 64 * j, w); }
        float a[16];
#pragma unroll
        for (int e = 0; e < 16; ++e) { float s = 0.f;
#pragma unroll
            for (int j = 0; j < 4; ++j) { const f32x4 w = *(const LAS f32x4*)(wrT + e * 1024 + 4 * lane + 256 * j); s += (v[j][0] * w[0] + v[j][1] * w[1]) + (v[j][2] * w[2] + v[j][3] * w[3]); }
            asm volatile("" : "+v"(s) :: "memory"); a[e] = s; }
        ss = wave_sum(ss); const float rstd = rsqrtf(ss * (1.0f / 1024.0f) + EPS_);
        if (lane == 0) rstd_h[row] = rstd;
        float a8[8], a4[4], a2[2], a1;
#pragma unroll
        for (int k = 0; k < 8; ++k) { const float send = b5 ? a[k] : a[k + 8]; const float recv = __shfl_xor(send, 32); a8[k] = (b5 ? a[k + 8] : a[k]) + recv; }
#pragma unroll
        for (int k = 0; k < 4; ++k) { const float send = b4 ? a8[k] : a8[k + 4]; const float recv = __shfl_xor(send, 16); a4[k] = (b4 ? a8[k + 4] : a8[k]) + recv; }
#pragma unroll
        for (int k = 0; k < 2; ++k) { const float send = b3 ? a4[k] : a4[k + 2]; const float recv = __shfl_xor(send, 8); a2[k] = (b3 ? a4[k + 2] : a4[k]) + recv; }
        { const float send = b2 ? a2[0] : a2[1]; const float recv = __shfl_xor(send, 4); a1 = (b2 ? a2[1] : a2[0]) + recv; }
        a1 += __shfl_xor(a1, 2); a1 += __shfl_xor(a1, 1);
        const float logit = a1 * rstd + bias;
        float mx = logit; mx = fmaxf(mx, __shfl_xor(mx, 4)); mx = fmaxf(mx, __shfl_xor(mx, 8)); mx = fmaxf(mx, __shfl_xor(mx, 16)); mx = fmaxf(mx, __shfl_xor(mx, 32));
        const float pe = expf(logit - mx); float sm = pe; sm += __shfl_xor(sm, 4); sm += __shfl_xor(sm, 8); sm += __shfl_xor(sm, 16); sm += __shfl_xor(sm, 32);
        if ((lane & 3) == 0) aff[(size_t)row * 16 + e_me] = pe / sm;
    }
    __syncthreads();
}

__device__ __forceinline__ void phase7(const Ptrs& P, LAS unsigned char* lds, int G) {
    LAS unsigned* keys = (LAS unsigned*)lds;
    LAS unsigned* hist = keys + 4096;
    LAS unsigned* misc = hist + 256;
    LAS int* tokl = (LAS int*)(misc + 32);
    int tid_ = threadIdx.x; asm volatile("" : "+v"(tid_));
    const int tid = tid_, lane = tid & 63, wid = tid >> 6;
    const float* aff = (const float*)(P.ws + WS_AFF); int* idx = (int*)(P.ws + WS_IDX); float* gsel = (float*)(P.ws + WS_GSEL); int* sel = (int*)(P.ws + WS_SEL);
    const bf16_t* hb = (const bf16_t*)(P.ws + WS_HB); bf16_t* xs = (bf16_t*)(P.ws + WS_XS); const float* rstd_h = (const float*)(P.ws + WS_RSTDH); float* rstd_xs = (float*)(P.ws + WS_RSTDXS);
    for (int task = blockIdx.x; task < 128; task += G) {
        const int b = task >> 4, e = task & 15;
        { float kvv[8];
#pragma unroll
          for (int k = 0; k < 8; ++k) kvv[k] = aff[((size_t)b * S_ + tid + NTHREADS * k) * 16 + e];
#pragma unroll
          for (int k = 0; k < 8; ++k) keys[tid + NTHREADS * k] = __float_as_uint(kvv[k]); }
        if (tid == 0) { misc[0] = 0u; misc[1] = 512u; }
        __syncthreads();
        for (int shift = 24; shift >= 0; shift -= 8) {
            if (tid < 256) hist[tid] = 0u;
            __syncthreads();
            const unsigned prefix = misc[0];
#pragma unroll
            for (int j = 0; j < 8; ++j) { const unsigned k = keys[tid * 8 + j]; if (shift == 24 || (k >> (shift + 8)) == prefix) __hip_atomic_fetch_add(&hist[(k >> shift) & 255u], 1u, __ATOMIC_RELAXED, __HIP_MEMORY_SCOPE_WORKGROUP); }
            __syncthreads();
            if (wid == 0) {
                const unsigned kk = misc[1];
                const unsigned h0 = hist[4 * lane], h1 = hist[4 * lane + 1], h2 = hist[4 * lane + 2], h3 = hist[4 * lane + 3];
                const unsigned s = h0 + h1 + h2 + h3;
                unsigned incl = s;
#pragma unroll
                for (int o = 1; o < 64; o <<= 1) { const unsigned t = __shfl_down(incl, o); if (lane + o < 64) incl += t; }
                const unsigned excl = incl - s;
                if (excl < kk && kk <= incl) {
                    unsigned rem = kk - excl; unsigned bin;
                    if (rem <= h3) { bin = 3; } else { rem -= h3; if (rem <= h2) { bin = 2; } else { rem -= h2; if (rem <= h1) { bin = 1; } else { rem -= h1; bin = 0; } } }
                    misc[0] = (prefix << 8) | (unsigned)(4 * lane + bin); misc[1] = rem;
                }
            }
            __syncthreads();
        }
        const unsigned thr = misc[0], kk = misc[1];
        unsigned kv[8]; unsigned cg_ = 0, ce = 0;
#pragma unroll
        for (int j = 0; j < 8; ++j) { kv[j] = keys[tid * 8 + j]; cg_ += kv[j] > thr ? 1u : 0u; ce += kv[j] == thr ? 1u : 0u; }
        unsigned ig = cg_, ie = ce;
#pragma unroll
        for (int o = 1; o < 64; o <<= 1) { const unsigned tg = __shfl_up(ig, o), te = __shfl_up(ie, o); if (lane >= o) { ig += tg; ie += te; } }
        if (lane == 63) { misc[8 + wid] = ig; misc[16 + wid] = ie; }
        __syncthreads();
        unsigned bg = ig - cg_, be = ie - ce;
        for (int w = 0; w < wid; ++w) { bg += misc[8 + w]; be += misc[16 + w]; }
#pragma unroll
        for (int j = 0; j < 8; ++j) { const int t = tid * 8 + j; const bool isg = kv[j] > thr, ise = kv[j] == thr; const bool s_ = isg || (ise && be < kk);
            const unsigned slot = bg + (be < kk ? be : kk);
            if (s_) { idx[task * 512 + slot] = t; gsel[task * 512 + slot] = __uint_as_float(kv[j]); tokl[slot] = t; }
            sel[((size_t)b * S_ + t) * 16 + e] = s_ ? (int)slot : -1;
            bg += isg ? 1u : 0u; be += ise ? 1u : 0u; }
        __syncthreads();
        { const int t = tokl[tid]; rstd_xs[(size_t)task * 512 + tid] = rstd_h[(size_t)b * S_ + t]; }
        __syncthreads();
    }
}

__device__ __forceinline__ void phase10(const Ptrs& P, int gw, int NGW, int lane) {
    const bf16_t* hbb = (const bf16_t*)(P.ws + WS_HB); const bf16_t* ybuf = (const bf16_t*)(P.ws + WS_XS); const int* sel = (const int*)(P.ws + WS_SEL);
    f32x4 gf[4];
#pragma unroll
    for (int j = 0; j < 4; ++j) gf[j] = ((const f32x4*)PGFINAL(P))[lane + 64 * j];
    u32x2 hw[4]; int sv = -1;
    if (gw < T_) { const u32x2* hr = (const u32x2*)(hbb + (size_t)gw * D_) + lane;
#pragma unroll
        for (int j = 0; j < 4; ++j) hw[j] = ld_g<14>(hr + 64 * j);
        sv = sel[(size_t)gw * 16 + (lane & 15)]; }
    for (int row = gw; row < T_; row += NGW) {
        f32x4 v[4];
#pragma unroll
        for (int j = 0; j < 4; ++j) { v[j][0] = bflo(hw[j].x); v[j][1] = bfhi(hw[j].x); v[j][2] = bflo(hw[j].y); v[j][3] = bfhi(hw[j].y); }
        const int svc = sv; const int b = row >> 12;
        unsigned mask = (unsigned)(__ballot(svc >= 0) & 0xffffull);
        const int nrow = row + NGW;
        if (nrow < T_) { const u32x2* hr = (const u32x2*)(hbb + (size_t)nrow * D_) + lane;
#pragma unroll
            for (int j = 0; j < 4; ++j) hw[j] = ld_g<14>(hr + 64 * j);
            sv = sel[(size_t)nrow * 16 + (lane & 15)]; }
        while (mask) {
            const int e0 = __builtin_ctz(mask); mask &= mask - 1u; const bool two = mask != 0u; const int e1 = two ? __builtin_ctz(mask) : e0; if (two) mask &= mask - 1u;
            const int s0 = __builtin_amdgcn_readlane(svc, e0), s1 = __builtin_amdgcn_readlane(svc, e1);
            const u32x2* y0 = (const u32x2*)(ybuf + ((size_t)(b * 16 + e0) * 512 + s0) * D_) + lane; const u32x2* y1 = (const u32x2*)(ybuf + ((size_t)(b * 16 + e1) * 512 + s1) * D_) + lane;
            u32x2 w0[4], w1[4];
#pragma unroll
            for (int j = 0; j < 4; ++j) { w0[j] = ld_g<14>(y0 + 64 * j); w1[j] = ld_g<14>(y1 + 64 * j); }
            const float f1 = two ? 1.0f : 0.0f;
#pragma unroll
            for (int j = 0; j < 4; ++j) { v[j][0] += bflo(w0[j].x) + f1 * bflo(w1[j].x); v[j][1] += bfhi(w0[j].x) + f1 * bfhi(w1[j].x); v[j][2] += bflo(w0[j].y) + f1 * bflo(w1[j].y); v[j][3] += bfhi(w0[j].y) + f1 * bfhi(w1[j].y); }
        }
        float ss = 0.f;
#pragma unroll
        for (int j = 0; j < 4; ++j) ss += (v[j][0] * v[j][0] + v[j][1] * v[j][1]) + (v[j][2] * v[j][2] + v[j][3] * v[j][3]);
        ss = wave_sum(ss); const float rs = rsqrtf(ss * (1.0f / 1024.0f) + EPS_);
        f32x4* orow = (f32x4*)(P.out + (size_t)row * D_) + lane;
#pragma unroll
        for (int j = 0; j < 4; ++j) st_g<9>(orow + 64 * j, v[j] * rs * gf[j]);
    }
}

#ifndef MK_LAUNCHES
#define MK_LAUNCHES 1
#endif
constexpr int NPHASES = 11;

__global__ void __launch_bounds__(NTHREADS, 2) mk_fwd(Args args) {
    extern __shared__ __attribute__((aligned(16))) unsigned char lds_raw[];
    LAS unsigned char* lds = (LAS unsigned char*)lds_raw;
    cg::grid_group grid = cg::this_grid();
    const int tid = threadIdx.x, lane = tid & 63; const int wave = __builtin_amdgcn_readfirstlane(tid >> 6);
    const int G = gridDim.x; int bx = blockIdx.x; int vcu = (G % 8 == 0) ? (bx % 8) * (G / 8) + bx / 8 : bx;
    int gw = vcu * 8 + wave; const int NGW = G * 8;
    const Args& P = args;
    unsigned char* ws = args.ws; unsigned char* dob = (unsigned char*)args.out;
    const int lo = args.ph_lo, hi = args.ph_hi;
    volatile LAS unsigned* xst = (volatile LAS unsigned*)(lds + LDS_BYTES - 16);
    if (tid < 12) ((volatile LAS unsigned*)(lds + LDS_BYTES - 48))[tid] = 0u;
    __syncthreads();
    XcdBarrier xbar; xbar.bar = (unsigned*)(args.ws + WS_CTL); xbar.x = 0; xbar.st = xst;
    if (args.coop) xbar = xcd_barrier_post((unsigned*)(args.ws + WS_CTL), xst);
#ifndef MK_ONLY
#define MK_ONLY -1
#endif
#define IN(k) ((MK_ONLY < 0 || MK_ONLY == (k)) && lo <= (k) && (k) < hi)
#ifndef MK_REPEAT
#define MK_REPEAT -1
#endif
#define REPS(k) ((MK_REPEAT == (k)) ? 2 : 1)
#ifndef MLA_CALL
#define MLA_CALL att::attn_unit_mla3<0>(lds, A, bh >> 3, bh & 7, U & 15)
#endif
#ifndef ATT_MEM_CALL
#define ATT_MEM_CALL att::attn_unit<128, 128, 1, false>(lds, A, bh >> 2, bh & 3, U & 15)
#endif
#ifndef NA_NS
#define NA_NS na3
#endif
#ifndef MK_NA_V1
#define MK_NA_V1 0
#endif
#ifndef MK_CG_SEAMS
#define MK_CG_SEAMS 0
#endif
#define SEAM(k) do { if (IN(k) && IN((k) + 1)) { if ((k) < MK_CG_SEAMS) grid.sync(); else xcd_barrier(xbar); } } while (0)

    if (args.pad == 0x5eed) grid.sync();
    if (IN(0)) for (int rep = 0; rep < REPS(0); ++rep) { if (rep) xcd_barrier(xbar); phase0(P, lds, gw, NGW, wave, lane); }
    SEAM(0);
#ifndef MK_XCC_ORDER
#define MK_XCC_ORDER 0
#endif
    if (MK_XCC_ORDER && args.coop && lo == 0 && hi > 1 && (G % 8) == 0) {
        if (tid == 0) { unsigned* bar = (unsigned*)(args.ws + WS_CTL); bool ok = true;
#pragma unroll
            for (unsigned j = 0; j < 16; ++j) { const unsigned c = xb_ld(&bar[XB_XCNT(j)]); ok = ok && (c == (j < 8 ? (unsigned)(G / 8) : 0u)); }
            ((volatile LAS unsigned*)(lds + LDS_BYTES - 32))[0] = ok ? 1u : 0u; }
        __syncthreads();
        if (((volatile LAS unsigned*)(lds + LDS_BYTES - 32))[0]) { bx = (int)(xst[2] * 8u + xst[3]); vcu = (bx % 8) * (G / 8) + bx / 8; gw = vcu * 8 + wave; }
        __syncthreads();
    }
    if (IN(1)) for (int rep = 0; rep < REPS(1); ++rep) { if (rep) xcd_barrier(xbar);
        SchedP1 S{bx, G, (const char*)XB_PTR(P), (const char*)(ws + WS_WIN), (const char*)(ws + WS_MEMB), (const char*)(ws + WS_WMK)};
        EpiP1 E{(const float*)(ws + WS_RSTDX), (const float*)(ws + WS_RSTDM), (bf16_t*)(ws + WS_NA), (bf16_t*)(ws + WS_ZC), (bf16_t*)(ws + WS_ZQM), (bf16_t*)(ws + WS_ZG), (bf16_t*)(ws + WS_KVMEM),
                (bf16_t*)(dob + DO_KPE), (float*)(ws + WS_SSQQ), (float*)(ws + WS_SSQKV), (const float*)(ws + WS_ROPE),
                (unsigned*)(ws + WS_CTL) + XH_FLAG, (XH_SPLIT && G == 256) ? 96u : 0u,
                __builtin_amdgcn_make_buffer_rsrc((void*)ws, (short)0, (int)WS_END, 0x00020000), (const char*)ws};
#ifndef MK_P1_SKEW
#define MK_P1_SKEW 1300
#endif
        if (XH_SPLIT && G == 256) {
            if (bx >= 160) {
                p0_rows<11, 1>(PX(P), XB_PTR(P), (float*)(ws + WS_RSTDX), T_ / 2, (bx - 160) * 8 + wave, 768, lane);
                asm volatile("s_waitcnt vmcnt(0)" ::: "memory");
                __syncthreads();
                if (tid == 0) { __builtin_amdgcn_fence(__ATOMIC_RELEASE, "agent"); __hip_atomic_fetch_add((unsigned*)(ws + WS_CTL) + XH_FLAG, 1u, __ATOMIC_RELAXED, __HIP_MEMORY_SCOPE_AGENT); }
            }
        }
        else if (EX_N1A > 0 && G == 256) { if (bx >= 160) p0_expert_range(P, lds, 0, EX_N1A, (bx - 160) * 8 + wave, 768, wave, lane); __syncthreads(); }
        else if (MK_P1_SKEW > 0 && G == 256) {
            const unsigned long long dly = (bx >= 160) ? (unsigned long long)MK_P1_SKEW : 0ull;
            const unsigned long long t0 = __builtin_amdgcn_s_memrealtime();
            while (__builtin_amdgcn_s_memrealtime() - t0 < dly) __builtin_amdgcn_s_sleep(32);
        }
        pg8::gemm_phase<EpiP1, SchedP1, false>(lds, 1024, 1024, S, E);
        if (EX_DEFER > 0) { if (G == 256) { if (bx >= 160) p0_expert_range(P, lds, EX_N1A, EX_N1, (bx - 160) * 8 + wave, 768, wave, lane); }
                            else p0_expert_range(P, lds, 0, EX_TAILS, gw, NGW, wave, lane); }
    }
    SEAM(1);
    if (IN(2)) for (int rep = 0; rep < REPS(2); ++rep) { if (rep) xcd_barrier(xbar);
        SchedP2 S{bx, G, (const char*)(ws + WS_ZC), (const char*)(ws + WS_WUQ), (const char*)(ws + WS_WUKV)};
        EpiP2 E{(const float*)(ws + WS_SSQQ), (const float*)(ws + WS_SSQKV), (bf16_t*)(dob + DO_QMLA), (bf16_t*)(dob + DO_KVBUF), (const float*)(ws + WS_ROPE)};
        pg8::gemm_phase<EpiP2, SchedP2, false>(lds, 768, 384, S, E);
        if (EX_N2 > 0 && G == 256 && bx >= 128) p0_expert_range(P, lds, EX_N1A + EX_N1, EX_N2, (bx - 128) * 8 + wave, 1024, wave, lane);
    }
    SEAM(2);
#ifndef EX_SLOTS
#define EX_SLOTS 7
#endif
#define EX_P3_RUN do { p0_expert_range(P, lds, EX_TAILS, EX_NP3, vcu * 8 + wave, G * 8, wave, lane); __syncthreads(); exdone_ = true; } while (0)
    if (IN(3)) {
        bool exdone_ = true;
#ifdef MK_ABL
        { att::AttnArgs A{(const bf16_t*)(dob + DO_QMLA), (const bf16_t*)(dob + DO_KVBUF), (const bf16_t*)(dob + DO_KPE), (const bf16_t*)(dob + DO_KVBUF) + 512, (bf16_t*)(ws + WS_ZC), nullptr};
          for (int U = vcu; U < 1024; U += G) { const int bh = U >> 4; att::attn_unit_mla3<MK_ABL>(lds, A, bh >> 3, bh & 7, U & 15); } xcd_barrier(xbar); }
#endif
        { att::AttnArgs A{(const bf16_t*)(dob + DO_QMLA), (const bf16_t*)(dob + DO_KVBUF), (const bf16_t*)(dob + DO_KPE), (const bf16_t*)(dob + DO_KVBUF) + 512, (bf16_t*)(ws + WS_ZC), nullptr};
          for (int rep = 0; rep < REPS(30); ++rep) { if (rep) xcd_barrier(xbar);
          int it_ = 0; const int slot_ = vcu % EX_SLOTS; exdone_ = (EX_NP3 == 0) || rep > 0;
          for (int U = vcu; U < 1024; U += G, ++it_) {
              if (!exdone_ && it_ == slot_) { EX_P3_RUN; }
              const int bh = U >> 4; MLA_CALL; }
          if (!exdone_ && slot_ <= 4) { EX_P3_RUN; } } }
        NA_NS::na_phase(lds, (const bf16_t*)(ws + WS_NA), (const bf16_t*)(ws + WS_NA) + (size_t)T_ * 512, (const bf16_t*)(ws + WS_NA) + (size_t)2 * T_ * 512, (bf16_t*)(ws + WS_NA), args.in[4], vcu, G, -1);
        if (!exdone_ && (vcu % EX_SLOTS) == 5) { EX_P3_RUN; }
        { att::AttnArgs A{(const bf16_t*)(ws + WS_ZQM), (const bf16_t*)(ws + WS_KVMEM), nullptr, (const bf16_t*)(ws + WS_KVMEM) + 512, (bf16_t*)(ws + WS_ZQM), nullptr};
          for (int U = vcu; U < 512; U += G) { const int bh = U >> 4; ATT_MEM_CALL; } }
        if (!exdone_) { EX_P3_RUN; }
    }
    SEAM(3);
    if (IN(4)) for (int rep = 0; rep < REPS(4); ++rep) { if (rep) xcd_barrier(xbar);
        SchedP4 S{bx, G, (const char*)(ws + WS_NA), (const char*)(ws + WS_ZC), (const char*)(ws + WS_ZQM), (const char*)(ws + WS_WO)};
#ifndef MK_P4_NOHOOK
#define MK_P4_NOHOOK 0
#endif
        EpiP4 E{(const bf16_t*)(ws + WS_ZG), (bf16_t*)(dob + DO_MERGED), (MK_P4_NOHOOK && REPS(4) == 2 && rep == 0) ? 1 : 0};
#ifndef MK_P4_SKEW
#define MK_P4_SKEW 0
#endif
        if (MK_P4_SKEW > 0) {
            const unsigned long long dly = (bx & 8) ? (unsigned long long)MK_P4_SKEW : 0ull;
            const unsigned long long t0 = __builtin_amdgcn_s_memrealtime();
            while (__builtin_amdgcn_s_memrealtime() - t0 < dly) __builtin_amdgcn_s_sleep(32);
        }
        pg8::gemm_phase<EpiP4, SchedP4, true>(lds, 512, 1536, S, E);
    }
    SEAM(4);
    if (IN(5)) for (int rep = 0; rep < REPS(5); ++rep) { if (rep) xcd_barrier(xbar);
        SchedP5 S{bx, G, (const char*)(dob + DO_MERGED), (const char*)(ws + WS_WOUT)};
        EpiP5 E{(bf16_t*)(ws + WS_H)};
        pg8::gemm_phase<EpiP5, SchedP5, false>(lds, 1024, 1024, S, E);
    }
    SEAM(5);
    if (IN(6)) for (int rep = 0; rep < REPS(6); ++rep) { if (rep) xcd_barrier(xbar); phase6(P, lds, gw, NGW, lane); }
    SEAM(6);
    if (IN(7)) for (int rep = 0; rep < REPS(7); ++rep) { if (rep) xcd_barrier(xbar); phase7(P, lds, G);
        if (EX_N3 > 0 && G == 256 && (int)blockIdx.x >= 128) p0_expert_range(P, lds, EX_N1A + EX_N1 + EX_N2, EX_N3, ((int)blockIdx.x - 128) * 8 + wave, 1024, wave, lane); }
    SEAM(7);
    if (IN(8)) for (int rep = 0; rep < REPS(8); ++rep) { if (rep) xcd_barrier(xbar);
        SchedP8 S{bx, G, (const char*)(ws + WS_HB), (const char*)(ws + WS_WGU)};
        EpiP8 E{(const float*)(ws + WS_RSTDXS), (bf16_t*)(dob + DO_ACT)};
        LAS int* gtab = (LAS int*)(lds + pg8::STAGE_BYTES);
        { const int* idxg = (const int*)(ws + WS_IDX); pg8::Unit u_; int rowv[8], tokv[8];
#pragma unroll
          for (int i = 0; i < 8; ++i) { rowv[i] = S.next(i, u_) ? u_.pm * 256 + (tid & 255) : -1; }
#pragma unroll
          for (int i = 0; i < 8; ++i) tokv[i] = (rowv[i] >= 0) ? idxg[rowv[i]] : 0;
#pragma unroll
          for (int i = 0; i < 8; ++i) if (rowv[i] >= 0 && tid < 256) gtab[i * 256 + tid] = tokv[i] + (rowv[i] >> 13) * S_;
          __syncthreads(); }
        pg8::gemm_phase<EpiP8, SchedP8, false, true>(lds, 1024, 1024, S, E, gtab);
    }
    SEAM(8);
    if (IN(9)) for (int rep = 0; rep < REPS(9); ++rep) { if (rep) xcd_barrier(xbar);
        SchedP9 S{bx, G, (const char*)(dob + DO_ACT), (const char*)(ws + WS_WD)};
        EpiP9 E{(const float*)(ws + WS_GSEL), (bf16_t*)(ws + WS_XS)};
        pg8::gemm_phase<EpiP9, SchedP9, false>(lds, 1024, 1024, S, E);
    }
    SEAM(9);
    if (IN(10)) for (int rep = 0; rep < REPS(10); ++rep) { if (rep) xcd_barrier(xbar); phase10(P, gw, NGW, lane); }
#undef IN
#undef SEAM
}

extern "C" void kernel_launch(void* const* d_in, const int* in_sizes, int n_in, void* d_out, int out_size, void* d_ws, size_t ws_size, hipStream_t stream) {
    static int grid = 0;
    if (grid == 0) {
        if (n_in != 22 || out_size != T_ * D_ || ws_size < WS_END) { fprintf(stderr, "kernel_launch: unexpected shapes (n_in %d out %d ws %zu)\n", n_in, out_size, ws_size); grid = -1; return; }
        int dev = 0, cus = 0, per_cu = 0;
        hipGetDevice(&dev); hipDeviceGetAttribute(&cus, hipDeviceAttributeMultiprocessorCount, dev);
        if (hipFuncSetAttribute((const void*)mk_fwd, hipFuncAttributeMaxDynamicSharedMemorySize, LDS_BYTES) != hipSuccess) { fprintf(stderr, "kernel_launch: hipFuncSetAttribute failed\n"); grid = -1; return; }
        hipOccupancyMaxActiveBlocksPerMultiprocessor(&per_cu, (const void*)mk_fwd, NTHREADS, LDS_BYTES);
        (void)hipGetLastError();
        if (per_cu < 1) { fprintf(stderr, "kernel_launch: occupancy query says %d blocks per CU\n", per_cu); per_cu = 1; }
        grid = cus * 1;
        fprintf(stderr, "kernel_launch: cus %d per_cu %d grid %d ws %zu\n", cus, per_cu, grid, ws_size);
    }
    if (grid < 0) return;
    if (hipMemsetAsync((char*)d_ws + WS_CTL, 0, CTL_BYTES, stream) != hipSuccess) { fprintf(stderr, "kernel_launch: memset failed\n"); return; }
    Args a{};
    for (int i = 0; i < 22; ++i) a.in[i] = (const float*)d_in[i];
    a.out = (float*)d_out; a.ws = (unsigned char*)d_ws;
#if MK_LAUNCHES == 1
    a.ph_lo = 0; a.ph_hi = NPHASES; a.coop = 1;
    void* kargs[] = {&a};
    hipError_t e = hipLaunchCooperativeKernel((const void*)mk_fwd, dim3(grid), dim3(NTHREADS), kargs, LDS_BYTES, stream);
    if (e != hipSuccess) fprintf(stderr, "kernel_launch: cooperative launch failed: %s (grid %d)\n", hipGetErrorString(e), grid);
#else
    for (int p = 0; p < NPHASES; ++p) { a.ph_lo = p; a.ph_hi = p + 1; a.coop = 0; hipLaunchKernelGGL(mk_fwd, dim3(grid), dim3(NTHREADS), LDS_BYTES, stream, a); }
#endif
}
```
